# Optimizing an MI355X kernel written in HIP

```python
import math
import jax
import jax.numpy as jnp
from jax import lax
import numpy as np

D_MODEL = 1024
BATCH = 4
SEQ = 8192
DEPTH = 4

HEAD_DIM = 64
N_HEADS_TOTAL = D_MODEL // HEAD_DIM
N_MEM_HEADS = 4
N_SELF_HEADS = N_HEADS_TOTAL - N_MEM_HEADS
SELF_WIDTH = N_SELF_HEADS * HEAD_DIM
MEM_WIDTH = N_MEM_HEADS * HEAD_DIM
IN_COLS = 3 * SELF_WIDTH + MEM_WIDTH
N_MEM = 256
N_MIXERS = 2
N_MOBA_LAYERS = (DEPTH + 1) // 2
N_FOX_LAYERS = DEPTH // 2
MOBA_BLOCK = 256
MOBA_TOPK = 3
MOBA_Q_CHUNK = 16
FOX_Q_BLOCK = 128
FOX_GATE_BIAS_INIT = 2.0
N_EXPERTS = 32
TOP_K = 4
D_FF = D_MODEL
SWIGLU_LIMIT = 7.0
SWIGLU_ALPHA = 1.702
MOE_BLOCK = 512
DEEPNORM_ALPHA = (2 * DEPTH) ** 0.25
DEEPNORM_BETA = (8 * DEPTH) ** -0.25
LN_EPS = 1e-5

kernel_name = 'hybrid_moba_fox_memxattn_moe_deepnorm'


def _alibi_slopes(n):
    def pow2(m):
        start = 2.0 ** (-(2.0 ** -(math.log2(m) - 3)))
        return [start * start ** i for i in range(m)]
    if math.log2(n).is_integer():
        s = pow2(n)
    else:
        c = 2 ** math.floor(math.log2(n))
        s = pow2(c) + pow2(2 * c)[0::2][: n - c]
    return jnp.asarray(np.array(s, dtype=np.float32))


def layer_norm(x, g, b):
    xf = x.astype(jnp.float32)
    mu = jnp.mean(xf, axis=-1, keepdims=True)
    var = jnp.mean(jnp.square(xf - mu), axis=-1, keepdims=True)
    y = (xf - mu) * lax.rsqrt(var + LN_EPS) * g.astype(jnp.float32) + b.astype(jnp.float32)
    return y.astype(x.dtype)


def split_heads(t, n):
    b, s, _ = t.shape
    return t.reshape(b, s, n, HEAD_DIM).transpose(0, 2, 1, 3)


def moba_attention(q, k, v):
    B, H, T, dh = q.shape
    L = MOBA_BLOCK
    nb = -(-T // L)
    tp = nb * L
    pad = ((0, 0), (0, 0), (0, tp - T), (0, 0))
    q = jnp.pad(q, pad)
    k = jnp.pad(k, pad)
    v = jnp.pad(v, pad)
    kb = k.reshape(B, H, nb, L, dh)
    vb = v.reshape(B, H, nb, L, dh)
    kbar = jnp.mean(kb.astype(jnp.float32), axis=3)
    tpos = jnp.arange(tp)
    qblk = tpos // L
    gate = jnp.einsum('bhtd,bhnd->bhtn', q.astype(jnp.float32), kbar)
    past = jnp.arange(nb)[None, :] < qblk[:, None]
    gate = jnp.where(past, gate, -jnp.inf)
    ks = min(MOBA_TOPK, nb)
    _, sel = lax.top_k(gate, ks)
    sel_ok = sel < qblk[:, None]
    slopes = _alibi_slopes(H)[None, :, None, None]
    scale = dh ** -0.5
    gather = jax.vmap(jax.vmap(lambda blocks, ids: blocks[ids]))
    offs = jnp.arange(L)
    QC = MOBA_Q_CHUNK

    def chunk(i):
        t0 = i * QC
        qc = lax.dynamic_slice_in_dim(q, t0, QC, axis=2)
        tq = t0 + jnp.arange(QC)
        own = t0 // L
        k_own = lax.dynamic_index_in_dim(kb, own, axis=2, keepdims=False)
        v_own = lax.dynamic_index_in_dim(vb, own, axis=2, keepdims=False)
        ids = lax.dynamic_slice_in_dim(sel, t0, QC, axis=2)
        ok = lax.dynamic_slice_in_dim(sel_ok, t0, QC, axis=2)
        k_sel = gather(kb, ids)
        v_sel = gather(vb, ids)
        d_own = tq[:, None] - (own * L + offs)[None, :]
        s_own = jnp.einsum('bhqd,bhkd->bhqk', qc, k_own, preferred_element_type=jnp.float32) * scale
        s_own = jnp.where(d_own >= 0, s_own - slopes * d_own.astype(jnp.float32), -jnp.inf)
        d_sel = tq[None, None, :, None, None] - (ids[..., None] * L + offs)
        s_sel = jnp.einsum('bhqd,bhqjkd->bhqjk', qc, k_sel, preferred_element_type=jnp.float32) * scale
        s_sel = jnp.where(ok[..., None], s_sel - slopes[..., None] * d_sel.astype(jnp.float32), -jnp.inf)
        s = jnp.concatenate([s_own, s_sel.reshape(B, H, QC, ks * L)], axis=-1)
        p = jax.nn.softmax(s, axis=-1).astype(v.dtype)
        p_own = p[..., :L]
        p_sel = p[..., L:].reshape(B, H, QC, ks, L)
        return (jnp.einsum('bhqk,bhkd->bhqd', p_own, v_own)
                + jnp.einsum('bhqjk,bhqjkd->bhqd', p_sel, v_sel))

    out = lax.map(chunk, jnp.arange(tp // QC))
    out = out.transpose(1, 2, 0, 3, 4).reshape(B, H, tp, dh)
    return out[:, :, :T]


def fox_attention(q, k, v, fg_logit):
    B, H, T, dh = q.shape
    c = jnp.cumsum(jax.nn.log_sigmoid(fg_logit.astype(jnp.float32)), axis=-1)
    scale = dh ** -0.5
    kpos = jnp.arange(T)
    QB = FOX_Q_BLOCK

    def block(i):
        t0 = i * QB
        qb = lax.dynamic_slice_in_dim(q, t0, QB, axis=2)
        cq = lax.dynamic_slice_in_dim(c, t0, QB, axis=2)
        tq = t0 + jnp.arange(QB)
        s = jnp.einsum('bhqd,bhkd->bhqk', qb, k, preferred_element_type=jnp.float32) * scale
        s = s + (cq[..., None] - c[:, :, None, :])
        s = jnp.where(kpos[None, :] <= tq[:, None], s, -jnp.inf)
        p = jax.nn.softmax(s, axis=-1).astype(v.dtype)
        return jnp.einsum('bhqk,bhkd->bhqd', p, v)

    out = lax.map(block, jnp.arange(T // QB))
    return out.transpose(1, 2, 0, 3, 4).reshape(B, H, T, dh)


def memory_attention(q, mk, mv):
    s = jnp.einsum('bhqd,bhmd->bhqm', q, mk, preferred_element_type=jnp.float32) * (HEAD_DIM ** -0.5)
    p = jax.nn.softmax(s, axis=-1).astype(mv.dtype)
    return jnp.einsum('bhqm,bhmd->bhqd', p, mv)


def moe(h, router_w, router_b, w_gu, b_gu, w_dn, b_dn):
    B, T, D = h.shape
    N = B * T
    xt = h.reshape(N, D)
    logits = (xt @ router_w).astype(jnp.float32) + router_b.astype(jnp.float32)
    top_v, top_i = lax.top_k(logits, TOP_K)
    gates = jax.nn.softmax(top_v, axis=-1)
    A = N * TOP_K
    flat_e = top_i.reshape(A)
    flat_tok = jnp.repeat(jnp.arange(N), TOP_K)
    order = jnp.argsort(flat_e)
    nblk = A // MOE_BLOCK
    se_blk = flat_e[order].reshape(nblk, MOE_BLOCK)
    stok_blk = flat_tok[order].reshape(nblk, MOE_BLOCK)
    sg_blk = gates.reshape(A)[order].reshape(nblk, MOE_BLOCK)
    e_first = se_blk[:, 0]
    e_last = se_blk[:, -1]
    cnt = e_last - e_first + 1
    ends = jnp.cumsum(cnt)
    starts = ends - cnt
    n_items = nblk + N_EXPERTS - 1
    it = jnp.arange(n_items)
    item_ok = it < ends[-1]
    item_blk = jnp.minimum(jnp.searchsorted(ends, it, side='right'), nblk - 1)
    item_e = jnp.clip(e_first[item_blk] + it - starts[item_blk], 0, N_EXPERTS - 1)

    def run(args):
        b, e, ok = args
        xb = xt[stok_blk[b]]
        gu = xb @ w_gu[e] + b_gu[e]
        g = jnp.minimum(gu[:, :D_FF], SWIGLU_LIMIT)
        u = jnp.clip(gu[:, D_FF:], -SWIGLU_LIMIT, SWIGLU_LIMIT)
        a = g * jax.nn.sigmoid(SWIGLU_ALPHA * g) * (u + 1)
        y = a @ w_dn[e] + b_dn[e]
        wt = jnp.where((se_blk[b] == e) & ok, sg_blk[b], 0.0)
        return y * wt.astype(y.dtype)[:, None]

    ys = lax.map(run, (item_blk, item_e, item_ok))
    out = jnp.zeros((N, D), ys.dtype).at[stok_blk[item_blk].reshape(-1)].add(ys.reshape(-1, D))
    return out.reshape(B, T, D)


def setup_inputs(seed: int = 0) -> dict:
    key = jax.random.key(seed)
    ks = jax.random.split(key, 19)
    nrm = jax.random.normal
    s_in = D_MODEL ** -0.5
    return {
        'x': nrm(ks[0], (BATCH, SEQ, D_MODEL), jnp.float32),
        'mem': nrm(ks[1], (BATCH, N_MEM, D_MODEL), jnp.float32),
        'w_in_moba': nrm(ks[2], (N_MOBA_LAYERS, D_MODEL, IN_COLS), jnp.float32) * s_in,
        'w_in_fox': nrm(ks[3], (N_FOX_LAYERS, D_MODEL, IN_COLS + N_SELF_HEADS), jnp.float32) * s_in,
        'b_fgate': FOX_GATE_BIAS_INIT + 0.1 * nrm(ks[4], (N_FOX_LAYERS, N_SELF_HEADS), jnp.float32),
        'w_mem_kv': nrm(ks[5], (D_MODEL, 2 * MEM_WIDTH), jnp.float32) * s_in,
        'w_o': nrm(ks[6], (DEPTH, D_MODEL, D_MODEL), jnp.float32) * (s_in * DEEPNORM_BETA),
        'ln1_g': 1.0 + 0.02 * nrm(ks[7], (DEPTH, D_MODEL), jnp.float32),
        'ln1_b': 0.02 * nrm(ks[8], (DEPTH, D_MODEL), jnp.float32),
        'router_w': nrm(ks[9], (DEPTH, D_MODEL, N_EXPERTS), jnp.float32) * s_in,
        'router_b': 0.01 * nrm(ks[10], (DEPTH, N_EXPERTS), jnp.float32),
        'w_gate_up': nrm(ks[11], (DEPTH, N_EXPERTS, D_MODEL, 2 * D_FF), jnp.float32) * s_in,
        'b_gate_up': 0.01 * nrm(ks[12], (DEPTH, N_EXPERTS, 2 * D_FF), jnp.float32),
        'w_down': nrm(ks[13], (DEPTH, N_EXPERTS, D_FF, D_MODEL), jnp.float32) * (D_FF ** -0.5 * DEEPNORM_BETA),
        'b_down': 0.01 * nrm(ks[14], (DEPTH, N_EXPERTS, D_MODEL), jnp.float32),
        'ln2_g': 1.0 + 0.02 * nrm(ks[15], (DEPTH, D_MODEL), jnp.float32),
        'ln2_b': 0.02 * nrm(ks[16], (DEPTH, D_MODEL), jnp.float32),
    }


def reference(x, mem, w_in_moba, w_in_fox, b_fgate, w_mem_kv, w_o, ln1_g, ln1_b,
              router_w, router_b, w_gate_up, b_gate_up, w_down, b_down, ln2_g, ln2_b):
    B, T, D = x.shape
    mkv = mem @ w_mem_kv
    mk = split_heads(mkv[..., :MEM_WIDTH], N_MEM_HEADS)
    mv = split_heads(mkv[..., MEM_WIDTH:], N_MEM_HEADS)
    h = x
    for i in range(DEPTH):
        j = i // N_MIXERS
        is_moba = (i % N_MIXERS) == 0
        proj = h @ (w_in_moba[j] if is_moba else w_in_fox[j])
        q_s = split_heads(proj[..., :SELF_WIDTH], N_SELF_HEADS)
        k_s = split_heads(proj[..., SELF_WIDTH:2 * SELF_WIDTH], N_SELF_HEADS)
        v_s = split_heads(proj[..., 2 * SELF_WIDTH:3 * SELF_WIDTH], N_SELF_HEADS)
        q_m = split_heads(proj[..., 3 * SELF_WIDTH:IN_COLS], N_MEM_HEADS)
        if is_moba:
            o_self = moba_attention(q_s, k_s, v_s)
        else:
            fg = (proj[..., IN_COLS:] + b_fgate[j]).transpose(0, 2, 1)
            o_self = fox_attention(q_s, k_s, v_s, fg)
        o_mem = memory_attention(q_m, mk, mv)
        heads = jnp.concatenate([o_self, o_mem], axis=1)
        merged = heads.transpose(0, 2, 1, 3).reshape(B, T, D)
        h = layer_norm(DEEPNORM_ALPHA * h + merged @ w_o[i], ln1_g[i], ln1_b[i])
        f = moe(h, router_w[i], router_b[i], w_gate_up[i], b_gate_up[i], w_down[i], b_down[i])
        h = layer_norm(DEEPNORM_ALPHA * h + f, ln2_g[i], ln2_b[i])
    return h
```

```cpp
#include <hip/hip_runtime.h>
#include <cstdio>
#include <cstdint>

#define GAS __attribute__((address_space(1)))
#define LAS __attribute__((address_space(3)))
typedef unsigned short bf16;
typedef unsigned v4u __attribute__((ext_vector_type(4)));
typedef unsigned v2u __attribute__((ext_vector_type(2)));
typedef float f32x4 __attribute__((ext_vector_type(4)));
typedef short bf16x8 __attribute__((ext_vector_type(8)));

constexpr int NB = 4, SEQ = 8192, DM = 1024, NTOK = NB * SEQ;
constexpr int HS = 12, HMEM = 4, HD = 64, NMEM = 256, NPROJ = 2560, QM_COL = 2304, K_COL = 768, V_COL = 1536;
constexpr int NEXP = 32, TOPK = 4, DEPTH = 4, NASSIGN = NTOK * TOPK, DFF = 1024;
constexpr float ALPHA = 1.6817928305074290f, LN_EPS = 1e-5f, LOG2E = 1.4426950408889634f, C2 = 0.125f * 1.4426950408889634f;
constexpr float SW_LIMIT = 7.0f, SW_ALPHA = 1.702f;
constexpr int NWAVES = 8, NTHR = 512;

constexpr size_t MiB = 1u << 20;
constexpr size_t WS_CTL = 0, CTL_ZERO_BYTES = 1 * MiB;
constexpr size_t WS_WIN = 2 * MiB;
constexpr size_t WS_WFG = WS_WIN + (size_t)4 * NPROJ * DM * 2;
constexpr size_t WS_WMKV = WS_WFG + 1 * MiB;
constexpr size_t WS_WO = WS_WMKV + 1 * MiB;
constexpr size_t WS_WGU = WS_WO + 8 * MiB;
constexpr size_t WS_WDN = WS_WGU + 512 * MiB;
constexpr size_t WS_HB = WS_WDN + 256 * MiB;
constexpr size_t WS_MEMB = WS_HB + 64 * MiB;
constexpr size_t WS_MKV = WS_MEMB + 2 * MiB;
constexpr size_t WS_PROJ = WS_MKV + 1 * MiB;
constexpr size_t WS_CFOX = WS_PROJ + 160 * MiB;
constexpr size_t WS_LF = WS_CFOX + 2 * MiB;
constexpr size_t WS_KBAR = WS_LF + 2 * MiB;
constexpr size_t WS_ATT = WS_KBAR + 1 * MiB;
constexpr size_t WS_ELIST = WS_ATT + 64 * MiB;
constexpr size_t WS_AGATE = WS_ELIST + 4 * MiB;
constexpr size_t WS_ABUF = WS_AGATE + 1 * MiB;
constexpr size_t WS_YBUF = WS_ABUF + 256 * MiB;
constexpr size_t WS_END = WS_YBUF + 256 * MiB;

constexpr int CW_ECNT = 1024;
constexpr int CW_BAR = 4096;
constexpr int NPHASE = 1 + 8 * DEPTH;

constexpr int LDS_BYTES = 147456, SCR_BYTES = 146432, MISC_OFF = SCR_BYTES;

__device__ __forceinline__ unsigned f2bf(float f) { unsigned u = __float_as_uint(f); return (u + 0x7fffu + ((u >> 16) & 1u)) >> 16; }
__device__ __forceinline__ unsigned pk2(float lo, float hi) { unsigned r; asm("v_cvt_pk_bf16_f32 %0, %1, %2" : "=v"(r) : "v"(lo), "v"(hi)); return r; }
__device__ __forceinline__ float bflo(unsigned w) { return __uint_as_float(w << 16); }
__device__ __forceinline__ float bfhi(unsigned w) { return __uint_as_float(w & 0xffff0000u); }
__device__ __forceinline__ float wave_sum(float v) {
#pragma unroll
    for (int o = 1; o < 64; o <<= 1) v += __shfl_xor(v, o);
    return v;
}
__device__ __forceinline__ float fexp2(float x) { return __builtin_amdgcn_exp2f(x); }
#define PH_IDS int tid = threadIdx.x; asm volatile("" : "+v"(tid)); const int lane = tid & 63; const int wid = __builtin_amdgcn_readfirstlane(tid >> 6); (void)lane; (void)wid

#define XB_TMO      128
#define XB_XCNT(j)  (256  + 64 * (j))
#define XB_XSUB(j)  (1280 + 64 * (j))
#define XB_XGEN(j)  (2304 + 64 * (j))
#define XB_TOP      3328
#define XB_TOPGEN   3392
#define XCD_BAR_WORDS 3456
#define XB_SPIN_CAP (1u << 22)
__device__ __forceinline__ unsigned xb_ld(unsigned* p)              { return __hip_atomic_load(p, __ATOMIC_RELAXED, __HIP_MEMORY_SCOPE_AGENT); }
__device__ __forceinline__ unsigned xb_add(unsigned* p, unsigned v) { return __hip_atomic_fetch_add(p, v, __ATOMIC_RELAXED, __HIP_MEMORY_SCOPE_AGENT); }
__device__ __forceinline__ unsigned xb_xcc_id() { return (unsigned)__builtin_amdgcn_s_getreg((3 << 11) | 20) & 0xFu; }
#define XB_SPIN(cond, bar) do { unsigned _sp = 0; while (cond) { __builtin_amdgcn_s_sleep(1); \
    if ((++_sp & 255u) == 0u) { if (xb_ld(&(bar)[XB_TMO])) break; if (_sp > XB_SPIN_CAP) { atomicAdd(&(bar)[XB_TMO], 1u); break; } } } } while (0)
struct XcdBarrier { unsigned* bar; unsigned x; volatile LAS unsigned* st; };
__device__ __forceinline__ XcdBarrier xcd_barrier_post(unsigned* bar, volatile LAS unsigned* st) {
    XcdBarrier b; b.bar = bar; b.x = xb_xcc_id(); b.st = st;
    if (threadIdx.x == 0) (void)xb_add(&bar[XB_XCNT(b.x)], 1u);
    return b;
}
__device__ __forceinline__ void xcd_barrier_complete(unsigned* bar, unsigned x, unsigned& nloc, unsigned& nx) {
    const unsigned G = gridDim.x * gridDim.y * gridDim.z;
    unsigned sum, cnt, mine, sp = 0u;
    for (;;) {
        sum = 0u; cnt = 0u; mine = 0u;
#pragma unroll
        for (unsigned j = 0; j < 16; ++j) { const unsigned c = xb_ld(&bar[XB_XCNT(j)]); sum += c; cnt += (c > 0u) ? 1u : 0u; mine = (j == x) ? c : mine; }
        if (sum == G) break;
        __builtin_amdgcn_s_sleep(1);
        if ((++sp & 255u) == 0u) { if (xb_ld(&bar[XB_TMO])) break; if (sp > XB_SPIN_CAP) { atomicAdd(&bar[XB_TMO], 1u); break; } }
    }
    nloc = mine > 0u ? mine : 1u; nx = cnt > 0u ? cnt : 1u;
}
__device__ __forceinline__ void xcd_barrier(const XcdBarrier& b) {
    asm volatile("s_waitcnt vmcnt(0)" ::: "memory");
    __syncthreads();
    if (threadIdx.x == 0) {
        unsigned* bar = b.bar;
        __builtin_amdgcn_s_waitcnt(0);
        unsigned nloc = b.st[0], nx = b.st[1];
        if (nloc == 0u) { xcd_barrier_complete(bar, b.x, nloc, nx); b.st[0] = nloc; b.st[1] = nx; }
        const unsigned old = xb_add(&bar[XB_XSUB(b.x)], 1u);
        const unsigned gen = old / nloc;
        if (old + 1u == (gen + 1u) * nloc) {
            __builtin_amdgcn_fence(__ATOMIC_RELEASE, "agent");
            asm volatile("s_waitcnt vmcnt(0)" ::: "memory");
            const unsigned og = xb_add(&bar[XB_TOP], 1u);
            const unsigned tg = og / nx;
            if (og + 1u == (tg + 1u) * nx) xb_add(&bar[XB_TOPGEN], 1u);
            else XB_SPIN(xb_ld(&bar[XB_TOPGEN]) == tg, bar);
            __builtin_amdgcn_fence(__ATOMIC_ACQUIRE, "agent");
            xb_add(&bar[XB_XGEN(b.x)], 1u);
            asm volatile("s_waitcnt vmcnt(0)" ::: "memory");
        } else {
            XB_SPIN(xb_ld(&bar[XB_XGEN(b.x)]) == gen, bar);
            __builtin_amdgcn_fence(__ATOMIC_ACQUIRE, "agent");
            asm volatile("s_waitcnt vmcnt(0)" ::: "memory");
        }
    }
    __syncthreads();
}

struct Args { const float* in[17]; float* out; unsigned char* ws; int p_lo, p_hi; };
enum { I_X = 0, I_MEM, I_WIN_MOBA, I_WIN_FOX, I_BFG, I_WMKV, I_WO, I_LN1G, I_LN1B, I_RW, I_RB, I_WGU, I_BGU, I_WDN, I_BDN, I_LN2G, I_LN2B };

__device__ __forceinline__ void cvt_item(const float* W, int pitch, int col0, int k0, bf16* WT, int drow0, LAS float* scr, int lane) {
    f32x4 v[16];
    const int a = lane >> 4, b4 = (lane & 15) * 4;
#pragma unroll
    for (int i = 0; i < 16; ++i) v[i] = *(const f32x4*)(W + (size_t)(k0 + 4 * i + a) * pitch + col0 + b4);
#pragma unroll
    for (int i = 0; i < 16; ++i) { LAS float* s = scr + (4 * i + a) * 65 + b4; s[0] = v[i].x; s[1] = v[i].y; s[2] = v[i].z; s[3] = v[i].w; }
    asm volatile("s_waitcnt lgkmcnt(0)" ::: "memory");
    const int c = lane & 7;
#pragma unroll
    for (int j = 0; j < 8; ++j) {
        const int n = (lane >> 3) + 8 * j; const LAS float* s = scr + (8 * c) * 65 + n;
        v4u o; o.x = pk2(s[0], s[65]); o.y = pk2(s[2 * 65], s[3 * 65]); o.z = pk2(s[4 * 65], s[5 * 65]); o.w = pk2(s[6 * 65], s[7 * 65]);
        *(v4u*)(WT + (size_t)(drow0 + n) * DM + k0 + 8 * c) = o;
    }
    asm volatile("s_waitcnt lgkmcnt(0)" ::: "memory");
}
__device__ __forceinline__ void ph_convert(const Args& A, LAS unsigned char* lds, int wg, int G) {
    PH_IDS;
    unsigned char* ws = A.ws;
    LAS float* scr = (LAS float*)(lds + wid * 16896);
    const int gw = wg * NWAVES + wid, NGW = G * NWAVES;
    constexpr int I_IN = 16 * 40;
    constexpr int I_MK = 16 * 8, I_O1 = 16 * 16, I_GU1 = 16 * 32, I_DN1 = 16 * 16;
    constexpr int N_IN = 4 * I_IN, N_MK = I_MK, N_O = 4 * I_O1, N_GU = 128 * I_GU1, N_DN = 128 * I_DN1;
    constexpr int NITEMS = N_IN + N_MK + N_O + N_GU + N_DN;
    for (int it = gw; it < NITEMS; it += NGW) {
        int r = it;
        if (r < N_IN) { const int l = r / I_IN, q = r % I_IN, kb = q / 40, nb = q % 40; const int j = l >> 1;
            const float* W = (l & 1) ? A.in[I_WIN_FOX] + (size_t)j * DM * (NPROJ + HS) : A.in[I_WIN_MOBA] + (size_t)j * DM * NPROJ;
            cvt_item(W, (l & 1) ? NPROJ + HS : NPROJ, 64 * nb, 64 * kb, (bf16*)(ws + WS_WIN) + (size_t)l * NPROJ * DM, 64 * nb, scr, lane); continue; }
        r -= N_IN;
        if (r < N_MK) { const int kb = r / 8, nb = r % 8; cvt_item(A.in[I_WMKV], 512, 64 * nb, 64 * kb, (bf16*)(ws + WS_WMKV), 64 * nb, scr, lane); continue; }
        r -= N_MK;
        if (r < N_O) { const int l = r / I_O1, q = r % I_O1, kb = q / 16, nb = q % 16;
            cvt_item(A.in[I_WO] + (size_t)l * DM * DM, DM, 64 * nb, 64 * kb, (bf16*)(ws + WS_WO) + (size_t)l * DM * DM, 64 * nb, scr, lane); continue; }
        r -= N_O;
        if (r < N_GU) { const int le = r / I_GU1, q = r % I_GU1, kb = q / 32, nb = q % 32; const int col0 = 64 * nb;
            const int cc = col0 & 1023, drow0 = (cc >> 7) * 256 + (cc & 127) + ((col0 >= 1024) ? 128 : 0);
            cvt_item(A.in[I_WGU] + (size_t)le * DM * 2048, 2048, col0, 64 * kb, (bf16*)(ws + WS_WGU) + (size_t)le * 2048 * DM, drow0, scr, lane); continue; }
        r -= N_GU;
        { const int le = r / I_DN1, q = r % I_DN1, kb = q / 16, nb = q % 16;
            cvt_item(A.in[I_WDN] + (size_t)le * DM * DM, DM, 64 * nb, 64 * kb, (bf16*)(ws + WS_WDN) + (size_t)le * DM * DM, 64 * nb, scr, lane); }
    }
    { const int gt = wg * NTHR + tid, NGT = G * NTHR;
      for (int i = gt; i < 2 * 16 * DM; i += NGT) { const int j = i / (16 * DM), hh = (i / DM) & 15, k = i % DM;
          const float v = hh < HS ? A.in[I_WIN_FOX][(size_t)j * DM * (NPROJ + HS) + (size_t)k * (NPROJ + HS) + NPROJ + hh] : 0.f;
          ((bf16*)(ws + WS_WFG))[i] = (bf16)f2bf(v); }
      for (size_t i = gt; i < (size_t)NTOK * DM / 8; i += NGT) { const f32x4 a = ((const f32x4*)A.in[I_X])[2 * i], b = ((const f32x4*)A.in[I_X])[2 * i + 1];
          v4u o; o.x = pk2(a.x, a.y); o.y = pk2(a.z, a.w); o.z = pk2(b.x, b.y); o.w = pk2(b.z, b.w); ((v4u*)(ws + WS_HB))[i] = o; }
      for (size_t i = gt; i < (size_t)NB * NMEM * DM / 8; i += NGT) { const f32x4 a = ((const f32x4*)A.in[I_MEM])[2 * i], b = ((const f32x4*)A.in[I_MEM])[2 * i + 1];
          v4u o; o.x = pk2(a.x, a.y); o.y = pk2(a.z, a.w); o.z = pk2(b.x, b.y); o.w = pk2(b.z, b.w); ((v4u*)(ws + WS_MEMB))[i] = o; }
    }
}

struct Unit { int pm, pn, e, rows; const bf16* B; const unsigned* list; };
struct DenseSched {
    const bf16* A; const bf16* Bt; int nM, nN, G, c;
    __device__ __forceinline__ bool next(int i, Unit& u) const {
        const int L = i * G + c; if (L >= nM * nN) return false;
        u.pm = L / nN; u.pn = L % nN; u.e = 0; u.rows = 256; u.B = Bt + (size_t)u.pn * 256 * DM; u.list = nullptr; return true; }
    __device__ __forceinline__ unsigned arow(const Unit& u, int r) const { return (unsigned)(u.pm * 256 + r); }
};
struct MoeSched {
    const bf16* A; const bf16* Bt; const unsigned* elist; const LAS int* tab; int nN, ntot, G, c, shift;
    __device__ __forceinline__ bool next(int i, Unit& u) const {
        const int L = i * G + c; const int total = tab[64 + 32] * nN; if (L >= total) return false;
        u.pn = L % nN; const int g = L / nN; int e = 0;
        for (int j = 1; j < 32; ++j) if (tab[64 + j] <= g) e = j;
        u.e = e; u.pm = g - tab[64 + e]; const int rem = tab[e] - 256 * u.pm; u.rows = rem < 256 ? rem : 256;
        u.B = Bt + ((size_t)e * ntot + (size_t)u.pn * 256) * DM; u.list = elist + (size_t)e * NTOK + 256 * u.pm; return true; }
    __device__ __forceinline__ unsigned arow(const Unit& u, int r) const { return r < u.rows ? (u.list[r] >> shift) : 0u; }
};
__device__ __forceinline__ void moe_tables(LAS int* tab, const unsigned* ecnt) {
    if (threadIdx.x == 0) { int acc = 0; for (int e = 0; e < 32; ++e) { const int c = (int)ecnt[e]; tab[e] = c; tab[64 + e] = acc; acc += (c + 255) >> 8; } tab[64 + 32] = acc; }
    __syncthreads();
}

struct EpiProj {
    bf16* O; int ldc, q_end, qm_begin;
    __device__ __forceinline__ void operator()(const f32x4 (&acc)[2][2][4][2], const Unit& u, int wr, int wc, int fr, int fq) const {
#pragma unroll
        for (int ai = 0; ai < 2; ++ai)
#pragma unroll
            for (int m = 0; m < 4; ++m) { const int row = u.pm * 256 + ai * 128 + wr * 64 + m * 16 + fr;
#pragma unroll
                for (int bj = 0; bj < 2; ++bj) { const int col = u.pn * 256 + bj * 128 + wc * 32 + 8 * fq; const float sc = (col < q_end || col >= qm_begin) ? C2 : 1.f;
                    const f32x4 v0 = acc[ai][bj][m][0] * sc, v1 = acc[ai][bj][m][1] * sc;
                    v4u w; w.x = pk2(v0.x, v0.y); w.y = pk2(v0.z, v0.w); w.z = pk2(v1.x, v1.y); w.w = pk2(v1.z, v1.w);
                    *(v4u*)(O + (size_t)row * ldc + col) = w; } }
    }
};
struct EpiOut {
    const float* base; float* out;
    __device__ __forceinline__ void operator()(const f32x4 (&acc)[2][2][4][2], const Unit& u, int wr, int wc, int fr, int fq) const {
#pragma unroll
        for (int ai = 0; ai < 2; ++ai)
#pragma unroll
            for (int m = 0; m < 4; ++m) { const int row = u.pm * 256 + ai * 128 + wr * 64 + m * 16 + fr;
#pragma unroll
                for (int bj = 0; bj < 2; ++bj) { const size_t off = (size_t)row * DM + u.pn * 256 + bj * 128 + wc * 32 + 8 * fq;
                    const f32x4 b0 = *(const f32x4*)(base + off), b1 = *(const f32x4*)(base + off + 4);
                    *(f32x4*)(out + off) = b0 * ALPHA + acc[ai][bj][m][0]; *(f32x4*)(out + off + 4) = b1 * ALPHA + acc[ai][bj][m][1]; } }
    }
};
__device__ __forceinline__ float swiglu(float g, float uu) {
    g = fminf(g, SW_LIMIT); uu = fminf(fmaxf(uu, -SW_LIMIT), SW_LIMIT);
    const float sg = __builtin_amdgcn_rcpf(1.f + fexp2(-SW_ALPHA * LOG2E * g));
    return g * sg * (uu + 1.f);
}
struct EpiGU {
    bf16* abuf; const float* bgu;
    __device__ __forceinline__ void operator()(const f32x4 (&acc)[2][2][4][2], const Unit& u, int wr, int wc, int fr, int fq) const {
        const int c0 = u.pn * 128 + wc * 32 + 8 * fq; const float* bg = bgu + (size_t)u.e * 2048 + c0;
        const f32x4 g0 = *(const f32x4*)bg, g1 = *(const f32x4*)(bg + 4), u0 = *(const f32x4*)(bg + 1024), u1 = *(const f32x4*)(bg + 1028);
#pragma unroll
        for (int ai = 0; ai < 2; ++ai)
#pragma unroll
            for (int m = 0; m < 4; ++m) { const int r = ai * 128 + wr * 64 + m * 16 + fr;
                if (r < u.rows) { const unsigned aid = u.list[r];
                    const f32x4 ga = acc[ai][0][m][0] + g0, gb = acc[ai][0][m][1] + g1, ua = acc[ai][1][m][0] + u0, ub = acc[ai][1][m][1] + u1;
                    v4u w; w.x = pk2(swiglu(ga.x, ua.x), swiglu(ga.y, ua.y)); w.y = pk2(swiglu(ga.z, ua.z), swiglu(ga.w, ua.w));
                    w.z = pk2(swiglu(gb.x, ub.x), swiglu(gb.y, ub.y)); w.w = pk2(swiglu(gb.z, ub.z), swiglu(gb.w, ub.w));
                    *(v4u*)(abuf + (size_t)aid * DM + c0) = w; } }
    }
};
struct EpiDN {
    bf16* ybuf; const float* bdn; const float* agate;
    __device__ __forceinline__ void operator()(const f32x4 (&acc)[2][2][4][2], const Unit& u, int wr, int wc, int fr, int fq) const {
        f32x4 bv[2][2];
#pragma unroll
        for (int bj = 0; bj < 2; ++bj) { const float* bp = bdn + (size_t)u.e * DM + u.pn * 256 + bj * 128 + wc * 32 + 8 * fq; bv[bj][0] = *(const f32x4*)bp; bv[bj][1] = *(const f32x4*)(bp + 4); }
#pragma unroll
        for (int ai = 0; ai < 2; ++ai)
#pragma unroll
            for (int m = 0; m < 4; ++m) { const int r = ai * 128 + wr * 64 + m * 16 + fr;
                if (r < u.rows) { const unsigned aid = u.list[r]; const float gt = agate[aid];
#pragma unroll
                    for (int bj = 0; bj < 2; ++bj) { const f32x4 v0 = (acc[ai][bj][m][0] + bv[bj][0]) * gt, v1 = (acc[ai][bj][m][1] + bv[bj][1]) * gt;
                        v4u w; w.x = pk2(v0.x, v0.y); w.y = pk2(v0.z, v0.w); w.z = pk2(v1.x, v1.y); w.w = pk2(v1.z, v1.w);
                        *(v4u*)(ybuf + (size_t)aid * DM + u.pn * 256 + bj * 128 + wc * 32 + 8 * fq) = w; } } }
    }
};

template <class Epi, class Sched>
__device__ __forceinline__ void gemm_simple(const Sched& S, const Epi& E) {
    PH_IDS;
    const int wr = wid >> 2, wc = wid & 3, fr = lane & 15, fq = lane >> 4;
    Unit u;
    for (int i = 0; S.next(i, u); ++i) {
        f32x4 acc[2][2][4][2];
#pragma unroll
        for (int a = 0; a < 2; ++a)
#pragma unroll
            for (int b = 0; b < 2; ++b)
#pragma unroll
                for (int m = 0; m < 4; ++m)
#pragma unroll
                    for (int n = 0; n < 2; ++n) acc[a][b][m][n] = (f32x4){0.f, 0.f, 0.f, 0.f};
        unsigned aoff[2][4], boff[2][2];
#pragma unroll
        for (int ai = 0; ai < 2; ++ai)
#pragma unroll
            for (int m = 0; m < 4; ++m) aoff[ai][m] = S.arow(u, ai * 128 + wr * 64 + m * 16 + fr) * DM + 8 * fq;
#pragma unroll
        for (int bj = 0; bj < 2; ++bj)
#pragma unroll
            for (int n = 0; n < 2; ++n) boff[bj][n] = (unsigned)(bj * 128 + wc * 32 + 8 * (fr >> 2) + 4 * n + (fr & 3)) * DM + 8 * fq;
#pragma unroll 1
        for (int k0 = 0; k0 < DM; k0 += 32) {
            bf16x8 b[2][2];
#pragma unroll
            for (int bj = 0; bj < 2; ++bj)
#pragma unroll
                for (int n = 0; n < 2; ++n) b[bj][n] = *(const bf16x8*)(u.B + boff[bj][n] + k0);
#pragma unroll
            for (int ai = 0; ai < 2; ++ai) {
                bf16x8 a[4];
#pragma unroll
                for (int m = 0; m < 4; ++m) a[m] = *(const bf16x8*)(S.A + aoff[ai][m] + k0);
#pragma unroll
                for (int bj = 0; bj < 2; ++bj)
#pragma unroll
                    for (int m = 0; m < 4; ++m)
#pragma unroll
                        for (int n = 0; n < 2; ++n) acc[ai][bj][m][n] = __builtin_amdgcn_mfma_f32_16x16x32_bf16(b[bj][n], a[m], acc[ai][bj][m][n], 0, 0, 0);
            }
        }
        E(acc, u, wr, wc, fr, fq);
    }
}

__device__ __forceinline__ void ph_fox_gate(const Args& A, int j, int wg, int G) {
    PH_IDS;
    const bf16* hb = (const bf16*)(A.ws + WS_HB); const bf16* wfg = (const bf16*)(A.ws + WS_WFG) + (size_t)j * 16 * DM; float* lf = (float*)(A.ws + WS_LF);
    const float* bfg = A.in[I_BFG] + j * HS;
    const int gw = wg * NWAVES + wid, NGW = G * NWAVES;
    for (int n = gw; n < NTOK; n += NGW) {
        const v4u* hp = (const v4u*)(hb + (size_t)n * DM + 16 * lane); const v4u h0 = hp[0], h1 = hp[1];
        float hv[16] = {bflo(h0.x), bfhi(h0.x), bflo(h0.y), bfhi(h0.y), bflo(h0.z), bfhi(h0.z), bflo(h0.w), bfhi(h0.w), bflo(h1.x), bfhi(h1.x), bflo(h1.y), bfhi(h1.y), bflo(h1.z), bfhi(h1.z), bflo(h1.w), bfhi(h1.w)};
        float mine = 0.f;
#pragma unroll
        for (int hh = 0; hh < HS; ++hh) {
            const v4u* wp = (const v4u*)(wfg + (size_t)hh * DM + 16 * lane); const v4u w0 = wp[0], w1 = wp[1];
            float s = hv[0] * bflo(w0.x) + hv[1] * bfhi(w0.x) + hv[2] * bflo(w0.y) + hv[3] * bfhi(w0.y) + hv[4] * bflo(w0.z) + hv[5] * bfhi(w0.z) + hv[6] * bflo(w0.w) + hv[7] * bfhi(w0.w)
                    + hv[8] * bflo(w1.x) + hv[9] * bfhi(w1.x) + hv[10] * bflo(w1.y) + hv[11] * bfhi(w1.y) + hv[12] * bflo(w1.z) + hv[13] * bfhi(w1.z) + hv[14] * bflo(w1.w) + hv[15] * bfhi(w1.w);
            s = wave_sum(s);
            if (lane == hh) mine = s;
        }
        if (lane < HS) { const float z = mine + bfg[lane];
            const float ls = fminf(z, 0.f) - log1pf(expf(-fabsf(z)));
            const int b = n >> 13, t = n & (SEQ - 1); lf[((size_t)(b * HS + lane)) * SEQ + t] = ls; }
    }
}
__device__ __forceinline__ void ph_fox_scan(const Args& A, LAS unsigned char* lds, int wg, int G) {
    PH_IDS;
    const float* lf = (const float*)(A.ws + WS_LF); float* c2 = (float*)(A.ws + WS_CFOX); LAS float* part = (LAS float*)lds;
    for (int s = wg; s < NB * HS; s += G) {
        const float* src = lf + (size_t)s * SEQ + tid * 16; float v[16]; float run = 0.f;
#pragma unroll
        for (int i = 0; i < 16; ++i) { run += src[i]; v[i] = run; }
        part[tid] = run; __syncthreads();
        if (tid == 0) { float acc = 0.f; for (int i = 0; i < NTHR; ++i) { const float x = part[i]; part[i] = acc; acc += x; } }
        __syncthreads();
        const float base = part[tid]; float* dst = c2 + (size_t)s * SEQ + tid * 16;
#pragma unroll
        for (int i = 0; i < 16; ++i) dst[i] = (base + v[i]) * LOG2E;
        __syncthreads();
    }
}
__device__ __forceinline__ void ph_kbar(const Args& A, LAS unsigned char* lds, int wg, int G) {
    PH_IDS;
    const bf16* proj = (const bf16*)(A.ws + WS_PROJ); float* kbar = (float*)(A.ws + WS_KBAR); LAS float* part = (LAS float*)lds;
    const int d = tid & 63, r8 = tid >> 6;
    for (int uidx = wg; uidx < NB * HS * 32; uidx += G) {
        const int j = uidx & 31, bh = uidx >> 5, b = bh / HS, h = bh % HS;
        const bf16* kp = proj + ((size_t)(b * SEQ + j * 256 + r8 * 32)) * NPROJ + K_COL + h * 64 + d;
        float s = 0.f;
        for (int r = 0; r < 32; ++r) s += __uint_as_float((unsigned)kp[(size_t)r * NPROJ] << 16);
        part[tid] = s; __syncthreads();
        if (tid < 64) { float t = 0.f;
#pragma unroll
            for (int q = 0; q < 8; ++q) t += part[q * 64 + tid];
            kbar[(size_t)uidx * 64 + tid] = t * (1.f / 256.f); }
        __syncthreads();
    }
}

__device__ __forceinline__ float alibi_slope(int h) { return h < 8 ? exp2f(-(float)(h + 1)) : exp2f(-(0.5f + (float)(h - 8))); }
#define ROW8(w, base, arr) do { arr[base + 0] = bflo(w.x); arr[base + 1] = bfhi(w.x); arr[base + 2] = bflo(w.y); arr[base + 3] = bfhi(w.y); arr[base + 4] = bflo(w.z); arr[base + 5] = bfhi(w.z); arr[base + 6] = bflo(w.w); arr[base + 7] = bfhi(w.w); } while (0)
__device__ __forceinline__ float dot_row64(const float (&q)[64], const bf16* p) {
    const v4u* p4 = (const v4u*)p; float s0 = 0.f, s1 = 0.f;
#pragma unroll
    for (int i = 0; i < 8; ++i) { if (i == 4) asm volatile("" ::: "memory"); const v4u w = p4[i];
        s0 += q[8 * i + 0] * bflo(w.x); s1 += q[8 * i + 1] * bfhi(w.x); s0 += q[8 * i + 2] * bflo(w.y); s1 += q[8 * i + 3] * bfhi(w.y);
        s0 += q[8 * i + 4] * bflo(w.z); s1 += q[8 * i + 5] * bfhi(w.z); s0 += q[8 * i + 6] * bflo(w.w); s1 += q[8 * i + 7] * bfhi(w.w); }
    return s0 + s1;
}
__device__ __forceinline__ void att_upd(float x, const bf16* vrow, float& m, float& l, float (&o)[64]) {
    const float mn = fmaxf(m, x), al = fexp2(m - mn), pp = fexp2(x - mn); m = mn; l = l * al + pp;
    const v4u* p4 = (const v4u*)vrow; asm volatile("" ::: "memory");
#pragma unroll
    for (int i = 0; i < 8; ++i) { if ((i & 1) == 0) asm volatile("" ::: "memory"); const v4u w = p4[i];
        o[8 * i + 0] = o[8 * i + 0] * al + pp * bflo(w.x); o[8 * i + 1] = o[8 * i + 1] * al + pp * bfhi(w.x); o[8 * i + 2] = o[8 * i + 2] * al + pp * bflo(w.y); o[8 * i + 3] = o[8 * i + 3] * al + pp * bfhi(w.y);
        o[8 * i + 4] = o[8 * i + 4] * al + pp * bflo(w.z); o[8 * i + 5] = o[8 * i + 5] * al + pp * bfhi(w.z); o[8 * i + 6] = o[8 * i + 6] * al + pp * bflo(w.w); o[8 * i + 7] = o[8 * i + 7] * al + pp * bfhi(w.w); }
}
template <int MODE>
__device__ __forceinline__ void ph_attn_naive(const Args& A, int wg, int G) {
    PH_IDS;
    const bf16* proj = (const bf16*)(A.ws + WS_PROJ); const bf16* mkv = (const bf16*)(A.ws + WS_MKV); bf16* att = (bf16*)(A.ws + WS_ATT);
    const float* kbar = (const float*)(A.ws + WS_KBAR); const float* cfox = (const float*)(A.ws + WS_CFOX);
    constexpr int NIT = 16 * (NTOK / 64);
    const int gw = wg * NWAVES + wid, NGW = G * NWAVES;
    for (int base = 0, rnd = 0; base < NIT; base += NGW, ++rnd) {
        const int it = base + ((rnd & 1) ? (NGW - 1 - gw) : gw);
        if (it >= NIT) continue;
        const int hh = it & 15, tg = it >> 4, n = tg * 64 + lane, b = n >> 13, t = n & (SEQ - 1);
        float q[64];
        { const v4u* p4 = (const v4u*)(proj + (size_t)n * NPROJ + (hh < HS ? hh * 64 : QM_COL + (hh - HS) * 64));
#pragma unroll
          for (int i = 0; i < 8; ++i) { const v4u w = p4[i]; ROW8(w, 8 * i, q); } }
        float m = -1e30f, l = 0.f; float o[64];
#pragma unroll
        for (int i = 0; i < 64; ++i) o[i] = 0.f;
        if (hh < HS) {
            const bf16* Kb = proj + (size_t)(b * SEQ) * NPROJ + K_COL + hh * 64; const bf16* Vb = Kb + (V_COL - K_COL);
            if (MODE == 0) {
                const float slope2 = alibi_slope(hh) * LOG2E; const int qb = t >> 8;
                const float* kb = kbar + (size_t)((b * HS + hh) * 32) * 64;
                float g0 = -INFINITY, g1 = -INFINITY, g2 = -INFINITY; int i0 = -1, i1 = -1, i2 = -1;
                for (int j = 0; j < qb; ++j) { float s0 = 0.f, s1 = 0.f;
#pragma unroll
                    for (int d = 0; d < 64; d += 2) { s0 += q[d] * kb[j * 64 + d]; s1 += q[d + 1] * kb[j * 64 + d + 1]; }
                    const float g = s0 + s1;
                    if (g > g0) { g2 = g1; i2 = i1; g1 = g0; i1 = i0; g0 = g; i0 = j; } else if (g > g1) { g2 = g1; i2 = i1; g1 = g; i1 = j; } else if (g > g2) { g2 = g; i2 = j; } }
                const int tend = (t | 63);
                for (int s = qb * 256; s <= tend; ++s) { if (s <= t) { const float x = dot_row64(q, Kb + (size_t)s * NPROJ) - slope2 * (float)(t - s); att_upd(x, Vb + (size_t)s * NPROJ, m, l, o); } }
                for (int sl = 0; sl < 3; ++sl) { const int jb = sl == 0 ? i0 : (sl == 1 ? i1 : i2);
                    if (jb >= 0) for (int s = 0; s < 256; ++s) { const int key = jb * 256 + s; const float x = dot_row64(q, Kb + (size_t)key * NPROJ) - slope2 * (float)(t - key); att_upd(x, Vb + (size_t)key * NPROJ, m, l, o); } }
            } else {
                const float* c2 = cfox + (size_t)(b * HS + hh) * SEQ; const float cq = c2[t]; const int tend = (t | 63);
                for (int s = 0; s <= tend; ++s) { if (s <= t) { const float x = dot_row64(q, Kb + (size_t)s * NPROJ) + (cq - c2[s]); att_upd(x, Vb + (size_t)s * NPROJ, m, l, o); } }
            }
        } else {
            const bf16* Kb = mkv + (size_t)(b * NMEM) * 512 + (hh - HS) * 64; const bf16* Vb = Kb + 256;
            for (int s = 0; s < NMEM; ++s) { const float x = dot_row64(q, Kb + (size_t)s * 512); att_upd(x, Vb + (size_t)s * 512, m, l, o); }
        }
        const float rl = 1.f / l; v4u* op = (v4u*)(att + (size_t)n * DM + hh * 64);
#pragma unroll
        for (int i = 0; i < 8; ++i) { v4u w; w.x = pk2(o[8 * i] * rl, o[8 * i + 1] * rl); w.y = pk2(o[8 * i + 2] * rl, o[8 * i + 3] * rl); w.z = pk2(o[8 * i + 4] * rl, o[8 * i + 5] * rl); w.w = pk2(o[8 * i + 6] * rl, o[8 * i + 7] * rl); op[i] = w; }
    }
}

__device__ __forceinline__ void ph_ln1_router(const Args& A, int layer, LAS unsigned char* lds, int wg, int G) {
    PH_IDS;
    float* hres = A.out; bf16* hb = (bf16*)(A.ws + WS_HB); unsigned* elist = (unsigned*)(A.ws + WS_ELIST); float* agate = (float*)(A.ws + WS_AGATE);
    unsigned* ecnt = (unsigned*)(A.ws + WS_CTL) + CW_ECNT + layer * 64;
    const float* rw = A.in[I_RW] + (size_t)layer * DM * NEXP; const float* rb = A.in[I_RB] + layer * NEXP;
    const float* g1 = A.in[I_LN1G] + layer * DM; const float* b1 = A.in[I_LN1B] + layer * DM;
    LAS float* rwT = (LAS float*)lds; LAS int* lcnt = (LAS int*)(lds + 131072); LAS int* gbase = lcnt + 32; LAS unsigned* rec = (LAS unsigned*)(lds + 131584);
    const int RPW = (NTOK + G - 1) / G;
    for (int i = tid; i < DM * NEXP; i += NTHR) rwT[(i & 31) * DM + (i >> 5)] = rw[i];
    if (tid < 32) lcnt[tid] = 0;
    __syncthreads();
    const int row0 = wg * RPW, row1 = (row0 + RPW < NTOK) ? row0 + RPW : NTOK;
    for (int n = row0 + wid; n < row1; n += NWAVES) {
        f32x4 v[4]; float s = 0.f; float* xr = hres + (size_t)n * DM;
#pragma unroll
        for (int j = 0; j < 4; ++j) { v[j] = *(const f32x4*)(xr + 4 * lane + 256 * j); s += (v[j].x + v[j].y) + (v[j].z + v[j].w); }
        const float mean = wave_sum(s) * (1.f / DM); float s2 = 0.f;
#pragma unroll
        for (int j = 0; j < 4; ++j) { v[j] = v[j] - mean; s2 += (v[j].x * v[j].x + v[j].y * v[j].y) + (v[j].z * v[j].z + v[j].w * v[j].w); }
        const float rstd = 1.f / sqrtf(wave_sum(s2) * (1.f / DM) + LN_EPS);
#pragma unroll
        for (int j = 0; j < 4; ++j) { const f32x4 gg = *(const f32x4*)(g1 + 4 * lane + 256 * j), bb = *(const f32x4*)(b1 + 4 * lane + 256 * j);
            v[j] = v[j] * rstd * gg + bb; *(f32x4*)(xr + 4 * lane + 256 * j) = v[j];
            v2u w; w.x = pk2(v[j].x, v[j].y); w.y = pk2(v[j].z, v[j].w); *(v2u*)(hb + (size_t)n * DM + 4 * lane + 256 * j) = w; }
        float lg[32];
#pragma unroll
        for (int e = 0; e < 32; ++e) { float p = 0.f;
#pragma unroll
            for (int j = 0; j < 4; ++j) { const f32x4 r4 = *(const LAS f32x4*)(rwT + e * DM + 4 * lane + 256 * j); p += (v[j].x * r4.x + v[j].y * r4.y) + (v[j].z * r4.z + v[j].w * r4.w); }
            lg[e] = wave_sum(p) + rb[e]; asm volatile("" ::: "memory"); }
        float tv[4]; int ti[4];
#pragma unroll
        for (int k = 0; k < 4; ++k) { float best = -INFINITY; int bi = 0;
#pragma unroll
            for (int e = 0; e < 32; ++e) { if (lg[e] > best) { best = lg[e]; bi = e; } }
            tv[k] = best; ti[k] = bi;
#pragma unroll
            for (int e = 0; e < 32; ++e) if (e == bi) lg[e] = -INFINITY; }
        const float e1 = expf(tv[1] - tv[0]), e2 = expf(tv[2] - tv[0]), e3 = expf(tv[3] - tv[0]); const float inv = 1.f / (1.f + e1 + e2 + e3);
        if (lane < 4) { const int ek = lane == 0 ? ti[0] : lane == 1 ? ti[1] : lane == 2 ? ti[2] : ti[3]; const float gk = (lane == 0 ? 1.f : lane == 1 ? e1 : lane == 2 ? e2 : e3) * inv;
            const int lp = atomicAdd((int*)lcnt + ek, 1);
            const int ri = (n - row0) * 4 + lane; rec[2 * ri] = (unsigned)ek | ((unsigned)lp << 8); rec[2 * ri + 1] = __float_as_uint(gk); }
    }
    __syncthreads();
    if (tid < 32) gbase[tid] = (int)__hip_atomic_fetch_add(ecnt + tid, (unsigned)lcnt[tid], __ATOMIC_RELAXED, __HIP_MEMORY_SCOPE_AGENT);
    __syncthreads();
    for (int ri = tid; ri < (row1 - row0) * 4; ri += NTHR) { const unsigned w = rec[2 * ri]; const int e = w & 31, lp = w >> 8; const unsigned aid = (unsigned)(row0 * 4 + ri);
        elist[(size_t)e * NTOK + gbase[e] + lp] = aid; agate[aid] = __uint_as_float(rec[2 * ri + 1]); }
    __syncthreads();
}

__device__ __forceinline__ void ph_combine_ln2(const Args& A, int layer, int wg, int G) {
    PH_IDS;
    float* hres = A.out; bf16* hb = (bf16*)(A.ws + WS_HB); const bf16* ybuf = (const bf16*)(A.ws + WS_YBUF);
    const float* g2 = A.in[I_LN2G] + layer * DM; const float* b2 = A.in[I_LN2B] + layer * DM;
    const int gw = wg * NWAVES + wid, NGW = G * NWAVES;
    for (int n = gw; n < NTOK; n += NGW) {
        f32x4 v[4]; float s = 0.f; float* xr = hres + (size_t)n * DM;
#pragma unroll
        for (int j = 0; j < 4; ++j) { v[j] = *(const f32x4*)(xr + 4 * lane + 256 * j) * ALPHA;
#pragma unroll
            for (int k = 0; k < 4; ++k) { const v2u w = *(const v2u*)(ybuf + ((size_t)n * 4 + k) * DM + 4 * lane + 256 * j); v[j].x += bflo(w.x); v[j].y += bfhi(w.x); v[j].z += bflo(w.y); v[j].w += bfhi(w.y); }
            s += (v[j].x + v[j].y) + (v[j].z + v[j].w); }
        const float mean = wave_sum(s) * (1.f / DM); float s2 = 0.f;
#pragma unroll
        for (int j = 0; j < 4; ++j) { v[j] = v[j] - mean; s2 += (v[j].x * v[j].x + v[j].y * v[j].y) + (v[j].z * v[j].z + v[j].w * v[j].w); }
        const float rstd = 1.f / sqrtf(wave_sum(s2) * (1.f / DM) + LN_EPS);
#pragma unroll
        for (int j = 0; j < 4; ++j) { const f32x4 gg = *(const f32x4*)(g2 + 4 * lane + 256 * j), bb = *(const f32x4*)(b2 + 4 * lane + 256 * j);
            v[j] = v[j] * rstd * gg + bb; *(f32x4*)(xr + 4 * lane + 256 * j) = v[j];
            v2u w; w.x = pk2(v[j].x, v[j].y); w.y = pk2(v[j].z, v[j].w); *(v2u*)(hb + (size_t)n * DM + 4 * lane + 256 * j) = w; }
    }
}

__global__ void __launch_bounds__(NTHR, 2) k_main(Args A) {
    extern __shared__ __attribute__((aligned(16))) unsigned char lds_raw[];
    LAS unsigned char* lds = (LAS unsigned char*)lds_raw;
    volatile LAS unsigned* MISC = (volatile LAS unsigned*)(lds + MISC_OFF);
    const int tid = threadIdx.x;
    const int G = gridDim.x, wg = blockIdx.x;
    unsigned* ctl = (unsigned*)(A.ws + WS_CTL);
    const int lo = A.p_lo, hi = A.p_hi;
    if (tid < 64) MISC[tid] = 0u;
    __syncthreads();
    XcdBarrier bar; bar.bar = ctl + CW_BAR; bar.x = 0; bar.st = nullptr;
    if (hi - lo > 1) bar = xcd_barrier_post(ctl + CW_BAR + (size_t)lo * XCD_BAR_WORDS, MISC + 8);
#define IN(k) (lo <= (k) && (k) < hi)
#define SEAM(k) do { if ((k) + 1 < hi) xcd_barrier(bar); } while (0)
    unsigned char* ws = A.ws;
    if (IN(0)) { ph_convert(A, lds, wg, G); SEAM(0); }
    for (int layer = 0; layer < DEPTH; ++layer) {
        const int pb = 1 + 8 * layer; const bool fox = (layer & 1) != 0;
        if (IN(pb + 0)) {
            { DenseSched S{(const bf16*)(ws + WS_HB), (const bf16*)(ws + WS_WIN) + (size_t)layer * NPROJ * DM, NTOK / 256, NPROJ / 256, G, wg};
              EpiProj E{(bf16*)(ws + WS_PROJ), NPROJ, K_COL, QM_COL};
              gemm_simple(S, E); }
            if (layer == 0) { DenseSched S{(const bf16*)(ws + WS_MEMB), (const bf16*)(ws + WS_WMKV), NB * NMEM / 256, 2, G, wg};
              EpiProj E{(bf16*)(ws + WS_MKV), 512, 0, 1 << 30};
              gemm_simple(S, E); }
            if (fox) ph_fox_gate(A, layer >> 1, wg, G);
            SEAM(pb + 0);
        }
        if (IN(pb + 1)) { if (fox) ph_fox_scan(A, lds, wg, G); else ph_kbar(A, lds, wg, G); SEAM(pb + 1); }
        if (IN(pb + 2)) { if (fox) ph_attn_naive<1>(A, wg, G); else ph_attn_naive<0>(A, wg, G); SEAM(pb + 2); }
        if (IN(pb + 3)) {
            DenseSched S{(const bf16*)(ws + WS_ATT), (const bf16*)(ws + WS_WO) + (size_t)layer * DM * DM, NTOK / 256, DM / 256, G, wg};
            EpiOut E{layer == 0 ? A.in[I_X] : A.out, A.out};
            gemm_simple(S, E); SEAM(pb + 3);
        }
        if (IN(pb + 4)) { ph_ln1_router(A, layer, lds, wg, G); SEAM(pb + 4); }
        if (IN(pb + 5)) {
            LAS int* tab = (LAS int*)lds; moe_tables(tab, ctl + CW_ECNT + layer * 64);
            MoeSched S{(const bf16*)(ws + WS_HB), (const bf16*)(ws + WS_WGU) + (size_t)layer * NEXP * 2048 * DM, (const unsigned*)(ws + WS_ELIST), tab, 8, 2048, G, wg, 2};
            EpiGU E{(bf16*)(ws + WS_ABUF), A.in[I_BGU] + (size_t)layer * NEXP * 2048};
            gemm_simple(S, E); __syncthreads(); SEAM(pb + 5);
        }
        if (IN(pb + 6)) {
            LAS int* tab = (LAS int*)lds; moe_tables(tab, ctl + CW_ECNT + layer * 64);
            MoeSched S{(const bf16*)(ws + WS_ABUF), (const bf16*)(ws + WS_WDN) + (size_t)layer * NEXP * DM * DM, (const unsigned*)(ws + WS_ELIST), tab, 4, 1024, G, wg, 0};
            EpiDN E{(bf16*)(ws + WS_YBUF), A.in[I_BDN] + (size_t)layer * NEXP * DM, (const float*)(ws + WS_AGATE)};
            gemm_simple(S, E); __syncthreads(); SEAM(pb + 6);
        }
        if (IN(pb + 7)) { ph_combine_ln2(A, layer, wg, G); SEAM(pb + 7); }
    }
#undef IN
#undef SEAM
}

#ifndef MK_ONE_LAUNCH
#define MK_ONE_LAUNCH 0
#endif
extern "C" void kernel_launch(void* const* d_in, const int* in_sizes, int n_in, void* d_out, int out_size, void* d_ws, size_t ws_size, hipStream_t stream) {
    static int grid = 0;
    if (grid == 0) {
        if (n_in != 17 || out_size != NTOK * DM || ws_size < WS_END) { fprintf(stderr, "kernel_launch: unexpected shapes (n_in %d out %d ws %zu, need %zu)\n", n_in, out_size, ws_size, (size_t)WS_END); grid = -1; return; }
        int dev = 0, cus = 0, per_cu = 0;
        if (hipGetDevice(&dev) != hipSuccess || hipDeviceGetAttribute(&cus, hipDeviceAttributeMultiprocessorCount, dev) != hipSuccess) { grid = -1; return; }
        if (hipFuncSetAttribute((const void*)k_main, hipFuncAttributeMaxDynamicSharedMemorySize, LDS_BYTES) != hipSuccess) { fprintf(stderr, "kernel_launch: hipFuncSetAttribute failed\n"); grid = -1; return; }
        if (hipOccupancyMaxActiveBlocksPerMultiprocessor(&per_cu, (const void*)k_main, NTHR, LDS_BYTES) != hipSuccess || per_cu < 1) { fprintf(stderr, "kernel_launch: occupancy query says %d\n", per_cu); }
        (void)hipGetLastError();
        grid = cus;
    }
    if (grid < 0) return;
    (void)hipMemsetAsync((char*)d_ws + WS_CTL, 0, CTL_ZERO_BYTES, stream);
    Args a{};
    for (int i = 0; i < 17; ++i) a.in[i] = (const float*)d_in[i];
    a.out = (float*)d_out; a.ws = (unsigned char*)d_ws;
#if MK_ONE_LAUNCH
    a.p_lo = 0; a.p_hi = NPHASE;
    hipLaunchKernelGGL(k_main, dim3(grid), dim3(NTHR), LDS_BYTES, stream, a);
#else
    for (int p = 0; p < NPHASE; ++p) { a.p_lo = p; a.p_hi = p + 1; hipLaunchKernelGGL(k_main, dim3(grid), dim3(NTHR), LDS_BYTES, stream, a); }
#endif
}
```

```cpp
#include <hip/hip_runtime.h>
#include <cstdio>
#include <cstdint>

#define GAS __attribute__((address_space(1)))
#define LAS __attribute__((address_space(3)))
typedef unsigned short bf16;
typedef unsigned v4u __attribute__((ext_vector_type(4)));
typedef unsigned v2u __attribute__((ext_vector_type(2)));
typedef float f32x4 __attribute__((ext_vector_type(4)));
typedef short bf16x8 __attribute__((ext_vector_type(8)));

constexpr int NB = 4, SEQ = 8192, DM = 1024, NTOK = NB * SEQ;
constexpr int HS = 12, HMEM = 4, HD = 64, NMEM = 256, NPROJ = 2560, QM_COL = 2304, K_COL = 768, V_COL = 1536;
constexpr int NEXP = 32, TOPK = 4, DEPTH = 4, NASSIGN = NTOK * TOPK, DFF = 1024;
constexpr float ALPHA = 1.6817928305074290f, LN_EPS = 1e-5f, LOG2E = 1.4426950408889634f, C2 = 0.125f * 1.4426950408889634f;
constexpr float SW_LIMIT = 7.0f, SW_ALPHA = 1.702f;
constexpr int NWAVES = 8, NTHR = 512;

constexpr size_t MiB = 1u << 20;
constexpr size_t WS_CTL = 0, CTL_ZERO_BYTES = 1 * MiB;
constexpr size_t WS_WIN = 2 * MiB;
constexpr size_t WS_WFG = WS_WIN + (size_t)4 * NPROJ * DM * 2;
constexpr size_t WS_WMKV = WS_WFG + 1 * MiB;
constexpr size_t WS_WO = WS_WMKV + 1 * MiB;
constexpr size_t WS_WGU = WS_WO + 8 * MiB;
constexpr size_t WS_WDN = WS_WGU + 512 * MiB;
constexpr size_t WS_HB = WS_WDN + 256 * MiB;
constexpr size_t WS_MEMB = WS_HB + 64 * MiB;
constexpr size_t WS_MKV = WS_MEMB + 2 * MiB;
constexpr size_t WS_PROJ = WS_MKV + 1 * MiB;
constexpr size_t WS_CFOX = WS_PROJ + 160 * MiB;
constexpr size_t WS_LF = WS_CFOX + 2 * MiB;
constexpr size_t WS_KBAR = WS_LF + 2 * MiB;
constexpr size_t WS_ATT = WS_KBAR + 1 * MiB;
constexpr size_t WS_ELIST = WS_ATT + 64 * MiB;
constexpr size_t WS_AGATE = WS_ELIST + 4 * MiB;
constexpr size_t WS_ABUF = WS_AGATE + 1 * MiB;
constexpr size_t WS_YBUF = WS_ABUF + 256 * MiB;
constexpr size_t WS_END = WS_YBUF + 256 * MiB;

constexpr int CW_ECNT = 1024;
constexpr int CW_BAR = 4096;
constexpr int NPHASE = 1 + 8 * DEPTH;

constexpr int LDS_BYTES = 147456, SCR_BYTES = 146432, MISC_OFF = SCR_BYTES;

__device__ __forceinline__ unsigned f2bf(float f) { unsigned u = __float_as_uint(f); return (u + 0x7fffu + ((u >> 16) & 1u)) >> 16; }
__device__ __forceinline__ unsigned pk2(float lo, float hi) { unsigned r; asm("v_cvt_pk_bf16_f32 %0, %1, %2" : "=v"(r) : "v"(lo), "v"(hi)); return r; }
__device__ __forceinline__ float bflo(unsigned w) { return __uint_as_float(w << 16); }
__device__ __forceinline__ float bfhi(unsigned w) { return __uint_as_float(w & 0xffff0000u); }
__device__ __forceinline__ float wave_sum(float v) {
#pragma unroll
    for (int o = 1; o < 64; o <<= 1) v += __shfl_xor(v, o);
    return v;
}
__device__ __forceinline__ float fexp2(float x) { return __builtin_amdgcn_exp2f(x); }
#define PH_IDS int tid = threadIdx.x; asm volatile("" : "+v"(tid)); const int lane = tid & 63; const int wid = __builtin_amdgcn_readfirstlane(tid >> 6); (void)lane; (void)wid

#define XB_TMO      128
#define XB_XCNT(j)  (256  + 64 * (j))
#define XB_XSUB(j)  (1280 + 64 * (j))
#define XB_XGEN(j)  (2304 + 64 * (j))
#define XB_TOP      3328
#define XB_TOPGEN   3392
#define XCD_BAR_WORDS 3456
#define XB_SPIN_CAP (1u << 22)
__device__ __forceinline__ unsigned xb_ld(unsigned* p)              { return __hip_atomic_load(p, __ATOMIC_RELAXED, __HIP_MEMORY_SCOPE_AGENT); }
__device__ __forceinline__ unsigned xb_add(unsigned* p, unsigned v) { return __hip_atomic_fetch_add(p, v, __ATOMIC_RELAXED, __HIP_MEMORY_SCOPE_AGENT); }
__device__ __forceinline__ unsigned xb_xcc_id() { return (unsigned)__builtin_amdgcn_s_getreg((3 << 11) | 20) & 0xFu; }
#define XB_SPIN(cond, bar) do { unsigned _sp = 0; while (cond) { __builtin_amdgcn_s_sleep(1); \
    if ((++_sp & 255u) == 0u) { if (xb_ld(&(bar)[XB_TMO])) break; if (_sp > XB_SPIN_CAP) { atomicAdd(&(bar)[XB_TMO], 1u); break; } } } } while (0)
struct XcdBarrier { unsigned* bar; unsigned x; volatile LAS unsigned* st; };
__device__ __forceinline__ XcdBarrier xcd_barrier_post(unsigned* bar, volatile LAS unsigned* st) {
    XcdBarrier b; b.bar = bar; b.x = xb_xcc_id(); b.st = st;
    if (threadIdx.x == 0) (void)xb_add(&bar[XB_XCNT(b.x)], 1u);
    return b;
}
__device__ __forceinline__ void xcd_barrier_complete(unsigned* bar, unsigned x, unsigned& nloc, unsigned& nx) {
    const unsigned G = gridDim.x * gridDim.y * gridDim.z;
    unsigned sum, cnt, mine, sp = 0u;
    for (;;) {
        sum = 0u; cnt = 0u; mine = 0u;
#pragma unroll
        for (unsigned j = 0; j < 16; ++j) { const unsigned c = xb_ld(&bar[XB_XCNT(j)]); sum += c; cnt += (c > 0u) ? 1u : 0u; mine = (j == x) ? c : mine; }
        if (sum == G) break;
        __builtin_amdgcn_s_sleep(1);
        if ((++sp & 255u) == 0u) { if (xb_ld(&bar[XB_TMO])) break; if (sp > XB_SPIN_CAP) { atomicAdd(&bar[XB_TMO], 1u); break; } }
    }
    nloc = mine > 0u ? mine : 1u; nx = cnt > 0u ? cnt : 1u;
}
__device__ __forceinline__ void xcd_barrier(const XcdBarrier& b) {
    asm volatile("s_waitcnt vmcnt(0)" ::: "memory");
    __syncthreads();
    if (threadIdx.x == 0) {
        unsigned* bar = b.bar;
        __builtin_amdgcn_s_waitcnt(0);
        unsigned nloc = b.st[0], nx = b.st[1];
        if (nloc == 0u) { xcd_barrier_complete(bar, b.x, nloc, nx); b.st[0] = nloc; b.st[1] = nx; }
        const unsigned old = xb_add(&bar[XB_XSUB(b.x)], 1u);
        const unsigned gen = old / nloc;
        if (old + 1u == (gen + 1u) * nloc) {
            __builtin_amdgcn_fence(__ATOMIC_RELEASE, "agent");
            asm volatile("s_waitcnt vmcnt(0)" ::: "memory");
            const unsigned og = xb_add(&bar[XB_TOP], 1u);
            const unsigned tg = og / nx;
            if (og + 1u == (tg + 1u) * nx) xb_add(&bar[XB_TOPGEN], 1u);
            else XB_SPIN(xb_ld(&bar[XB_TOPGEN]) == tg, bar);
            __builtin_amdgcn_fence(__ATOMIC_ACQUIRE, "agent");
            xb_add(&bar[XB_XGEN(b.x)], 1u);
            asm volatile("s_waitcnt vmcnt(0)" ::: "memory");
        } else {
            XB_SPIN(xb_ld(&bar[XB_XGEN(b.x)]) == gen, bar);
            __builtin_amdgcn_fence(__ATOMIC_ACQUIRE, "agent");
            asm volatile("s_waitcnt vmcnt(0)" ::: "memory");
        }
    }
    __syncthreads();
}

struct Args { const float* in[17]; float* out; unsigned char* ws; int p_lo, p_hi; };
enum { I_X = 0, I_MEM, I_WIN_MOBA, I_WIN_FOX, I_BFG, I_WMKV, I_WO, I_LN1G, I_LN1B, I_RW, I_RB, I_WGU, I_BGU, I_WDN, I_BDN, I_LN2G, I_LN2B };

__device__ __forceinline__ void cvt_item(const float* W, int pitch, int col0, int k0, bf16* WT, int drow0, LAS float* scr, int lane) {
    f32x4 v[16];
    const int a = lane >> 4, b4 = (lane & 15) * 4;
#pragma unroll
    for (int i = 0; i < 16; ++i) v[i] = *(const f32x4*)(W + (size_t)(k0 + 4 * i + a) * pitch + col0 + b4);
#pragma unroll
    for (int i = 0; i < 16; ++i) { LAS float* s = scr + (4 * i + a) * 65 + b4; s[0] = v[i].x; s[1] = v[i].y; s[2] = v[i].z; s[3] = v[i].w; }
    asm volatile("s_waitcnt lgkmcnt(0)" ::: "memory");
    const int c = lane & 7;
#pragma unroll
    for (int j = 0; j < 8; ++j) {
        const int n = (lane >> 3) + 8 * j; const LAS float* s = scr + (8 * c) * 65 + n;
        v4u o; o.x = pk2(s[0], s[65]); o.y = pk2(s[2 * 65], s[3 * 65]); o.z = pk2(s[4 * 65], s[5 * 65]); o.w = pk2(s[6 * 65], s[7 * 65]);
        *(v4u*)(WT + (size_t)(drow0 + n) * DM + k0 + 8 * c) = o;
    }
    asm volatile("s_waitcnt lgkmcnt(0)" ::: "memory");
}
__device__ __forceinline__ void ph_convert(const Args& A, LAS unsigned char* lds, int wg, int G) {
    PH_IDS;
    unsigned char* ws = A.ws;
    LAS float* scr = (LAS float*)(lds + wid * 16896);
    const int gw = wg * NWAVES + wid, NGW = G * NWAVES;
    constexpr int I_IN = 16 * 40;
    constexpr int I_MK = 16 * 8, I_O1 = 16 * 16, I_GU1 = 16 * 32, I_DN1 = 16 * 16;
    constexpr int N_IN = 4 * I_IN, N_MK = I_MK, N_O = 4 * I_O1, N_GU = 128 * I_GU1, N_DN = 128 * I_DN1;
    constexpr int NITEMS = N_IN + N_MK + N_O + N_GU + N_DN;
    for (int it = gw; it < NITEMS; it += NGW) {
        int r = it;
        if (r < N_IN) { const int l = r / I_IN, q = r % I_IN, kb = q / 40, nb = q % 40; const int j = l >> 1;
            const float* W = (l & 1) ? A.in[I_WIN_FOX] + (size_t)j * DM * (NPROJ + HS) : A.in[I_WIN_MOBA] + (size_t)j * DM * NPROJ;
            cvt_item(W, (l & 1) ? NPROJ + HS : NPROJ, 64 * nb, 64 * kb, (bf16*)(ws + WS_WIN) + (size_t)l * NPROJ * DM, 64 * nb, scr, lane); continue; }
        r -= N_IN;
        if (r < N_MK) { const int kb = r / 8, nb = r % 8; cvt_item(A.in[I_WMKV], 512, 64 * nb, 64 * kb, (bf16*)(ws + WS_WMKV), 64 * nb, scr, lane); continue; }
        r -= N_MK;
        if (r < N_O) { const int l = r / I_O1, q = r % I_O1, kb = q / 16, nb = q % 16;
            cvt_item(A.in[I_WO] + (size_t)l * DM * DM, DM, 64 * nb, 64 * kb, (bf16*)(ws + WS_WO) + (size_t)l * DM * DM, 64 * nb, scr, lane); continue; }
        r -= N_O;
        if (r < N_GU) { const int le = r / I_GU1, q = r % I_GU1, kb = q / 32, nb = q % 32; const int col0 = 64 * nb;
            const int cc = col0 & 1023, drow0 = (cc >> 7) * 256 + (cc & 127) + ((col0 >= 1024) ? 128 : 0);
            cvt_item(A.in[I_WGU] + (size_t)le * DM * 2048, 2048, col0, 64 * kb, (bf16*)(ws + WS_WGU) + (size_t)le * 2048 * DM, drow0, scr, lane); continue; }
        r -= N_GU;
        { const int le = r / I_DN1, q = r % I_DN1, kb = q / 16, nb = q % 16;
            cvt_item(A.in[I_WDN] + (size_t)le * DM * DM, DM, 64 * nb, 64 * kb, (bf16*)(ws + WS_WDN) + (size_t)le * DM * DM, 64 * nb, scr, lane); }
    }
    { const int gt = wg * NTHR + tid, NGT = G * NTHR;
      for (int i = gt; i < 2 * 16 * DM; i += NGT) { const int j = i / (16 * DM), hh = (i / DM) & 15, k = i % DM;
          const float v = hh < HS ? A.in[I_WIN_FOX][(size_t)j * DM * (NPROJ + HS) + (size_t)k * (NPROJ + HS) + NPROJ + hh] : 0.f;
          ((bf16*)(ws + WS_WFG))[i] = (bf16)f2bf(v); }
      for (size_t i = gt; i < (size_t)NTOK * DM / 8; i += NGT) { const f32x4 a = ((const f32x4*)A.in[I_X])[2 * i], b = ((const f32x4*)A.in[I_X])[2 * i + 1];
          v4u o; o.x = pk2(a.x, a.y); o.y = pk2(a.z, a.w); o.z = pk2(b.x, b.y); o.w = pk2(b.z, b.w); ((v4u*)(ws + WS_HB))[i] = o; }
      for (size_t i = gt; i < (size_t)NB * NMEM * DM / 8; i += NGT) { const f32x4 a = ((const f32x4*)A.in[I_MEM])[2 * i], b = ((const f32x4*)A.in[I_MEM])[2 * i + 1];
          v4u o; o.x = pk2(a.x, a.y); o.y = pk2(a.z, a.w); o.z = pk2(b.x, b.y); o.w = pk2(b.z, b.w); ((v4u*)(ws + WS_MEMB))[i] = o; }
    }
}

struct Unit { int pm, pn, e, rows; const bf16* B; const unsigned* list; };
struct DenseSched {
    const bf16* A; const bf16* Bt; int nM, nN, G, c;
    __device__ __forceinline__ bool next(int i, Unit& u) const {
        const int L = i * G + c; if (L >= nM * nN) return false;
        u.pm = L / nN; u.pn = L % nN; u.e = 0; u.rows = 256; u.B = Bt + (size_t)u.pn * 256 * DM; u.list = nullptr; return true; }
    __device__ __forceinline__ unsigned arow(const Unit& u, int r) const { return (unsigned)(u.pm * 256 + r); }
};
struct MoeSched {
    const bf16* A; const bf16* Bt; const unsigned* elist; const LAS int* tab; int nN, ntot, G, c, shift;
    __device__ __forceinline__ bool next(int i, Unit& u) const {
        const int L = i * G + c; const int total = tab[64 + 32] * nN; if (L >= total) return false;
        u.pn = L % nN; const int g = L / nN; int e = 0;
        for (int j = 1; j < 32; ++j) if (tab[64 + j] <= g) e = j;
        u.e = e; u.pm = g - tab[64 + e]; const int rem = tab[e] - 256 * u.pm; u.rows = rem < 256 ? rem : 256;
        u.B = Bt + ((size_t)e * ntot + (size_t)u.pn * 256) * DM; u.list = elist + (size_t)e * NTOK + 256 * u.pm; return true; }
    __device__ __forceinline__ unsigned arow(const Unit& u, int r) const { return r < u.rows ? (u.list[r] >> shift) : 0u; }
};
__device__ __forceinline__ void moe_tables(LAS int* tab, const unsigned* ecnt) {
    if (threadIdx.x == 0) { int acc = 0; for (int e = 0; e < 32; ++e) { const int c = (int)ecnt[e]; tab[e] = c; tab[64 + e] = acc; acc += (c + 255) >> 8; } tab[64 + 32] = acc; }
    __syncthreads();
}

struct EpiProj {
    bf16* O; int ldc, q_end, qm_begin;
    __device__ __forceinline__ void operator()(const f32x4 (&acc)[2][2][4][2], const Unit& u, int wr, int wc, int fr, int fq) const {
#pragma unroll
        for (int ai = 0; ai < 2; ++ai)
#pragma unroll
            for (int m = 0; m < 4; ++m) { const int row = u.pm * 256 + ai * 128 + wr * 64 + m * 16 + fr;
#pragma unroll
                for (int bj = 0; bj < 2; ++bj) { const int col = u.pn * 256 + bj * 128 + wc * 32 + 8 * fq; const float sc = (col < q_end || col >= qm_begin) ? C2 : 1.f;
                    const f32x4 v0 = acc[ai][bj][m][0] * sc, v1 = acc[ai][bj][m][1] * sc;
                    v4u w; w.x = pk2(v0.x, v0.y); w.y = pk2(v0.z, v0.w); w.z = pk2(v1.x, v1.y); w.w = pk2(v1.z, v1.w);
                    *(v4u*)(O + (size_t)row * ldc + col) = w; } }
    }
};
struct EpiOut {
    const float* base; float* out;
    __device__ __forceinline__ void operator()(const f32x4 (&acc)[2][2][4][2], const Unit& u, int wr, int wc, int fr, int fq) const {
#pragma unroll
        for (int ai = 0; ai < 2; ++ai)
#pragma unroll
            for (int m = 0; m < 4; ++m) { const int row = u.pm * 256 + ai * 128 + wr * 64 + m * 16 + fr;
#pragma unroll
                for (int bj = 0; bj < 2; ++bj) { const size_t off = (size_t)row * DM + u.pn * 256 + bj * 128 + wc * 32 + 8 * fq;
                    const f32x4 b0 = *(const f32x4*)(base + off), b1 = *(const f32x4*)(base + off + 4);
                    *(f32x4*)(out + off) = b0 * ALPHA + acc[ai][bj][m][0]; *(f32x4*)(out + off + 4) = b1 * ALPHA + acc[ai][bj][m][1]; } }
    }
};
__device__ __forceinline__ float swiglu(float g, float uu) {
    g = fminf(g, SW_LIMIT); uu = fminf(fmaxf(uu, -SW_LIMIT), SW_LIMIT);
    const float sg = __builtin_amdgcn_rcpf(1.f + fexp2(-SW_ALPHA * LOG2E * g));
    return g * sg * (uu + 1.f);
}
struct EpiGU {
    bf16* abuf; const float* bgu;
    __device__ __forceinline__ void operator()(const f32x4 (&acc)[2][2][4][2], const Unit& u, int wr, int wc, int fr, int fq) const {
        const int c0 = u.pn * 128 + wc * 32 + 8 * fq; const float* bg = bgu + (size_t)u.e * 2048 + c0;
        const f32x4 g0 = *(const f32x4*)bg, g1 = *(const f32x4*)(bg + 4), u0 = *(const f32x4*)(bg + 1024), u1 = *(const f32x4*)(bg + 1028);
#pragma unroll
        for (int ai = 0; ai < 2; ++ai)
#pragma unroll
            for (int m = 0; m < 4; ++m) { const int r = ai * 128 + wr * 64 + m * 16 + fr;
                if (r < u.rows) { const unsigned aid = u.list[r];
                    const f32x4 ga = acc[ai][0][m][0] + g0, gb = acc[ai][0][m][1] + g1, ua = acc[ai][1][m][0] + u0, ub = acc[ai][1][m][1] + u1;
                    v4u w; w.x = pk2(swiglu(ga.x, ua.x), swiglu(ga.y, ua.y)); w.y = pk2(swiglu(ga.z, ua.z), swiglu(ga.w, ua.w));
                    w.z = pk2(swiglu(gb.x, ub.x), swiglu(gb.y, ub.y)); w.w = pk2(swiglu(gb.z, ub.z), swiglu(gb.w, ub.w));
                    *(v4u*)(abuf + (size_t)aid * DM + c0) = w; } }
    }
};
struct EpiDN {
    bf16* ybuf; const float* bdn; const float* agate;
    __device__ __forceinline__ void operator()(const f32x4 (&acc)[2][2][4][2], const Unit& u, int wr, int wc, int fr, int fq) const {
        f32x4 bv[2][2];
#pragma unroll
        for (int bj = 0; bj < 2; ++bj) { const float* bp = bdn + (size_t)u.e * DM + u.pn * 256 + bj * 128 + wc * 32 + 8 * fq; bv[bj][0] = *(const f32x4*)bp; bv[bj][1] = *(const f32x4*)(bp + 4); }
#pragma unroll
        for (int ai = 0; ai < 2; ++ai)
#pragma unroll
            for (int m = 0; m < 4; ++m) { const int r = ai * 128 + wr * 64 + m * 16 + fr;
                if (r < u.rows) { const unsigned aid = u.list[r]; const float gt = agate[aid];
#pragma unroll
                    for (int bj = 0; bj < 2; ++bj) { const f32x4 v0 = (acc[ai][bj][m][0] + bv[bj][0]) * gt, v1 = (acc[ai][bj][m][1] + bv[bj][1]) * gt;
                        v4u w; w.x = pk2(v0.x, v0.y); w.y = pk2(v0.z, v0.w); w.z = pk2(v1.x, v1.y); w.w = pk2(v1.z, v1.w);
                        *(v4u*)(ybuf + (size_t)aid * DM + u.pn * 256 + bj * 128 + wc * 32 + 8 * fq) = w; } } }
    }
};

template <class Epi, class Sched>
__device__ __forceinline__ void gemm_simple(const Sched& S, const Epi& E) {
    PH_IDS;
    const int wr = wid >> 2, wc = wid & 3, fr = lane & 15, fq = lane >> 4;
    Unit u;
    for (int i = 0; S.next(i, u); ++i) {
        f32x4 acc[2][2][4][2];
#pragma unroll
        for (int a = 0; a < 2; ++a)
#pragma unroll
            for (int b = 0; b < 2; ++b)
#pragma unroll
                for (int m = 0; m < 4; ++m)
#pragma unroll
                    for (int n = 0; n < 2; ++n) acc[a][b][m][n] = (f32x4){0.f, 0.f, 0.f, 0.f};
        unsigned aoff[2][4], boff[2][2];
#pragma unroll
        for (int ai = 0; ai < 2; ++ai)
#pragma unroll
            for (int m = 0; m < 4; ++m) aoff[ai][m] = S.arow(u, ai * 128 + wr * 64 + m * 16 + fr) * DM + 8 * fq;
#pragma unroll
        for (int bj = 0; bj < 2; ++bj)
#pragma unroll
            for (int n = 0; n < 2; ++n) boff[bj][n] = (unsigned)(bj * 128 + wc * 32 + 8 * (fr >> 2) + 4 * n + (fr & 3)) * DM + 8 * fq;
#pragma unroll 1
        for (int k0 = 0; k0 < DM; k0 += 32) {
            bf16x8 b[2][2];
#pragma unroll
            for (int bj = 0; bj < 2; ++bj)
#pragma unroll
                for (int n = 0; n < 2; ++n) b[bj][n] = *(const bf16x8*)(u.B + boff[bj][n] + k0);
#pragma unroll
            for (int ai = 0; ai < 2; ++ai) {
                bf16x8 a[4];
#pragma unroll
                for (int m = 0; m < 4; ++m) a[m] = *(const bf16x8*)(S.A + aoff[ai][m] + k0);
#pragma unroll
                for (int bj = 0; bj < 2; ++bj)
#pragma unroll
                    for (int m = 0; m < 4; ++m)
#pragma unroll
                        for (int n = 0; n < 2; ++n) acc[ai][bj][m][n] = __builtin_amdgcn_mfma_f32_16x16x32_bf16(b[bj][n], a[m], acc[ai][bj][m][n], 0, 0, 0);
            }
        }
        E(acc, u, wr, wc, fr, fq);
    }
}

__device__ __forceinline__ void ph_fox_gate(const Args& A, int j, int wg, int G) {
    PH_IDS;
    const bf16* hb = (const bf16*)(A.ws + WS_HB); const bf16* wfg = (const bf16*)(A.ws + WS_WFG) + (size_t)j * 16 * DM; float* lf = (float*)(A.ws + WS_LF);
    const float* bfg = A.in[I_BFG] + j * HS;
    const int gw = wg * NWAVES + wid, NGW = G * NWAVES;
    for (int n = gw; n < NTOK; n += NGW) {
        const v4u* hp = (const v4u*)(hb + (size_t)n * DM + 16 * lane); const v4u h0 = hp[0], h1 = hp[1];
        float hv[16] = {bflo(h0.x), bfhi(h0.x), bflo(h0.y), bfhi(h0.y), bflo(h0.z), bfhi(h0.z), bflo(h0.w), bfhi(h0.w), bflo(h1.x), bfhi(h1.x), bflo(h1.y), bfhi(h1.y), bflo(h1.z), bfhi(h1.z), bflo(h1.w), bfhi(h1.w)};
        float mine = 0.f;
#pragma unroll
        for (int hh = 0; hh < HS; ++hh) {
            const v4u* wp = (const v4u*)(wfg + (size_t)hh * DM + 16 * lane); const v4u w0 = wp[0], w1 = wp[1];
            float s = hv[0] * bflo(w0.x) + hv[1] * bfhi(w0.x) + hv[2] * bflo(w0.y) + hv[3] * bfhi(w0.y) + hv[4] * bflo(w0.z) + hv[5] * bfhi(w0.z) + hv[6] * bflo(w0.w) + hv[7] * bfhi(w0.w)
                    + hv[8] * bflo(w1.x) + hv[9] * bfhi(w1.x) + hv[10] * bflo(w1.y) + hv[11] * bfhi(w1.y) + hv[12] * bflo(w1.z) + hv[13] * bfhi(w1.z) + hv[14] * bflo(w1.w) + hv[15] * bfhi(w1.w);
            s = wave_sum(s);
            if (lane == hh) mine = s;
        }
        if (lane < HS) { const float z = mine + bfg[lane];
            const float ls = fminf(z, 0.f) - log1pf(expf(-fabsf(z)));
            const int b = n >> 13, t = n & (SEQ - 1); lf[((size_t)(b * HS + lane)) * SEQ + t] = ls; }
    }
}
__device__ __forceinline__ void ph_fox_scan(const Args& A, LAS unsigned char* lds, int wg, int G) {
    PH_IDS;
    const float* lf = (const float*)(A.ws + WS_LF); float* c2 = (float*)(A.ws + WS_CFOX); LAS float* part = (LAS float*)lds;
    for (int s = wg; s < NB * HS; s += G) {
        const float* src = lf + (size_t)s * SEQ + tid * 16; float v[16]; float run = 0.f;
#pragma unroll
        for (int i = 0; i < 16; ++i) { run += src[i]; v[i] = run; }
        part[tid] = run; __syncthreads();
        if (tid == 0) { float acc = 0.f; for (int i = 0; i < NTHR; ++i) { const float x = part[i]; part[i] = acc; acc += x; } }
        __syncthreads();
        const float base = part[tid]; float* dst = c2 + (size_t)s * SEQ + tid * 16;
#pragma unroll
        for (int i = 0; i < 16; ++i) dst[i] = (base + v[i]) * LOG2E;
        __syncthreads();
    }
}
__device__ __forceinline__ void ph_kbar(const Args& A, LAS unsigned char* lds, int wg, int G) {
    PH_IDS;
    const bf16* proj = (const bf16*)(A.ws + WS_PROJ); float* kbar = (float*)(A.ws + WS_KBAR); LAS float* part = (LAS float*)lds;
    const int d = tid & 63, r8 = tid >> 6;
    for (int uidx = wg; uidx < NB * HS * 32; uidx += G) {
        const int j = uidx & 31, bh = uidx >> 5, b = bh / HS, h = bh % HS;
        const bf16* kp = proj + ((size_t)(b * SEQ + j * 256 + r8 * 32)) * NPROJ + K_COL + h * 64 + d;
        float s = 0.f;
        for (int r = 0; r < 32; ++r) s += __uint_as_float((unsigned)kp[(size_t)r * NPROJ] << 16);
        part[tid] = s; __syncthreads();
        if (tid < 64) { float t = 0.f;
#pragma unroll
            for (int q = 0; q < 8; ++q) t += part[q * 64 + tid];
            kbar[(size_t)uidx * 64 + tid] = t * (1.f / 256.f); }
        __syncthreads();
    }
}

__device__ __forceinline__ float alibi_slope(int h) { return h < 8 ? exp2f(-(float)(h + 1)) : exp2f(-(0.5f + (float)(h - 8))); }
#define ROW8(w, base, arr) do { arr[base + 0] = bflo(w.x); arr[base + 1] = bfhi(w.x); arr[base + 2] = bflo(w.y); arr[base + 3] = bfhi(w.y); arr[base + 4] = bflo(w.z); arr[base + 5] = bfhi(w.z); arr[base + 6] = bflo(w.w); arr[base + 7] = bfhi(w.w); } while (0)
__device__ __forceinline__ float dot_row64(const float (&q)[64], const bf16* p) {
    const v4u* p4 = (const v4u*)p; float s0 = 0.f, s1 = 0.f;
#pragma unroll
    for (int i = 0; i < 8; ++i) { if (i == 4) asm volatile("" ::: "memory"); const v4u w = p4[i];
        s0 += q[8 * i + 0] * bflo(w.x); s1 += q[8 * i + 1] * bfhi(w.x); s0 += q[8 * i + 2] * bflo(w.y); s1 += q[8 * i + 3] * bfhi(w.y);
        s0 += q[8 * i + 4] * bflo(w.z); s1 += q[8 * i + 5] * bfhi(w.z); s0 += q[8 * i + 6] * bflo(w.w); s1 += q[8 * i + 7] * bfhi(w.w); }
    return s0 + s1;
}
__device__ __forceinline__ void att_upd(float x, const bf16* vrow, float& m, float& l, float (&o)[64]) {
    const float mn = fmaxf(m, x), al = fexp2(m - mn), pp = fexp2(x - mn); m = mn; l = l * al + pp;
    const v4u* p4 = (const v4u*)vrow; asm volatile("" ::: "memory");
#pragma unroll
    for (int i = 0; i < 8; ++i) { if ((i & 1) == 0) asm volatile("" ::: "memory"); const v4u w = p4[i];
        o[8 * i + 0] = o[8 * i + 0] * al + pp * bflo(w.x); o[8 * i + 1] = o[8 * i + 1] * al + pp * bfhi(w.x); o[8 * i + 2] = o[8 * i + 2] * al + pp * bflo(w.y); o[8 * i + 3] = o[8 * i + 3] * al + pp * bfhi(w.y);
        o[8 * i + 4] = o[8 * i + 4] * al + pp * bflo(w.z); o[8 * i + 5] = o[8 * i + 5] * al + pp * bfhi(w.z); o[8 * i + 6] = o[8 * i + 6] * al + pp * bflo(w.w); o[8 * i + 7] = o[8 * i + 7] * al + pp * bfhi(w.w); }
}
template <int MODE>
__device__ __forceinline__ void ph_attn_naive(const Args& A, int wg, int G) {
    PH_IDS;
    const bf16* proj = (const bf16*)(A.ws + WS_PROJ); const bf16* mkv = (const bf16*)(A.ws + WS_MKV); bf16* att = (bf16*)(A.ws + WS_ATT);
    const float* kbar = (const float*)(A.ws + WS_KBAR); const float* cfox = (const float*)(A.ws + WS_CFOX);
    constexpr int NIT = 16 * (NTOK / 64);
    const int gw = wg * NWAVES + wid, NGW = G * NWAVES;
    for (int base = 0, rnd = 0; base < NIT; base += NGW, ++rnd) {
        const int it = base + ((rnd & 1) ? (NGW - 1 - gw) : gw);
        if (it >= NIT) continue;
        const int hh = it & 15, tg = it >> 4, n = tg * 64 + lane, b = n >> 13, t = n & (SEQ - 1);
        float q[64];
        { const v4u* p4 = (const v4u*)(proj + (size_t)n * NPROJ + (hh < HS ? hh * 64 : QM_COL + (hh - HS) * 64));
#pragma unroll
          for (int i = 0; i < 8; ++i) { const v4u w = p4[i]; ROW8(w, 8 * i, q); } }
        float m = -1e30f, l = 0.f; float o[64];
#pragma unroll
        for (int i = 0; i < 64; ++i) o[i] = 0.f;
        if (hh < HS) {
            const bf16* Kb = proj + (size_t)(b * SEQ) * NPROJ + K_COL + hh * 64; const bf16* Vb = Kb + (V_COL - K_COL);
            if (MODE == 0) {
                const float slope2 = alibi_slope(hh) * LOG2E; const int qb = t >> 8;
                const float* kb = kbar + (size_t)((b * HS + hh) * 32) * 64;
                float g0 = -INFINITY, g1 = -INFINITY, g2 = -INFINITY; int i0 = -1, i1 = -1, i2 = -1;
                for (int j = 0; j < qb; ++j) { float s0 = 0.f, s1 = 0.f;
#pragma unroll
                    for (int d = 0; d < 64; d += 2) { s0 += q[d] * kb[j * 64 + d]; s1 += q[d + 1] * kb[j * 64 + d + 1]; }
                    const float g = s0 + s1;
                    if (g > g0) { g2 = g1; i2 = i1; g1 = g0; i1 = i0; g0 = g; i0 = j; } else if (g > g1) { g2 = g1; i2 = i1; g1 = g; i1 = j; } else if (g > g2) { g2 = g; i2 = j; } }
                const int tend = (t | 63);
                for (int s = qb * 256; s <= tend; ++s) { if (s <= t) { const float x = dot_row64(q, Kb + (size_t)s * NPROJ) - slope2 * (float)(t - s); att_upd(x, Vb + (size_t)s * NPROJ, m, l, o); } }
                for (int sl = 0; sl < 3; ++sl) { const int jb = sl == 0 ? i0 : (sl == 1 ? i1 : i2);
                    if (jb >= 0) for (int s = 0; s < 256; ++s) { const int key = jb * 256 + s; const float x = dot_row64(q, Kb + (size_t)key * NPROJ) - slope2 * (float)(t - key); att_upd(x, Vb + (size_t)key * NPROJ, m, l, o); } }
            } else {
                const float* c2 = cfox + (size_t)(b * HS + hh) * SEQ; const float cq = c2[t]; const int tend = (t | 63);
                for (int s = 0; s <= tend; ++s) { if (s <= t) { const float x = dot_row64(q, Kb + (size_t)s * NPROJ) + (cq - c2[s]); att_upd(x, Vb + (size_t)s * NPROJ, m, l, o); } }
            }
        } else {
            const bf16* Kb = mkv + (size_t)(b * NMEM) * 512 + (hh - HS) * 64; const bf16* Vb = Kb + 256;
            for (int s = 0; s < NMEM; ++s) { const float x = dot_row64(q, Kb + (size_t)s * 512); att_upd(x, Vb + (size_t)s * 512, m, l, o); }
        }
        const float rl = 1.f / l; v4u* op = (v4u*)(att + (size_t)n * DM + hh * 64);
#pragma unroll
        for (int i = 0; i < 8; ++i) { v4u w; w.x = pk2(o[8 * i] * rl, o[8 * i + 1] * rl); w.y = pk2(o[8 * i + 2] * rl, o[8 * i + 3] * rl); w.z = pk2(o[8 * i + 4] * rl, o[8 * i + 5] * rl); w.w = pk2(o[8 * i + 6] * rl, o[8 * i + 7] * rl); op[i] = w; }
    }
}

__device__ __forceinline__ void ph_ln1_router(const Args& A, int layer, LAS unsigned char* lds, int wg, int G) {
    PH_IDS;
    float* hres = A.out; bf16* hb = (bf16*)(A.ws + WS_HB); unsigned* elist = (unsigned*)(A.ws + WS_ELIST); float* agate = (float*)(A.ws + WS_AGATE);
    unsigned* ecnt = (unsigned*)(A.ws + WS_CTL) + CW_ECNT + layer * 64;
    const float* rw = A.in[I_RW] + (size_t)layer * DM * NEXP; const float* rb = A.in[I_RB] + layer * NEXP;
    const float* g1 = A.in[I_LN1G] + layer * DM; const float* b1 = A.in[I_LN1B] + layer * DM;
    LAS float* rwT = (LAS float*)lds; LAS int* lcnt = (LAS int*)(lds + 131072); LAS int* gbase = lcnt + 32; LAS unsigned* rec = (LAS unsigned*)(lds + 131584);
    const int RPW = (NTOK + G - 1) / G;
    for (int i = tid; i < DM * NEXP; i += NTHR) rwT[(i & 31) * DM + (i >> 5)] = rw[i];
    if (tid < 32) lcnt[tid] = 0;
    __syncthreads();
    const int row0 = wg * RPW, row1 = (row0 + RPW < NTOK) ? row0 + RPW : NTOK;
    for (int n = row0 + wid; n < row1; n += NWAVES) {
        f32x4 v[4]; float s = 0.f; float* xr = hres + (size_t)n * DM;
#pragma unroll
        for (int j = 0; j < 4; ++j) { v[j] = *(const f32x4*)(xr + 4 * lane + 256 * j); s += (v[j].x + v[j].y) + (v[j].z + v[j].w); }
        const float mean = wave_sum(s) * (1.f / DM); float s2 = 0.f;
#pragma unroll
        for (int j = 0; j < 4; ++j) { v[j] = v[j] - mean; s2 += (v[j].x * v[j].x + v[j].y * v[j].y) + (v[j].z * v[j].z + v[j].w * v[j].w); }
        const float rstd = 1.f / sqrtf(wave_sum(s2) * (1.f / DM) + LN_EPS);
#pragma unroll
        for (int j = 0; j < 4; ++j) { const f32x4 gg = *(const f32x4*)(g1 + 4 * lane + 256 * j), bb = *(const f32x4*)(b1 + 4 * lane + 256 * j);
            v[j] = v[j] * rstd * gg + bb; *(f32x4*)(xr + 4 * lane + 256 * j) = v[j];
            v2u w; w.x = pk2(v[j].x, v[j].y); w.y = pk2(v[j].z, v[j].w); *(v2u*)(hb + (size_t)n * DM + 4 * lane + 256 * j) = w; }
        float lg[32];
#pragma unroll
        for (int e = 0; e < 32; ++e) { float p = 0.f;
#pragma unroll
            for (int j = 0; j < 4; ++j) { const f32x4 r4 = *(const LAS f32x4*)(rwT + e * DM + 4 * lane + 256 * j); p += (v[j].x * r4.x + v[j].y * r4.y) + (v[j].z * r4.z + v[j].w * r4.w); }
            lg[e] = wave_sum(p) + rb[e]; asm volatile("" ::: "memory"); }
        float tv[4]; int ti[4];
#pragma unroll
        for (int k = 0; k < 4; ++k) { float best = -INFINITY; int bi = 0;
#pragma unroll
            for (int e = 0; e < 32; ++e) { if (lg[e] > best) { best = lg[e]; bi = e; } }
            tv[k] = best; ti[k] = bi;
#pragma unroll
            for (int e = 0; e < 32; ++e) if (e == bi) lg[e] = -INFINITY; }
        const float e1 = expf(tv[1] - tv[0]), e2 = expf(tv[2] - tv[0]), e3 = expf(tv[3] - tv[0]); const float inv = 1.f / (1.f + e1 + e2 + e3);
        if (lane < 4) { const int ek = lane == 0 ? ti[0] : lane == 1 ? ti[1] : lane == 2 ? ti[2] : ti[3]; const float gk = (lane == 0 ? 1.f : lane == 1 ? e1 : lane == 2 ? e2 : e3) * inv;
            const int lp = atomicAdd((int*)lcnt + ek, 1);
            const int ri = (n - row0) * 4 + lane; rec[2 * ri] = (unsigned)ek | ((unsigned)lp << 8); rec[2 * ri + 1] = __float_as_uint(gk); }
    }
    __syncthreads();
    if (tid < 32) gbase[tid] = (int)__hip_atomic_fetch_add(ecnt + tid, (unsigned)lcnt[tid], __ATOMIC_RELAXED, __HIP_MEMORY_SCOPE_AGENT);
    __syncthreads();
    for (int ri = tid; ri < (row1 - row0) * 4; ri += NTHR) { const unsigned w = rec[2 * ri]; const int e = w & 31, lp = w >> 8; const unsigned aid = (unsigned)(row0 * 4 + ri);
        elist[(size_t)e * NTOK + gbase[e] + lp] = aid; agate[aid] = __uint_as_float(rec[2 * ri + 1]); }
    __syncthreads();
}

__device__ __forceinline__ void ph_combine_ln2(const Args& A, int layer, int wg, int G) {
    PH_IDS;
    float* hres = A.out; bf16* hb = (bf16*)(A.ws + WS_HB); const bf16* ybuf = (const bf16*)(A.ws + WS_YBUF);
    const float* g2 = A.in[I_LN2G] + layer * DM; const float* b2 = A.in[I_LN2B] + layer * DM;
    const int gw = wg * NWAVES + wid, NGW = G * NWAVES;
    for (int n = gw; n < NTOK; n += NGW) {
        f32x4 v[4]; float s = 0.f; float* xr = hres + (size_t)n * DM;
#pragma unroll
        for (int j = 0; j < 4; ++j) { v[j] = *(const f32x4*)(xr + 4 * lane + 256 * j) * ALPHA;
#pragma unroll
            for (int k = 0; k < 4; ++k) { const v2u w = *(const v2u*)(ybuf + ((size_t)n * 4 + k) * DM + 4 * lane + 256 * j); v[j].x += bflo(w.x); v[j].y += bfhi(w.x); v[j].z += bflo(w.y); v[j].w += bfhi(w.y); }
            s += (v[j].x + v[j].y) + (v[j].z + v[j].w); }
        const float mean = wave_sum(s) * (1.f / DM); float s2 = 0.f;
#pragma unroll
        for (int j = 0; j < 4; ++j) { v[j] = v[j] - mean; s2 += (v[j].x * v[j].x + v[j].y * v[j].y) + (v[j].z * v[j].z + v[j].w * v[j].w); }
        const float rstd = 1.f / sqrtf(wave_sum(s2) * (1.f / DM) + LN_EPS);
#pragma unroll
        for (int j = 0; j < 4; ++j) { const f32x4 gg = *(const f32x4*)(g2 + 4 * lane + 256 * j), bb = *(const f32x4*)(b2 + 4 * lane + 256 * j);
            v[j] = v[j] * rstd * gg + bb; *(f32x4*)(xr + 4 * lane + 256 * j) = v[j];
            v2u w; w.x = pk2(v[j].x, v[j].y); w.y = pk2(v[j].z, v[j].w); *(v2u*)(hb + (size_t)n * DM + 4 * lane + 256 * j) = w; }
    }
}

__global__ void __launch_bounds__(NTHR, 2) k_main(Args A) {
    extern __shared__ __attribute__((aligned(16))) unsigned char lds_raw[];
    LAS unsigned char* lds = (LAS unsigned char*)lds_raw;
    volatile LAS unsigned* MISC = (volatile LAS unsigned*)(lds + MISC_OFF);
    const int tid = threadIdx.x;
    const int G = gridDim.x, wg = blockIdx.x;
    unsigned* ctl = (unsigned*)(A.ws + WS_CTL);
    const int lo = A.p_lo, hi = A.p_hi;
    if (tid < 64) MISC[tid] = 0u;
    __syncthreads();
    XcdBarrier bar; bar.bar = ctl + CW_BAR; bar.x = 0; bar.st = nullptr;
    if (hi - lo > 1) bar = xcd_barrier_post(ctl + CW_BAR + (size_t)lo * XCD_BAR_WORDS, MISC + 8);
#define IN(k) (lo <= (k) && (k) < hi)
#define SEAM(k) do { if ((k) + 1 < hi) xcd_barrier(bar); } while (0)
    unsigned char* ws = A.ws;
    if (IN(0)) { ph_convert(A, lds, wg, G); SEAM(0); }
    for (int layer = 0; layer < DEPTH; ++layer) {
        const int pb = 1 + 8 * layer; const bool fox = (layer & 1) != 0;
        if (IN(pb + 0)) {
            { DenseSched S{(const bf16*)(ws + WS_HB), (const bf16*)(ws + WS_WIN) + (size_t)layer * NPROJ * DM, NTOK / 256, NPROJ / 256, G, wg};
              EpiProj E{(bf16*)(ws + WS_PROJ), NPROJ, K_COL, QM_COL};
              gemm_simple(S, E); }
            if (layer == 0) { DenseSched S{(const bf16*)(ws + WS_MEMB), (const bf16*)(ws + WS_WMKV), NB * NMEM / 256, 2, G, wg};
              EpiProj E{(bf16*)(ws + WS_MKV), 512, 0, 1 << 30};
              gemm_simple(S, E); }
            if (fox) ph_fox_gate(A, layer >> 1, wg, G);
            SEAM(pb + 0);
        }
        if (IN(pb + 1)) { if (fox) ph_fox_scan(A, lds, wg, G); else ph_kbar(A, lds, wg, G); SEAM(pb + 1); }
        if (IN(pb + 2)) { if (fox) ph_attn_naive<1>(A, wg, G); else ph_attn_naive<0>(A, wg, G); SEAM(pb + 2); }
        if (IN(pb + 3)) {
            DenseSched S{(const bf16*)(ws + WS_ATT), (const bf16*)(ws + WS_WO) + (size_t)layer * DM * DM, NTOK / 256, DM / 256, G, wg};
            EpiOut E{layer == 0 ? A.in[I_X] : A.out, A.out};
            gemm_simple(S, E); SEAM(pb + 3);
        }
        if (IN(pb + 4)) { ph_ln1_router(A, layer, lds, wg, G); SEAM(pb + 4); }
        if (IN(pb + 5)) {
            LAS int* tab = (LAS int*)lds; moe_tables(tab, ctl + CW_ECNT + layer * 64);
            MoeSched S{(const bf16*)(ws + WS_HB), (const bf16*)(ws + WS_WGU) + (size_t)layer * NEXP * 2048 * DM, (const unsigned*)(ws + WS_ELIST), tab, 8, 2048, G, wg, 2};
            EpiGU E{(bf16*)(ws + WS_ABUF), A.in[I_BGU] + (size_t)layer * NEXP * 2048};
            gemm_simple(S, E); __syncthreads(); SEAM(pb + 5);
        }
        if (IN(pb + 6)) {
            LAS int* tab = (LAS int*)lds; moe_tables(tab, ctl + CW_ECNT + layer * 64);
            MoeSched S{(const bf16*)(ws + WS_ABUF), (const bf16*)(ws + WS_WDN) + (size_t)layer * NEXP * DM * DM, (const unsigned*)(ws + WS_ELIST), tab, 4, 1024, G, wg, 0};
            EpiDN E{(bf16*)(ws + WS_YBUF), A.in[I_BDN] + (size_t)layer * NEXP * DM, (const float*)(ws + WS_AGATE)};
            gemm_simple(S, E); __syncthreads(); SEAM(pb + 6);
        }
        if (IN(pb + 7)) { ph_combine_ln2(A, layer, wg, G); SEAM(pb + 7); }
    }
#undef IN
#undef SEAM
}

#ifndef MK_ONE_LAUNCH
#define MK_ONE_LAUNCH 1
#endif
extern "C" void kernel_launch(void* const* d_in, const int* in_sizes, int n_in, void* d_out, int out_size, void* d_ws, size_t ws_size, hipStream_t stream) {
    static int grid = 0;
    if (grid == 0) {
        if (n_in != 17 || out_size != NTOK * DM || ws_size < WS_END) { fprintf(stderr, "kernel_launch: unexpected shapes (n_in %d out %d ws %zu, need %zu)\n", n_in, out_size, ws_size, (size_t)WS_END); grid = -1; return; }
        int dev = 0, cus = 0, per_cu = 0;
        if (hipGetDevice(&dev) != hipSuccess || hipDeviceGetAttribute(&cus, hipDeviceAttributeMultiprocessorCount, dev) != hipSuccess) { grid = -1; return; }
        if (hipFuncSetAttribute((const void*)k_main, hipFuncAttributeMaxDynamicSharedMemorySize, LDS_BYTES) != hipSuccess) { fprintf(stderr, "kernel_launch: hipFuncSetAttribute failed\n"); grid = -1; return; }
        if (hipOccupancyMaxActiveBlocksPerMultiprocessor(&per_cu, (const void*)k_main, NTHR, LDS_BYTES) != hipSuccess || per_cu < 1) { fprintf(stderr, "kernel_launch: occupancy query says %d\n", per_cu); }
        (void)hipGetLastError();
        grid = cus;
    }
    if (grid < 0) return;
    (void)hipMemsetAsync((char*)d_ws + WS_CTL, 0, CTL_ZERO_BYTES, stream);
    Args a{};
    for (int i = 0; i < 17; ++i) a.in[i] = (const float*)d_in[i];
    a.out = (float*)d_out; a.ws = (unsigned char*)d_ws;
#if MK_ONE_LAUNCH
    a.p_lo = 0; a.p_hi = NPHASE;
    hipLaunchKernelGGL(k_main, dim3(grid), dim3(NTHR), LDS_BYTES, stream, a);
#else
    for (int p = 0; p < NPHASE; ++p) { a.p_lo = p; a.p_hi = p + 1; hipLaunchKernelGGL(k_main, dim3(grid), dim3(NTHR), LDS_BYTES, stream, a); }
#endif
}
```

```cpp
#include <hip/hip_runtime.h>
#include <cstdio>
#include <cstdint>

#define GAS __attribute__((address_space(1)))
#define LAS __attribute__((address_space(3)))
typedef unsigned short bf16;
typedef unsigned v4u __attribute__((ext_vector_type(4)));
typedef unsigned v2u __attribute__((ext_vector_type(2)));
typedef float f32x4 __attribute__((ext_vector_type(4)));
typedef short bf16x8 __attribute__((ext_vector_type(8)));

constexpr int NB = 4, SEQ = 8192, DM = 1024, NTOK = NB * SEQ;
constexpr int HS = 12, HMEM = 4, HD = 64, NMEM = 256, NPROJ = 2560, QM_COL = 2304, K_COL = 768, V_COL = 1536;
constexpr int NEXP = 32, TOPK = 4, DEPTH = 4, NASSIGN = NTOK * TOPK, DFF = 1024;
constexpr float ALPHA = 1.6817928305074290f, LN_EPS = 1e-5f, LOG2E = 1.4426950408889634f, C2 = 0.125f * 1.4426950408889634f;
constexpr float SW_LIMIT = 7.0f, SW_ALPHA = 1.702f;
constexpr int NWAVES = 8, NTHR = 512;

constexpr size_t MiB = 1u << 20;
constexpr size_t WS_CTL = 0, CTL_ZERO_BYTES = 1 * MiB;
constexpr size_t WS_WIN = 2 * MiB;
constexpr size_t WS_WFG = WS_WIN + (size_t)4 * NPROJ * DM * 2;
constexpr size_t WS_WMKV = WS_WFG + 1 * MiB;
constexpr size_t WS_WO = WS_WMKV + 1 * MiB;
constexpr size_t WS_WGU = WS_WO + 8 * MiB;
constexpr size_t WS_WDN = WS_WGU + 512 * MiB;
constexpr size_t WS_HB = WS_WDN + 256 * MiB;
constexpr size_t WS_MEMB = WS_HB + 64 * MiB;
constexpr size_t WS_MKV = WS_MEMB + 2 * MiB;
constexpr size_t WS_PROJ = WS_MKV + 1 * MiB;
constexpr size_t WS_CFOX = WS_PROJ + 160 * MiB;
constexpr size_t WS_LF = WS_CFOX + 2 * MiB;
constexpr size_t WS_KBAR = WS_LF + 2 * MiB;
constexpr size_t WS_ATT = WS_KBAR + 1 * MiB;
constexpr size_t WS_ELIST = WS_ATT + 64 * MiB;
constexpr size_t WS_AGATE = WS_ELIST + 4 * MiB;
constexpr size_t WS_ABUF = WS_AGATE + 1 * MiB;
constexpr size_t WS_YBUF = WS_ABUF + 256 * MiB;
constexpr size_t WS_END = WS_YBUF + 256 * MiB;

constexpr int CW_ECNT = 1024;
constexpr int CW_BAR = 4096;
constexpr int NPHASE = 1 + 8 * DEPTH;

constexpr int LDS_BYTES = 147456, SCR_BYTES = 146432, MISC_OFF = SCR_BYTES;

__device__ __forceinline__ unsigned f2bf(float f) { unsigned u = __float_as_uint(f); return (u + 0x7fffu + ((u >> 16) & 1u)) >> 16; }
__device__ __forceinline__ unsigned pk2(float lo, float hi) { unsigned r; asm("v_cvt_pk_bf16_f32 %0, %1, %2" : "=v"(r) : "v"(lo), "v"(hi)); return r; }
__device__ __forceinline__ float bflo(unsigned w) { return __uint_as_float(w << 16); }
__device__ __forceinline__ float bfhi(unsigned w) { return __uint_as_float(w & 0xffff0000u); }
__device__ __forceinline__ float wave_sum(float v) {
    v += __builtin_bit_cast(float, __builtin_amdgcn_update_dpp(0, __builtin_bit_cast(int, v), 0xB1, 0xF, 0xF, false));
    v += __builtin_bit_cast(float, __builtin_amdgcn_update_dpp(0, __builtin_bit_cast(int, v), 0x4E, 0xF, 0xF, false));
    v += __builtin_bit_cast(float, __builtin_amdgcn_update_dpp(0, __builtin_bit_cast(int, v), 0x141, 0xF, 0xF, false));
    v += __builtin_bit_cast(float, __builtin_amdgcn_update_dpp(0, __builtin_bit_cast(int, v), 0x140, 0xF, 0xF, false));
    v += __builtin_bit_cast(float, __builtin_amdgcn_update_dpp(0, __builtin_bit_cast(int, v), 0x142, 0xA, 0xF, false));
    v += __builtin_bit_cast(float, __builtin_amdgcn_update_dpp(0, __builtin_bit_cast(int, v), 0x143, 0xC, 0xF, false));
    return __builtin_bit_cast(float, __builtin_amdgcn_readlane(__builtin_bit_cast(int, v), 63));
}
__device__ __forceinline__ float fexp2(float x) { return __builtin_amdgcn_exp2f(x); }
#define PH_IDS int lane; asm volatile("v_mbcnt_lo_u32_b32 %0, -1, 0\n\tv_mbcnt_hi_u32_b32 %0, -1, %0" : "=v"(lane)); const int wid = __builtin_amdgcn_readfirstlane(g_wid); const int tid = wid * 64 + lane; (void)tid

#define XB_TMO      128
#define XB_XCNT(j)  (256  + 64 * (j))
#define XB_XSUB(j)  (1280 + 64 * (j))
#define XB_XGEN(j)  (2304 + 64 * (j))
#define XB_TOP      3328
#define XB_TOPGEN   3392
#define XCD_BAR_WORDS 3456
#define XB_SPIN_CAP (1u << 22)
__device__ __forceinline__ unsigned xb_ld(unsigned* p)              { return __hip_atomic_load(p, __ATOMIC_RELAXED, __HIP_MEMORY_SCOPE_AGENT); }
__device__ __forceinline__ unsigned xb_add(unsigned* p, unsigned v) { return __hip_atomic_fetch_add(p, v, __ATOMIC_RELAXED, __HIP_MEMORY_SCOPE_AGENT); }
__device__ __forceinline__ unsigned xb_xcc_id() { return (unsigned)__builtin_amdgcn_s_getreg((3 << 11) | 20) & 0xFu; }
#define XB_SPIN(cond, bar) do { unsigned _sp = 0; while (cond) { __builtin_amdgcn_s_sleep(1); \
    if ((++_sp & 255u) == 0u) { if (xb_ld(&(bar)[XB_TMO])) break; if (_sp > XB_SPIN_CAP) { atomicAdd(&(bar)[XB_TMO], 1u); break; } } } } while (0)
struct XcdBarrier { unsigned* bar; unsigned x; volatile LAS unsigned* st; int wid; };
__device__ __forceinline__ bool xb_t0(int w) { int l; asm volatile("v_mbcnt_lo_u32_b32 %0, -1, 0\n\tv_mbcnt_hi_u32_b32 %0, -1, %0" : "=v"(l)); return w == 0 && l == 0; }
#define XB_T0(w) xb_t0(w)
__device__ __forceinline__ XcdBarrier xcd_barrier_post(unsigned* bar, volatile LAS unsigned* st, int wid) {
    XcdBarrier b; b.bar = bar; b.x = xb_xcc_id(); b.st = st; b.wid = wid;
    if (XB_T0(wid)) (void)xb_add(&bar[XB_XCNT(b.x)], 1u);
    return b;
}
__device__ __forceinline__ void xcd_barrier_complete(unsigned* bar, unsigned x, unsigned& nloc, unsigned& nx) {
    const unsigned G = gridDim.x * gridDim.y * gridDim.z;
    unsigned sum, cnt, mine, sp = 0u;
    for (;;) {
        sum = 0u; cnt = 0u; mine = 0u;
#pragma unroll
        for (unsigned j = 0; j < 16; ++j) { const unsigned c = xb_ld(&bar[XB_XCNT(j)]); sum += c; cnt += (c > 0u) ? 1u : 0u; mine = (j == x) ? c : mine; }
        if (sum == G) break;
        __builtin_amdgcn_s_sleep(1);
        if ((++sp & 255u) == 0u) { if (xb_ld(&bar[XB_TMO])) break; if (sp > XB_SPIN_CAP) { atomicAdd(&bar[XB_TMO], 1u); break; } }
    }
    nloc = mine > 0u ? mine : 1u; nx = cnt > 0u ? cnt : 1u;
}
__device__ __forceinline__ void xcd_barrier(const XcdBarrier& b) {
    asm volatile("s_waitcnt vmcnt(0)" ::: "memory");
    __syncthreads();
    if (XB_T0(b.wid)) {
        unsigned* bar = b.bar;
        __builtin_amdgcn_s_waitcnt(0);
        unsigned nloc = b.st[0], nx = b.st[1];
        if (nloc == 0u) { xcd_barrier_complete(bar, b.x, nloc, nx); b.st[0] = nloc; b.st[1] = nx; }
        const unsigned old = xb_add(&bar[XB_XSUB(b.x)], 1u);
        const unsigned gen = old / nloc;
        if (old + 1u == (gen + 1u) * nloc) {
            __builtin_amdgcn_fence(__ATOMIC_RELEASE, "agent");
            asm volatile("s_waitcnt vmcnt(0)" ::: "memory");
            const unsigned og = xb_add(&bar[XB_TOP], 1u);
            const unsigned tg = og / nx;
            if (og + 1u == (tg + 1u) * nx) xb_add(&bar[XB_TOPGEN], 1u);
            else XB_SPIN(xb_ld(&bar[XB_TOPGEN]) == tg, bar);
            __builtin_amdgcn_fence(__ATOMIC_ACQUIRE, "agent");
            xb_add(&bar[XB_XGEN(b.x)], 1u);
            asm volatile("s_waitcnt vmcnt(0)" ::: "memory");
        } else {
            XB_SPIN(xb_ld(&bar[XB_XGEN(b.x)]) == gen, bar);
            __builtin_amdgcn_fence(__ATOMIC_ACQUIRE, "agent");
            asm volatile("s_waitcnt vmcnt(0)" ::: "memory");
        }
    }
    __syncthreads();
}

struct Args { const float* in[17]; float* out; unsigned char* ws; int p_lo, p_hi; };
enum { I_X = 0, I_MEM, I_WIN_MOBA, I_WIN_FOX, I_BFG, I_WMKV, I_WO, I_LN1G, I_LN1B, I_RW, I_RB, I_WGU, I_BGU, I_WDN, I_BDN, I_LN2G, I_LN2B };

__device__ __forceinline__ Args load_args() {
#if defined(__HIP_DEVICE_COMPILE__)
    const __attribute__((address_space(4))) unsigned long long* p = (const __attribute__((address_space(4))) unsigned long long*)__builtin_amdgcn_kernarg_segment_ptr();
    asm volatile("" : "+s"(p));
    Args a;
#pragma unroll
    for (int i = 0; i < 17; ++i) a.in[i] = (const float*)(const GAS float*)p[i];
    a.out = (float*)(GAS float*)p[17]; a.ws = (unsigned char*)(GAS unsigned char*)p[18]; const unsigned long long w = p[19]; a.p_lo = (int)(unsigned)w; a.p_hi = (int)(unsigned)(w >> 32);
    return a;
#else
    return Args{};
#endif
}
__device__ __forceinline__ void cvt_item(const float* W, int pitch, int col0, int k0, bf16* WT, int drow0, LAS float* scr, int lane) {
    f32x4 v[16];
    const int a = lane >> 4, b4 = (lane & 15) * 4;
#pragma unroll
    for (int i = 0; i < 16; ++i) v[i] = *(const f32x4*)(W + (size_t)(k0 + 4 * i + a) * pitch + col0 + b4);
#pragma unroll
    for (int i = 0; i < 16; ++i) { LAS float* s = scr + (4 * i + a) * 65 + b4; s[0] = v[i].x; s[1] = v[i].y; s[2] = v[i].z; s[3] = v[i].w; }
    asm volatile("s_waitcnt lgkmcnt(0)" ::: "memory");
    const int c = lane & 7;
#pragma unroll
    for (int j = 0; j < 8; ++j) {
        const int n = (lane >> 3) + 8 * j; const LAS float* s = scr + (8 * c) * 65 + n;
        v4u o; o.x = pk2(s[0], s[65]); o.y = pk2(s[2 * 65], s[3 * 65]); o.z = pk2(s[4 * 65], s[5 * 65]); o.w = pk2(s[6 * 65], s[7 * 65]);
        *(v4u*)(WT + (size_t)(drow0 + n) * DM + k0 + 8 * c) = o;
    }
    asm volatile("s_waitcnt lgkmcnt(0)" ::: "memory");
}
__device__ __forceinline__ void ph_convert(const Args& A, LAS unsigned char* lds, int wg, int G, int g_wid) {
    PH_IDS;
    unsigned char* ws = A.ws;
    LAS float* scr = (LAS float*)(lds + wid * 16896);
    const int gw = wg * NWAVES + wid, NGW = G * NWAVES;
    constexpr int I_IN = 16 * 40;
    constexpr int I_MK = 16 * 8, I_O1 = 16 * 16, I_GU1 = 16 * 32, I_DN1 = 16 * 16;
    constexpr int N_IN = 4 * I_IN, N_MK = I_MK, N_O = 4 * I_O1, N_GU = 128 * I_GU1, N_DN = 128 * I_DN1;
    constexpr int NITEMS = N_IN + N_MK + N_O + N_GU + N_DN;
    for (int it = gw; it < NITEMS; it += NGW) {
        int r = it;
        if (r < N_IN) { const int l = r / I_IN, q = r % I_IN, kb = q / 40, nb = q % 40; const int j = l >> 1;
            const float* W = (l & 1) ? A.in[I_WIN_FOX] + (size_t)j * DM * (NPROJ + HS) : A.in[I_WIN_MOBA] + (size_t)j * DM * NPROJ;
            cvt_item(W, (l & 1) ? NPROJ + HS : NPROJ, 64 * nb, 64 * kb, (bf16*)(ws + WS_WIN) + (size_t)l * NPROJ * DM, 64 * nb, scr, lane); continue; }
        r -= N_IN;
        if (r < N_MK) { const int kb = r / 8, nb = r % 8; cvt_item(A.in[I_WMKV], 512, 64 * nb, 64 * kb, (bf16*)(ws + WS_WMKV), 64 * nb, scr, lane); continue; }
        r -= N_MK;
        if (r < N_O) { const int l = r / I_O1, q = r % I_O1, kb = q / 16, nb = q % 16;
            cvt_item(A.in[I_WO] + (size_t)l * DM * DM, DM, 64 * nb, 64 * kb, (bf16*)(ws + WS_WO) + (size_t)l * DM * DM, 64 * nb, scr, lane); continue; }
        r -= N_O;
        if (r < N_GU) { const int le = r / I_GU1, q = r % I_GU1, kb = q / 32, nb = q % 32; const int col0 = 64 * nb;
            const int cc = col0 & 1023, drow0 = (cc >> 7) * 256 + (cc & 127) + ((col0 >= 1024) ? 128 : 0);
            cvt_item(A.in[I_WGU] + (size_t)le * DM * 2048, 2048, col0, 64 * kb, (bf16*)(ws + WS_WGU) + (size_t)le * 2048 * DM, drow0, scr, lane); continue; }
        r -= N_GU;
        { const int le = r / I_DN1, q = r % I_DN1, kb = q / 16, nb = q % 16;
            cvt_item(A.in[I_WDN] + (size_t)le * DM * DM, DM, 64 * nb, 64 * kb, (bf16*)(ws + WS_WDN) + (size_t)le * DM * DM, 64 * nb, scr, lane); }
    }
    { const int gt = wg * NTHR + tid, NGT = G * NTHR;
      for (int i = gt; i < 2 * 16 * DM; i += NGT) { const int j = i / (16 * DM), hh = (i / DM) & 15, k = i % DM;
          const float v = hh < HS ? A.in[I_WIN_FOX][(size_t)j * DM * (NPROJ + HS) + (size_t)k * (NPROJ + HS) + NPROJ + hh] : 0.f;
          ((bf16*)(ws + WS_WFG))[i] = (bf16)f2bf(v); }
      for (size_t i = gt; i < (size_t)NTOK * DM / 8; i += NGT) { const f32x4 a = ((const f32x4*)A.in[I_X])[2 * i], b = ((const f32x4*)A.in[I_X])[2 * i + 1];
          v4u o; o.x = pk2(a.x, a.y); o.y = pk2(a.z, a.w); o.z = pk2(b.x, b.y); o.w = pk2(b.z, b.w); ((v4u*)(ws + WS_HB))[i] = o; }
      for (size_t i = gt; i < (size_t)NB * NMEM * DM / 8; i += NGT) { const f32x4 a = ((const f32x4*)A.in[I_MEM])[2 * i], b = ((const f32x4*)A.in[I_MEM])[2 * i + 1];
          v4u o; o.x = pk2(a.x, a.y); o.y = pk2(a.z, a.w); o.z = pk2(b.x, b.y); o.w = pk2(b.z, b.w); ((v4u*)(ws + WS_MEMB))[i] = o; }
    }
}

struct Unit { int pm, pn, e, rows; const bf16* B; const unsigned* list; };
struct DenseSched {
    const bf16* A; const bf16* Bt; int nM, nN, G, c;
    __device__ __forceinline__ bool next(int i, Unit& u) const {
        const int L = i * G + c; if (L >= nM * nN) return false;
        u.pm = L / nN; u.pn = L % nN; u.e = 0; u.rows = 256; u.B = Bt + (size_t)u.pn * 256 * DM; u.list = nullptr; return true; }
    __device__ __forceinline__ unsigned arow(const Unit& u, int r) const { return (unsigned)(u.pm * 256 + r); }
};
struct MoeSched {
    const bf16* A; const bf16* Bt; const unsigned* elist; const LAS int* tab; int nN, ntot, G, c, shift;
    __device__ __forceinline__ bool next(int i, Unit& u) const {
        const int L = i * G + c; const int total = __builtin_amdgcn_readfirstlane(tab[64 + 32]) * nN; if (L >= total) return false;
        u.pn = L % nN; const int g = L / nN;
        int ln; asm volatile("v_mbcnt_lo_u32_b32 %0, -1, 0\n\tv_mbcnt_hi_u32_b32 %0, -1, %0" : "=v"(ln));
        const int offv = tab[64 + (ln & 31)];
        const unsigned long long mk = __builtin_amdgcn_ballot_w64(ln < 32 && offv <= g);
        const int e = __builtin_popcountll(mk) - 1;
        u.e = e; u.pm = g - __builtin_amdgcn_readfirstlane(tab[64 + e]); const int rem = __builtin_amdgcn_readfirstlane(tab[e]) - 256 * u.pm; u.rows = rem < 256 ? rem : 256;
        u.B = Bt + ((size_t)e * ntot + (size_t)u.pn * 256) * DM; u.list = elist + (size_t)e * NTOK + 256 * u.pm; return true; }
    __device__ __forceinline__ unsigned arow(const Unit& u, int r) const { const unsigned rr = (unsigned)r < (unsigned)u.rows ? (unsigned)r : (unsigned)(u.rows - 1); return *(const unsigned*)((const char*)u.list + rr * 4u) >> shift; }
};
__device__ __forceinline__ void moe_tables(LAS int* tab, const unsigned* ecnt, int g_wid) {
    PH_IDS;
    if (tid == 0) { int acc = 0; for (int e = 0; e < 32; ++e) { const int c = (int)ecnt[e]; tab[e] = c; tab[64 + e] = acc; acc += (c + 255) >> 8; } tab[64 + 32] = acc; }
    __syncthreads();
}

struct EpiProj {
    bf16* O; int ldc, q_end, qm_begin;
    __device__ __forceinline__ void operator()(const f32x4 (&acc)[2][2][4][2], const Unit& u, int wr, int wc, int fr, int fq) const {
#pragma unroll
        for (int ai = 0; ai < 2; ++ai)
#pragma unroll
            for (int m = 0; m < 4; ++m) { const int row = u.pm * 256 + ai * 128 + wr * 64 + m * 16 + fr;
#pragma unroll
                for (int bj = 0; bj < 2; ++bj) { const int col = u.pn * 256 + bj * 128 + wc * 32 + 8 * fq; const float sc = (col < q_end || col >= qm_begin) ? C2 : 1.f;
                    const f32x4 v0 = acc[ai][bj][m][0] * sc, v1 = acc[ai][bj][m][1] * sc;
                    v4u w; w.x = pk2(v0.x, v0.y); w.y = pk2(v0.z, v0.w); w.z = pk2(v1.x, v1.y); w.w = pk2(v1.z, v1.w);
                    *(v4u*)((char*)O + (unsigned)(row * ldc + col) * 2u) = w; } }
    }
};
struct EpiOut {
    const float* base; float* out;
    __device__ __forceinline__ void operator()(const f32x4 (&acc)[2][2][4][2], const Unit& u, int wr, int wc, int fr, int fq) const {
#pragma unroll
        for (int ai = 0; ai < 2; ++ai)
#pragma unroll
            for (int m = 0; m < 4; ++m) { const int row = u.pm * 256 + ai * 128 + wr * 64 + m * 16 + fr;
#pragma unroll
                for (int bj = 0; bj < 2; ++bj) { const unsigned off = (unsigned)(row * DM + u.pn * 256 + bj * 128 + wc * 32 + 8 * fq) * 4u;
                    const f32x4 b0 = *(const f32x4*)((const char*)base + off), b1 = *(const f32x4*)((const char*)base + off + 16);
                    *(f32x4*)((char*)out + off) = b0 * ALPHA + acc[ai][bj][m][0]; *(f32x4*)((char*)out + off + 16) = b1 * ALPHA + acc[ai][bj][m][1]; } }
    }
};
__device__ __forceinline__ float swiglu(float g, float uu) {
    g = fminf(g, SW_LIMIT); uu = fminf(fmaxf(uu, -SW_LIMIT), SW_LIMIT);
    const float sg = __builtin_amdgcn_rcpf(1.f + fexp2(-SW_ALPHA * LOG2E * g));
    return g * sg * (uu + 1.f);
}
struct EpiGU {
    bf16* abuf; const float* bgu;
    __device__ __forceinline__ void operator()(const f32x4 (&acc)[2][2][4][2], const Unit& u, int wr, int wc, int fr, int fq) const {
        const int c0 = u.pn * 128 + wc * 32 + 8 * fq; const float* bg = bgu + (size_t)u.e * 2048 + c0;
        const f32x4 g0 = *(const f32x4*)bg, g1 = *(const f32x4*)(bg + 4), u0 = *(const f32x4*)(bg + 1024), u1 = *(const f32x4*)(bg + 1028);
#pragma unroll
        for (int ai = 0; ai < 2; ++ai)
#pragma unroll
            for (int m = 0; m < 4; ++m) { const int r = ai * 128 + wr * 64 + m * 16 + fr;
                if (r < u.rows) { const unsigned aid = *(const unsigned*)((const char*)u.list + (unsigned)r * 4u);
                    const f32x4 ga = acc[ai][0][m][0] + g0, gb = acc[ai][0][m][1] + g1, ua = acc[ai][1][m][0] + u0, ub = acc[ai][1][m][1] + u1;
                    v4u w; w.x = pk2(swiglu(ga.x, ua.x), swiglu(ga.y, ua.y)); w.y = pk2(swiglu(ga.z, ua.z), swiglu(ga.w, ua.w));
                    w.z = pk2(swiglu(gb.x, ub.x), swiglu(gb.y, ub.y)); w.w = pk2(swiglu(gb.z, ub.z), swiglu(gb.w, ub.w));
                    *(v4u*)((char*)abuf + (aid * (unsigned)DM + (unsigned)c0) * 2u) = w; } }
    }
};
struct EpiDN {
    bf16* ybuf; const float* bdn; const float* agate;
    __device__ __forceinline__ void operator()(const f32x4 (&acc)[2][2][4][2], const Unit& u, int wr, int wc, int fr, int fq) const {
        f32x4 bv[2][2];
#pragma unroll
        for (int bj = 0; bj < 2; ++bj) { const float* bp = bdn + (size_t)u.e * DM + u.pn * 256 + bj * 128 + wc * 32 + 8 * fq; bv[bj][0] = *(const f32x4*)bp; bv[bj][1] = *(const f32x4*)(bp + 4); }
#pragma unroll
        for (int ai = 0; ai < 2; ++ai)
#pragma unroll
            for (int m = 0; m < 4; ++m) { const int r = ai * 128 + wr * 64 + m * 16 + fr;
                if (r < u.rows) { const unsigned aid = *(const unsigned*)((const char*)u.list + (unsigned)r * 4u); const float gt = *(const float*)((const char*)agate + aid * 4u);
#pragma unroll
                    for (int bj = 0; bj < 2; ++bj) { const f32x4 v0 = (acc[ai][bj][m][0] + bv[bj][0]) * gt, v1 = (acc[ai][bj][m][1] + bv[bj][1]) * gt;
                        v4u w; w.x = pk2(v0.x, v0.y); w.y = pk2(v0.z, v0.w); w.z = pk2(v1.x, v1.y); w.w = pk2(v1.z, v1.w);
                        *(v4u*)((char*)ybuf + (aid * (unsigned)DM + (unsigned)(u.pn * 256 + bj * 128 + wc * 32 + 8 * fq)) * 2u) = w; } } }
    }
};

template <class Epi, class Sched>
__device__ __forceinline__ void gemm_simple(const Sched& S, const Epi& E, int g_wid) {
    PH_IDS;
    const int wr = wid >> 2, wc = wid & 3, fr = lane & 15, fq = lane >> 4;
    Unit u;
    for (int i = 0; S.next(i, u); ++i) {
        f32x4 acc[2][2][4][2];
#pragma unroll
        for (int a = 0; a < 2; ++a)
#pragma unroll
            for (int b = 0; b < 2; ++b)
#pragma unroll
                for (int m = 0; m < 4; ++m)
#pragma unroll
                    for (int n = 0; n < 2; ++n) acc[a][b][m][n] = (f32x4){0.f, 0.f, 0.f, 0.f};
        unsigned aoff[2][4], boff[2][2];
#pragma unroll
        for (int ai = 0; ai < 2; ++ai)
#pragma unroll
            for (int m = 0; m < 4; ++m) aoff[ai][m] = S.arow(u, ai * 128 + wr * 64 + m * 16 + fr) * DM + 8 * fq;
#pragma unroll
        for (int bj = 0; bj < 2; ++bj)
#pragma unroll
            for (int n = 0; n < 2; ++n) boff[bj][n] = (unsigned)(bj * 128 + wc * 32 + 8 * (fr >> 2) + 4 * n + (fr & 3)) * DM + 8 * fq;
#pragma unroll 1
        for (int k0 = 0; k0 < DM; k0 += 32) {
            bf16x8 b[2][2];
#pragma unroll
            for (int bj = 0; bj < 2; ++bj)
#pragma unroll
                for (int n = 0; n < 2; ++n) b[bj][n] = *(const bf16x8*)(u.B + boff[bj][n] + k0);
#pragma unroll
            for (int ai = 0; ai < 2; ++ai) {
                bf16x8 a[4];
#pragma unroll
                for (int m = 0; m < 4; ++m) a[m] = *(const bf16x8*)(S.A + aoff[ai][m] + k0);
#pragma unroll
                for (int bj = 0; bj < 2; ++bj)
#pragma unroll
                    for (int m = 0; m < 4; ++m)
#pragma unroll
                        for (int n = 0; n < 2; ++n) acc[ai][bj][m][n] = __builtin_amdgcn_mfma_f32_16x16x32_bf16(b[bj][n], a[m], acc[ai][bj][m][n], 0, 0, 0);
            }
        }
        E(acc, u, wr, wc, fr, fq);
    }
}


namespace pg8 {
constexpr int BM = 256, BK = 64, HALF = 128, HTB = HALF * BK * 2, STAGE_BYTES = 8 * HTB;
__device__ __forceinline__ int lds_byte(int r, int c) { const int st = (r >> 4) * 2 + (c >> 5), rr = r & 15, cc = c & 31, ob = rr * 64 + cc * 2; return st * 1024 + (ob ^ (((ob >> 9) & 1) << 5)); }
__device__ __forceinline__ void stage_rc(int b, int& R, int& C) { const int st = b / 1024, sb = b % 1024, swz = sb ^ (((sb >> 9) & 1) << 5); R = (st >> 1) * 16 + swz / 64; C = (st & 1) * 32 + (swz % 64) / 2; }
__device__ __forceinline__ int perm32(int rho) { const int n = rho >> 4, i = rho & 15; return 8 * (i >> 2) + 4 * n + (i & 3); }
}
template <class Epi, class Sched, bool ALIGN_EPI>
__device__ __forceinline__ void gemm_fast(LAS unsigned char* lds, const Sched& S, const Epi& E, int g_wid) {
    using namespace pg8;
    PH_IDS;
    const int wr = wid >> 2, wc = wid & 3, fr = lane & 15, fq = lane >> 4;
    constexpr int K = DM, nt = K / BK;
    int Rr[2], Cc[2]; unsigned voffB[2];
#pragma unroll
    for (int i = 0; i < 2; ++i) { int R, C; stage_rc(tid * 16 + i * 8192, R, C); Rr[i] = R; Cc[i] = C; const int Rb = (R & ~31) + perm32(R & 31); voffB[i] = (unsigned)(Rb * K + C) * 2u; }
    constexpr unsigned kstep = BK * 2, hstep = HALF * K * 2;
    const unsigned ldsw = (unsigned)wid * 1024u;
    const int aoff = lds_byte(wr * 64 + fr, fq * 8), boff = lds_byte(wc * 32 + fr, fq * 8);
    const char* Ab = (const char*)S.A;
#define PG8_SA(b, h) (((b) * 2 + (h)) * HTB)
#define PG8_SB(b, h) ((4 + (b) * 2 + (h)) * HTB)
#define PG8_STAGEB(bufoff, gbase) do { _Pragma("unroll") for (int _i = 0; _i < 2; ++_i) \
        __builtin_amdgcn_global_load_lds((const unsigned*)((const char*)(gbase) + voffB[_i]), (LAS unsigned*)(lds + (bufoff) + ldsw + _i * 8192), 16, 0, 0); } while (0)
#define PG8_STAGEA(bufoff, kb, vo) do { _Pragma("unroll") for (int _i = 0; _i < 2; ++_i) \
        __builtin_amdgcn_global_load_lds((const unsigned*)(Ab + (size_t)(kb) + (vo)[_i]), (LAS unsigned*)(lds + (bufoff) + ldsw + _i * 8192), 16, 0, 0); } while (0)
#define PG8_LDA(dst, b, h) do { _Pragma("unroll") for (int m = 0; m < 4; ++m) _Pragma("unroll") for (int k = 0; k < 2; ++k) dst[m][k] = *(const LAS bf16x8*)(lds + PG8_SA(b, h) + aoff + m * 2048 + k * 1024); } while (0)
#define PG8_LDB(dst, b, h) do { _Pragma("unroll") for (int n = 0; n < 2; ++n) _Pragma("unroll") for (int k = 0; k < 2; ++k) dst[n][k] = *(const LAS bf16x8*)(lds + PG8_SB(b, h) + boff + n * 2048 + k * 1024); } while (0)
#define PG8_MMA(ai, bj, At, Bt) do { __builtin_amdgcn_s_setprio(1); _Pragma("unroll") for (int m = 0; m < 4; ++m) _Pragma("unroll") for (int n = 0; n < 2; ++n) _Pragma("unroll") for (int k = 0; k < 2; ++k) \
        acc[ai][bj][m][n] = __builtin_amdgcn_mfma_f32_16x16x32_bf16(Bt[n][k], At[m][k], acc[ai][bj][m][n], 0, 0, 0); __builtin_amdgcn_s_setprio(0); } while (0)
#define PG8_WAIT_V(n) asm volatile("s_waitcnt vmcnt(" #n ")" ::: "memory")
#define PG8_WAIT_L(n) asm volatile("s_waitcnt lgkmcnt(" #n ")" ::: "memory")
#define PG8_BAR __builtin_amdgcn_s_barrier()
#define PG8_SCHED __builtin_amdgcn_sched_barrier(0)
#define PG8_OFFS(dst, un) do { _Pragma("unroll") for (int _h = 0; _h < 2; ++_h) _Pragma("unroll") for (int _i = 0; _i < 2; ++_i) dst[_h][_i] = (S.arow(un, _h * 128 + Rr[_i]) * (unsigned)K + (unsigned)Cc[_i]) * 2u; } while (0)
    Unit cur, nxt; int ui = 0;
    if (!S.next(0, cur)) return;
    f32x4 acc[2][2][4][2];
#pragma unroll
    for (int a = 0; a < 2; ++a)
#pragma unroll
        for (int b = 0; b < 2; ++b)
#pragma unroll
            for (int m = 0; m < 4; ++m)
#pragma unroll
                for (int n = 0; n < 2; ++n) acc[a][b][m][n] = (f32x4){0.f, 0.f, 0.f, 0.f};
    bf16x8 At[4][2], B0[2][2], B1[2][2];
    unsigned vA[2][2], vN[2][2];
    PG8_OFFS(vA, cur);
    const char* cB = (const char*)cur.B;
    PG8_STAGEB(PG8_SB(0, 0), cB); PG8_STAGEB(PG8_SB(0, 1), cB + hstep); PG8_STAGEA(PG8_SA(0, 0), 0, vA[0]); PG8_STAGEA(PG8_SA(0, 1), 0, vA[1]);
    if (wr == 1) PG8_BAR;
    PG8_WAIT_V(2); PG8_BAR;
    PG8_STAGEB(PG8_SB(1, 0), cB + kstep); PG8_STAGEA(PG8_SA(1, 0), kstep, vA[0]); PG8_STAGEB(PG8_SB(1, 1), cB + hstep + kstep);
    PG8_WAIT_V(6); PG8_BAR;
    for (;;) {
        const bool has_next = S.next(ui + 1, nxt);
        if (has_next) { PG8_OFFS(vN, nxt); } else {
#pragma unroll
            for (int h = 0; h < 2; ++h)
#pragma unroll
                for (int i = 0; i < 2; ++i) vN[h][i] = vA[h][i]; }
        const char* nB = has_next ? (const char*)nxt.B : cB;
#define PG8_KSTEP(LAST, t) do { \
            const unsigned kb1 = (unsigned)((t) + 1) * kstep, kb2 = (LAST) ? 0u : (unsigned)((t) + 2) * kstep, kb3 = kb2 + kstep; \
            const char* b2 = (LAST) ? nB : cB + (size_t)((t) + 2) * kstep; const char* b3 = b2 + kstep; \
            PG8_LDB(B0, 0, 0); PG8_LDB(B1, 0, 1); PG8_SCHED; PG8_LDA(At, 0, 0); PG8_STAGEA(PG8_SA(1, 1), kb1, vA[1]); \
            PG8_WAIT_V(8); PG8_WAIT_L(0); PG8_BAR; PG8_MMA(0, 0, At, B0); PG8_MMA(0, 1, At, B1); PG8_BAR; PG8_SCHED; \
            PG8_LDA(At, 0, 1); PG8_STAGEB(PG8_SB(0, 0), b2); PG8_STAGEB(PG8_SB(0, 1), b2 + hstep); if (LAST) { PG8_STAGEA(PG8_SA(0, 0), kb2, vN[0]); } else { PG8_STAGEA(PG8_SA(0, 0), kb2, vA[0]); } \
            PG8_WAIT_V(8); PG8_WAIT_L(0); PG8_BAR; PG8_MMA(1, 0, At, B0); PG8_MMA(1, 1, At, B1); PG8_BAR; PG8_SCHED; \
            PG8_LDB(B0, 1, 0); PG8_LDB(B1, 1, 1); PG8_SCHED; PG8_LDA(At, 1, 0); if (LAST) { PG8_STAGEA(PG8_SA(0, 1), kb2, vN[1]); } else { PG8_STAGEA(PG8_SA(0, 1), kb2, vA[1]); } \
            PG8_WAIT_V(8); PG8_WAIT_L(0); PG8_BAR; PG8_MMA(0, 0, At, B0); PG8_MMA(0, 1, At, B1); PG8_BAR; PG8_SCHED; \
            PG8_LDA(At, 1, 1); PG8_STAGEB(PG8_SB(1, 0), b3); PG8_STAGEB(PG8_SB(1, 1), b3 + hstep); if (LAST) { PG8_STAGEA(PG8_SA(1, 0), kb3, vN[0]); } else { PG8_STAGEA(PG8_SA(1, 0), kb3, vA[0]); } \
            PG8_WAIT_V(8); PG8_WAIT_L(0); PG8_BAR; PG8_MMA(1, 0, At, B0); PG8_MMA(1, 1, At, B1); PG8_BAR; PG8_SCHED; } while (0)
        for (int t = 0; t < nt - 2; t += 2) PG8_KSTEP(false, t);
        PG8_KSTEP(true, nt - 2);
#undef PG8_KSTEP
        if constexpr (ALIGN_EPI) { if (wr == 0) PG8_BAR; }
        { int fr_e = fr, fq_e = fq; asm volatile("" : "+v"(fr_e), "+v"(fq_e));
          E(acc, cur, wr, wc, fr_e, fq_e); }
        if (!has_next) break;
#pragma unroll
        for (int a = 0; a < 2; ++a)
#pragma unroll
            for (int b = 0; b < 2; ++b)
#pragma unroll
                for (int m = 0; m < 4; ++m)
#pragma unroll
                    for (int n = 0; n < 2; ++n) acc[a][b][m][n] = (f32x4){0.f, 0.f, 0.f, 0.f};
        cur = nxt; cB = nB; ++ui;
#pragma unroll
        for (int h = 0; h < 2; ++h)
#pragma unroll
            for (int i = 0; i < 2; ++i) vA[h][i] = vN[h][i];
        if constexpr (ALIGN_EPI) { if (wr == 1) PG8_BAR; }
    }
    PG8_WAIT_V(0);
    if constexpr (!ALIGN_EPI) { if (wr == 0) PG8_BAR; }
    PG8_BAR;
#undef PG8_SA
#undef PG8_SB
#undef PG8_STAGEA
#undef PG8_STAGEB
#undef PG8_LDA
#undef PG8_LDB
#undef PG8_MMA
#undef PG8_WAIT_V
#undef PG8_WAIT_L
#undef PG8_BAR
#undef PG8_SCHED
#undef PG8_OFFS
}

__device__ __forceinline__ void ph_fox_gate(const Args& A, int j, int wg, int G, int g_wid) {
    PH_IDS;
    const bf16* hb = (const bf16*)(A.ws + WS_HB); const bf16* wfg = (const bf16*)(A.ws + WS_WFG) + (size_t)j * 16 * DM; float* lf = (float*)(A.ws + WS_LF);
    const float* bfg = A.in[I_BFG] + j * HS;
    const int gw = wg * NWAVES + wid, NGW = G * NWAVES;
    for (int n = gw; n < NTOK; n += NGW) {
        const v4u* hp = (const v4u*)(hb + (size_t)n * DM + 16 * lane); const v4u h0 = hp[0], h1 = hp[1];
        float hv[16] = {bflo(h0.x), bfhi(h0.x), bflo(h0.y), bfhi(h0.y), bflo(h0.z), bfhi(h0.z), bflo(h0.w), bfhi(h0.w), bflo(h1.x), bfhi(h1.x), bflo(h1.y), bfhi(h1.y), bflo(h1.z), bfhi(h1.z), bflo(h1.w), bfhi(h1.w)};
        float mine = 0.f;
#pragma unroll
        for (int hh = 0; hh < HS; ++hh) {
            const v4u* wp = (const v4u*)(wfg + (size_t)hh * DM + 16 * lane); const v4u w0 = wp[0], w1 = wp[1];
            float s = hv[0] * bflo(w0.x) + hv[1] * bfhi(w0.x) + hv[2] * bflo(w0.y) + hv[3] * bfhi(w0.y) + hv[4] * bflo(w0.z) + hv[5] * bfhi(w0.z) + hv[6] * bflo(w0.w) + hv[7] * bfhi(w0.w)
                    + hv[8] * bflo(w1.x) + hv[9] * bfhi(w1.x) + hv[10] * bflo(w1.y) + hv[11] * bfhi(w1.y) + hv[12] * bflo(w1.z) + hv[13] * bfhi(w1.z) + hv[14] * bflo(w1.w) + hv[15] * bfhi(w1.w);
            s = wave_sum(s);
            if (lane == hh) mine = s;
        }
        if (lane < HS) { const float z = mine + bfg[lane];
            const float ls = fminf(z, 0.f) - __builtin_amdgcn_logf(1.f + fexp2(-fabsf(z) * LOG2E)) * 0.6931471805599453f;
            const int b = n >> 13, t = n & (SEQ - 1); lf[((size_t)(b * HS + lane)) * SEQ + t] = ls; }
    }
}
__device__ __forceinline__ void ph_fox_scan(const Args& A, LAS unsigned char* lds, int wg, int G, int g_wid) {
    PH_IDS;
    const float* lf = (const float*)(A.ws + WS_LF); float* c2 = (float*)(A.ws + WS_CFOX); LAS float* part = (LAS float*)lds;
    for (int s = wg; s < NB * HS; s += G) {
        const float* src = lf + (size_t)s * SEQ + tid * 16; float v[16]; float run = 0.f;
#pragma unroll
        for (int i = 0; i < 16; ++i) { run += src[i]; v[i] = run; }
        part[tid] = run; __syncthreads();
        if (tid == 0) { float acc = 0.f; for (int i = 0; i < NTHR; ++i) { const float x = part[i]; part[i] = acc; acc += x; } }
        __syncthreads();
        const float base = part[tid]; float* dst = c2 + (size_t)s * SEQ + tid * 16;
#pragma unroll
        for (int i = 0; i < 16; ++i) dst[i] = (base + v[i]) * LOG2E;
        __syncthreads();
    }
}
__device__ __forceinline__ void ph_kbar(const Args& A, LAS unsigned char* lds, int wg, int G, int g_wid) {
    PH_IDS;
    const bf16* proj = (const bf16*)(A.ws + WS_PROJ); float* kbar = (float*)(A.ws + WS_KBAR); LAS float* part = (LAS float*)lds;
    const int d = tid & 63, r8 = tid >> 6;
    for (int uidx = wg; uidx < NB * HS * 32; uidx += G) {
        const int j = uidx & 31, bh = uidx >> 5, b = bh / HS, h = bh % HS;
        const bf16* kp = proj + ((size_t)(b * SEQ + j * 256 + r8 * 32)) * NPROJ + K_COL + h * 64 + d;
        float s = 0.f;
        for (int r = 0; r < 32; ++r) s += __uint_as_float((unsigned)kp[(size_t)r * NPROJ] << 16);
        part[tid] = s; __syncthreads();
        if (tid < 64) { float t = 0.f;
#pragma unroll
            for (int q = 0; q < 8; ++q) t += part[q * 64 + tid];
            kbar[(size_t)uidx * 64 + tid] = t * (1.f / 256.f); }
        __syncthreads();
    }
}

__device__ __forceinline__ float alibi_slope(int h) { return h < 8 ? exp2f(-(float)(h + 1)) : exp2f(-(0.5f + (float)(h - 8))); }
#define ROW8(w, base, arr) do { arr[base + 0] = bflo(w.x); arr[base + 1] = bfhi(w.x); arr[base + 2] = bflo(w.y); arr[base + 3] = bfhi(w.y); arr[base + 4] = bflo(w.z); arr[base + 5] = bfhi(w.z); arr[base + 6] = bflo(w.w); arr[base + 7] = bfhi(w.w); } while (0)
__device__ __forceinline__ float dot_row64(const float (&q)[64], const bf16* p) {
    const v4u* p4 = (const v4u*)p; float s0 = 0.f, s1 = 0.f;
#pragma unroll
    for (int i = 0; i < 8; ++i) { if (i == 4) asm volatile("" ::: "memory"); const v4u w = p4[i];
        s0 += q[8 * i + 0] * bflo(w.x); s1 += q[8 * i + 1] * bfhi(w.x); s0 += q[8 * i + 2] * bflo(w.y); s1 += q[8 * i + 3] * bfhi(w.y);
        s0 += q[8 * i + 4] * bflo(w.z); s1 += q[8 * i + 5] * bfhi(w.z); s0 += q[8 * i + 6] * bflo(w.w); s1 += q[8 * i + 7] * bfhi(w.w); }
    return s0 + s1;
}
__device__ __forceinline__ void att_upd(float x, const bf16* vrow, float& m, float& l, float (&o)[64]) {
    const float mn = fmaxf(m, x), al = fexp2(m - mn), pp = fexp2(x - mn); m = mn; l = l * al + pp;
    const v4u* p4 = (const v4u*)vrow; asm volatile("" ::: "memory");
#pragma unroll
    for (int i = 0; i < 8; ++i) { if ((i & 1) == 0) asm volatile("" ::: "memory"); const v4u w = p4[i];
        o[8 * i + 0] = o[8 * i + 0] * al + pp * bflo(w.x); o[8 * i + 1] = o[8 * i + 1] * al + pp * bfhi(w.x); o[8 * i + 2] = o[8 * i + 2] * al + pp * bflo(w.y); o[8 * i + 3] = o[8 * i + 3] * al + pp * bfhi(w.y);
        o[8 * i + 4] = o[8 * i + 4] * al + pp * bflo(w.z); o[8 * i + 5] = o[8 * i + 5] * al + pp * bfhi(w.z); o[8 * i + 6] = o[8 * i + 6] * al + pp * bflo(w.w); o[8 * i + 7] = o[8 * i + 7] * al + pp * bfhi(w.w); }
}
template <int MODE>
__device__ __forceinline__ void ph_attn_naive(const Args& A, int wg, int G, int g_wid) {
    PH_IDS;
    const bf16* proj = (const bf16*)(A.ws + WS_PROJ); const bf16* mkv = (const bf16*)(A.ws + WS_MKV); bf16* att = (bf16*)(A.ws + WS_ATT);
    const float* kbar = (const float*)(A.ws + WS_KBAR); const float* cfox = (const float*)(A.ws + WS_CFOX);
    constexpr int NIT = 16 * (NTOK / 64);
    const int gw = wg * NWAVES + wid, NGW = G * NWAVES;
    for (int base = 0, rnd = 0; base < NIT; base += NGW, ++rnd) {
        const int it = base + ((rnd & 1) ? (NGW - 1 - gw) : gw);
        if (it >= NIT) continue;
        const int hh = it & 15, tg = it >> 4, n = tg * 64 + lane, b = n >> 13, t = n & (SEQ - 1);
        float q[64];
        { const v4u* p4 = (const v4u*)(proj + (size_t)n * NPROJ + (hh < HS ? hh * 64 : QM_COL + (hh - HS) * 64));
#pragma unroll
          for (int i = 0; i < 8; ++i) { const v4u w = p4[i]; ROW8(w, 8 * i, q); } }
        float m = -1e30f, l = 0.f; float o[64];
#pragma unroll
        for (int i = 0; i < 64; ++i) o[i] = 0.f;
        if (hh < HS) {
            const bf16* Kb = proj + (size_t)(b * SEQ) * NPROJ + K_COL + hh * 64; const bf16* Vb = Kb + (V_COL - K_COL);
            if (MODE == 0) {
                const float slope2 = alibi_slope(hh) * LOG2E; const int qb = t >> 8;
                const float* kb = kbar + (size_t)((b * HS + hh) * 32) * 64;
                float g0 = -INFINITY, g1 = -INFINITY, g2 = -INFINITY; int i0 = -1, i1 = -1, i2 = -1;
                for (int j = 0; j < qb; ++j) { float s0 = 0.f, s1 = 0.f;
#pragma unroll
                    for (int d = 0; d < 64; d += 2) { s0 += q[d] * kb[j * 64 + d]; s1 += q[d + 1] * kb[j * 64 + d + 1]; }
                    const float g = s0 + s1;
                    if (g > g0) { g2 = g1; i2 = i1; g1 = g0; i1 = i0; g0 = g; i0 = j; } else if (g > g1) { g2 = g1; i2 = i1; g1 = g; i1 = j; } else if (g > g2) { g2 = g; i2 = j; } }
                const int tend = (t | 63);
                for (int s = qb * 256; s <= tend; ++s) { if (s <= t) { const float x = dot_row64(q, Kb + (size_t)s * NPROJ) - slope2 * (float)(t - s); att_upd(x, Vb + (size_t)s * NPROJ, m, l, o); } }
                for (int sl = 0; sl < 3; ++sl) { const int jb = sl == 0 ? i0 : (sl == 1 ? i1 : i2);
                    if (jb >= 0) for (int s = 0; s < 256; ++s) { const int key = jb * 256 + s; const float x = dot_row64(q, Kb + (size_t)key * NPROJ) - slope2 * (float)(t - key); att_upd(x, Vb + (size_t)key * NPROJ, m, l, o); } }
            } else {
                const float* c2 = cfox + (size_t)(b * HS + hh) * SEQ; const float cq = c2[t]; const int tend = (t | 63);
                for (int s = 0; s <= tend; ++s) { if (s <= t) { const float x = dot_row64(q, Kb + (size_t)s * NPROJ) + (cq - c2[s]); att_upd(x, Vb + (size_t)s * NPROJ, m, l, o); } }
            }
        } else {
            const bf16* Kb = mkv + (size_t)(b * NMEM) * 512 + (hh - HS) * 64; const bf16* Vb = Kb + 256;
            for (int s = 0; s < NMEM; ++s) { const float x = dot_row64(q, Kb + (size_t)s * 512); att_upd(x, Vb + (size_t)s * 512, m, l, o); }
        }
        const float rl = 1.f / l; v4u* op = (v4u*)(att + (size_t)n * DM + hh * 64);
#pragma unroll
        for (int i = 0; i < 8; ++i) { v4u w; w.x = pk2(o[8 * i] * rl, o[8 * i + 1] * rl); w.y = pk2(o[8 * i + 2] * rl, o[8 * i + 3] * rl); w.z = pk2(o[8 * i + 4] * rl, o[8 * i + 5] * rl); w.w = pk2(o[8 * i + 6] * rl, o[8 * i + 7] * rl); op[i] = w; }
    }
}

__device__ __forceinline__ void ph_ln1_router(const Args& A, int layer, LAS unsigned char* lds, int wg, int G, int g_wid) {
    PH_IDS;
    float* hres = A.out; bf16* hb = (bf16*)(A.ws + WS_HB); unsigned* elist = (unsigned*)(A.ws + WS_ELIST); float* agate = (float*)(A.ws + WS_AGATE);
    unsigned* ecnt = (unsigned*)(A.ws + WS_CTL) + CW_ECNT + layer * 64;
    const float* rw = A.in[I_RW] + (size_t)layer * DM * NEXP; const float* rb = A.in[I_RB] + layer * NEXP;
    const float* g1 = A.in[I_LN1G] + layer * DM; const float* b1 = A.in[I_LN1B] + layer * DM;
    LAS float* rwT = (LAS float*)lds; LAS int* lcnt = (LAS int*)(lds + 131072); LAS int* gbase = lcnt + 32; LAS unsigned* rec = (LAS unsigned*)(lds + 131584);
    const int RPW = (NTOK + G - 1) / G;
    for (int i = tid; i < DM * NEXP; i += NTHR) rwT[(i & 31) * DM + (i >> 5)] = rw[i];
    if (tid < 32) lcnt[tid] = 0;
    __syncthreads();
    const int row0 = wg * RPW, row1 = (row0 + RPW < NTOK) ? row0 + RPW : NTOK;
    for (int n = row0 + wid; n < row1; n += NWAVES) {
        f32x4 v[4]; float s = 0.f; float* xr = hres + (size_t)n * DM;
#pragma unroll
        for (int j = 0; j < 4; ++j) { v[j] = *(const f32x4*)(xr + 4 * lane + 256 * j); s += (v[j].x + v[j].y) + (v[j].z + v[j].w); }
        const float mean = wave_sum(s) * (1.f / DM); float s2 = 0.f;
#pragma unroll
        for (int j = 0; j < 4; ++j) { v[j] = v[j] - mean; s2 += (v[j].x * v[j].x + v[j].y * v[j].y) + (v[j].z * v[j].z + v[j].w * v[j].w); }
        const float rstd = 1.f / sqrtf(wave_sum(s2) * (1.f / DM) + LN_EPS);
#pragma unroll
        for (int j = 0; j < 4; ++j) { const f32x4 gg = *(const f32x4*)(g1 + 4 * lane + 256 * j), bb = *(const f32x4*)(b1 + 4 * lane + 256 * j);
            v[j] = v[j] * rstd * gg + bb; *(f32x4*)(xr + 4 * lane + 256 * j) = v[j];
            v2u w; w.x = pk2(v[j].x, v[j].y); w.y = pk2(v[j].z, v[j].w); *(v2u*)(hb + (size_t)n * DM + 4 * lane + 256 * j) = w; }
        float lg[32];
#pragma unroll
        for (int e = 0; e < 32; ++e) { float p = 0.f;
#pragma unroll
            for (int j = 0; j < 4; ++j) { const f32x4 r4 = *(const LAS f32x4*)(rwT + e * DM + 4 * lane + 256 * j); p += (v[j].x * r4.x + v[j].y * r4.y) + (v[j].z * r4.z + v[j].w * r4.w); }
            lg[e] = wave_sum(p) + rb[e]; asm volatile("" ::: "memory"); }
        float tv[4]; int ti[4];
#pragma unroll
        for (int k = 0; k < 4; ++k) { float best = -INFINITY; int bi = 0;
#pragma unroll
            for (int e = 0; e < 32; ++e) { if (lg[e] > best) { best = lg[e]; bi = e; } }
            tv[k] = best; ti[k] = bi;
#pragma unroll
            for (int e = 0; e < 32; ++e) if (e == bi) lg[e] = -INFINITY; }
        const float e1 = expf(tv[1] - tv[0]), e2 = expf(tv[2] - tv[0]), e3 = expf(tv[3] - tv[0]); const float inv = 1.f / (1.f + e1 + e2 + e3);
        if (lane < 4) { const int ek = lane == 0 ? ti[0] : lane == 1 ? ti[1] : lane == 2 ? ti[2] : ti[3]; const float gk = (lane == 0 ? 1.f : lane == 1 ? e1 : lane == 2 ? e2 : e3) * inv;
            const int lp = atomicAdd((int*)lcnt + ek, 1);
            const int ri = (n - row0) * 4 + lane; rec[2 * ri] = (unsigned)ek | ((unsigned)lp << 8); rec[2 * ri + 1] = __float_as_uint(gk); }
    }
    __syncthreads();
    if (tid < 32) gbase[tid] = (int)__hip_atomic_fetch_add(ecnt + tid, (unsigned)lcnt[tid], __ATOMIC_RELAXED, __HIP_MEMORY_SCOPE_AGENT);
    __syncthreads();
    for (int ri = tid; ri < (row1 - row0) * 4; ri += NTHR) { const unsigned w = rec[2 * ri]; const int e = w & 31, lp = w >> 8; const unsigned aid = (unsigned)(row0 * 4 + ri);
        elist[(size_t)e * NTOK + gbase[e] + lp] = aid; agate[aid] = __uint_as_float(rec[2 * ri + 1]); }
    __syncthreads();
}

__device__ __forceinline__ void ph_combine_ln2(const Args& A, int layer, int wg, int G, int g_wid) {
    PH_IDS;
    float* hres = A.out; bf16* hb = (bf16*)(A.ws + WS_HB); const bf16* ybuf = (const bf16*)(A.ws + WS_YBUF);
    const float* g2 = A.in[I_LN2G] + layer * DM; const float* b2 = A.in[I_LN2B] + layer * DM;
    const int gw = wg * NWAVES + wid, NGW = G * NWAVES;
    for (int n = gw; n < NTOK; n += NGW) {
        f32x4 v[4]; float s = 0.f; float* xr = hres + (size_t)n * DM;
#pragma unroll
        for (int j = 0; j < 4; ++j) { v[j] = *(const f32x4*)(xr + 4 * lane + 256 * j) * ALPHA;
#pragma unroll
            for (int k = 0; k < 4; ++k) { const v2u w = *(const v2u*)(ybuf + ((size_t)n * 4 + k) * DM + 4 * lane + 256 * j); v[j].x += bflo(w.x); v[j].y += bfhi(w.x); v[j].z += bflo(w.y); v[j].w += bfhi(w.y); }
            s += (v[j].x + v[j].y) + (v[j].z + v[j].w); }
        const float mean = wave_sum(s) * (1.f / DM); float s2 = 0.f;
#pragma unroll
        for (int j = 0; j < 4; ++j) { v[j] = v[j] - mean; s2 += (v[j].x * v[j].x + v[j].y * v[j].y) + (v[j].z * v[j].z + v[j].w * v[j].w); }
        const float rstd = 1.f / sqrtf(wave_sum(s2) * (1.f / DM) + LN_EPS);
#pragma unroll
        for (int j = 0; j < 4; ++j) { const f32x4 gg = *(const f32x4*)(g2 + 4 * lane + 256 * j), bb = *(const f32x4*)(b2 + 4 * lane + 256 * j);
            v[j] = v[j] * rstd * gg + bb; *(f32x4*)(xr + 4 * lane + 256 * j) = v[j];
            v2u w; w.x = pk2(v[j].x, v[j].y); w.y = pk2(v[j].z, v[j].w); *(v2u*)(hb + (size_t)n * DM + 4 * lane + 256 * j) = w; }
    }
}

#define IN(k) (lo <= (k) && (k) < hi)
#define SEAM(k) do { if ((k) + 1 < hi) xcd_barrier(bar); } while (0)
template <int layer>
__device__ __forceinline__ void run_layer(LAS unsigned char* lds, const int wg, const int G, const int wid0, const int lo, const int hi, const XcdBarrier& bar) {
        constexpr int pb = 1 + 8 * layer; constexpr bool fox = (layer & 1) != 0;
        if (IN(pb + 0)) {
            { const Args A = load_args(); unsigned char* ws = A.ws;
              DenseSched S{(const bf16*)(ws + WS_HB), (const bf16*)(ws + WS_WIN) + (size_t)layer * NPROJ * DM, NTOK / 256, NPROJ / 256, G, wg};
              EpiProj E{(bf16*)(ws + WS_PROJ), NPROJ, K_COL, QM_COL};
              gemm_fast<EpiProj, DenseSched, true>(lds, S, E, wid0); }
            if constexpr (layer == 0) { const Args A = load_args(); unsigned char* ws = A.ws;
              DenseSched S{(const bf16*)(ws + WS_MEMB), (const bf16*)(ws + WS_WMKV), NB * NMEM / 256, 2, G, wg};
              EpiProj E{(bf16*)(ws + WS_MKV), 512, 0, 1 << 30};
              gemm_fast<EpiProj, DenseSched, true>(lds, S, E, wid0); }
            if constexpr (fox) { const Args A = load_args(); ph_fox_gate(A, layer >> 1, wg, G, wid0); }
            SEAM(pb + 0);
        }
        if (IN(pb + 1)) { const Args A = load_args(); if constexpr (fox) ph_fox_scan(A, lds, wg, G, wid0); else ph_kbar(A, lds, wg, G, wid0); SEAM(pb + 1); }
        if (IN(pb + 2)) { const Args A = load_args(); ph_attn_naive<fox ? 1 : 0>(A, wg, G, wid0); SEAM(pb + 2); }
        if (IN(pb + 3)) {
            const Args A = load_args(); unsigned char* ws = A.ws;
            DenseSched S{(const bf16*)(ws + WS_ATT), (const bf16*)(ws + WS_WO) + (size_t)layer * DM * DM, NTOK / 256, DM / 256, G, wg};
            EpiOut E{layer == 0 ? A.in[I_X] : A.out, A.out};
            gemm_fast<EpiOut, DenseSched, true>(lds, S, E, wid0); SEAM(pb + 3);
        }
        if (IN(pb + 4)) { const Args A = load_args(); ph_ln1_router(A, layer, lds, wg, G, wid0); SEAM(pb + 4); }
        if (IN(pb + 5)) {
            const Args A = load_args(); unsigned char* ws = A.ws;
            LAS int* tab = (LAS int*)(lds + MISC_OFF) + 64; moe_tables(tab, (unsigned*)(ws + WS_CTL) + CW_ECNT + layer * 64, wid0);
            MoeSched S{(const bf16*)(ws + WS_HB), (const bf16*)(ws + WS_WGU) + (size_t)layer * NEXP * 2048 * DM, (const unsigned*)(ws + WS_ELIST), tab, 8, 2048, G, wg, 2};
            EpiGU E{(bf16*)(ws + WS_ABUF), A.in[I_BGU] + (size_t)layer * NEXP * 2048};
            gemm_fast<EpiGU, MoeSched, true>(lds, S, E, wid0); __syncthreads(); SEAM(pb + 5);
        }
        if (IN(pb + 6)) {
            const Args A = load_args(); unsigned char* ws = A.ws;
            LAS int* tab = (LAS int*)(lds + MISC_OFF) + 64; moe_tables(tab, (unsigned*)(ws + WS_CTL) + CW_ECNT + layer * 64, wid0);
            MoeSched S{(const bf16*)(ws + WS_ABUF), (const bf16*)(ws + WS_WDN) + (size_t)layer * NEXP * DM * DM, (const unsigned*)(ws + WS_ELIST), tab, 4, 1024, G, wg, 0};
            EpiDN E{(bf16*)(ws + WS_YBUF), A.in[I_BDN] + (size_t)layer * NEXP * DM, (const float*)(ws + WS_AGATE)};
            gemm_fast<EpiDN, MoeSched, true>(lds, S, E, wid0); __syncthreads(); SEAM(pb + 6);
        }
        if (IN(pb + 7)) { const Args A = load_args(); ph_combine_ln2(A, layer, wg, G, wid0); SEAM(pb + 7); }
}
__global__ void __launch_bounds__(NTHR, 2) k_main(Args A0) {
    extern __shared__ __attribute__((aligned(16))) unsigned char lds_raw[];
    LAS unsigned char* lds = (LAS unsigned char*)lds_raw;
    volatile LAS unsigned* MISC = (volatile LAS unsigned*)(lds + MISC_OFF);
    const int wid0 = __builtin_amdgcn_readfirstlane((int)threadIdx.x >> 6);
    const int G = gridDim.x, wg = blockIdx.x;
    const int lo = A0.p_lo, hi = A0.p_hi;
    if (threadIdx.x < 64) MISC[threadIdx.x] = 0u;
    __syncthreads();
    XcdBarrier bar; bar.bar = (unsigned*)(A0.ws + WS_CTL) + CW_BAR; bar.x = 0; bar.st = nullptr; bar.wid = wid0;
    if (hi - lo > 1) bar = xcd_barrier_post((unsigned*)(A0.ws + WS_CTL) + CW_BAR + (size_t)lo * XCD_BAR_WORDS, MISC + 8, wid0);
    if (IN(0)) { const Args A = load_args(); ph_convert(A, lds, wg, G, wid0); SEAM(0); }
    run_layer<0>(lds, wg, G, wid0, lo, hi, bar); run_layer<1>(lds, wg, G, wid0, lo, hi, bar); run_layer<2>(lds, wg, G, wid0, lo, hi, bar); run_layer<3>(lds, wg, G, wid0, lo, hi, bar);
#undef IN
#undef SEAM
}

#ifndef MK_ONE_LAUNCH
#define MK_ONE_LAUNCH 1
#endif
extern "C" void kernel_launch(void* const* d_in, const int* in_sizes, int n_in, void* d_out, int out_size, void* d_ws, size_t ws_size, hipStream_t stream) {
    static int grid = 0;
    if (grid == 0) {
        if (n_in != 17 || out_size != NTOK * DM || ws_size < WS_END) { fprintf(stderr, "kernel_launch: unexpected shapes (n_in %d out %d ws %zu, need %zu)\n", n_in, out_size, ws_size, (size_t)WS_END); grid = -1; return; }
        int dev = 0, cus = 0, per_cu = 0;
        if (hipGetDevice(&dev) != hipSuccess || hipDeviceGetAttribute(&cus, hipDeviceAttributeMultiprocessorCount, dev) != hipSuccess) { grid = -1; return; }
        if (hipFuncSetAttribute((const void*)k_main, hipFuncAttributeMaxDynamicSharedMemorySize, LDS_BYTES) != hipSuccess) { fprintf(stderr, "kernel_launch: hipFuncSetAttribute failed\n"); grid = -1; return; }
        if (hipOccupancyMaxActiveBlocksPerMultiprocessor(&per_cu, (const void*)k_main, NTHR, LDS_BYTES) != hipSuccess || per_cu < 1) { fprintf(stderr, "kernel_launch: occupancy query says %d\n", per_cu); }
        (void)hipGetLastError();
        grid = cus;
    }
    if (grid < 0) return;
    (void)hipMemsetAsync((char*)d_ws + WS_CTL, 0, CTL_ZERO_BYTES, stream);
    Args a{};
    for (int i = 0; i < 17; ++i) a.in[i] = (const float*)d_in[i];
    a.out = (float*)d_out; a.ws = (unsigned char*)d_ws;
#if MK_ONE_LAUNCH
    a.p_lo = 0; a.p_hi = NPHASE;
    hipLaunchKernelGGL(k_main, dim3(grid), dim3(NTHR), LDS_BYTES, stream, a);
#else
    for (int p = 0; p < NPHASE; ++p) { a.p_lo = p; a.p_hi = p + 1; hipLaunchKernelGGL(k_main, dim3(grid), dim3(NTHR), LDS_BYTES, stream, a); }
#endif
}
```

```cpp
#include <hip/hip_runtime.h>
#include <cstdio>
#include <cstdint>

#define GAS __attribute__((address_space(1)))
#define LAS __attribute__((address_space(3)))
typedef unsigned short bf16;
typedef unsigned v4u __attribute__((ext_vector_type(4)));
typedef unsigned v2u __attribute__((ext_vector_type(2)));
typedef float f32x4 __attribute__((ext_vector_type(4)));
typedef short bf16x8 __attribute__((ext_vector_type(8)));

constexpr int NB = 4, SEQ = 8192, DM = 1024, NTOK = NB * SEQ;
constexpr int HS = 12, HMEM = 4, HD = 64, NMEM = 256, NPROJ = 2560, QM_COL = 2304, K_COL = 768, V_COL = 1536;
constexpr int NEXP = 32, TOPK = 4, DEPTH = 4, NASSIGN = NTOK * TOPK, DFF = 1024;
constexpr float ALPHA = 1.6817928305074290f, LN_EPS = 1e-5f, LOG2E = 1.4426950408889634f, C2 = 0.125f * 1.4426950408889634f;
constexpr float SW_LIMIT = 7.0f, SW_ALPHA = 1.702f;
constexpr int NWAVES = 8, NTHR = 512;

constexpr size_t MiB = 1u << 20;
constexpr size_t WS_CTL = 0, CTL_ZERO_BYTES = 1 * MiB;
constexpr size_t WS_WIN = 2 * MiB;
constexpr size_t WS_WFG = WS_WIN + (size_t)4 * NPROJ * DM * 2;
constexpr size_t WS_WMKV = WS_WFG + 1 * MiB;
constexpr size_t WS_WO = WS_WMKV + 1 * MiB;
constexpr size_t WS_WGU = WS_WO + 8 * MiB;
constexpr size_t WS_WDN = WS_WGU + 512 * MiB;
constexpr size_t WS_HB = WS_WDN + 256 * MiB;
constexpr size_t WS_MEMB = WS_HB + 64 * MiB;
constexpr size_t WS_MKV = WS_MEMB + 2 * MiB;
constexpr size_t WS_PROJ = WS_MKV + 1 * MiB;
constexpr size_t WS_CFOX = WS_PROJ + 160 * MiB;
constexpr size_t WS_LF = WS_CFOX + 2 * MiB;
constexpr size_t WS_KBAR = WS_LF + 2 * MiB;
constexpr size_t WS_ATT = WS_KBAR + 1 * MiB;
constexpr size_t WS_ELIST = WS_ATT + 64 * MiB;
constexpr size_t WS_AGATE = WS_ELIST + 4 * MiB;
constexpr size_t WS_ABUF = WS_AGATE + 1 * MiB;
constexpr size_t WS_YBUF = WS_ABUF + 256 * MiB;
constexpr size_t WS_END = WS_YBUF + 256 * MiB;

constexpr int CW_ECNT = 1024;
constexpr int CW_BAR = 4096;
constexpr int NPHASE = 1 + 8 * DEPTH;

constexpr int LDS_BYTES = 147456, SCR_BYTES = 146432, MISC_OFF = SCR_BYTES;

__device__ __forceinline__ unsigned f2bf(float f) { unsigned u = __float_as_uint(f); return (u + 0x7fffu + ((u >> 16) & 1u)) >> 16; }
typedef float f32x2_t __attribute__((ext_vector_type(2))); typedef __bf16 bf16x2_t __attribute__((ext_vector_type(2)));
__device__ __forceinline__ unsigned pk2(float lo, float hi) { const f32x2_t v = {lo, hi}; const bf16x2_t b = __builtin_convertvector(v, bf16x2_t); return __builtin_bit_cast(unsigned, b); }
__device__ __forceinline__ float bflo(unsigned w) { return __uint_as_float(w << 16); }
__device__ __forceinline__ float bfhi(unsigned w) { return __uint_as_float(w & 0xffff0000u); }
__device__ __forceinline__ float wave_sum(float v) {
    v += __builtin_bit_cast(float, __builtin_amdgcn_update_dpp(0, __builtin_bit_cast(int, v), 0xB1, 0xF, 0xF, false));
    v += __builtin_bit_cast(float, __builtin_amdgcn_update_dpp(0, __builtin_bit_cast(int, v), 0x4E, 0xF, 0xF, false));
    v += __builtin_bit_cast(float, __builtin_amdgcn_update_dpp(0, __builtin_bit_cast(int, v), 0x141, 0xF, 0xF, false));
    v += __builtin_bit_cast(float, __builtin_amdgcn_update_dpp(0, __builtin_bit_cast(int, v), 0x140, 0xF, 0xF, false));
    v += __builtin_bit_cast(float, __builtin_amdgcn_update_dpp(0, __builtin_bit_cast(int, v), 0x142, 0xA, 0xF, false));
    v += __builtin_bit_cast(float, __builtin_amdgcn_update_dpp(0, __builtin_bit_cast(int, v), 0x143, 0xC, 0xF, false));
    return __builtin_bit_cast(float, __builtin_amdgcn_readlane(__builtin_bit_cast(int, v), 63));
}
__device__ __forceinline__ float fexp2(float x) { return __builtin_amdgcn_exp2f(x); }
#define PH_IDS int lane; asm volatile("v_mbcnt_lo_u32_b32 %0, -1, 0\n\tv_mbcnt_hi_u32_b32 %0, -1, %0" : "=v"(lane)); const int wid = __builtin_amdgcn_readfirstlane(g_wid); const int tid = wid * 64 + lane; (void)tid

#define XB_TMO      128
#define XB_XCNT(j)  (256  + 64 * (j))
#define XB_XSUB(j)  (1280 + 64 * (j))
#define XB_XGEN(j)  (2304 + 64 * (j))
#define XB_TOP      3328
#define XB_TOPGEN   3392
#define XCD_BAR_WORDS 3456
#define XB_SPIN_CAP (1u << 22)
__device__ __forceinline__ unsigned xb_ld(unsigned* p)              { return __hip_atomic_load(p, __ATOMIC_RELAXED, __HIP_MEMORY_SCOPE_AGENT); }
__device__ __forceinline__ unsigned xb_add(unsigned* p, unsigned v) { return __hip_atomic_fetch_add(p, v, __ATOMIC_RELAXED, __HIP_MEMORY_SCOPE_AGENT); }
__device__ __forceinline__ unsigned xb_xcc_id() { return (unsigned)__builtin_amdgcn_s_getreg((3 << 11) | 20) & 0xFu; }
#define XB_SPIN(cond, bar) do { unsigned _sp = 0; while (cond) { __builtin_amdgcn_s_sleep(1); \
    if ((++_sp & 255u) == 0u) { if (xb_ld(&(bar)[XB_TMO])) break; if (_sp > XB_SPIN_CAP) { atomicAdd(&(bar)[XB_TMO], 1u); break; } } } } while (0)
struct XcdBarrier { unsigned* bar; unsigned x; volatile LAS unsigned* st; int wid; };
__device__ __forceinline__ bool xb_t0(int w) { int l; asm volatile("v_mbcnt_lo_u32_b32 %0, -1, 0\n\tv_mbcnt_hi_u32_b32 %0, -1, %0" : "=v"(l)); return w == 0 && l == 0; }
#define XB_T0(w) xb_t0(w)
__device__ __forceinline__ XcdBarrier xcd_barrier_post(unsigned* bar, volatile LAS unsigned* st, int wid) {
    XcdBarrier b; b.bar = bar; b.x = xb_xcc_id(); b.st = st; b.wid = wid;
    if (XB_T0(wid)) (void)xb_add(&bar[XB_XCNT(b.x)], 1u);
    return b;
}
__device__ __forceinline__ void xcd_barrier_complete(unsigned* bar, unsigned x, unsigned& nloc, unsigned& nx) {
    const unsigned G = gridDim.x * gridDim.y * gridDim.z;
    unsigned sum, cnt, mine, sp = 0u;
    for (;;) {
        sum = 0u; cnt = 0u; mine = 0u;
#pragma unroll
        for (unsigned j = 0; j < 16; ++j) { const unsigned c = xb_ld(&bar[XB_XCNT(j)]); sum += c; cnt += (c > 0u) ? 1u : 0u; mine = (j == x) ? c : mine; }
        if (sum == G) break;
        __builtin_amdgcn_s_sleep(1);
        if ((++sp & 255u) == 0u) { if (xb_ld(&bar[XB_TMO])) break; if (sp > XB_SPIN_CAP) { atomicAdd(&bar[XB_TMO], 1u); break; } }
    }
    nloc = mine > 0u ? mine : 1u; nx = cnt > 0u ? cnt : 1u;
}
__device__ __forceinline__ void xcd_barrier(const XcdBarrier& b) {
    asm volatile("s_waitcnt vmcnt(0)" ::: "memory");
    __syncthreads();
    if (XB_T0(b.wid)) {
        unsigned* bar = b.bar;
        __builtin_amdgcn_s_waitcnt(0);
        unsigned nloc = b.st[0], nx = b.st[1];
        if (nloc == 0u) { xcd_barrier_complete(bar, b.x, nloc, nx); b.st[0] = nloc; b.st[1] = nx; }
        const unsigned old = xb_add(&bar[XB_XSUB(b.x)], 1u);
        const unsigned gen = old / nloc;
        if (old + 1u == (gen + 1u) * nloc) {
            __builtin_amdgcn_fence(__ATOMIC_RELEASE, "agent");
            asm volatile("s_waitcnt vmcnt(0)" ::: "memory");
            const unsigned og = xb_add(&bar[XB_TOP], 1u);
            const unsigned tg = og / nx;
            if (og + 1u == (tg + 1u) * nx) xb_add(&bar[XB_TOPGEN], 1u);
            else XB_SPIN(xb_ld(&bar[XB_TOPGEN]) == tg, bar);
            __builtin_amdgcn_fence(__ATOMIC_ACQUIRE, "agent");
            xb_add(&bar[XB_XGEN(b.x)], 1u);
            asm volatile("s_waitcnt vmcnt(0)" ::: "memory");
        } else {
            XB_SPIN(xb_ld(&bar[XB_XGEN(b.x)]) == gen, bar);
            __builtin_amdgcn_fence(__ATOMIC_ACQUIRE, "agent");
            asm volatile("s_waitcnt vmcnt(0)" ::: "memory");
        }
    }
    __syncthreads();
}

struct Args { const float* in[17]; float* out; unsigned char* ws; int p_lo, p_hi; };
enum { I_X = 0, I_MEM, I_WIN_MOBA, I_WIN_FOX, I_BFG, I_WMKV, I_WO, I_LN1G, I_LN1B, I_RW, I_RB, I_WGU, I_BGU, I_WDN, I_BDN, I_LN2G, I_LN2B };

__device__ __forceinline__ Args load_args() {
#if defined(__HIP_DEVICE_COMPILE__)
    const __attribute__((address_space(4))) unsigned long long* p = (const __attribute__((address_space(4))) unsigned long long*)__builtin_amdgcn_kernarg_segment_ptr();
    asm volatile("" : "+s"(p));
    Args a;
#pragma unroll
    for (int i = 0; i < 17; ++i) a.in[i] = (const float*)(const GAS float*)p[i];
    a.out = (float*)(GAS float*)p[17]; a.ws = (unsigned char*)(GAS unsigned char*)p[18]; const unsigned long long w = p[19]; a.p_lo = (int)(unsigned)w; a.p_hi = (int)(unsigned)(w >> 32);
    return a;
#else
    return Args{};
#endif
}
__device__ __forceinline__ void cvt_item(const float* W, int pitch, int col0, int k0, bf16* WT, int drow0, LAS float* scr, int lane) {
    f32x4 v[16];
    const int a = lane >> 4, b4 = (lane & 15) * 4;
#pragma unroll
    for (int i = 0; i < 16; ++i) v[i] = *(const f32x4*)(W + (size_t)(k0 + 4 * i + a) * pitch + col0 + b4);
#pragma unroll
    for (int i = 0; i < 16; ++i) { LAS float* s = scr + (4 * i + a) * 65 + b4; s[0] = v[i].x; s[1] = v[i].y; s[2] = v[i].z; s[3] = v[i].w; }
    asm volatile("s_waitcnt lgkmcnt(0)" ::: "memory");
    const int c = lane & 7;
#pragma unroll
    for (int j = 0; j < 8; ++j) {
        const int n = (lane >> 3) + 8 * j; const LAS float* s = scr + (8 * c) * 65 + n;
        v4u o; o.x = pk2(s[0], s[65]); o.y = pk2(s[2 * 65], s[3 * 65]); o.z = pk2(s[4 * 65], s[5 * 65]); o.w = pk2(s[6 * 65], s[7 * 65]);
        *(v4u*)(WT + (size_t)(drow0 + n) * DM + k0 + 8 * c) = o;
    }
    asm volatile("s_waitcnt lgkmcnt(0)" ::: "memory");
}
__device__ __forceinline__ void ph_convert(const Args& A, LAS unsigned char* lds, int wg, int G, int g_wid) {
    PH_IDS;
    unsigned char* ws = A.ws;
    LAS float* scr = (LAS float*)(lds + wid * 16896);
    const int gw = wg * NWAVES + wid, NGW = G * NWAVES;
    constexpr int I_IN = 16 * 40;
    constexpr int I_MK = 16 * 8, I_O1 = 16 * 16, I_GU1 = 16 * 32, I_DN1 = 16 * 16;
    constexpr int N_IN = 4 * I_IN, N_MK = I_MK, N_O = 4 * I_O1, N_GU = 128 * I_GU1, N_DN = 128 * I_DN1;
    constexpr int NITEMS = N_IN + N_MK + N_O + N_GU + N_DN;
    for (int it = gw; it < NITEMS; it += NGW) {
        int r = it;
        if (r < N_IN) { const int l = r / I_IN, q = r % I_IN, kb = q / 40, nb = q % 40; const int j = l >> 1;
            const float* W = (l & 1) ? A.in[I_WIN_FOX] + (size_t)j * DM * (NPROJ + HS) : A.in[I_WIN_MOBA] + (size_t)j * DM * NPROJ;
            cvt_item(W, (l & 1) ? NPROJ + HS : NPROJ, 64 * nb, 64 * kb, (bf16*)(ws + WS_WIN) + (size_t)l * NPROJ * DM, 64 * nb, scr, lane); continue; }
        r -= N_IN;
        if (r < N_MK) { const int kb = r / 8, nb = r % 8; cvt_item(A.in[I_WMKV], 512, 64 * nb, 64 * kb, (bf16*)(ws + WS_WMKV), 64 * nb, scr, lane); continue; }
        r -= N_MK;
        if (r < N_O) { const int l = r / I_O1, q = r % I_O1, kb = q / 16, nb = q % 16;
            cvt_item(A.in[I_WO] + (size_t)l * DM * DM, DM, 64 * nb, 64 * kb, (bf16*)(ws + WS_WO) + (size_t)l * DM * DM, 64 * nb, scr, lane); continue; }
        r -= N_O;
        if (r < N_GU) { const int le = r / I_GU1, q = r % I_GU1, kb = q / 32, nb = q % 32; const int col0 = 64 * nb;
            const int cc = col0 & 1023, drow0 = (cc >> 7) * 256 + (cc & 127) + ((col0 >= 1024) ? 128 : 0);
            cvt_item(A.in[I_WGU] + (size_t)le * DM * 2048, 2048, col0, 64 * kb, (bf16*)(ws + WS_WGU) + (size_t)le * 2048 * DM, drow0, scr, lane); continue; }
        r -= N_GU;
        { const int le = r / I_DN1, q = r % I_DN1, kb = q / 16, nb = q % 16;
            cvt_item(A.in[I_WDN] + (size_t)le * DM * DM, DM, 64 * nb, 64 * kb, (bf16*)(ws + WS_WDN) + (size_t)le * DM * DM, 64 * nb, scr, lane); }
    }
    { const int gt = wg * NTHR + tid, NGT = G * NTHR;
      for (int i = gt; i < 2 * 16 * DM; i += NGT) { const int j = i / (16 * DM), hh = (i / DM) & 15, k = i % DM;
          const float v = hh < HS ? A.in[I_WIN_FOX][(size_t)j * DM * (NPROJ + HS) + (size_t)k * (NPROJ + HS) + NPROJ + hh] : 0.f;
          ((bf16*)(ws + WS_WFG))[i] = (bf16)f2bf(v); }
      for (size_t i = gt; i < (size_t)NTOK * DM / 8; i += NGT) { const f32x4 a = ((const f32x4*)A.in[I_X])[2 * i], b = ((const f32x4*)A.in[I_X])[2 * i + 1];
          v4u o; o.x = pk2(a.x, a.y); o.y = pk2(a.z, a.w); o.z = pk2(b.x, b.y); o.w = pk2(b.z, b.w); ((v4u*)(ws + WS_HB))[i] = o; }
      for (size_t i = gt; i < (size_t)NB * NMEM * DM / 8; i += NGT) { const f32x4 a = ((const f32x4*)A.in[I_MEM])[2 * i], b = ((const f32x4*)A.in[I_MEM])[2 * i + 1];
          v4u o; o.x = pk2(a.x, a.y); o.y = pk2(a.z, a.w); o.z = pk2(b.x, b.y); o.w = pk2(b.z, b.w); ((v4u*)(ws + WS_MEMB))[i] = o; }
    }
}

struct Unit { int pm, pn, e, rows; const bf16* B; const unsigned* list; };
struct DenseSched {
    const bf16* A; const bf16* Bt; int nM, nN, G, c;
    __device__ __forceinline__ bool next(int i, Unit& u) const {
        const int L = i * G + c; if (L >= nM * nN) return false;
        u.pm = L / nN; u.pn = L % nN; u.e = 0; u.rows = 256; u.B = Bt + (size_t)u.pn * 256 * DM; u.list = nullptr; return true; }
    __device__ __forceinline__ unsigned arow(const Unit& u, int r) const { return (unsigned)(u.pm * 256 + r); }
};
struct MoeSched {
    const bf16* A; const bf16* Bt; const unsigned* elist; const LAS int* tab; int nN, ntot, G, c, shift;
    __device__ __forceinline__ bool next(int i, Unit& u) const {
        const int L = i * G + c; const int total = __builtin_amdgcn_readfirstlane(tab[64 + 32]) * nN; if (L >= total) return false;
        u.pn = L % nN; const int g = L / nN;
        int ln; asm volatile("v_mbcnt_lo_u32_b32 %0, -1, 0\n\tv_mbcnt_hi_u32_b32 %0, -1, %0" : "=v"(ln));
        const int offv = tab[64 + (ln & 31)];
        const unsigned long long mk = __builtin_amdgcn_ballot_w64(ln < 32 && offv <= g);
        const int e = __builtin_popcountll(mk) - 1;
        u.e = e; u.pm = g - __builtin_amdgcn_readfirstlane(tab[64 + e]); const int rem = __builtin_amdgcn_readfirstlane(tab[e]) - 256 * u.pm; u.rows = rem < 256 ? rem : 256;
        u.B = Bt + ((size_t)e * ntot + (size_t)u.pn * 256) * DM; u.list = elist + (size_t)e * NTOK + 256 * u.pm; return true; }
    __device__ __forceinline__ unsigned arow(const Unit& u, int r) const { const unsigned rr = (unsigned)r < (unsigned)u.rows ? (unsigned)r : (unsigned)(u.rows - 1); return *(const unsigned*)((const char*)u.list + rr * 4u) >> shift; }
};
__device__ __forceinline__ void moe_tables(LAS int* tab, const unsigned* ecnt, int g_wid) {
    PH_IDS;
    if (tid == 0) { int acc = 0; for (int e = 0; e < 32; ++e) { const int c = (int)ecnt[e]; tab[e] = c; tab[64 + e] = acc; acc += (c + 255) >> 8; } tab[64 + 32] = acc; }
    __syncthreads();
}

struct EpiProj {
    bf16* O; int ldc, q_end, qm_begin;
    __device__ __forceinline__ void operator()(const f32x4 (&acc)[2][2][4][2], const Unit& u, int wr, int wc, int fr, int fq) const {
#pragma unroll
        for (int ai = 0; ai < 2; ++ai)
#pragma unroll
            for (int m = 0; m < 4; ++m) { const int row = u.pm * 256 + ai * 128 + wr * 64 + m * 16 + fr;
#pragma unroll
                for (int bj = 0; bj < 2; ++bj) { const int col = u.pn * 256 + bj * 128 + wc * 32 + 8 * fq; const float sc = (col < q_end || col >= qm_begin) ? C2 : 1.f;
                    const f32x4 v0 = acc[ai][bj][m][0] * sc, v1 = acc[ai][bj][m][1] * sc;
                    v4u w; w.x = pk2(v0.x, v0.y); w.y = pk2(v0.z, v0.w); w.z = pk2(v1.x, v1.y); w.w = pk2(v1.z, v1.w);
                    *(v4u*)((char*)O + (unsigned)(row * ldc + col) * 2u) = w; } }
    }
};
struct EpiOut {
    const float* base; float* out;
    __device__ __forceinline__ void operator()(const f32x4 (&acc)[2][2][4][2], const Unit& u, int wr, int wc, int fr, int fq) const {
#pragma unroll
        for (int ai = 0; ai < 2; ++ai)
#pragma unroll
            for (int m = 0; m < 4; ++m) { const int row = u.pm * 256 + ai * 128 + wr * 64 + m * 16 + fr;
#pragma unroll
                for (int bj = 0; bj < 2; ++bj) { const unsigned off = (unsigned)(row * DM + u.pn * 256 + bj * 128 + wc * 32 + 8 * fq) * 4u;
                    const f32x4 b0 = *(const f32x4*)((const char*)base + off), b1 = *(const f32x4*)((const char*)base + off + 16);
                    *(f32x4*)((char*)out + off) = b0 * ALPHA + acc[ai][bj][m][0]; *(f32x4*)((char*)out + off + 16) = b1 * ALPHA + acc[ai][bj][m][1]; } }
    }
};
__device__ __forceinline__ float swiglu(float g, float uu) {
    g = fminf(g, SW_LIMIT); uu = fminf(fmaxf(uu, -SW_LIMIT), SW_LIMIT);
    const float sg = __builtin_amdgcn_rcpf(1.f + fexp2(-SW_ALPHA * LOG2E * g));
    return g * sg * (uu + 1.f);
}
struct EpiGU {
    bf16* abuf; const float* bgu;
    __device__ __forceinline__ void operator()(const f32x4 (&acc)[2][2][4][2], const Unit& u, int wr, int wc, int fr, int fq) const {
        const int c0 = u.pn * 128 + wc * 32 + 8 * fq; const float* bg = bgu + (size_t)u.e * 2048 + c0;
        const f32x4 g0 = *(const f32x4*)bg, g1 = *(const f32x4*)(bg + 4), u0 = *(const f32x4*)(bg + 1024), u1 = *(const f32x4*)(bg + 1028);
#pragma unroll
        for (int ai = 0; ai < 2; ++ai)
#pragma unroll
            for (int m = 0; m < 4; ++m) { const int r = ai * 128 + wr * 64 + m * 16 + fr;
                if (r < u.rows) { const unsigned aid = *(const unsigned*)((const char*)u.list + (unsigned)r * 4u);
                    const f32x4 ga = acc[ai][0][m][0] + g0, gb = acc[ai][0][m][1] + g1, ua = acc[ai][1][m][0] + u0, ub = acc[ai][1][m][1] + u1;
                    v4u w; w.x = pk2(swiglu(ga.x, ua.x), swiglu(ga.y, ua.y)); w.y = pk2(swiglu(ga.z, ua.z), swiglu(ga.w, ua.w));
                    w.z = pk2(swiglu(gb.x, ub.x), swiglu(gb.y, ub.y)); w.w = pk2(swiglu(gb.z, ub.z), swiglu(gb.w, ub.w));
                    *(v4u*)((char*)abuf + (aid * (unsigned)DM + (unsigned)c0) * 2u) = w; } }
    }
};
struct EpiDN {
    bf16* ybuf; const float* bdn; const float* agate;
    __device__ __forceinline__ void operator()(const f32x4 (&acc)[2][2][4][2], const Unit& u, int wr, int wc, int fr, int fq) const {
        f32x4 bv[2][2];
#pragma unroll
        for (int bj = 0; bj < 2; ++bj) { const float* bp = bdn + (size_t)u.e * DM + u.pn * 256 + bj * 128 + wc * 32 + 8 * fq; bv[bj][0] = *(const f32x4*)bp; bv[bj][1] = *(const f32x4*)(bp + 4); }
#pragma unroll
        for (int ai = 0; ai < 2; ++ai)
#pragma unroll
            for (int m = 0; m < 4; ++m) { const int r = ai * 128 + wr * 64 + m * 16 + fr;
                if (r < u.rows) { const unsigned aid = *(const unsigned*)((const char*)u.list + (unsigned)r * 4u); const float gt = *(const float*)((const char*)agate + aid * 4u);
#pragma unroll
                    for (int bj = 0; bj < 2; ++bj) { const f32x4 v0 = (acc[ai][bj][m][0] + bv[bj][0]) * gt, v1 = (acc[ai][bj][m][1] + bv[bj][1]) * gt;
                        v4u w; w.x = pk2(v0.x, v0.y); w.y = pk2(v0.z, v0.w); w.z = pk2(v1.x, v1.y); w.w = pk2(v1.z, v1.w);
                        *(v4u*)((char*)ybuf + (aid * (unsigned)DM + (unsigned)(u.pn * 256 + bj * 128 + wc * 32 + 8 * fq)) * 2u) = w; } } }
    }
};

template <class Epi, class Sched>
__device__ __forceinline__ void gemm_simple(const Sched& S, const Epi& E, int g_wid) {
    PH_IDS;
    const int wr = wid >> 2, wc = wid & 3, fr = lane & 15, fq = lane >> 4;
    Unit u;
    for (int i = 0; S.next(i, u); ++i) {
        f32x4 acc[2][2][4][2];
#pragma unroll
        for (int a = 0; a < 2; ++a)
#pragma unroll
            for (int b = 0; b < 2; ++b)
#pragma unroll
                for (int m = 0; m < 4; ++m)
#pragma unroll
                    for (int n = 0; n < 2; ++n) acc[a][b][m][n] = (f32x4){0.f, 0.f, 0.f, 0.f};
        unsigned aoff[2][4], boff[2][2];
#pragma unroll
        for (int ai = 0; ai < 2; ++ai)
#pragma unroll
            for (int m = 0; m < 4; ++m) aoff[ai][m] = S.arow(u, ai * 128 + wr * 64 + m * 16 + fr) * DM + 8 * fq;
#pragma unroll
        for (int bj = 0; bj < 2; ++bj)
#pragma unroll
            for (int n = 0; n < 2; ++n) boff[bj][n] = (unsigned)(bj * 128 + wc * 32 + 8 * (fr >> 2) + 4 * n + (fr & 3)) * DM + 8 * fq;
#pragma unroll 1
        for (int k0 = 0; k0 < DM; k0 += 32) {
            bf16x8 b[2][2];
#pragma unroll
            for (int bj = 0; bj < 2; ++bj)
#pragma unroll
                for (int n = 0; n < 2; ++n) b[bj][n] = *(const bf16x8*)(u.B + boff[bj][n] + k0);
#pragma unroll
            for (int ai = 0; ai < 2; ++ai) {
                bf16x8 a[4];
#pragma unroll
                for (int m = 0; m < 4; ++m) a[m] = *(const bf16x8*)(S.A + aoff[ai][m] + k0);
#pragma unroll
                for (int bj = 0; bj < 2; ++bj)
#pragma unroll
                    for (int m = 0; m < 4; ++m)
#pragma unroll
                        for (int n = 0; n < 2; ++n) acc[ai][bj][m][n] = __builtin_amdgcn_mfma_f32_16x16x32_bf16(b[bj][n], a[m], acc[ai][bj][m][n], 0, 0, 0);
            }
        }
        E(acc, u, wr, wc, fr, fq);
    }
}


namespace pg8 {
constexpr int BM = 256, BK = 64, HALF = 128, HTB = HALF * BK * 2, STAGE_BYTES = 8 * HTB;
__device__ __forceinline__ int lds_byte(int r, int c) { const int st = (r >> 4) * 2 + (c >> 5), rr = r & 15, cc = c & 31, ob = rr * 64 + cc * 2; return st * 1024 + (ob ^ (((ob >> 9) & 1) << 5)); }
__device__ __forceinline__ void stage_rc(int b, int& R, int& C) { const int st = b / 1024, sb = b % 1024, swz = sb ^ (((sb >> 9) & 1) << 5); R = (st >> 1) * 16 + swz / 64; C = (st & 1) * 32 + (swz % 64) / 2; }
__device__ __forceinline__ int perm32(int rho) { const int n = rho >> 4, i = rho & 15; return 8 * (i >> 2) + 4 * n + (i & 3); }
}
template <class Epi, class Sched, bool ALIGN_EPI>
__device__ __forceinline__ void gemm_fast(LAS unsigned char* lds, const Sched& S, const Epi& E, int g_wid) {
    using namespace pg8;
    PH_IDS;
    const int wr = wid >> 2, wc = wid & 3, fr = lane & 15, fq = lane >> 4;
    constexpr int K = DM, nt = K / BK;
    int Rr[2], Cc[2]; unsigned voffB[2];
#pragma unroll
    for (int i = 0; i < 2; ++i) { int R, C; stage_rc(tid * 16 + i * 8192, R, C); Rr[i] = R; Cc[i] = C; const int Rb = (R & ~31) + perm32(R & 31); voffB[i] = (unsigned)(Rb * K + C) * 2u; }
    constexpr unsigned kstep = BK * 2, hstep = HALF * K * 2;
    const unsigned ldsw = (unsigned)wid * 1024u;
    const int aoff = lds_byte(wr * 64 + fr, fq * 8), boff = lds_byte(wc * 32 + fr, fq * 8);
    const char* Ab = (const char*)S.A;
#define PG8_SA(b, h) (((b) * 2 + (h)) * HTB)
#define PG8_SB(b, h) ((4 + (b) * 2 + (h)) * HTB)
#define PG8_STAGEB(bufoff, gbase) do { _Pragma("unroll") for (int _i = 0; _i < 2; ++_i) \
        __builtin_amdgcn_global_load_lds((const unsigned*)((const char*)(gbase) + voffB[_i]), (LAS unsigned*)(lds + (bufoff) + ldsw + _i * 8192), 16, 0, 0); } while (0)
#define PG8_STAGEA(bufoff, kb, vo) do { _Pragma("unroll") for (int _i = 0; _i < 2; ++_i) \
        __builtin_amdgcn_global_load_lds((const unsigned*)(Ab + (size_t)(kb) + (vo)[_i]), (LAS unsigned*)(lds + (bufoff) + ldsw + _i * 8192), 16, 0, 0); } while (0)
#define PG8_LDA(dst, b, h) do { _Pragma("unroll") for (int m = 0; m < 4; ++m) _Pragma("unroll") for (int k = 0; k < 2; ++k) dst[m][k] = *(const LAS bf16x8*)(lds + PG8_SA(b, h) + aoff + m * 2048 + k * 1024); } while (0)
#define PG8_LDB(dst, b, h) do { _Pragma("unroll") for (int n = 0; n < 2; ++n) _Pragma("unroll") for (int k = 0; k < 2; ++k) dst[n][k] = *(const LAS bf16x8*)(lds + PG8_SB(b, h) + boff + n * 2048 + k * 1024); } while (0)
#define PG8_MMA(ai, bj, At, Bt) do { __builtin_amdgcn_s_setprio(1); _Pragma("unroll") for (int m = 0; m < 4; ++m) _Pragma("unroll") for (int n = 0; n < 2; ++n) _Pragma("unroll") for (int k = 0; k < 2; ++k) \
        acc[ai][bj][m][n] = __builtin_amdgcn_mfma_f32_16x16x32_bf16(Bt[n][k], At[m][k], acc[ai][bj][m][n], 0, 0, 0); __builtin_amdgcn_s_setprio(0); } while (0)
#define PG8_WAIT_V(n) asm volatile("s_waitcnt vmcnt(" #n ")" ::: "memory")
#define PG8_WAIT_L(n) asm volatile("s_waitcnt lgkmcnt(" #n ")" ::: "memory")
#define PG8_BAR __builtin_amdgcn_s_barrier()
#define PG8_SCHED __builtin_amdgcn_sched_barrier(0)
#define PG8_OFFS(dst, un) do { _Pragma("unroll") for (int _h = 0; _h < 2; ++_h) _Pragma("unroll") for (int _i = 0; _i < 2; ++_i) dst[_h][_i] = (S.arow(un, _h * 128 + Rr[_i]) * (unsigned)K + (unsigned)Cc[_i]) * 2u; } while (0)
    Unit cur, nxt; int ui = 0;
    if (!S.next(0, cur)) return;
    f32x4 acc[2][2][4][2];
#pragma unroll
    for (int a = 0; a < 2; ++a)
#pragma unroll
        for (int b = 0; b < 2; ++b)
#pragma unroll
            for (int m = 0; m < 4; ++m)
#pragma unroll
                for (int n = 0; n < 2; ++n) acc[a][b][m][n] = (f32x4){0.f, 0.f, 0.f, 0.f};
    bf16x8 At[4][2], B0[2][2], B1[2][2];
    unsigned vA[2][2], vN[2][2];
    PG8_OFFS(vA, cur);
    const char* cB = (const char*)cur.B;
    PG8_STAGEB(PG8_SB(0, 0), cB); PG8_STAGEB(PG8_SB(0, 1), cB + hstep); PG8_STAGEA(PG8_SA(0, 0), 0, vA[0]); PG8_STAGEA(PG8_SA(0, 1), 0, vA[1]);
    if (wr == 1) PG8_BAR;
    PG8_WAIT_V(2); PG8_BAR;
    PG8_STAGEB(PG8_SB(1, 0), cB + kstep); PG8_STAGEA(PG8_SA(1, 0), kstep, vA[0]); PG8_STAGEB(PG8_SB(1, 1), cB + hstep + kstep);
    PG8_WAIT_V(6); PG8_BAR;
    for (;;) {
        const bool has_next = S.next(ui + 1, nxt);
        if (has_next) { PG8_OFFS(vN, nxt); } else {
#pragma unroll
            for (int h = 0; h < 2; ++h)
#pragma unroll
                for (int i = 0; i < 2; ++i) vN[h][i] = vA[h][i]; }
        const char* nB = has_next ? (const char*)nxt.B : cB;
#define PG8_KSTEP(LAST, t) do { \
            const unsigned kb1 = (unsigned)((t) + 1) * kstep, kb2 = (LAST) ? 0u : (unsigned)((t) + 2) * kstep, kb3 = kb2 + kstep; \
            const char* b2 = (LAST) ? nB : cB + (size_t)((t) + 2) * kstep; const char* b3 = b2 + kstep; \
            PG8_LDB(B0, 0, 0); PG8_LDB(B1, 0, 1); PG8_SCHED; PG8_LDA(At, 0, 0); PG8_STAGEA(PG8_SA(1, 1), kb1, vA[1]); \
            PG8_WAIT_V(8); PG8_WAIT_L(0); PG8_BAR; PG8_MMA(0, 0, At, B0); PG8_MMA(0, 1, At, B1); PG8_BAR; PG8_SCHED; \
            PG8_LDA(At, 0, 1); PG8_STAGEB(PG8_SB(0, 0), b2); PG8_STAGEB(PG8_SB(0, 1), b2 + hstep); if (LAST) { PG8_STAGEA(PG8_SA(0, 0), kb2, vN[0]); } else { PG8_STAGEA(PG8_SA(0, 0), kb2, vA[0]); } \
            PG8_WAIT_V(8); PG8_WAIT_L(0); PG8_BAR; PG8_MMA(1, 0, At, B0); PG8_MMA(1, 1, At, B1); PG8_BAR; PG8_SCHED; \
            PG8_LDB(B0, 1, 0); PG8_LDB(B1, 1, 1); PG8_SCHED; PG8_LDA(At, 1, 0); if (LAST) { PG8_STAGEA(PG8_SA(0, 1), kb2, vN[1]); } else { PG8_STAGEA(PG8_SA(0, 1), kb2, vA[1]); } \
            PG8_WAIT_V(8); PG8_WAIT_L(0); PG8_BAR; PG8_MMA(0, 0, At, B0); PG8_MMA(0, 1, At, B1); PG8_BAR; PG8_SCHED; \
            PG8_LDA(At, 1, 1); PG8_STAGEB(PG8_SB(1, 0), b3); PG8_STAGEB(PG8_SB(1, 1), b3 + hstep); if (LAST) { PG8_STAGEA(PG8_SA(1, 0), kb3, vN[0]); } else { PG8_STAGEA(PG8_SA(1, 0), kb3, vA[0]); } \
            PG8_WAIT_V(8); PG8_WAIT_L(0); PG8_BAR; PG8_MMA(1, 0, At, B0); PG8_MMA(1, 1, At, B1); PG8_BAR; PG8_SCHED; } while (0)
        for (int t = 0; t < nt - 2; t += 2) PG8_KSTEP(false, t);
        PG8_KSTEP(true, nt - 2);
#undef PG8_KSTEP
        if constexpr (ALIGN_EPI) { if (wr == 0) PG8_BAR; }
        { int fr_e = fr, fq_e = fq; asm volatile("" : "+v"(fr_e), "+v"(fq_e));
          E(acc, cur, wr, wc, fr_e, fq_e); }
        if (!has_next) break;
#pragma unroll
        for (int a = 0; a < 2; ++a)
#pragma unroll
            for (int b = 0; b < 2; ++b)
#pragma unroll
                for (int m = 0; m < 4; ++m)
#pragma unroll
                    for (int n = 0; n < 2; ++n) acc[a][b][m][n] = (f32x4){0.f, 0.f, 0.f, 0.f};
        cur = nxt; cB = nB; ++ui;
#pragma unroll
        for (int h = 0; h < 2; ++h)
#pragma unroll
            for (int i = 0; i < 2; ++i) vA[h][i] = vN[h][i];
        if constexpr (ALIGN_EPI) { if (wr == 1) PG8_BAR; }
    }
    PG8_WAIT_V(0);
    if constexpr (!ALIGN_EPI) { if (wr == 0) PG8_BAR; }
    PG8_BAR;
#undef PG8_SA
#undef PG8_SB
#undef PG8_STAGEA
#undef PG8_STAGEB
#undef PG8_LDA
#undef PG8_LDB
#undef PG8_MMA
#undef PG8_WAIT_V
#undef PG8_WAIT_L
#undef PG8_BAR
#undef PG8_SCHED
#undef PG8_OFFS
}

__device__ __forceinline__ void ph_fox_gate(const Args& A, int j, int wg, int G, int g_wid) {
    PH_IDS;
    const bf16* hb = (const bf16*)(A.ws + WS_HB); const bf16* wfg = (const bf16*)(A.ws + WS_WFG) + (size_t)j * 16 * DM; float* lf = (float*)(A.ws + WS_LF);
    const float* bfg = A.in[I_BFG] + j * HS;
    const int gw = wg * NWAVES + wid, NGW = G * NWAVES;
    for (int n = gw; n < NTOK; n += NGW) {
        const v4u* hp = (const v4u*)(hb + (size_t)n * DM + 16 * lane); const v4u h0 = hp[0], h1 = hp[1];
        float hv[16] = {bflo(h0.x), bfhi(h0.x), bflo(h0.y), bfhi(h0.y), bflo(h0.z), bfhi(h0.z), bflo(h0.w), bfhi(h0.w), bflo(h1.x), bfhi(h1.x), bflo(h1.y), bfhi(h1.y), bflo(h1.z), bfhi(h1.z), bflo(h1.w), bfhi(h1.w)};
        float mine = 0.f;
#pragma unroll
        for (int hh = 0; hh < HS; ++hh) {
            const v4u* wp = (const v4u*)(wfg + (size_t)hh * DM + 16 * lane); const v4u w0 = wp[0], w1 = wp[1];
            float s = hv[0] * bflo(w0.x) + hv[1] * bfhi(w0.x) + hv[2] * bflo(w0.y) + hv[3] * bfhi(w0.y) + hv[4] * bflo(w0.z) + hv[5] * bfhi(w0.z) + hv[6] * bflo(w0.w) + hv[7] * bfhi(w0.w)
                    + hv[8] * bflo(w1.x) + hv[9] * bfhi(w1.x) + hv[10] * bflo(w1.y) + hv[11] * bfhi(w1.y) + hv[12] * bflo(w1.z) + hv[13] * bfhi(w1.z) + hv[14] * bflo(w1.w) + hv[15] * bfhi(w1.w);
            s = wave_sum(s);
            if (lane == hh) mine = s;
        }
        if (lane < HS) { const float z = mine + bfg[lane];
            const float ls = fminf(z, 0.f) - __builtin_amdgcn_logf(1.f + fexp2(-fabsf(z) * LOG2E)) * 0.6931471805599453f;
            const int b = n >> 13, t = n & (SEQ - 1); lf[((size_t)(b * HS + lane)) * SEQ + t] = ls; }
    }
}
__device__ __forceinline__ void ph_fox_scan(const Args& A, LAS unsigned char* lds, int wg, int G, int g_wid) {
    PH_IDS;
    const float* lf = (const float*)(A.ws + WS_LF); float* c2 = (float*)(A.ws + WS_CFOX); LAS float* part = (LAS float*)lds;
    for (int s = wg; s < NB * HS; s += G) {
        const float* src = lf + (size_t)s * SEQ + tid * 16; float v[16]; float run = 0.f;
#pragma unroll
        for (int i = 0; i < 16; ++i) { run += src[i]; v[i] = run; }
        part[tid] = run; __syncthreads();
        if (tid == 0) { float acc = 0.f; for (int i = 0; i < NTHR; ++i) { const float x = part[i]; part[i] = acc; acc += x; } }
        __syncthreads();
        const float base = part[tid]; float* dst = c2 + (size_t)s * SEQ + tid * 16;
#pragma unroll
        for (int i = 0; i < 16; ++i) dst[i] = (base + v[i]) * LOG2E;
        __syncthreads();
    }
}
__device__ __forceinline__ void ph_kbar(const Args& A, LAS unsigned char* lds, int wg, int G, int g_wid) {
    PH_IDS;
    const bf16* proj = (const bf16*)(A.ws + WS_PROJ); float* kbar = (float*)(A.ws + WS_KBAR); LAS float* part = (LAS float*)lds;
    const int d = tid & 63, r8 = tid >> 6;
    for (int uidx = wg; uidx < NB * HS * 32; uidx += G) {
        const int j = uidx & 31, bh = uidx >> 5, b = bh / HS, h = bh % HS;
        const bf16* kp = proj + ((size_t)(b * SEQ + j * 256 + r8 * 32)) * NPROJ + K_COL + h * 64 + d;
        float s = 0.f;
        for (int r = 0; r < 32; ++r) s += __uint_as_float((unsigned)kp[(size_t)r * NPROJ] << 16);
        part[tid] = s; __syncthreads();
        if (tid < 64) { float t = 0.f;
#pragma unroll
            for (int q = 0; q < 8; ++q) t += part[q * 64 + tid];
            kbar[(size_t)uidx * 64 + tid] = t * (1.f / 256.f); ((bf16*)(A.ws + WS_KBAR + 512 * 1024))[(size_t)uidx * 64 + tid] = (bf16)f2bf(t * (1.f / 256.f)); }
        __syncthreads();
    }
}

__device__ __forceinline__ float alibi_slope(int h) { return h < 8 ? exp2f(-(float)(h + 1)) : exp2f(-(0.5f + (float)(h - 8))); }
#define ROW8(w, base, arr) do { arr[base + 0] = bflo(w.x); arr[base + 1] = bfhi(w.x); arr[base + 2] = bflo(w.y); arr[base + 3] = bfhi(w.y); arr[base + 4] = bflo(w.z); arr[base + 5] = bfhi(w.z); arr[base + 6] = bflo(w.w); arr[base + 7] = bfhi(w.w); } while (0)
__device__ __forceinline__ float dot_row64(const float (&q)[64], const bf16* p) {
    const v4u* p4 = (const v4u*)p; float s0 = 0.f, s1 = 0.f;
#pragma unroll
    for (int i = 0; i < 8; ++i) { if (i == 4) asm volatile("" ::: "memory"); const v4u w = p4[i];
        s0 += q[8 * i + 0] * bflo(w.x); s1 += q[8 * i + 1] * bfhi(w.x); s0 += q[8 * i + 2] * bflo(w.y); s1 += q[8 * i + 3] * bfhi(w.y);
        s0 += q[8 * i + 4] * bflo(w.z); s1 += q[8 * i + 5] * bfhi(w.z); s0 += q[8 * i + 6] * bflo(w.w); s1 += q[8 * i + 7] * bfhi(w.w); }
    return s0 + s1;
}
__device__ __forceinline__ void att_upd(float x, const bf16* vrow, float& m, float& l, float (&o)[64]) {
    const float mn = fmaxf(m, x), al = fexp2(m - mn), pp = fexp2(x - mn); m = mn; l = l * al + pp;
    const v4u* p4 = (const v4u*)vrow; asm volatile("" ::: "memory");
#pragma unroll
    for (int i = 0; i < 8; ++i) { if ((i & 1) == 0) asm volatile("" ::: "memory"); const v4u w = p4[i];
        o[8 * i + 0] = o[8 * i + 0] * al + pp * bflo(w.x); o[8 * i + 1] = o[8 * i + 1] * al + pp * bfhi(w.x); o[8 * i + 2] = o[8 * i + 2] * al + pp * bflo(w.y); o[8 * i + 3] = o[8 * i + 3] * al + pp * bfhi(w.y);
        o[8 * i + 4] = o[8 * i + 4] * al + pp * bflo(w.z); o[8 * i + 5] = o[8 * i + 5] * al + pp * bfhi(w.z); o[8 * i + 6] = o[8 * i + 6] * al + pp * bflo(w.w); o[8 * i + 7] = o[8 * i + 7] * al + pp * bfhi(w.w); }
}
template <int MODE, int H_LO = 0, int H_HI = 16>
__device__ __forceinline__ void ph_attn_naive(const Args& A, int wg, int G, int g_wid) {
    PH_IDS;
    const bf16* proj = (const bf16*)(A.ws + WS_PROJ); const bf16* mkv = (const bf16*)(A.ws + WS_MKV); bf16* att = (bf16*)(A.ws + WS_ATT);
    const float* kbar = (const float*)(A.ws + WS_KBAR); const float* cfox = (const float*)(A.ws + WS_CFOX);
    constexpr int NIT = 16 * (NTOK / 64);
    const int gw = wg * NWAVES + wid, NGW = G * NWAVES;
    for (int base = 0, rnd = 0; base < NIT; base += NGW, ++rnd) {
        const int it = base + ((rnd & 1) ? (NGW - 1 - gw) : gw);
        if (it >= NIT) continue;
        const int hh = it & 15, tg = it >> 4, n = tg * 64 + lane, b = n >> 13, t = n & (SEQ - 1);
        if (hh < H_LO || hh >= H_HI) continue;
        float q[64];
        { const v4u* p4 = (const v4u*)(proj + (size_t)n * NPROJ + (hh < HS ? hh * 64 : QM_COL + (hh - HS) * 64));
#pragma unroll
          for (int i = 0; i < 8; ++i) { const v4u w = p4[i]; ROW8(w, 8 * i, q); } }
        float m = -1e30f, l = 0.f; float o[64];
#pragma unroll
        for (int i = 0; i < 64; ++i) o[i] = 0.f;
        if (hh < HS) {
            const bf16* Kb = proj + (size_t)(b * SEQ) * NPROJ + K_COL + hh * 64; const bf16* Vb = Kb + (V_COL - K_COL);
            if (MODE == 0) {
                const float slope2 = alibi_slope(hh) * LOG2E; const int qb = t >> 8;
                const float* kb = kbar + (size_t)((b * HS + hh) * 32) * 64;
                float g0 = -INFINITY, g1 = -INFINITY, g2 = -INFINITY; int i0 = -1, i1 = -1, i2 = -1;
                for (int j = 0; j < qb; ++j) { float s0 = 0.f, s1 = 0.f;
#pragma unroll
                    for (int d = 0; d < 64; d += 2) { s0 += q[d] * kb[j * 64 + d]; s1 += q[d + 1] * kb[j * 64 + d + 1]; }
                    const float g = s0 + s1;
                    if (g > g0) { g2 = g1; i2 = i1; g1 = g0; i1 = i0; g0 = g; i0 = j; } else if (g > g1) { g2 = g1; i2 = i1; g1 = g; i1 = j; } else if (g > g2) { g2 = g; i2 = j; } }
                const int tend = (t | 63);
                for (int s = qb * 256; s <= tend; ++s) { if (s <= t) { const float x = dot_row64(q, Kb + (size_t)s * NPROJ) - slope2 * (float)(t - s); att_upd(x, Vb + (size_t)s * NPROJ, m, l, o); } }
                for (int sl = 0; sl < 3; ++sl) { const int jb = sl == 0 ? i0 : (sl == 1 ? i1 : i2);
                    if (jb >= 0) for (int s = 0; s < 256; ++s) { const int key = jb * 256 + s; const float x = dot_row64(q, Kb + (size_t)key * NPROJ) - slope2 * (float)(t - key); att_upd(x, Vb + (size_t)key * NPROJ, m, l, o); } }
            } else {
                const float* c2 = cfox + (size_t)(b * HS + hh) * SEQ; const float cq = c2[t]; const int tend = (t | 63);
                for (int s = 0; s <= tend; ++s) { if (s <= t) { const float x = dot_row64(q, Kb + (size_t)s * NPROJ) + (cq - c2[s]); att_upd(x, Vb + (size_t)s * NPROJ, m, l, o); } }
            }
        } else {
            const bf16* Kb = mkv + (size_t)(b * NMEM) * 512 + (hh - HS) * 64; const bf16* Vb = Kb + 256;
            for (int s = 0; s < NMEM; ++s) { const float x = dot_row64(q, Kb + (size_t)s * 512); att_upd(x, Vb + (size_t)s * 512, m, l, o); }
        }
        const float rl = 1.f / l; v4u* op = (v4u*)(att + (size_t)n * DM + hh * 64);
#pragma unroll
        for (int i = 0; i < 8; ++i) { v4u w; w.x = pk2(o[8 * i] * rl, o[8 * i + 1] * rl); w.y = pk2(o[8 * i + 2] * rl, o[8 * i + 3] * rl); w.z = pk2(o[8 * i + 4] * rl, o[8 * i + 5] * rl); w.w = pk2(o[8 * i + 6] * rl, o[8 * i + 7] * rl); op[i] = w; }
    }
}


typedef float f32x16 __attribute__((ext_vector_type(16)));
typedef short s16x4 __attribute__((ext_vector_type(4)));
__device__ __forceinline__ int crow(int r, int hi) { return (r & 3) + 8 * (r >> 2) + 4 * hi; }
__device__ __forceinline__ void glds16(const void* gsrc, unsigned lds_dst) { unsigned keep;
    asm volatile("s_mov_b32 %0, m0\n\ts_mov_b32 m0, %2\n\ts_nop 0\n\tglobal_load_lds_dwordx4 %1, off\n\ts_mov_b32 m0, %0" : "=&s"(keep) : "v"(gsrc), "s"(lds_dst) : "memory"); }
__device__ __forceinline__ void glds4(const void* gsrc, unsigned lds_dst) { unsigned keep;
    asm volatile("s_mov_b32 %0, m0\n\ts_mov_b32 m0, %2\n\ts_nop 0\n\tglobal_load_lds_dword %1, off\n\ts_mov_b32 m0, %0" : "=&s"(keep) : "v"(gsrc), "s"(lds_dst) : "memory"); }
#define ATT_WAIT_BAR() asm volatile("s_waitcnt vmcnt(0) lgkmcnt(0)\n\ts_barrier" ::: "memory")
constexpr int ATT_K = 0, ATT_V = 16384, ATT_CK = 32768;
constexpr float ATT_THR = 8.0f;
__device__ __forceinline__ float swap_other(float v, int hi) { auto rr = __builtin_amdgcn_permlane32_swap(__float_as_uint(v), __float_as_uint(v), false, false); return __uint_as_float(hi ? rr[0] : rr[1]); }
__device__ __forceinline__ int swap_other_i(int v, int hi) { auto rr = __builtin_amdgcn_permlane32_swap((unsigned)v, (unsigned)v, false, false); return (int)(hi ? rr[0] : rr[1]); }

template <int MODE>
__device__ __forceinline__ void attn_unit(const Args& A, LAS unsigned char* lds, const int b, const int h, const int qb, const int wid, const int lane) {
    const int r32 = lane & 31, hi = lane >> 5, q0 = qb * 256, wrow0 = q0 + wid * 32, trow = wrow0 + r32;
    const bf16* proj = (const bf16*)(A.ws + WS_PROJ);
    constexpr int pitch = (MODE == 2) ? 512 : NPROJ;
    const bf16* Kb = (MODE == 2) ? (const bf16*)(A.ws + WS_MKV) + (size_t)(b * NMEM) * 512 + h * 64 : proj + (size_t)(b * SEQ) * NPROJ + K_COL + h * 64;
    const bf16* Vb = (MODE == 2) ? Kb + 256 : Kb + (V_COL - K_COL);
    const bf16* Qrow = proj + (size_t)(b * SEQ + trow) * NPROJ + ((MODE == 2) ? QM_COL : 0) + h * 64;
    bf16x8 qr[4];
#pragma unroll
    for (int d0 = 0; d0 < 4; ++d0) qr[d0] = *(const bf16x8*)(Qrow + 16 * d0 + 8 * hi);
    const unsigned ldsb = (unsigned)(uintptr_t)lds;
    const bf16* ksrc = Kb + (size_t)lane * pitch + wid * 8;
    const bf16* vsrc = Vb + (size_t)(16 * (wid & 3) + (lane >> 2)) * pitch + (wid >> 2) * 32 + (lane & 3) * 8;
    float cq = 0.f, slope2 = 0.f; const float* c2 = nullptr;
    if (MODE == 1) { c2 = (const float*)(A.ws + WS_CFOX) + (size_t)(b * HS + h) * SEQ; cq = c2[trow]; }
    if (MODE == 0) { slope2 = alibi_slope(h) * LOG2E; cq = -slope2 * (float)(trow - q0); }
#define ATT_STAGE(kt, buf) do { glds16(ksrc + (size_t)(kt) * 64 * pitch, (unsigned)__builtin_amdgcn_readfirstlane(ldsb + ATT_K + (buf) * 8192 + wid * 1024)); \
        glds16(vsrc + (size_t)(kt) * 64 * pitch, (unsigned)__builtin_amdgcn_readfirstlane(ldsb + ATT_V + (buf) * 8192 + wid * 1024)); \
        if (MODE == 1 && wid == 0) glds4(c2 + (kt) * 64 + lane, (unsigned)__builtin_amdgcn_readfirstlane(ldsb + ATT_CK + (buf) * 256)); \
        if (MODE == 0 && wid == 0) ((LAS float*)(lds + ATT_CK + (buf) * 256))[lane] = -slope2 * (float)((kt) * 64 + lane - q0); } while (0)
    unsigned selmask = 0u;
    if (MODE == 0) { if (qb > 0) {
        const bf16* kbp = (const bf16*)(A.ws + WS_KBAR + 512 * 1024) + ((size_t)((b * HS + h) * 32 + r32)) * 64 + 8 * hi;
        f32x16 g;
#pragma unroll
        for (int i = 0; i < 16; ++i) g[i] = 0.f;
#pragma unroll
        for (int d0 = 0; d0 < 4; ++d0) g = __builtin_amdgcn_mfma_f32_32x32x16_bf16(*(const bf16x8*)(kbp + 16 * d0), qr[d0], g, 0, 0, 0);
#pragma unroll
        for (int i = 0; i < 16; ++i) if (crow(i, hi) >= qb) g[i] = -INFINITY;
#pragma unroll
        for (int pick = 0; pick < 3; ++pick) {
            float bv = -INFINITY; int bj = 64;
#pragma unroll
            for (int i = 0; i < 16; ++i) if (g[i] > bv) { bv = g[i]; bj = crow(i, hi); }
            const float pv = swap_other(bv, hi); const int pj = swap_other_i(bj, hi);
            if (pv > bv || (pv == bv && pj < bj)) { bv = pv; bj = pj; }
            if (bv > -INFINITY) { selmask |= 1u << bj;
#pragma unroll
                for (int i = 0; i < 16; ++i) if (crow(i, hi) == bj) g[i] = -INFINITY; }
        } } }
    const int ktop = (MODE == 2) ? 3 : 4 * qb + 3, klo = 0, ntile = ktop - klo + 1;
    float mhat = 0.f, lsum = 0.f; bool started = false;
    f32x16 o0, o1;
#pragma unroll
    for (int i = 0; i < 16; ++i) { o0[i] = 0.f; o1[i] = 0.f; }
    const LAS unsigned char* vp0 = lds + ATT_V + ((lane >> 4) & 1) * 32 + (lane & 3) * 8 + (4 * hi + ((lane & 15) >> 2)) * 64;
    ATT_STAGE(ktop, 0);
    for (int it = 0; it < ntile; ++it) {
        const int kt = ktop - it, buf = it & 1;
        ATT_WAIT_BAR();
        if (it + 1 < ntile) ATT_STAGE(kt - 1, buf ^ 1);
        bool active = true, diag = false, selv = true;
        if (MODE != 2) {
            if (kt * 64 > wrow0 + 31) active = false;
            diag = (kt * 64 + 63 > wrow0);
            if (MODE == 0) { const int j = kt >> 2; if (j < qb) { selv = ((selmask >> j) & 1u) != 0u; if (__builtin_amdgcn_ballot_w64(selv) == 0ull) active = false; } }
        }
        if (active) {
            f32x16 p0, p1;
            const float bs = (MODE == 2) ? -mhat : (selv ? cq - mhat : -INFINITY);
            if (MODE == 2) {
#pragma unroll
                for (int r = 0; r < 16; ++r) { p0[r] = bs; p1[r] = bs; }
            } else {
                const LAS f32x4* ckp = (const LAS f32x4*)(lds + ATT_CK + buf * 256);
#pragma unroll
                for (int g = 0; g < 4; ++g) { const f32x4 c = ckp[2 * g + hi], d = ckp[8 + 2 * g + hi];
                    p0[4 * g] = bs - c.x; p0[4 * g + 1] = bs - c.y; p0[4 * g + 2] = bs - c.z; p0[4 * g + 3] = bs - c.w;
                    p1[4 * g] = bs - d.x; p1[4 * g + 1] = bs - d.y; p1[4 * g + 2] = bs - d.z; p1[4 * g + 3] = bs - d.w; }
            }
            const LAS unsigned char* kb = lds + ATT_K + buf * 8192 + hi * 1024 + r32 * 16;
#pragma unroll
            for (int d0 = 0; d0 < 4; ++d0) { const bf16x8 k0 = *(const LAS bf16x8*)(kb + d0 * 2048), k1 = *(const LAS bf16x8*)(kb + d0 * 2048 + 512);
                p0 = __builtin_amdgcn_mfma_f32_32x32x16_bf16(k0, qr[d0], p0, 0, 0, 0); p1 = __builtin_amdgcn_mfma_f32_32x32x16_bf16(k1, qr[d0], p1, 0, 0, 0); }
            if (diag) {
#pragma unroll
                for (int r = 0; r < 16; ++r) { const int kv = kt * 64 + crow(r, hi); if (kv > trow) p0[r] = -INFINITY; if (kv + 32 > trow) p1[r] = -INFINITY; }
            }
            float rm = fmaxf(p0[0], p1[0]);
#pragma unroll
            for (int r = 1; r < 16; ++r) rm = fmaxf(rm, fmaxf(p0[r], p1[r]));
            rm = fmaxf(rm, swap_other(rm, hi));
            const bool need = started ? (__builtin_amdgcn_ballot_w64(rm > ATT_THR) != 0ull) : true;
            if (need) { const float dl = started ? fmaxf(rm, 0.f) : rm; mhat += dl;
#pragma unroll
                for (int r = 0; r < 16; ++r) { p0[r] -= dl; p1[r] -= dl; }
                if (started) { const float f = fexp2(-dl); lsum *= f;
#pragma unroll
                    for (int r = 0; r < 16; ++r) { o0[r] *= f; o1[r] *= f; } }
                started = true; }
            float s0 = 0.f, s1 = 0.f;
#pragma unroll
            for (int r = 0; r < 16; ++r) { p0[r] = fexp2(p0[r]); p1[r] = fexp2(p1[r]); s0 += p0[r]; s1 += p1[r]; }
            lsum += s0 + s1;
            bf16x8 pa[4];
#pragma unroll
            for (int ks = 0; ks < 4; ++ks) { v4u w;
                if (ks < 2) { w.x = pk2(p0[8 * ks], p0[8 * ks + 1]); w.y = pk2(p0[8 * ks + 2], p0[8 * ks + 3]); w.z = pk2(p0[8 * ks + 4], p0[8 * ks + 5]); w.w = pk2(p0[8 * ks + 6], p0[8 * ks + 7]); }
                else { const int k2 = ks - 2; w.x = pk2(p1[8 * k2], p1[8 * k2 + 1]); w.y = pk2(p1[8 * k2 + 2], p1[8 * k2 + 3]); w.z = pk2(p1[8 * k2 + 4], p1[8 * k2 + 5]); w.w = pk2(p1[8 * k2 + 6], p1[8 * k2 + 7]); }
                pa[ks] = __builtin_bit_cast(bf16x8, w); }
            const LAS unsigned char* vp = vp0 + buf * 8192;
#pragma unroll
            for (int ks = 0; ks < 4; ++ks) {
#pragma unroll
                for (int d0 = 0; d0 < 2; ++d0) {
                    const s16x4 lo = __builtin_bit_cast(s16x4, __builtin_amdgcn_ds_read_tr16_b64_v4i16((LAS s16x4*)(vp + d0 * 4096 + ks * 1024)));
                    const s16x4 hh = __builtin_bit_cast(s16x4, __builtin_amdgcn_ds_read_tr16_b64_v4i16((LAS s16x4*)(vp + d0 * 4096 + ks * 1024 + 512)));
                    const bf16x8 vf = (bf16x8){lo[0], lo[1], lo[2], lo[3], hh[0], hh[1], hh[2], hh[3]};
                    if (d0 == 0) o0 = __builtin_amdgcn_mfma_f32_32x32x16_bf16(vf, pa[ks], o0, 0, 0, 0); else o1 = __builtin_amdgcn_mfma_f32_32x32x16_bf16(vf, pa[ks], o1, 0, 0, 0); } }
        }
    }
    ATT_WAIT_BAR();
    lsum += swap_other(lsum, hi);
    const float rl = 1.f / lsum;
    bf16* Op = (bf16*)(A.ws + WS_ATT) + (size_t)(b * SEQ + trow) * DM + ((MODE == 2) ? HS * 64 : 0) + h * 64 + 4 * hi;
#pragma unroll
    for (int g = 0; g < 4; ++g) {
        v2u w0, w1; w0.x = pk2(o0[4 * g] * rl, o0[4 * g + 1] * rl); w0.y = pk2(o0[4 * g + 2] * rl, o0[4 * g + 3] * rl);
        w1.x = pk2(o1[4 * g] * rl, o1[4 * g + 1] * rl); w1.y = pk2(o1[4 * g + 2] * rl, o1[4 * g + 3] * rl);
        *(v2u*)(Op + 8 * g) = w0; *(v2u*)(Op + 32 + 8 * g) = w1; }
#undef ATT_STAGE
}
template <int MODE01, bool DO_SELF = true, bool DO_MEM = true>
__device__ __forceinline__ void ph_attn_fast(const Args& A, LAS unsigned char* lds, int wg, int G, int g_wid) {
    PH_IDS;
    constexpr int NSELF = NB * HS * 32, NU = NSELF + NB * HMEM * 32;
    for (int i = 0; ; ++i) {
        const int slot = (i & 1) ? (G - 1 - wg) : wg; const int L = i * G + slot; if (i * G >= NU) break; if (L >= NU) continue;
        if (L < NSELF) { if (DO_SELF) { const int qb = 31 - L / (NB * HS), bh = L % (NB * HS); attn_unit<MODE01>(A, lds, bh / HS, bh % HS, qb, wid, lane); } }
        else if (DO_MEM) { const int m = L - NSELF, qb = m & 31, bhm = m >> 5; attn_unit<2>(A, lds, bhm >> 2, bhm & 3, qb, wid, lane); }
    }
}

__device__ __forceinline__ void ph_ln1_router(const Args& A, int layer, LAS unsigned char* lds, int wg, int G, int g_wid) {
    PH_IDS;
    float* hres = A.out; bf16* hb = (bf16*)(A.ws + WS_HB); unsigned* elist = (unsigned*)(A.ws + WS_ELIST); float* agate = (float*)(A.ws + WS_AGATE);
    unsigned* ecnt = (unsigned*)(A.ws + WS_CTL) + CW_ECNT + layer * 64;
    const float* rw = A.in[I_RW] + (size_t)layer * DM * NEXP; const float* rb = A.in[I_RB] + layer * NEXP;
    const float* g1 = A.in[I_LN1G] + layer * DM; const float* b1 = A.in[I_LN1B] + layer * DM;
    LAS float* rwT = (LAS float*)lds; LAS int* lcnt = (LAS int*)(lds + 131072); LAS int* gbase = lcnt + 32; LAS unsigned* rec = (LAS unsigned*)(lds + 131584);
    const int RPW = (NTOK + G - 1) / G;
    for (int i = tid; i < DM * NEXP; i += NTHR) rwT[(i & 31) * DM + (i >> 5)] = rw[i];
    if (tid < 32) lcnt[tid] = 0;
    __syncthreads();
    const int row0 = wg * RPW, row1 = (row0 + RPW < NTOK) ? row0 + RPW : NTOK;
    for (int n = row0 + wid; n < row1; n += NWAVES) {
        f32x4 v[4]; float s = 0.f; float* xr = hres + (size_t)n * DM;
#pragma unroll
        for (int j = 0; j < 4; ++j) { v[j] = *(const f32x4*)(xr + 4 * lane + 256 * j); s += (v[j].x + v[j].y) + (v[j].z + v[j].w); }
        const float mean = wave_sum(s) * (1.f / DM); float s2 = 0.f;
#pragma unroll
        for (int j = 0; j < 4; ++j) { v[j] = v[j] - mean; s2 += (v[j].x * v[j].x + v[j].y * v[j].y) + (v[j].z * v[j].z + v[j].w * v[j].w); }
        const float rstd = 1.f / sqrtf(wave_sum(s2) * (1.f / DM) + LN_EPS);
#pragma unroll
        for (int j = 0; j < 4; ++j) { const f32x4 gg = *(const f32x4*)(g1 + 4 * lane + 256 * j), bb = *(const f32x4*)(b1 + 4 * lane + 256 * j);
            v[j] = v[j] * rstd * gg + bb; *(f32x4*)(xr + 4 * lane + 256 * j) = v[j];
            v2u w; w.x = pk2(v[j].x, v[j].y); w.y = pk2(v[j].z, v[j].w); *(v2u*)(hb + (size_t)n * DM + 4 * lane + 256 * j) = w; }
        float lg[32];
#pragma unroll
        for (int e = 0; e < 32; ++e) { float p = 0.f;
#pragma unroll
            for (int j = 0; j < 4; ++j) { const f32x4 r4 = *(const LAS f32x4*)(rwT + e * DM + 4 * lane + 256 * j); p += (v[j].x * r4.x + v[j].y * r4.y) + (v[j].z * r4.z + v[j].w * r4.w); }
            lg[e] = wave_sum(p) + rb[e]; asm volatile("" ::: "memory"); }
        float tv[4]; int ti[4];
#pragma unroll
        for (int k = 0; k < 4; ++k) { float best = -INFINITY; int bi = 0;
#pragma unroll
            for (int e = 0; e < 32; ++e) { if (lg[e] > best) { best = lg[e]; bi = e; } }
            tv[k] = best; ti[k] = bi;
#pragma unroll
            for (int e = 0; e < 32; ++e) if (e == bi) lg[e] = -INFINITY; }
        const float e1 = expf(tv[1] - tv[0]), e2 = expf(tv[2] - tv[0]), e3 = expf(tv[3] - tv[0]); const float inv = 1.f / (1.f + e1 + e2 + e3);
        if (lane < 4) { const int ek = lane == 0 ? ti[0] : lane == 1 ? ti[1] : lane == 2 ? ti[2] : ti[3]; const float gk = (lane == 0 ? 1.f : lane == 1 ? e1 : lane == 2 ? e2 : e3) * inv;
            const int lp = atomicAdd((int*)lcnt + ek, 1);
            const int ri = (n - row0) * 4 + lane; rec[2 * ri] = (unsigned)ek | ((unsigned)lp << 8); rec[2 * ri + 1] = __float_as_uint(gk); }
    }
    __syncthreads();
    if (tid < 32) gbase[tid] = (int)__hip_atomic_fetch_add(ecnt + tid, (unsigned)lcnt[tid], __ATOMIC_RELAXED, __HIP_MEMORY_SCOPE_AGENT);
    __syncthreads();
    for (int ri = tid; ri < (row1 - row0) * 4; ri += NTHR) { const unsigned w = rec[2 * ri]; const int e = w & 31, lp = w >> 8; const unsigned aid = (unsigned)(row0 * 4 + ri);
        elist[(size_t)e * NTOK + gbase[e] + lp] = aid; agate[aid] = __uint_as_float(rec[2 * ri + 1]); }
    __syncthreads();
}

__device__ __forceinline__ void ph_combine_ln2(const Args& A, int layer, int wg, int G, int g_wid) {
    PH_IDS;
    float* hres = A.out; bf16* hb = (bf16*)(A.ws + WS_HB); const bf16* ybuf = (const bf16*)(A.ws + WS_YBUF);
    const float* g2 = A.in[I_LN2G] + layer * DM; const float* b2 = A.in[I_LN2B] + layer * DM;
    const int gw = wg * NWAVES + wid, NGW = G * NWAVES;
    for (int n = gw; n < NTOK; n += NGW) {
        f32x4 v[4]; float s = 0.f; float* xr = hres + (size_t)n * DM;
#pragma unroll
        for (int j = 0; j < 4; ++j) { v[j] = *(const f32x4*)(xr + 4 * lane + 256 * j) * ALPHA;
#pragma unroll
            for (int k = 0; k < 4; ++k) { const v2u w = *(const v2u*)(ybuf + ((size_t)n * 4 + k) * DM + 4 * lane + 256 * j); v[j].x += bflo(w.x); v[j].y += bfhi(w.x); v[j].z += bflo(w.y); v[j].w += bfhi(w.y); }
            s += (v[j].x + v[j].y) + (v[j].z + v[j].w); }
        const float mean = wave_sum(s) * (1.f / DM); float s2 = 0.f;
#pragma unroll
        for (int j = 0; j < 4; ++j) { v[j] = v[j] - mean; s2 += (v[j].x * v[j].x + v[j].y * v[j].y) + (v[j].z * v[j].z + v[j].w * v[j].w); }
        const float rstd = 1.f / sqrtf(wave_sum(s2) * (1.f / DM) + LN_EPS);
#pragma unroll
        for (int j = 0; j < 4; ++j) { const f32x4 gg = *(const f32x4*)(g2 + 4 * lane + 256 * j), bb = *(const f32x4*)(b2 + 4 * lane + 256 * j);
            v[j] = v[j] * rstd * gg + bb; *(f32x4*)(xr + 4 * lane + 256 * j) = v[j];
            v2u w; w.x = pk2(v[j].x, v[j].y); w.y = pk2(v[j].z, v[j].w); *(v2u*)(hb + (size_t)n * DM + 4 * lane + 256 * j) = w; }
    }
}

#define IN(k) (lo <= (k) && (k) < hi)
#define SEAM(k) do { if ((k) + 1 < hi) xcd_barrier(bar); } while (0)
template <int layer>
__device__ __forceinline__ void run_layer(LAS unsigned char* lds, const int wg, const int G, const int wid0, const int lo, const int hi, const XcdBarrier& bar) {
        constexpr int pb = 1 + 8 * layer; constexpr bool fox = (layer & 1) != 0;
        if (IN(pb + 0)) {
            { const Args A = load_args(); unsigned char* ws = A.ws;
              DenseSched S{(const bf16*)(ws + WS_HB), (const bf16*)(ws + WS_WIN) + (size_t)layer * NPROJ * DM, NTOK / 256, NPROJ / 256, G, wg};
              EpiProj E{(bf16*)(ws + WS_PROJ), NPROJ, K_COL, QM_COL};
              gemm_fast<EpiProj, DenseSched, true>(lds, S, E, wid0); }
            if constexpr (layer == 0) { const Args A = load_args(); unsigned char* ws = A.ws;
              DenseSched S{(const bf16*)(ws + WS_MEMB), (const bf16*)(ws + WS_WMKV), NB * NMEM / 256, 2, G, wg};
              EpiProj E{(bf16*)(ws + WS_MKV), 512, 0, 1 << 30};
              gemm_fast<EpiProj, DenseSched, true>(lds, S, E, wid0); }
            if constexpr (fox) { const Args A = load_args(); ph_fox_gate(A, layer >> 1, wg, G, wid0); }
            SEAM(pb + 0);
        }
        if (IN(pb + 1)) { const Args A = load_args(); if constexpr (fox) ph_fox_scan(A, lds, wg, G, wid0); else ph_kbar(A, lds, wg, G, wid0); SEAM(pb + 1); }
        if (IN(pb + 2)) { const Args A = load_args(); ph_attn_fast<fox ? 1 : 0>(A, lds, wg, G, wid0); SEAM(pb + 2); }
        if (IN(pb + 3)) {
            const Args A = load_args(); unsigned char* ws = A.ws;
            DenseSched S{(const bf16*)(ws + WS_ATT), (const bf16*)(ws + WS_WO) + (size_t)layer * DM * DM, NTOK / 256, DM / 256, G, wg};
            EpiOut E{layer == 0 ? A.in[I_X] : A.out, A.out};
            gemm_fast<EpiOut, DenseSched, true>(lds, S, E, wid0); SEAM(pb + 3);
        }
        if (IN(pb + 4)) { const Args A = load_args(); ph_ln1_router(A, layer, lds, wg, G, wid0); SEAM(pb + 4); }
        if (IN(pb + 5)) {
            const Args A = load_args(); unsigned char* ws = A.ws;
            LAS int* tab = (LAS int*)(lds + MISC_OFF) + 64; moe_tables(tab, (unsigned*)(ws + WS_CTL) + CW_ECNT + layer * 64, wid0);
            MoeSched S{(const bf16*)(ws + WS_HB), (const bf16*)(ws + WS_WGU) + (size_t)layer * NEXP * 2048 * DM, (const unsigned*)(ws + WS_ELIST), tab, 8, 2048, G, wg, 2};
            EpiGU E{(bf16*)(ws + WS_ABUF), A.in[I_BGU] + (size_t)layer * NEXP * 2048};
            gemm_fast<EpiGU, MoeSched, true>(lds, S, E, wid0); __syncthreads(); SEAM(pb + 5);
        }
        if (IN(pb + 6)) {
            const Args A = load_args(); unsigned char* ws = A.ws;
            LAS int* tab = (LAS int*)(lds + MISC_OFF) + 64; moe_tables(tab, (unsigned*)(ws + WS_CTL) + CW_ECNT + layer * 64, wid0);
            MoeSched S{(const bf16*)(ws + WS_ABUF), (const bf16*)(ws + WS_WDN) + (size_t)layer * NEXP * DM * DM, (const unsigned*)(ws + WS_ELIST), tab, 4, 1024, G, wg, 0};
            EpiDN E{(bf16*)(ws + WS_YBUF), A.in[I_BDN] + (size_t)layer * NEXP * DM, (const float*)(ws + WS_AGATE)};
            gemm_fast<EpiDN, MoeSched, true>(lds, S, E, wid0); __syncthreads(); SEAM(pb + 6);
        }
        if (IN(pb + 7)) { const Args A = load_args(); ph_combine_ln2(A, layer, wg, G, wid0); SEAM(pb + 7); }
}
__global__ void __launch_bounds__(NTHR, 2) k_main(Args A0) {
    extern __shared__ __attribute__((aligned(16))) unsigned char lds_raw[];
    LAS unsigned char* lds = (LAS unsigned char*)lds_raw;
    volatile LAS unsigned* MISC = (volatile LAS unsigned*)(lds + MISC_OFF);
    const int wid0 = __builtin_amdgcn_readfirstlane((int)threadIdx.x >> 6);
    const int G = gridDim.x, wg = blockIdx.x;
    const int lo = A0.p_lo, hi = A0.p_hi;
    if (threadIdx.x < 64) MISC[threadIdx.x] = 0u;
    __syncthreads();
    XcdBarrier bar; bar.bar = (unsigned*)(A0.ws + WS_CTL) + CW_BAR; bar.x = 0; bar.st = nullptr; bar.wid = wid0;
    if (hi - lo > 1) bar = xcd_barrier_post((unsigned*)(A0.ws + WS_CTL) + CW_BAR + (size_t)lo * XCD_BAR_WORDS, MISC + 8, wid0);
    if (IN(0)) { const Args A = load_args(); ph_convert(A, lds, wg, G, wid0); SEAM(0); }
    run_layer<0>(lds, wg, G, wid0, lo, hi, bar); run_layer<1>(lds, wg, G, wid0, lo, hi, bar); run_layer<2>(lds, wg, G, wid0, lo, hi, bar); run_layer<3>(lds, wg, G, wid0, lo, hi, bar);
#undef IN
#undef SEAM
}

#ifndef MK_ONE_LAUNCH
#define MK_ONE_LAUNCH 1
#endif
extern "C" void kernel_launch(void* const* d_in, const int* in_sizes, int n_in, void* d_out, int out_size, void* d_ws, size_t ws_size, hipStream_t stream) {
    static int grid = 0;
    if (grid == 0) {
        if (n_in != 17 || out_size != NTOK * DM || ws_size < WS_END) { fprintf(stderr, "kernel_launch: unexpected shapes (n_in %d out %d ws %zu, need %zu)\n", n_in, out_size, ws_size, (size_t)WS_END); grid = -1; return; }
        int dev = 0, cus = 0, per_cu = 0;
        if (hipGetDevice(&dev) != hipSuccess || hipDeviceGetAttribute(&cus, hipDeviceAttributeMultiprocessorCount, dev) != hipSuccess) { grid = -1; return; }
        if (hipFuncSetAttribute((const void*)k_main, hipFuncAttributeMaxDynamicSharedMemorySize, LDS_BYTES) != hipSuccess) { fprintf(stderr, "kernel_launch: hipFuncSetAttribute failed\n"); grid = -1; return; }
        if (hipOccupancyMaxActiveBlocksPerMultiprocessor(&per_cu, (const void*)k_main, NTHR, LDS_BYTES) != hipSuccess || per_cu < 1) { fprintf(stderr, "kernel_launch: occupancy query says %d\n", per_cu); }
        (void)hipGetLastError();
        grid = cus;
    }
    if (grid < 0) return;
    (void)hipMemsetAsync((char*)d_ws + WS_CTL, 0, CTL_ZERO_BYTES, stream);
    Args a{};
    for (int i = 0; i < 17; ++i) a.in[i] = (const float*)d_in[i];
    a.out = (float*)d_out; a.ws = (unsigned char*)d_ws;
#if MK_ONE_LAUNCH
    a.p_lo = 0; a.p_hi = NPHASE;
    hipLaunchKernelGGL(k_main, dim3(grid), dim3(NTHR), LDS_BYTES, stream, a);
#else
    for (int p = 0; p < NPHASE; ++p) { a.p_lo = p; a.p_hi = p + 1; hipLaunchKernelGGL(k_main, dim3(grid), dim3(NTHR), LDS_BYTES, stream, a); }
#endif
}
```

```cpp
#include <hip/hip_runtime.h>
#include <cstdio>
#include <cstdint>

#define GAS __attribute__((address_space(1)))
#define LAS __attribute__((address_space(3)))
typedef unsigned short bf16;
typedef unsigned v4u __attribute__((ext_vector_type(4)));
typedef unsigned v2u __attribute__((ext_vector_type(2)));
typedef float f32x4 __attribute__((ext_vector_type(4)));
typedef short bf16x8 __attribute__((ext_vector_type(8)));

constexpr int NB = 4, SEQ = 8192, DM = 1024, NTOK = NB * SEQ;
constexpr int HS = 12, HMEM = 4, HD = 64, NMEM = 256, NPROJ = 2560, QM_COL = 2304, K_COL = 768, V_COL = 1536;
constexpr int NEXP = 32, TOPK = 4, DEPTH = 4, NASSIGN = NTOK * TOPK, DFF = 1024;
constexpr float ALPHA = 1.6817928305074290f, LN_EPS = 1e-5f, LOG2E = 1.4426950408889634f, C2 = 0.125f * 1.4426950408889634f;
constexpr float SW_LIMIT = 7.0f, SW_ALPHA = 1.702f;
constexpr int NWAVES = 8, NTHR = 512;

constexpr size_t MiB = 1u << 20;
constexpr size_t WS_CTL = 0, CTL_ZERO_BYTES = 1 * MiB;
constexpr size_t WS_WIN = 2 * MiB;
constexpr size_t WS_WFG = WS_WIN + (size_t)4 * NPROJ * DM * 2;
constexpr size_t WS_WMKV = WS_WFG + 1 * MiB;
constexpr size_t WS_WO = WS_WMKV + 1 * MiB;
constexpr size_t WS_WGU = WS_WO + 8 * MiB;
constexpr size_t WS_WDN = WS_WGU + 512 * MiB;
constexpr size_t WS_HB = WS_WDN + 256 * MiB;
constexpr size_t WS_MEMB = WS_HB + 64 * MiB;
constexpr size_t WS_MKV = WS_MEMB + 2 * MiB;
constexpr size_t WS_PROJ = WS_MKV + 1 * MiB;
constexpr size_t WS_CFOX = WS_PROJ + 160 * MiB;
constexpr size_t WS_LF = WS_CFOX + 2 * MiB;
constexpr size_t WS_KBAR = WS_LF + 2 * MiB;
constexpr size_t WS_ATT = WS_KBAR + 1 * MiB;
constexpr size_t WS_ELIST = WS_ATT + 64 * MiB;
constexpr size_t WS_AGATE = WS_ELIST + 4 * MiB;
constexpr size_t WS_ABUF = WS_AGATE + 1 * MiB;
constexpr size_t WS_YBUF = WS_ABUF + 256 * MiB;
constexpr size_t WS_END = WS_YBUF + 256 * MiB;

constexpr int CW_ECNT = 1024;
constexpr int CW_NORM = 1536;
constexpr int CW_AQ = 2560;
constexpr int CW_BAR = 4096;
constexpr int NPHASE = 1 + 8 * DEPTH;

constexpr int LDS_BYTES = 147456, SCR_BYTES = 146432, MISC_OFF = SCR_BYTES;

__device__ __forceinline__ unsigned f2bf(float f) { unsigned u = __float_as_uint(f); return (u + 0x7fffu + ((u >> 16) & 1u)) >> 16; }
typedef float f32x2_t __attribute__((ext_vector_type(2))); typedef __bf16 bf16x2_t __attribute__((ext_vector_type(2)));
__device__ __forceinline__ unsigned pk2(float lo, float hi) { const f32x2_t v = {lo, hi}; const bf16x2_t b = __builtin_convertvector(v, bf16x2_t); return __builtin_bit_cast(unsigned, b); }
__device__ __forceinline__ float bflo(unsigned w) { return __uint_as_float(w << 16); }
__device__ __forceinline__ float bfhi(unsigned w) { return __uint_as_float(w & 0xffff0000u); }
__device__ __forceinline__ float wave_sum(float v) {
    v += __builtin_bit_cast(float, __builtin_amdgcn_update_dpp(0, __builtin_bit_cast(int, v), 0xB1, 0xF, 0xF, false));
    v += __builtin_bit_cast(float, __builtin_amdgcn_update_dpp(0, __builtin_bit_cast(int, v), 0x4E, 0xF, 0xF, false));
    v += __builtin_bit_cast(float, __builtin_amdgcn_update_dpp(0, __builtin_bit_cast(int, v), 0x141, 0xF, 0xF, false));
    v += __builtin_bit_cast(float, __builtin_amdgcn_update_dpp(0, __builtin_bit_cast(int, v), 0x140, 0xF, 0xF, false));
    v += __builtin_bit_cast(float, __builtin_amdgcn_update_dpp(0, __builtin_bit_cast(int, v), 0x142, 0xA, 0xF, false));
    v += __builtin_bit_cast(float, __builtin_amdgcn_update_dpp(0, __builtin_bit_cast(int, v), 0x143, 0xC, 0xF, false));
    return __builtin_bit_cast(float, __builtin_amdgcn_readlane(__builtin_bit_cast(int, v), 63));
}
__device__ __forceinline__ float fexp2(float x) { return __builtin_amdgcn_exp2f(x); }
#define PH_IDS int lane; asm volatile("v_mbcnt_lo_u32_b32 %0, -1, 0\n\tv_mbcnt_hi_u32_b32 %0, -1, %0" : "=v"(lane)); const int wid = __builtin_amdgcn_readfirstlane(g_wid); const int tid = wid * 64 + lane; (void)tid

#define XB_TMO      128
#define XB_XCNT(j)  (256  + 64 * (j))
#define XB_XSUB(j)  (1280 + 64 * (j))
#define XB_XGEN(j)  (2304 + 64 * (j))
#define XB_TOP      3328
#define XB_TOPGEN   3392
#define XCD_BAR_WORDS 3456
#define XB_SPIN_CAP (1u << 22)
__device__ __forceinline__ unsigned xb_ld(unsigned* p)              { return __hip_atomic_load(p, __ATOMIC_RELAXED, __HIP_MEMORY_SCOPE_AGENT); }
__device__ __forceinline__ unsigned xb_add(unsigned* p, unsigned v) { return __hip_atomic_fetch_add(p, v, __ATOMIC_RELAXED, __HIP_MEMORY_SCOPE_AGENT); }
__device__ __forceinline__ unsigned xb_xcc_id() { return (unsigned)__builtin_amdgcn_s_getreg((3 << 11) | 20) & 0xFu; }
#define XB_SPIN(cond, bar) do { unsigned _sp = 0; while (cond) { __builtin_amdgcn_s_sleep(1); \
    if ((++_sp & 255u) == 0u) { if (xb_ld(&(bar)[XB_TMO])) break; if (_sp > XB_SPIN_CAP) { atomicAdd(&(bar)[XB_TMO], 1u); break; } } } } while (0)
struct XcdBarrier { unsigned* bar; unsigned x; volatile LAS unsigned* st; int wid; };
__device__ __forceinline__ bool xb_t0(int w) { int l; asm volatile("v_mbcnt_lo_u32_b32 %0, -1, 0\n\tv_mbcnt_hi_u32_b32 %0, -1, %0" : "=v"(l)); return w == 0 && l == 0; }
#define XB_T0(w) xb_t0(w)
__device__ __forceinline__ XcdBarrier xcd_barrier_post(unsigned* bar, volatile LAS unsigned* st, int wid) {
    XcdBarrier b; b.bar = bar; b.x = xb_xcc_id(); b.st = st; b.wid = wid;
    if (XB_T0(wid)) (void)xb_add(&bar[XB_XCNT(b.x)], 1u);
    return b;
}
__device__ __forceinline__ void xcd_barrier_complete(unsigned* bar, unsigned x, unsigned& nloc, unsigned& nx) {
    const unsigned G = gridDim.x * gridDim.y * gridDim.z;
    unsigned sum, cnt, mine, sp = 0u;
    for (;;) {
        sum = 0u; cnt = 0u; mine = 0u;
#pragma unroll
        for (unsigned j = 0; j < 16; ++j) { const unsigned c = xb_ld(&bar[XB_XCNT(j)]); sum += c; cnt += (c > 0u) ? 1u : 0u; mine = (j == x) ? c : mine; }
        if (sum == G) break;
        __builtin_amdgcn_s_sleep(1);
        if ((++sp & 255u) == 0u) { if (xb_ld(&bar[XB_TMO])) break; if (sp > XB_SPIN_CAP) { atomicAdd(&bar[XB_TMO], 1u); break; } }
    }
    nloc = mine > 0u ? mine : 1u; nx = cnt > 0u ? cnt : 1u;
}
__device__ __forceinline__ void xcd_barrier(const XcdBarrier& b) {
    asm volatile("s_waitcnt vmcnt(0)" ::: "memory");
    __syncthreads();
    if (XB_T0(b.wid)) {
        unsigned* bar = b.bar;
        __builtin_amdgcn_s_waitcnt(0);
        unsigned nloc = b.st[0], nx = b.st[1];
        if (nloc == 0u) { xcd_barrier_complete(bar, b.x, nloc, nx); b.st[0] = nloc; b.st[1] = nx; }
        const unsigned old = xb_add(&bar[XB_XSUB(b.x)], 1u);
        const unsigned gen = old / nloc;
        if (old + 1u == (gen + 1u) * nloc) {
            __builtin_amdgcn_fence(__ATOMIC_RELEASE, "agent");
            asm volatile("s_waitcnt vmcnt(0)" ::: "memory");
            const unsigned og = xb_add(&bar[XB_TOP], 1u);
            const unsigned tg = og / nx;
            if (og + 1u == (tg + 1u) * nx) xb_add(&bar[XB_TOPGEN], 1u);
            else XB_SPIN(xb_ld(&bar[XB_TOPGEN]) == tg, bar);
            __builtin_amdgcn_fence(__ATOMIC_ACQUIRE, "agent");
            xb_add(&bar[XB_XGEN(b.x)], 1u);
            asm volatile("s_waitcnt vmcnt(0)" ::: "memory");
        } else {
            XB_SPIN(xb_ld(&bar[XB_XGEN(b.x)]) == gen, bar);
            __builtin_amdgcn_fence(__ATOMIC_ACQUIRE, "agent");
            asm volatile("s_waitcnt vmcnt(0)" ::: "memory");
        }
    }
    __syncthreads();
}

struct Args { const float* in[17]; float* out; unsigned char* ws; int p_lo, p_hi; };
enum { I_X = 0, I_MEM, I_WIN_MOBA, I_WIN_FOX, I_BFG, I_WMKV, I_WO, I_LN1G, I_LN1B, I_RW, I_RB, I_WGU, I_BGU, I_WDN, I_BDN, I_LN2G, I_LN2B };

__device__ __forceinline__ Args load_args() {
#if defined(__HIP_DEVICE_COMPILE__)
    const __attribute__((address_space(4))) unsigned long long* p = (const __attribute__((address_space(4))) unsigned long long*)__builtin_amdgcn_kernarg_segment_ptr();
    asm volatile("" : "+s"(p));
    Args a;
#pragma unroll
    for (int i = 0; i < 17; ++i) a.in[i] = (const float*)(const GAS float*)p[i];
    a.out = (float*)(GAS float*)p[17]; a.ws = (unsigned char*)(GAS unsigned char*)p[18]; const unsigned long long w = p[19]; a.p_lo = (int)(unsigned)w; a.p_hi = (int)(unsigned)(w >> 32);
    return a;
#else
    return Args{};
#endif
}
__device__ __forceinline__ void cvt_item(const float* W, int pitch, int col0, int k0, bf16* WT, int drow0, LAS float* scr, int lane) {
    f32x4 v[16];
    const int a = lane >> 4, b4 = (lane & 15) * 4;
#pragma unroll
    for (int i = 0; i < 16; ++i) v[i] = *(const f32x4*)(W + (size_t)(k0 + 4 * i + a) * pitch + col0 + b4);
#pragma unroll
    for (int i = 0; i < 16; ++i) { LAS float* s = scr + (4 * i + a) * 65 + b4; s[0] = v[i].x; s[1] = v[i].y; s[2] = v[i].z; s[3] = v[i].w; }
    asm volatile("s_waitcnt lgkmcnt(0)" ::: "memory");
    const int c = lane & 7;
#pragma unroll
    for (int j = 0; j < 8; ++j) {
        const int n = (lane >> 3) + 8 * j; const LAS float* s = scr + (8 * c) * 65 + n;
        v4u o; o.x = pk2(s[0], s[65]); o.y = pk2(s[2 * 65], s[3 * 65]); o.z = pk2(s[4 * 65], s[5 * 65]); o.w = pk2(s[6 * 65], s[7 * 65]);
        *(v4u*)(WT + (size_t)(drow0 + n) * DM + k0 + 8 * c) = o;
    }
    asm volatile("s_waitcnt lgkmcnt(0)" ::: "memory");
}
__device__ __forceinline__ void ph_convert(const Args& A, LAS unsigned char* lds, int wg, int G, int g_wid) {
    PH_IDS;
    unsigned char* ws = A.ws;
    LAS float* scr = (LAS float*)(lds + wid * 16896);
    const int gw = wg * NWAVES + wid, NGW = G * NWAVES;
    constexpr int I_IN = 16 * 40;
    constexpr int I_MK = 16 * 8, I_O1 = 16 * 16, I_GU1 = 16 * 32, I_DN1 = 16 * 16;
    constexpr int N_IN = 4 * I_IN, N_MK = I_MK, N_O = 4 * I_O1, N_GU = 128 * I_GU1, N_DN = 128 * I_DN1;
    constexpr int NITEMS = N_IN + N_MK + N_O + N_GU + N_DN;
    for (int it = gw; it < NITEMS; it += NGW) {
        int r = it;
        if (r < N_IN) { const int l = r / I_IN, q = r % I_IN, kb = q / 40, nb = q % 40; const int j = l >> 1;
            const float* W = (l & 1) ? A.in[I_WIN_FOX] + (size_t)j * DM * (NPROJ + HS) : A.in[I_WIN_MOBA] + (size_t)j * DM * NPROJ;
            cvt_item(W, (l & 1) ? NPROJ + HS : NPROJ, 64 * nb, 64 * kb, (bf16*)(ws + WS_WIN) + (size_t)l * NPROJ * DM, 64 * nb, scr, lane); continue; }
        r -= N_IN;
        if (r < N_MK) { const int kb = r / 8, nb = r % 8; cvt_item(A.in[I_WMKV], 512, 64 * nb, 64 * kb, (bf16*)(ws + WS_WMKV), 64 * nb, scr, lane); continue; }
        r -= N_MK;
        if (r < N_O) { const int l = r / I_O1, q = r % I_O1, kb = q / 16, nb = q % 16;
            cvt_item(A.in[I_WO] + (size_t)l * DM * DM, DM, 64 * nb, 64 * kb, (bf16*)(ws + WS_WO) + (size_t)l * DM * DM, 64 * nb, scr, lane); continue; }
        r -= N_O;
        if (r < N_GU) { const int le = r / I_GU1, q = r % I_GU1, kb = q / 32, nb = q % 32; const int col0 = 64 * nb;
            const int cc = col0 & 1023, drow0 = (cc >> 7) * 256 + (cc & 127) + ((col0 >= 1024) ? 128 : 0);
            cvt_item(A.in[I_WGU] + (size_t)le * DM * 2048, 2048, col0, 64 * kb, (bf16*)(ws + WS_WGU) + (size_t)le * 2048 * DM, drow0, scr, lane); continue; }
        r -= N_GU;
        { const int le = r / I_DN1, q = r % I_DN1, kb = q / 16, nb = q % 16;
            cvt_item(A.in[I_WDN] + (size_t)le * DM * DM, DM, 64 * nb, 64 * kb, (bf16*)(ws + WS_WDN) + (size_t)le * DM * DM, 64 * nb, scr, lane); }
    }
    { const int gt = wg * NTHR + tid, NGT = G * NTHR;
      for (int i = gt; i < 2 * 16 * DM; i += NGT) { const int j = i / (16 * DM), hh = (i / DM) & 15, k = i % DM;
          const float v = hh < HS ? A.in[I_WIN_FOX][(size_t)j * DM * (NPROJ + HS) + (size_t)k * (NPROJ + HS) + NPROJ + hh] : 0.f;
          ((bf16*)(ws + WS_WFG))[i] = (bf16)f2bf(v); }
      for (size_t i = gt; i < (size_t)NTOK * DM / 8; i += NGT) { const f32x4 a = ((const f32x4*)A.in[I_X])[2 * i], b = ((const f32x4*)A.in[I_X])[2 * i + 1];
          v4u o; o.x = pk2(a.x, a.y); o.y = pk2(a.z, a.w); o.z = pk2(b.x, b.y); o.w = pk2(b.z, b.w); ((v4u*)(ws + WS_HB))[i] = o; }
      for (size_t i = gt; i < (size_t)NB * NMEM * DM / 8; i += NGT) { const f32x4 a = ((const f32x4*)A.in[I_MEM])[2 * i], b = ((const f32x4*)A.in[I_MEM])[2 * i + 1];
          v4u o; o.x = pk2(a.x, a.y); o.y = pk2(a.z, a.w); o.z = pk2(b.x, b.y); o.w = pk2(b.z, b.w); ((v4u*)(ws + WS_MEMB))[i] = o; }
    }
}

struct Unit { int pm, pn, e, rows; const bf16* B; const unsigned* list; };
struct DenseSched {
    const bf16* A; const bf16* Bt; int nM, nN, G, c;
    __device__ __forceinline__ bool next(int i, Unit& u) const {
        const int L = i * G + c; if (L >= nM * nN) return false;
        u.pm = L / nN; u.pn = L % nN; u.e = 0; u.rows = 256; u.B = Bt + (size_t)u.pn * 256 * DM; u.list = nullptr; return true; }
    __device__ __forceinline__ unsigned arow(const Unit& u, int r) const { return (unsigned)(u.pm * 256 + r); }
};
struct MoeSched {
    const bf16* A; const bf16* Bt; const unsigned* elist; const LAS int* tab; int nN, ntot, G, c, shift;
    __device__ __forceinline__ bool next(int i, Unit& u) const {
        const int L = i * G + c; const int total = __builtin_amdgcn_readfirstlane(tab[64 + 32]) * nN; if (L >= total) return false;
        u.pn = L % nN; const int g = L / nN;
        int ln; asm volatile("v_mbcnt_lo_u32_b32 %0, -1, 0\n\tv_mbcnt_hi_u32_b32 %0, -1, %0" : "=v"(ln));
        const int offv = tab[64 + (ln & 31)];
        const unsigned long long mk = __builtin_amdgcn_ballot_w64(ln < 32 && offv <= g);
        const int e = __builtin_popcountll(mk) - 1;
        u.e = e; u.pm = g - __builtin_amdgcn_readfirstlane(tab[64 + e]); const int rem = __builtin_amdgcn_readfirstlane(tab[e]) - 256 * u.pm; u.rows = rem < 256 ? rem : 256;
        u.B = Bt + ((size_t)e * ntot + (size_t)u.pn * 256) * DM; u.list = elist + (size_t)e * NTOK + 256 * u.pm; return true; }
    __device__ __forceinline__ unsigned arow(const Unit& u, int r) const { const unsigned rr = (unsigned)r < (unsigned)u.rows ? (unsigned)r : (unsigned)(u.rows - 1); return *(const unsigned*)((const char*)u.list + rr * 4u) >> shift; }
};
__device__ __forceinline__ void moe_tables(LAS int* tab, const unsigned* ecnt, int g_wid) {
    PH_IDS;
    if (tid == 0) { int acc = 0; for (int e = 0; e < 32; ++e) { const int c = (int)ecnt[e]; tab[e] = c; tab[64 + e] = acc; acc += (c + 255) >> 8; } tab[64 + 32] = acc; }
    __syncthreads();
}

struct EpiProj {
    bf16* O; int ldc, q_end, qm_begin;
    __device__ __forceinline__ void operator()(const f32x4 (&acc)[2][2][4][2], const Unit& u, int wr, int wc, int fr, int fq) const {
#pragma unroll
        for (int ai = 0; ai < 2; ++ai)
#pragma unroll
            for (int m = 0; m < 4; ++m) { const int row = u.pm * 256 + ai * 128 + wr * 64 + m * 16 + fr;
#pragma unroll
                for (int bj = 0; bj < 2; ++bj) { const int col = u.pn * 256 + bj * 128 + wc * 32 + 8 * fq; const float sc = (col < q_end || col >= qm_begin) ? C2 : 1.f;
                    const f32x4 v0 = acc[ai][bj][m][0] * sc, v1 = acc[ai][bj][m][1] * sc;
                    v4u w; w.x = pk2(v0.x, v0.y); w.y = pk2(v0.z, v0.w); w.z = pk2(v1.x, v1.y); w.w = pk2(v1.z, v1.w);
                    *(v4u*)((char*)O + (unsigned)(row * ldc + col) * 2u) = w; } }
    }
};
struct EpiOut {
    const float* base; float* out;
    __device__ __forceinline__ void operator()(const f32x4 (&acc)[2][2][4][2], const Unit& u, int wr, int wc, int fr, int fq) const {
#pragma unroll
        for (int ai = 0; ai < 2; ++ai)
#pragma unroll
            for (int m = 0; m < 4; ++m) { const int row = u.pm * 256 + ai * 128 + wr * 64 + m * 16 + fr;
#pragma unroll
                for (int bj = 0; bj < 2; ++bj) { const unsigned off = (unsigned)(row * DM + u.pn * 256 + bj * 128 + wc * 32 + 8 * fq) * 4u;
                    const f32x4 b0 = *(const f32x4*)((const char*)base + off), b1 = *(const f32x4*)((const char*)base + off + 16);
                    *(f32x4*)((char*)out + off) = b0 * ALPHA + acc[ai][bj][m][0]; *(f32x4*)((char*)out + off + 16) = b1 * ALPHA + acc[ai][bj][m][1]; } }
    }
};
__device__ __forceinline__ float swiglu(float g, float uu) {
    g = fminf(g, SW_LIMIT); uu = fminf(fmaxf(uu, -SW_LIMIT), SW_LIMIT);
    const float sg = __builtin_amdgcn_rcpf(1.f + fexp2(-SW_ALPHA * LOG2E * g));
    return g * sg * (uu + 1.f);
}
struct EpiGU {
    bf16* abuf; const float* bgu;
    __device__ __forceinline__ void operator()(const f32x4 (&acc)[2][2][4][2], const Unit& u, int wr, int wc, int fr, int fq) const {
        const int c0 = u.pn * 128 + wc * 32 + 8 * fq; const float* bg = bgu + (size_t)u.e * 2048 + c0;
        const f32x4 g0 = *(const f32x4*)bg, g1 = *(const f32x4*)(bg + 4), u0 = *(const f32x4*)(bg + 1024), u1 = *(const f32x4*)(bg + 1028);
#pragma unroll
        for (int ai = 0; ai < 2; ++ai)
#pragma unroll
            for (int m = 0; m < 4; ++m) { const int r = ai * 128 + wr * 64 + m * 16 + fr;
                if (r < u.rows) { const unsigned aid = *(const unsigned*)((const char*)u.list + (unsigned)r * 4u);
                    const f32x4 ga = acc[ai][0][m][0] + g0, gb = acc[ai][0][m][1] + g1, ua = acc[ai][1][m][0] + u0, ub = acc[ai][1][m][1] + u1;
                    v4u w; w.x = pk2(swiglu(ga.x, ua.x), swiglu(ga.y, ua.y)); w.y = pk2(swiglu(ga.z, ua.z), swiglu(ga.w, ua.w));
                    w.z = pk2(swiglu(gb.x, ub.x), swiglu(gb.y, ub.y)); w.w = pk2(swiglu(gb.z, ub.z), swiglu(gb.w, ub.w));
                    *(v4u*)((char*)abuf + (aid * (unsigned)DM + (unsigned)c0) * 2u) = w; } }
    }
};
struct EpiDN {
    bf16* ybuf; const float* bdn; const float* agate;
    __device__ __forceinline__ void operator()(const f32x4 (&acc)[2][2][4][2], const Unit& u, int wr, int wc, int fr, int fq) const {
        f32x4 bv[2][2];
#pragma unroll
        for (int bj = 0; bj < 2; ++bj) { const float* bp = bdn + (size_t)u.e * DM + u.pn * 256 + bj * 128 + wc * 32 + 8 * fq; bv[bj][0] = *(const f32x4*)bp; bv[bj][1] = *(const f32x4*)(bp + 4); }
#pragma unroll
        for (int ai = 0; ai < 2; ++ai)
#pragma unroll
            for (int m = 0; m < 4; ++m) { const int r = ai * 128 + wr * 64 + m * 16 + fr;
                if (r < u.rows) { const unsigned aid = *(const unsigned*)((const char*)u.list + (unsigned)r * 4u); const float gt = *(const float*)((const char*)agate + aid * 4u);
#pragma unroll
                    for (int bj = 0; bj < 2; ++bj) { const f32x4 v0 = (acc[ai][bj][m][0] + bv[bj][0]) * gt, v1 = (acc[ai][bj][m][1] + bv[bj][1]) * gt;
                        v4u w; w.x = pk2(v0.x, v0.y); w.y = pk2(v0.z, v0.w); w.z = pk2(v1.x, v1.y); w.w = pk2(v1.z, v1.w);
                        *(v4u*)((char*)ybuf + (aid * (unsigned)DM + (unsigned)(u.pn * 256 + bj * 128 + wc * 32 + 8 * fq)) * 2u) = w; } } }
    }
};

template <class Epi, class Sched>
__device__ __forceinline__ void gemm_simple(const Sched& S, const Epi& E, int g_wid) {
    PH_IDS;
    const int wr = wid >> 2, wc = wid & 3, fr = lane & 15, fq = lane >> 4;
    Unit u;
    for (int i = 0; S.next(i, u); ++i) {
        f32x4 acc[2][2][4][2];
#pragma unroll
        for (int a = 0; a < 2; ++a)
#pragma unroll
            for (int b = 0; b < 2; ++b)
#pragma unroll
                for (int m = 0; m < 4; ++m)
#pragma unroll
                    for (int n = 0; n < 2; ++n) acc[a][b][m][n] = (f32x4){0.f, 0.f, 0.f, 0.f};
        unsigned aoff[2][4], boff[2][2];
#pragma unroll
        for (int ai = 0; ai < 2; ++ai)
#pragma unroll
            for (int m = 0; m < 4; ++m) aoff[ai][m] = S.arow(u, ai * 128 + wr * 64 + m * 16 + fr) * DM + 8 * fq;
#pragma unroll
        for (int bj = 0; bj < 2; ++bj)
#pragma unroll
            for (int n = 0; n < 2; ++n) boff[bj][n] = (unsigned)(bj * 128 + wc * 32 + 8 * (fr >> 2) + 4 * n + (fr & 3)) * DM + 8 * fq;
#pragma unroll 1
        for (int k0 = 0; k0 < DM; k0 += 32) {
            bf16x8 b[2][2];
#pragma unroll
            for (int bj = 0; bj < 2; ++bj)
#pragma unroll
                for (int n = 0; n < 2; ++n) b[bj][n] = *(const bf16x8*)(u.B + boff[bj][n] + k0);
#pragma unroll
            for (int ai = 0; ai < 2; ++ai) {
                bf16x8 a[4];
#pragma unroll
                for (int m = 0; m < 4; ++m) a[m] = *(const bf16x8*)(S.A + aoff[ai][m] + k0);
#pragma unroll
                for (int bj = 0; bj < 2; ++bj)
#pragma unroll
                    for (int m = 0; m < 4; ++m)
#pragma unroll
                        for (int n = 0; n < 2; ++n) acc[ai][bj][m][n] = __builtin_amdgcn_mfma_f32_16x16x32_bf16(b[bj][n], a[m], acc[ai][bj][m][n], 0, 0, 0);
            }
        }
        E(acc, u, wr, wc, fr, fq);
    }
}


namespace pg8 {
constexpr int BM = 256, BK = 64, HALF = 128, HTB = HALF * BK * 2, STAGE_BYTES = 8 * HTB;
__device__ __forceinline__ int lds_byte(int r, int c) { const int st = (r >> 4) * 2 + (c >> 5), rr = r & 15, cc = c & 31, ob = rr * 64 + cc * 2; return st * 1024 + (ob ^ (((ob >> 9) & 1) << 5)); }
__device__ __forceinline__ void stage_rc(int b, int& R, int& C) { const int st = b / 1024, sb = b % 1024, swz = sb ^ (((sb >> 9) & 1) << 5); R = (st >> 1) * 16 + swz / 64; C = (st & 1) * 32 + (swz % 64) / 2; }
__device__ __forceinline__ int perm32(int rho) { const int n = rho >> 4, i = rho & 15; return 8 * (i >> 2) + 4 * n + (i & 3); }
}
template <class Epi, class Sched, bool ALIGN_EPI>
__device__ __forceinline__ void gemm_fast(LAS unsigned char* lds, const Sched& S, const Epi& E, int g_wid) {
    using namespace pg8;
    PH_IDS;
    const int wr = wid >> 2, wc = wid & 3, fr = lane & 15, fq = lane >> 4;
    constexpr int K = DM, nt = K / BK;
    int Rr[2], Cc[2]; unsigned voffB[2];
#pragma unroll
    for (int i = 0; i < 2; ++i) { int R, C; stage_rc(tid * 16 + i * 8192, R, C); Rr[i] = R; Cc[i] = C; const int Rb = (R & ~31) + perm32(R & 31); voffB[i] = (unsigned)(Rb * K + C) * 2u; }
    constexpr unsigned kstep = BK * 2, hstep = HALF * K * 2;
    const unsigned ldsw = (unsigned)wid * 1024u;
    const int aoff = lds_byte(wr * 64 + fr, fq * 8), boff = lds_byte(wc * 32 + fr, fq * 8);
    const char* Ab = (const char*)S.A;
#define PG8_SA(b, h) (((b) * 2 + (h)) * HTB)
#define PG8_SB(b, h) ((4 + (b) * 2 + (h)) * HTB)
#define PG8_STAGEB(bufoff, gbase) do { _Pragma("unroll") for (int _i = 0; _i < 2; ++_i) \
        __builtin_amdgcn_global_load_lds((const unsigned*)((const char*)(gbase) + voffB[_i]), (LAS unsigned*)(lds + (bufoff) + ldsw + _i * 8192), 16, 0, 0); } while (0)
#define PG8_STAGEA(bufoff, kb, vo) do { _Pragma("unroll") for (int _i = 0; _i < 2; ++_i) \
        __builtin_amdgcn_global_load_lds((const unsigned*)(Ab + (size_t)(kb) + (vo)[_i]), (LAS unsigned*)(lds + (bufoff) + ldsw + _i * 8192), 16, 0, 0); } while (0)
#define PG8_LDA(dst, b, h) do { _Pragma("unroll") for (int m = 0; m < 4; ++m) _Pragma("unroll") for (int k = 0; k < 2; ++k) dst[m][k] = *(const LAS bf16x8*)(lds + PG8_SA(b, h) + aoff + m * 2048 + k * 1024); } while (0)
#define PG8_LDB(dst, b, h) do { _Pragma("unroll") for (int n = 0; n < 2; ++n) _Pragma("unroll") for (int k = 0; k < 2; ++k) dst[n][k] = *(const LAS bf16x8*)(lds + PG8_SB(b, h) + boff + n * 2048 + k * 1024); } while (0)
#define PG8_MMA(ai, bj, At, Bt) do { __builtin_amdgcn_s_setprio(1); _Pragma("unroll") for (int m = 0; m < 4; ++m) _Pragma("unroll") for (int n = 0; n < 2; ++n) _Pragma("unroll") for (int k = 0; k < 2; ++k) \
        acc[ai][bj][m][n] = __builtin_amdgcn_mfma_f32_16x16x32_bf16(Bt[n][k], At[m][k], acc[ai][bj][m][n], 0, 0, 0); __builtin_amdgcn_s_setprio(0); } while (0)
#define PG8_WAIT_V(n) asm volatile("s_waitcnt vmcnt(" #n ")" ::: "memory")
#define PG8_WAIT_L(n) asm volatile("s_waitcnt lgkmcnt(" #n ")" ::: "memory")
#define PG8_BAR __builtin_amdgcn_s_barrier()
#define PG8_SCHED __builtin_amdgcn_sched_barrier(0)
#define PG8_OFFS(dst, un) do { _Pragma("unroll") for (int _h = 0; _h < 2; ++_h) _Pragma("unroll") for (int _i = 0; _i < 2; ++_i) dst[_h][_i] = (S.arow(un, _h * 128 + Rr[_i]) * (unsigned)K + (unsigned)Cc[_i]) * 2u; } while (0)
    Unit cur, nxt; int ui = 0;
    if (!S.next(0, cur)) return;
    f32x4 acc[2][2][4][2];
#pragma unroll
    for (int a = 0; a < 2; ++a)
#pragma unroll
        for (int b = 0; b < 2; ++b)
#pragma unroll
            for (int m = 0; m < 4; ++m)
#pragma unroll
                for (int n = 0; n < 2; ++n) acc[a][b][m][n] = (f32x4){0.f, 0.f, 0.f, 0.f};
    bf16x8 At[4][2], B0[2][2], B1[2][2];
    unsigned vA[2][2], vN[2][2];
    PG8_OFFS(vA, cur);
    const char* cB = (const char*)cur.B;
    PG8_STAGEB(PG8_SB(0, 0), cB); PG8_STAGEB(PG8_SB(0, 1), cB + hstep); PG8_STAGEA(PG8_SA(0, 0), 0, vA[0]); PG8_STAGEA(PG8_SA(0, 1), 0, vA[1]);
    if (wr == 1) PG8_BAR;
    PG8_WAIT_V(2); PG8_BAR;
    PG8_STAGEB(PG8_SB(1, 0), cB + kstep); PG8_STAGEA(PG8_SA(1, 0), kstep, vA[0]); PG8_STAGEB(PG8_SB(1, 1), cB + hstep + kstep);
    PG8_WAIT_V(6); PG8_BAR;
    for (;;) {
        const bool has_next = S.next(ui + 1, nxt);
        if (has_next) { PG8_OFFS(vN, nxt); } else {
#pragma unroll
            for (int h = 0; h < 2; ++h)
#pragma unroll
                for (int i = 0; i < 2; ++i) vN[h][i] = vA[h][i]; }
        const char* nB = has_next ? (const char*)nxt.B : cB;
#define PG8_KSTEP(LAST, t) do { \
            const unsigned kb1 = (unsigned)((t) + 1) * kstep, kb2 = (LAST) ? 0u : (unsigned)((t) + 2) * kstep, kb3 = kb2 + kstep; \
            const char* b2 = (LAST) ? nB : cB + (size_t)((t) + 2) * kstep; const char* b3 = b2 + kstep; \
            PG8_LDB(B0, 0, 0); PG8_LDB(B1, 0, 1); PG8_SCHED; PG8_LDA(At, 0, 0); PG8_STAGEA(PG8_SA(1, 1), kb1, vA[1]); \
            PG8_WAIT_V(8); PG8_WAIT_L(0); PG8_BAR; PG8_MMA(0, 0, At, B0); PG8_MMA(0, 1, At, B1); PG8_BAR; PG8_SCHED; \
            PG8_LDA(At, 0, 1); PG8_STAGEB(PG8_SB(0, 0), b2); PG8_STAGEB(PG8_SB(0, 1), b2 + hstep); if (LAST) { PG8_STAGEA(PG8_SA(0, 0), kb2, vN[0]); } else { PG8_STAGEA(PG8_SA(0, 0), kb2, vA[0]); } \
            PG8_WAIT_V(8); PG8_WAIT_L(0); PG8_BAR; PG8_MMA(1, 0, At, B0); PG8_MMA(1, 1, At, B1); PG8_BAR; PG8_SCHED; \
            PG8_LDB(B0, 1, 0); PG8_LDB(B1, 1, 1); PG8_SCHED; PG8_LDA(At, 1, 0); if (LAST) { PG8_STAGEA(PG8_SA(0, 1), kb2, vN[1]); } else { PG8_STAGEA(PG8_SA(0, 1), kb2, vA[1]); } \
            PG8_WAIT_V(8); PG8_WAIT_L(0); PG8_BAR; PG8_MMA(0, 0, At, B0); PG8_MMA(0, 1, At, B1); PG8_BAR; PG8_SCHED; \
            PG8_LDA(At, 1, 1); PG8_STAGEB(PG8_SB(1, 0), b3); PG8_STAGEB(PG8_SB(1, 1), b3 + hstep); if (LAST) { PG8_STAGEA(PG8_SA(1, 0), kb3, vN[0]); } else { PG8_STAGEA(PG8_SA(1, 0), kb3, vA[0]); } \
            PG8_WAIT_V(8); PG8_WAIT_L(0); PG8_BAR; PG8_MMA(1, 0, At, B0); PG8_MMA(1, 1, At, B1); PG8_BAR; PG8_SCHED; } while (0)
        for (int t = 0; t < nt - 2; t += 2) PG8_KSTEP(false, t);
        PG8_KSTEP(true, nt - 2);
#undef PG8_KSTEP
        if constexpr (ALIGN_EPI) { if (wr == 0) PG8_BAR; }
        { int fr_e = fr, fq_e = fq; asm volatile("" : "+v"(fr_e), "+v"(fq_e));
          E(acc, cur, wr, wc, fr_e, fq_e); }
        if (!has_next) break;
#pragma unroll
        for (int a = 0; a < 2; ++a)
#pragma unroll
            for (int b = 0; b < 2; ++b)
#pragma unroll
                for (int m = 0; m < 4; ++m)
#pragma unroll
                    for (int n = 0; n < 2; ++n) acc[a][b][m][n] = (f32x4){0.f, 0.f, 0.f, 0.f};
        cur = nxt; cB = nB; ++ui;
#pragma unroll
        for (int h = 0; h < 2; ++h)
#pragma unroll
            for (int i = 0; i < 2; ++i) vA[h][i] = vN[h][i];
        if constexpr (ALIGN_EPI) { if (wr == 1) PG8_BAR; }
    }
    PG8_WAIT_V(0);
    if constexpr (!ALIGN_EPI) { if (wr == 0) PG8_BAR; }
    PG8_BAR;
#undef PG8_SA
#undef PG8_SB
#undef PG8_STAGEA
#undef PG8_STAGEB
#undef PG8_LDA
#undef PG8_LDB
#undef PG8_MMA
#undef PG8_WAIT_V
#undef PG8_WAIT_L
#undef PG8_BAR
#undef PG8_SCHED
#undef PG8_OFFS
}

__device__ __forceinline__ void ph_fox_gate(const Args& A, int j, int wg, int G, int g_wid) {
    PH_IDS;
    const bf16* hb = (const bf16*)(A.ws + WS_HB); const bf16* wfg = (const bf16*)(A.ws + WS_WFG) + (size_t)j * 16 * DM; float* lf = (float*)(A.ws + WS_LF);
    const float* bfg = A.in[I_BFG] + j * HS;
    const int gw = wg * NWAVES + wid, NGW = G * NWAVES;
    for (int n = gw; n < NTOK; n += NGW) {
        const v4u* hp = (const v4u*)(hb + (size_t)n * DM + 16 * lane); const v4u h0 = hp[0], h1 = hp[1];
        float hv[16] = {bflo(h0.x), bfhi(h0.x), bflo(h0.y), bfhi(h0.y), bflo(h0.z), bfhi(h0.z), bflo(h0.w), bfhi(h0.w), bflo(h1.x), bfhi(h1.x), bflo(h1.y), bfhi(h1.y), bflo(h1.z), bfhi(h1.z), bflo(h1.w), bfhi(h1.w)};
        float mine = 0.f;
#pragma unroll
        for (int hh = 0; hh < HS; ++hh) {
            const v4u* wp = (const v4u*)(wfg + (size_t)hh * DM + 16 * lane); const v4u w0 = wp[0], w1 = wp[1];
            float s = hv[0] * bflo(w0.x) + hv[1] * bfhi(w0.x) + hv[2] * bflo(w0.y) + hv[3] * bfhi(w0.y) + hv[4] * bflo(w0.z) + hv[5] * bfhi(w0.z) + hv[6] * bflo(w0.w) + hv[7] * bfhi(w0.w)
                    + hv[8] * bflo(w1.x) + hv[9] * bfhi(w1.x) + hv[10] * bflo(w1.y) + hv[11] * bfhi(w1.y) + hv[12] * bflo(w1.z) + hv[13] * bfhi(w1.z) + hv[14] * bflo(w1.w) + hv[15] * bfhi(w1.w);
            s = wave_sum(s);
            if (lane == hh) mine = s;
        }
        if (lane < HS) { const float z = mine + bfg[lane];
            const float ls = fminf(z, 0.f) - __builtin_amdgcn_logf(1.f + fexp2(-fabsf(z) * LOG2E)) * 0.6931471805599453f;
            const int b = n >> 13, t = n & (SEQ - 1); lf[((size_t)(b * HS + lane)) * SEQ + t] = ls; }
    }
}
__device__ __forceinline__ void ph_fox_scan(const Args& A, LAS unsigned char* lds, int wg, int G, int g_wid) {
    PH_IDS;
    const float* lf = (const float*)(A.ws + WS_LF); float* c2 = (float*)(A.ws + WS_CFOX); LAS float* part = (LAS float*)lds;
    for (int s = wg; s < NB * HS; s += G) {
        const float* src = lf + (size_t)s * SEQ + tid * 16; float v[16]; float run = 0.f;
#pragma unroll
        for (int i = 0; i < 16; ++i) { run += src[i]; v[i] = run; }
        part[tid] = run; __syncthreads();
        if (tid == 0) { float acc = 0.f; for (int i = 0; i < NTHR; ++i) { const float x = part[i]; part[i] = acc; acc += x; } }
        __syncthreads();
        const float base = part[tid]; float* dst = c2 + (size_t)s * SEQ + tid * 16;
#pragma unroll
        for (int i = 0; i < 16; ++i) dst[i] = (base + v[i]) * LOG2E;
        __syncthreads();
    }
}
__device__ __forceinline__ void ph_kbar(const Args& A, LAS unsigned char* lds, int wg, int G, int g_wid) {
    PH_IDS;
    const bf16* proj = (const bf16*)(A.ws + WS_PROJ); float* kbar = (float*)(A.ws + WS_KBAR); LAS float* part = (LAS float*)lds;
    const int d = tid & 63, r8 = tid >> 6;
    for (int uidx = wg; uidx < NB * HS * 32; uidx += G) {
        const int j = uidx & 31, bh = uidx >> 5, b = bh / HS, h = bh % HS;
        const bf16* kp = proj + ((size_t)(b * SEQ + j * 256 + r8 * 32)) * NPROJ + K_COL + h * 64 + d;
        float s = 0.f;
        for (int r = 0; r < 32; ++r) s += __uint_as_float((unsigned)kp[(size_t)r * NPROJ] << 16);
        part[tid] = s; __syncthreads();
        if (tid < 64) { float t = 0.f;
#pragma unroll
            for (int q = 0; q < 8; ++q) t += part[q * 64 + tid];
            kbar[(size_t)uidx * 64 + tid] = t * (1.f / 256.f); ((bf16*)(A.ws + WS_KBAR + 512 * 1024))[(size_t)uidx * 64 + tid] = (bf16)f2bf(t * (1.f / 256.f)); }
        __syncthreads();
    }
}

__device__ __forceinline__ float alibi_slope(int h) { return h < 8 ? exp2f(-(float)(h + 1)) : exp2f(-(0.5f + (float)(h - 8))); }
#define ROW8(w, base, arr) do { arr[base + 0] = bflo(w.x); arr[base + 1] = bfhi(w.x); arr[base + 2] = bflo(w.y); arr[base + 3] = bfhi(w.y); arr[base + 4] = bflo(w.z); arr[base + 5] = bfhi(w.z); arr[base + 6] = bflo(w.w); arr[base + 7] = bfhi(w.w); } while (0)
__device__ __forceinline__ float dot_row64(const float (&q)[64], const bf16* p) {
    const v4u* p4 = (const v4u*)p; float s0 = 0.f, s1 = 0.f;
#pragma unroll
    for (int i = 0; i < 8; ++i) { if (i == 4) asm volatile("" ::: "memory"); const v4u w = p4[i];
        s0 += q[8 * i + 0] * bflo(w.x); s1 += q[8 * i + 1] * bfhi(w.x); s0 += q[8 * i + 2] * bflo(w.y); s1 += q[8 * i + 3] * bfhi(w.y);
        s0 += q[8 * i + 4] * bflo(w.z); s1 += q[8 * i + 5] * bfhi(w.z); s0 += q[8 * i + 6] * bflo(w.w); s1 += q[8 * i + 7] * bfhi(w.w); }
    return s0 + s1;
}
__device__ __forceinline__ void att_upd(float x, const bf16* vrow, float& m, float& l, float (&o)[64]) {
    const float mn = fmaxf(m, x), al = fexp2(m - mn), pp = fexp2(x - mn); m = mn; l = l * al + pp;
    const v4u* p4 = (const v4u*)vrow; asm volatile("" ::: "memory");
#pragma unroll
    for (int i = 0; i < 8; ++i) { if ((i & 1) == 0) asm volatile("" ::: "memory"); const v4u w = p4[i];
        o[8 * i + 0] = o[8 * i + 0] * al + pp * bflo(w.x); o[8 * i + 1] = o[8 * i + 1] * al + pp * bfhi(w.x); o[8 * i + 2] = o[8 * i + 2] * al + pp * bflo(w.y); o[8 * i + 3] = o[8 * i + 3] * al + pp * bfhi(w.y);
        o[8 * i + 4] = o[8 * i + 4] * al + pp * bflo(w.z); o[8 * i + 5] = o[8 * i + 5] * al + pp * bfhi(w.z); o[8 * i + 6] = o[8 * i + 6] * al + pp * bflo(w.w); o[8 * i + 7] = o[8 * i + 7] * al + pp * bfhi(w.w); }
}
template <int MODE, int H_LO = 0, int H_HI = 16>
__device__ __forceinline__ void ph_attn_naive(const Args& A, int wg, int G, int g_wid) {
    PH_IDS;
    const bf16* proj = (const bf16*)(A.ws + WS_PROJ); const bf16* mkv = (const bf16*)(A.ws + WS_MKV); bf16* att = (bf16*)(A.ws + WS_ATT);
    const float* kbar = (const float*)(A.ws + WS_KBAR); const float* cfox = (const float*)(A.ws + WS_CFOX);
    constexpr int NIT = 16 * (NTOK / 64);
    const int gw = wg * NWAVES + wid, NGW = G * NWAVES;
    for (int base = 0, rnd = 0; base < NIT; base += NGW, ++rnd) {
        const int it = base + ((rnd & 1) ? (NGW - 1 - gw) : gw);
        if (it >= NIT) continue;
        const int hh = it & 15, tg = it >> 4, n = tg * 64 + lane, b = n >> 13, t = n & (SEQ - 1);
        if (hh < H_LO || hh >= H_HI) continue;
        float q[64];
        { const v4u* p4 = (const v4u*)(proj + (size_t)n * NPROJ + (hh < HS ? hh * 64 : QM_COL + (hh - HS) * 64));
#pragma unroll
          for (int i = 0; i < 8; ++i) { const v4u w = p4[i]; ROW8(w, 8 * i, q); } }
        float m = -1e30f, l = 0.f; float o[64];
#pragma unroll
        for (int i = 0; i < 64; ++i) o[i] = 0.f;
        if (hh < HS) {
            const bf16* Kb = proj + (size_t)(b * SEQ) * NPROJ + K_COL + hh * 64; const bf16* Vb = Kb + (V_COL - K_COL);
            if (MODE == 0) {
                const float slope2 = alibi_slope(hh) * LOG2E; const int qb = t >> 8;
                const float* kb = kbar + (size_t)((b * HS + hh) * 32) * 64;
                float g0 = -INFINITY, g1 = -INFINITY, g2 = -INFINITY; int i0 = -1, i1 = -1, i2 = -1;
                for (int j = 0; j < qb; ++j) { float s0 = 0.f, s1 = 0.f;
#pragma unroll
                    for (int d = 0; d < 64; d += 2) { s0 += q[d] * kb[j * 64 + d]; s1 += q[d + 1] * kb[j * 64 + d + 1]; }
                    const float g = s0 + s1;
                    if (g > g0) { g2 = g1; i2 = i1; g1 = g0; i1 = i0; g0 = g; i0 = j; } else if (g > g1) { g2 = g1; i2 = i1; g1 = g; i1 = j; } else if (g > g2) { g2 = g; i2 = j; } }
                const int tend = (t | 63);
                for (int s = qb * 256; s <= tend; ++s) { if (s <= t) { const float x = dot_row64(q, Kb + (size_t)s * NPROJ) - slope2 * (float)(t - s); att_upd(x, Vb + (size_t)s * NPROJ, m, l, o); } }
                for (int sl = 0; sl < 3; ++sl) { const int jb = sl == 0 ? i0 : (sl == 1 ? i1 : i2);
                    if (jb >= 0) for (int s = 0; s < 256; ++s) { const int key = jb * 256 + s; const float x = dot_row64(q, Kb + (size_t)key * NPROJ) - slope2 * (float)(t - key); att_upd(x, Vb + (size_t)key * NPROJ, m, l, o); } }
            } else {
                const float* c2 = cfox + (size_t)(b * HS + hh) * SEQ; const float cq = c2[t]; const int tend = (t | 63);
                for (int s = 0; s <= tend; ++s) { if (s <= t) { const float x = dot_row64(q, Kb + (size_t)s * NPROJ) + (cq - c2[s]); att_upd(x, Vb + (size_t)s * NPROJ, m, l, o); } }
            }
        } else {
            const bf16* Kb = mkv + (size_t)(b * NMEM) * 512 + (hh - HS) * 64; const bf16* Vb = Kb + 256;
            for (int s = 0; s < NMEM; ++s) { const float x = dot_row64(q, Kb + (size_t)s * 512); att_upd(x, Vb + (size_t)s * 512, m, l, o); }
        }
        const float rl = 1.f / l; v4u* op = (v4u*)(att + (size_t)n * DM + hh * 64);
#pragma unroll
        for (int i = 0; i < 8; ++i) { v4u w; w.x = pk2(o[8 * i] * rl, o[8 * i + 1] * rl); w.y = pk2(o[8 * i + 2] * rl, o[8 * i + 3] * rl); w.z = pk2(o[8 * i + 4] * rl, o[8 * i + 5] * rl); w.w = pk2(o[8 * i + 6] * rl, o[8 * i + 7] * rl); op[i] = w; }
    }
}


__device__ __forceinline__ void ph_norms(const Args& A, int layer, LAS unsigned char* lds, int wg, int G, int g_wid) {
    PH_IDS;
    const bf16* proj = (const bf16*)(A.ws + WS_PROJ); unsigned* gn = (unsigned*)(A.ws + WS_CTL) + CW_NORM + layer * 128;
    LAS unsigned* ln = (LAS unsigned*)(lds + 65536);
    if (tid < 128) ln[tid] = 0u;
    __syncthreads();
    const int gt = wg * NTHR + tid, NGT = G * NTHR;
    for (int it = gt; it < NTOK * 4; it += NGT) {
        const int n = it >> 2, part = it & 3, b = n >> 13;
#pragma unroll
        for (int hq = 0; hq < 3; ++hq) { const int hh = part * 3 + hq;
#pragma unroll
            for (int kq = 0; kq < 2; ++kq) { const v4u* p4 = (const v4u*)(proj + (size_t)n * NPROJ + kq * K_COL + hh * 64); float s = 0.f;
#pragma unroll
                for (int i = 0; i < 8; ++i) { const v4u w = p4[i]; const float a0 = bflo(w.x), a1 = bfhi(w.x), a2 = bflo(w.y), a3 = bfhi(w.y), a4 = bflo(w.z), a5 = bfhi(w.z), a6 = bflo(w.w), a7 = bfhi(w.w);
                    s += (a0 * a0 + a1 * a1) + (a2 * a2 + a3 * a3) + (a4 * a4 + a5 * a5) + (a6 * a6 + a7 * a7); }
                atomicMax((unsigned*)ln + (b * HS + hh) * 2 + kq, __float_as_uint(s)); } }
    }
    __syncthreads();
    if (tid < 96) { const unsigned v = ln[tid]; if (v) __hip_atomic_fetch_max(gn + tid, v, __ATOMIC_RELAXED, __HIP_MEMORY_SCOPE_AGENT); }
    __syncthreads();
}

typedef float f32x16 __attribute__((ext_vector_type(16)));
typedef short s16x4 __attribute__((ext_vector_type(4)));
__device__ __forceinline__ int crow(int r, int hi) { return (r & 3) + 8 * (r >> 2) + 4 * hi; }
__device__ __forceinline__ void glds16(const void* gsrc, unsigned lds_dst) { unsigned keep;
    asm volatile("s_mov_b32 %0, m0\n\ts_mov_b32 m0, %2\n\ts_nop 0\n\tglobal_load_lds_dwordx4 %1, off\n\ts_mov_b32 m0, %0" : "=&s"(keep) : "v"(gsrc), "s"(lds_dst) : "memory"); }
__device__ __forceinline__ void glds4(const void* gsrc, unsigned lds_dst) { unsigned keep;
    asm volatile("s_mov_b32 %0, m0\n\ts_mov_b32 m0, %2\n\ts_nop 0\n\tglobal_load_lds_dword %1, off\n\ts_mov_b32 m0, %0" : "=&s"(keep) : "v"(gsrc), "s"(lds_dst) : "memory"); }
#define ATT_WAIT_BAR() asm volatile("s_waitcnt vmcnt(0) lgkmcnt(0)\n\ts_barrier" ::: "memory")
constexpr int ATT_K = 0, ATT_V = 16384, ATT_CK = 32768;
constexpr float ATT_THR = 8.0f, ATT_THETA = 45.0f;
__device__ __forceinline__ float swap_other(float v, int hi) { auto rr = __builtin_amdgcn_permlane32_swap(__float_as_uint(v), __float_as_uint(v), false, false); return __uint_as_float(hi ? rr[0] : rr[1]); }
__device__ __forceinline__ int swap_other_i(int v, int hi) { auto rr = __builtin_amdgcn_permlane32_swap((unsigned)v, (unsigned)v, false, false); return (int)(hi ? rr[0] : rr[1]); }

template <int MODE>
__device__ __forceinline__ void attn_unit(const Args& A, LAS unsigned char* lds, const int layer, const int b, const int h, const int qb, const int wid, const int lane) {
    const int r32 = lane & 31, hi = lane >> 5, q0 = qb * 256, wrow0 = q0 + wid * 32, trow = wrow0 + r32;
    const bf16* proj = (const bf16*)(A.ws + WS_PROJ);
    constexpr int pitch = (MODE == 2) ? 512 : NPROJ;
    const bf16* Kb = (MODE == 2) ? (const bf16*)(A.ws + WS_MKV) + (size_t)(b * NMEM) * 512 + h * 64 : proj + (size_t)(b * SEQ) * NPROJ + K_COL + h * 64;
    const bf16* Vb = (MODE == 2) ? Kb + 256 : Kb + (V_COL - K_COL);
    const bf16* Qrow = proj + (size_t)(b * SEQ + trow) * NPROJ + ((MODE == 2) ? QM_COL : 0) + h * 64;
    bf16x8 qr[4];
#pragma unroll
    for (int d0 = 0; d0 < 4; ++d0) qr[d0] = *(const bf16x8*)(Qrow + 16 * d0 + 8 * hi);
    const unsigned ldsb = (unsigned)(uintptr_t)lds;
    const bf16* ksrc = Kb + (size_t)lane * pitch + wid * 8;
    const bf16* vsrc = Vb + (size_t)(16 * (wid & 3) + (lane >> 2)) * pitch + (wid >> 2) * 32 + (lane & 3) * 8;
    float cq = 0.f, slope2 = 0.f; const float* c2 = nullptr;
    if (MODE == 1) { c2 = (const float*)(A.ws + WS_CFOX) + (size_t)(b * HS + h) * SEQ; cq = c2[trow]; }
    if (MODE == 0) { slope2 = alibi_slope(h) * LOG2E; cq = -slope2 * (float)(trow - q0); }
#define ATT_STAGE(kt, buf) do { glds16(ksrc + (size_t)(kt) * 64 * pitch, (unsigned)__builtin_amdgcn_readfirstlane(ldsb + ATT_K + (buf) * 8192 + wid * 1024)); \
        glds16(vsrc + (size_t)(kt) * 64 * pitch, (unsigned)__builtin_amdgcn_readfirstlane(ldsb + ATT_V + (buf) * 8192 + wid * 1024)); \
        if (MODE == 1 && wid == 0) glds4(c2 + (kt) * 64 + lane, (unsigned)__builtin_amdgcn_readfirstlane(ldsb + ATT_CK + (buf) * 256)); \
        if (MODE == 0 && wid == 0) ((LAS float*)(lds + ATT_CK + (buf) * 256))[lane] = -slope2 * (float)((kt) * 64 + lane - q0); } while (0)
    unsigned selmask = 0u;
    if (MODE == 0) { if (qb > 0) {
        const bf16* kbp = (const bf16*)(A.ws + WS_KBAR + 512 * 1024) + ((size_t)((b * HS + h) * 32 + r32)) * 64 + 8 * hi;
        f32x16 g;
#pragma unroll
        for (int i = 0; i < 16; ++i) g[i] = 0.f;
#pragma unroll
        for (int d0 = 0; d0 < 4; ++d0) g = __builtin_amdgcn_mfma_f32_32x32x16_bf16(*(const bf16x8*)(kbp + 16 * d0), qr[d0], g, 0, 0, 0);
#pragma unroll
        for (int i = 0; i < 16; ++i) if (crow(i, hi) >= qb) g[i] = -INFINITY;
#pragma unroll
        for (int pick = 0; pick < 3; ++pick) {
            float bv = -INFINITY; int bj = 64;
#pragma unroll
            for (int i = 0; i < 16; ++i) if (g[i] > bv) { bv = g[i]; bj = crow(i, hi); }
            const float pv = swap_other(bv, hi); const int pj = swap_other_i(bj, hi);
            if (pv > bv || (pv == bv && pj < bj)) { bv = pv; bj = pj; }
            if (bv > -INFINITY) { selmask |= 1u << bj;
#pragma unroll
                for (int i = 0; i < 16; ++i) if (crow(i, hi) == bj) g[i] = -INFINITY; }
        } } }
    float SKIP = -INFINITY; int klo = 0;
    if (MODE != 2) { const unsigned* gn = (const unsigned*)(A.ws + WS_CTL) + CW_NORM + layer * 128 + (b * HS + h) * 2;
        const float Bq = sqrtf(__uint_as_float(gn[0]) * __uint_as_float(gn[1])); SKIP = -(ATT_THETA + 2.002f * Bq + 0.01f); }
    if (MODE == 0) { if (qb > 0) { const float fl = ((float)(q0 - 63) + SKIP / slope2) * (1.f / 64.f); klo = fl <= 0.f ? 0 : (int)ceilf(fl); if (klo > 4 * qb) klo = 4 * qb; } }
    if (MODE == 1) { if (qb > 0) { const float cq0 = c2[q0];
        for (int base = 4 * qb - 1; base >= 0; base -= 64) { const int kt = base - lane; bool sk = false; if (kt >= 0) sk = (cq0 - c2[64 * kt + 63]) < SKIP;
            const unsigned long long mk = __builtin_amdgcn_ballot_w64(sk); if (mk) { klo = base - (int)__builtin_ctzll(mk) + 1; break; } } } }
    const float cw = __builtin_bit_cast(float, __builtin_amdgcn_readfirstlane(__builtin_bit_cast(int, cq)));
    const int ktop = (MODE == 2) ? 3 : 4 * qb + 3, ntile = ktop - klo + 1;
    float mhat = 0.f, lsum = 0.f; bool started = false;
    f32x16 o0, o1;
#pragma unroll
    for (int i = 0; i < 16; ++i) { o0[i] = 0.f; o1[i] = 0.f; }
    const LAS unsigned char* vp0 = lds + ATT_V + ((lane >> 4) & 1) * 32 + (lane & 3) * 8 + (4 * hi + ((lane & 15) >> 2)) * 64;
    ATT_STAGE(ktop, 0);
    for (int it = 0; it < ntile; ++it) {
        const int kt = ktop - it, buf = it & 1;
        ATT_WAIT_BAR();
        if (it + 1 < ntile) ATT_STAGE(kt - 1, buf ^ 1);
        bool active = true, diag = false, selv = true;
        if (MODE != 2) {
            if (kt * 64 > wrow0 + 31) active = false;
            diag = (kt * 64 + 63 > wrow0);
            if (MODE == 0) { const int j = kt >> 2; if (j < qb) { selv = ((selmask >> j) & 1u) != 0u; if (__builtin_amdgcn_ballot_w64(selv) == 0ull) active = false; } }
            if (active && kt * 64 + 63 < wrow0) {
                if (MODE == 0) { if (-slope2 * (float)(wrow0 - kt * 64 - 63) < SKIP) active = false; }
                if (MODE == 1) { const float cke = __builtin_bit_cast(float, __builtin_amdgcn_readfirstlane(__builtin_bit_cast(int, ((const LAS float*)(lds + ATT_CK + buf * 256))[63]))); if (cw - cke < SKIP) active = false; } }
        }
        if (active) {
            f32x16 p0, p1;
            const float bs = (MODE == 2) ? -mhat : (selv ? cq - mhat : -INFINITY);
            if (MODE == 2) {
#pragma unroll
                for (int r = 0; r < 16; ++r) { p0[r] = bs; p1[r] = bs; }
            } else {
                const LAS f32x4* ckp = (const LAS f32x4*)(lds + ATT_CK + buf * 256);
#pragma unroll
                for (int g = 0; g < 4; ++g) { const f32x4 c = ckp[2 * g + hi], d = ckp[8 + 2 * g + hi];
                    p0[4 * g] = bs - c.x; p0[4 * g + 1] = bs - c.y; p0[4 * g + 2] = bs - c.z; p0[4 * g + 3] = bs - c.w;
                    p1[4 * g] = bs - d.x; p1[4 * g + 1] = bs - d.y; p1[4 * g + 2] = bs - d.z; p1[4 * g + 3] = bs - d.w; }
            }
            const LAS unsigned char* kb = lds + ATT_K + buf * 8192 + hi * 1024 + r32 * 16;
#pragma unroll
            for (int d0 = 0; d0 < 4; ++d0) { const bf16x8 k0 = *(const LAS bf16x8*)(kb + d0 * 2048), k1 = *(const LAS bf16x8*)(kb + d0 * 2048 + 512);
                p0 = __builtin_amdgcn_mfma_f32_32x32x16_bf16(k0, qr[d0], p0, 0, 0, 0); p1 = __builtin_amdgcn_mfma_f32_32x32x16_bf16(k1, qr[d0], p1, 0, 0, 0); }
            if (diag) {
#pragma unroll
                for (int r = 0; r < 16; ++r) { const int kv = kt * 64 + crow(r, hi); if (kv > trow) p0[r] = -INFINITY; if (kv + 32 > trow) p1[r] = -INFINITY; }
            }
            float rm = fmaxf(p0[0], p1[0]);
#pragma unroll
            for (int r = 1; r < 16; ++r) rm = fmaxf(rm, fmaxf(p0[r], p1[r]));
            rm = fmaxf(rm, swap_other(rm, hi));
            const bool need = started ? (__builtin_amdgcn_ballot_w64(rm > ATT_THR) != 0ull) : true;
            if (need) { const float dl = started ? fmaxf(rm, 0.f) : rm; mhat += dl;
#pragma unroll
                for (int r = 0; r < 16; ++r) { p0[r] -= dl; p1[r] -= dl; }
                if (started) { const float f = fexp2(-dl); lsum *= f;
#pragma unroll
                    for (int r = 0; r < 16; ++r) { o0[r] *= f; o1[r] *= f; } }
                started = true; }
            float s0 = 0.f, s1 = 0.f;
#pragma unroll
            for (int r = 0; r < 16; ++r) { p0[r] = fexp2(p0[r]); p1[r] = fexp2(p1[r]); s0 += p0[r]; s1 += p1[r]; }
            lsum += s0 + s1;
            bf16x8 pa[4];
#pragma unroll
            for (int ks = 0; ks < 4; ++ks) { v4u w;
                if (ks < 2) { w.x = pk2(p0[8 * ks], p0[8 * ks + 1]); w.y = pk2(p0[8 * ks + 2], p0[8 * ks + 3]); w.z = pk2(p0[8 * ks + 4], p0[8 * ks + 5]); w.w = pk2(p0[8 * ks + 6], p0[8 * ks + 7]); }
                else { const int k2 = ks - 2; w.x = pk2(p1[8 * k2], p1[8 * k2 + 1]); w.y = pk2(p1[8 * k2 + 2], p1[8 * k2 + 3]); w.z = pk2(p1[8 * k2 + 4], p1[8 * k2 + 5]); w.w = pk2(p1[8 * k2 + 6], p1[8 * k2 + 7]); }
                pa[ks] = __builtin_bit_cast(bf16x8, w); }
            const LAS unsigned char* vp = vp0 + buf * 8192;
#pragma unroll
            for (int ks = 0; ks < 4; ++ks) {
#pragma unroll
                for (int d0 = 0; d0 < 2; ++d0) {
                    const s16x4 lo = __builtin_bit_cast(s16x4, __builtin_amdgcn_ds_read_tr16_b64_v4i16((LAS s16x4*)(vp + d0 * 4096 + ks * 1024)));
                    const s16x4 hh = __builtin_bit_cast(s16x4, __builtin_amdgcn_ds_read_tr16_b64_v4i16((LAS s16x4*)(vp + d0 * 4096 + ks * 1024 + 512)));
                    const bf16x8 vf = (bf16x8){lo[0], lo[1], lo[2], lo[3], hh[0], hh[1], hh[2], hh[3]};
                    if (d0 == 0) o0 = __builtin_amdgcn_mfma_f32_32x32x16_bf16(vf, pa[ks], o0, 0, 0, 0); else o1 = __builtin_amdgcn_mfma_f32_32x32x16_bf16(vf, pa[ks], o1, 0, 0, 0); } }
        }
    }
    ATT_WAIT_BAR();
    lsum += swap_other(lsum, hi);
    const float rl = 1.f / lsum;
    bf16* Op = (bf16*)(A.ws + WS_ATT) + (size_t)(b * SEQ + trow) * DM + ((MODE == 2) ? HS * 64 : 0) + h * 64 + 4 * hi;
#pragma unroll
    for (int g = 0; g < 4; ++g) {
        v2u w0, w1; w0.x = pk2(o0[4 * g] * rl, o0[4 * g + 1] * rl); w0.y = pk2(o0[4 * g + 2] * rl, o0[4 * g + 3] * rl);
        w1.x = pk2(o1[4 * g] * rl, o1[4 * g + 1] * rl); w1.y = pk2(o1[4 * g + 2] * rl, o1[4 * g + 3] * rl);
        *(v2u*)(Op + 8 * g) = w0; *(v2u*)(Op + 32 + 8 * g) = w1; }
#undef ATT_STAGE
}
template <int MODE01>
__device__ __forceinline__ void ph_attn_fast(const Args& A, int layer, LAS unsigned char* lds, int wg, int G, int g_wid) {
    PH_IDS;
    constexpr int NSELF = NB * HS * 32, NU = NSELF + NB * HMEM * 32;
    unsigned* qh = (unsigned*)(A.ws + WS_CTL) + CW_AQ + layer * 64;
    volatile LAS int* qs = (volatile LAS int*)(lds + MISC_OFF) + 32;
    if (tid == 0) qs[0] = (int)__hip_atomic_fetch_add(qh, 1u, __ATOMIC_RELAXED, __HIP_MEMORY_SCOPE_AGENT);
    __syncthreads();
    int L = __builtin_amdgcn_readfirstlane(qs[0]);
    while (L < NU) {
        int nxt = 0;
        if (tid == 0) nxt = (int)__hip_atomic_fetch_add(qh, 1u, __ATOMIC_RELAXED, __HIP_MEMORY_SCOPE_AGENT);
        if (L < NSELF) { const int qb = 31 - L / (NB * HS), bh = L % (NB * HS); attn_unit<MODE01>(A, lds, layer, bh / HS, bh % HS, qb, wid, lane); }
        else { const int m = L - NSELF, qb = m & 31, bhm = m >> 5; attn_unit<2>(A, lds, layer, bhm >> 2, bhm & 3, qb, wid, lane); }
        if (tid == 0) qs[0] = nxt;
        __syncthreads();
        L = __builtin_amdgcn_readfirstlane(qs[0]);
        __syncthreads();
    }
}

__device__ __forceinline__ void ph_ln1_router(const Args& A, int layer, LAS unsigned char* lds, int wg, int G, int g_wid) {
    PH_IDS;
    float* hres = A.out; bf16* hb = (bf16*)(A.ws + WS_HB); unsigned* elist = (unsigned*)(A.ws + WS_ELIST); float* agate = (float*)(A.ws + WS_AGATE);
    unsigned* ecnt = (unsigned*)(A.ws + WS_CTL) + CW_ECNT + layer * 64;
    const float* rw = A.in[I_RW] + (size_t)layer * DM * NEXP; const float* rb = A.in[I_RB] + layer * NEXP;
    const float* g1 = A.in[I_LN1G] + layer * DM; const float* b1 = A.in[I_LN1B] + layer * DM;
    LAS float* rwT = (LAS float*)lds; LAS int* lcnt = (LAS int*)(lds + 131072); LAS int* gbase = lcnt + 32; LAS unsigned* rec = (LAS unsigned*)(lds + 131584);
    const int RPW = (NTOK + G - 1) / G;
    for (int i = tid; i < DM * NEXP; i += NTHR) rwT[(i & 31) * DM + (i >> 5)] = rw[i];
    if (tid < 32) lcnt[tid] = 0;
    __syncthreads();
    const int row0 = wg * RPW, row1 = (row0 + RPW < NTOK) ? row0 + RPW : NTOK;
    for (int n = row0 + wid; n < row1; n += NWAVES) {
        f32x4 v[4]; float s = 0.f; float* xr = hres + (size_t)n * DM;
#pragma unroll
        for (int j = 0; j < 4; ++j) { v[j] = *(const f32x4*)(xr + 4 * lane + 256 * j); s += (v[j].x + v[j].y) + (v[j].z + v[j].w); }
        const float mean = wave_sum(s) * (1.f / DM); float s2 = 0.f;
#pragma unroll
        for (int j = 0; j < 4; ++j) { v[j] = v[j] - mean; s2 += (v[j].x * v[j].x + v[j].y * v[j].y) + (v[j].z * v[j].z + v[j].w * v[j].w); }
        const float rstd = 1.f / sqrtf(wave_sum(s2) * (1.f / DM) + LN_EPS);
#pragma unroll
        for (int j = 0; j < 4; ++j) { const f32x4 gg = *(const f32x4*)(g1 + 4 * lane + 256 * j), bb = *(const f32x4*)(b1 + 4 * lane + 256 * j);
            v[j] = v[j] * rstd * gg + bb; *(f32x4*)(xr + 4 * lane + 256 * j) = v[j];
            v2u w; w.x = pk2(v[j].x, v[j].y); w.y = pk2(v[j].z, v[j].w); *(v2u*)(hb + (size_t)n * DM + 4 * lane + 256 * j) = w; }
        float lg[32];
#pragma unroll
        for (int e = 0; e < 32; ++e) { float p = 0.f;
#pragma unroll
            for (int j = 0; j < 4; ++j) { const f32x4 r4 = *(const LAS f32x4*)(rwT + e * DM + 4 * lane + 256 * j); p += (v[j].x * r4.x + v[j].y * r4.y) + (v[j].z * r4.z + v[j].w * r4.w); }
            lg[e] = wave_sum(p) + rb[e]; asm volatile("" ::: "memory"); }
        float tv[4]; int ti[4];
#pragma unroll
        for (int k = 0; k < 4; ++k) { float best = -INFINITY; int bi = 0;
#pragma unroll
            for (int e = 0; e < 32; ++e) { if (lg[e] > best) { best = lg[e]; bi = e; } }
            tv[k] = best; ti[k] = bi;
#pragma unroll
            for (int e = 0; e < 32; ++e) if (e == bi) lg[e] = -INFINITY; }
        const float e1 = expf(tv[1] - tv[0]), e2 = expf(tv[2] - tv[0]), e3 = expf(tv[3] - tv[0]); const float inv = 1.f / (1.f + e1 + e2 + e3);
        if (lane < 4) { const int ek = lane == 0 ? ti[0] : lane == 1 ? ti[1] : lane == 2 ? ti[2] : ti[3]; const float gk = (lane == 0 ? 1.f : lane == 1 ? e1 : lane == 2 ? e2 : e3) * inv;
            const int lp = atomicAdd((int*)lcnt + ek, 1);
            const int ri = (n - row0) * 4 + lane; rec[2 * ri] = (unsigned)ek | ((unsigned)lp << 8); rec[2 * ri + 1] = __float_as_uint(gk); }
    }
    __syncthreads();
    if (tid < 32) gbase[tid] = (int)__hip_atomic_fetch_add(ecnt + tid, (unsigned)lcnt[tid], __ATOMIC_RELAXED, __HIP_MEMORY_SCOPE_AGENT);
    __syncthreads();
    for (int ri = tid; ri < (row1 - row0) * 4; ri += NTHR) { const unsigned w = rec[2 * ri]; const int e = w & 31, lp = w >> 8; const unsigned aid = (unsigned)(row0 * 4 + ri);
        elist[(size_t)e * NTOK + gbase[e] + lp] = aid; agate[aid] = __uint_as_float(rec[2 * ri + 1]); }
    __syncthreads();
}

__device__ __forceinline__ void ph_combine_ln2(const Args& A, int layer, int wg, int G, int g_wid) {
    PH_IDS;
    float* hres = A.out; bf16* hb = (bf16*)(A.ws + WS_HB); const bf16* ybuf = (const bf16*)(A.ws + WS_YBUF);
    const float* g2 = A.in[I_LN2G] + layer * DM; const float* b2 = A.in[I_LN2B] + layer * DM;
    const int gw = wg * NWAVES + wid, NGW = G * NWAVES;
    for (int n = gw; n < NTOK; n += NGW) {
        f32x4 v[4]; float s = 0.f; float* xr = hres + (size_t)n * DM;
#pragma unroll
        for (int j = 0; j < 4; ++j) { v[j] = *(const f32x4*)(xr + 4 * lane + 256 * j) * ALPHA;
#pragma unroll
            for (int k = 0; k < 4; ++k) { const v2u w = *(const v2u*)(ybuf + ((size_t)n * 4 + k) * DM + 4 * lane + 256 * j); v[j].x += bflo(w.x); v[j].y += bfhi(w.x); v[j].z += bflo(w.y); v[j].w += bfhi(w.y); }
            s += (v[j].x + v[j].y) + (v[j].z + v[j].w); }
        const float mean = wave_sum(s) * (1.f / DM); float s2 = 0.f;
#pragma unroll
        for (int j = 0; j < 4; ++j) { v[j] = v[j] - mean; s2 += (v[j].x * v[j].x + v[j].y * v[j].y) + (v[j].z * v[j].z + v[j].w * v[j].w); }
        const float rstd = 1.f / sqrtf(wave_sum(s2) * (1.f / DM) + LN_EPS);
#pragma unroll
        for (int j = 0; j < 4; ++j) { const f32x4 gg = *(const f32x4*)(g2 + 4 * lane + 256 * j), bb = *(const f32x4*)(b2 + 4 * lane + 256 * j);
            v[j] = v[j] * rstd * gg + bb; *(f32x4*)(xr + 4 * lane + 256 * j) = v[j];
            v2u w; w.x = pk2(v[j].x, v[j].y); w.y = pk2(v[j].z, v[j].w); *(v2u*)(hb + (size_t)n * DM + 4 * lane + 256 * j) = w; }
    }
}

#define IN(k) (lo <= (k) && (k) < hi)
#define SEAM(k) do { if ((k) + 1 < hi) xcd_barrier(bar); } while (0)
template <int layer>
__device__ __forceinline__ void run_layer(LAS unsigned char* lds, const int wg, const int G, const int wid0, const int lo, const int hi, const XcdBarrier& bar) {
        constexpr int pb = 1 + 8 * layer; constexpr bool fox = (layer & 1) != 0;
        if (IN(pb + 0)) {
            { const Args A = load_args(); unsigned char* ws = A.ws;
              DenseSched S{(const bf16*)(ws + WS_HB), (const bf16*)(ws + WS_WIN) + (size_t)layer * NPROJ * DM, NTOK / 256, NPROJ / 256, G, wg};
              EpiProj E{(bf16*)(ws + WS_PROJ), NPROJ, K_COL, QM_COL};
              gemm_fast<EpiProj, DenseSched, true>(lds, S, E, wid0); }
            if constexpr (layer == 0) { const Args A = load_args(); unsigned char* ws = A.ws;
              DenseSched S{(const bf16*)(ws + WS_MEMB), (const bf16*)(ws + WS_WMKV), NB * NMEM / 256, 2, G, wg};
              EpiProj E{(bf16*)(ws + WS_MKV), 512, 0, 1 << 30};
              gemm_fast<EpiProj, DenseSched, true>(lds, S, E, wid0); }
            if constexpr (fox) { const Args A = load_args(); ph_fox_gate(A, layer >> 1, wg, G, wid0); }
            SEAM(pb + 0);
        }
        if (IN(pb + 1)) { const Args A = load_args(); if constexpr (fox) ph_fox_scan(A, lds, wg, G, wid0); else ph_kbar(A, lds, wg, G, wid0); ph_norms(A, layer, lds, wg, G, wid0); SEAM(pb + 1); }
        if (IN(pb + 2)) { const Args A = load_args(); ph_attn_fast<fox ? 1 : 0>(A, layer, lds, wg, G, wid0); SEAM(pb + 2); }
        if (IN(pb + 3)) {
            const Args A = load_args(); unsigned char* ws = A.ws;
            DenseSched S{(const bf16*)(ws + WS_ATT), (const bf16*)(ws + WS_WO) + (size_t)layer * DM * DM, NTOK / 256, DM / 256, G, wg};
            EpiOut E{layer == 0 ? A.in[I_X] : A.out, A.out};
            gemm_fast<EpiOut, DenseSched, true>(lds, S, E, wid0); SEAM(pb + 3);
        }
        if (IN(pb + 4)) { const Args A = load_args(); ph_ln1_router(A, layer, lds, wg, G, wid0); SEAM(pb + 4); }
        if (IN(pb + 5)) {
            const Args A = load_args(); unsigned char* ws = A.ws;
            LAS int* tab = (LAS int*)(lds + MISC_OFF) + 64; moe_tables(tab, (unsigned*)(ws + WS_CTL) + CW_ECNT + layer * 64, wid0);
            MoeSched S{(const bf16*)(ws + WS_HB), (const bf16*)(ws + WS_WGU) + (size_t)layer * NEXP * 2048 * DM, (const unsigned*)(ws + WS_ELIST), tab, 8, 2048, G, wg, 2};
            EpiGU E{(bf16*)(ws + WS_ABUF), A.in[I_BGU] + (size_t)layer * NEXP * 2048};
            gemm_fast<EpiGU, MoeSched, true>(lds, S, E, wid0); __syncthreads(); SEAM(pb + 5);
        }
        if (IN(pb + 6)) {
            const Args A = load_args(); unsigned char* ws = A.ws;
            LAS int* tab = (LAS int*)(lds + MISC_OFF) + 64; moe_tables(tab, (unsigned*)(ws + WS_CTL) + CW_ECNT + layer * 64, wid0);
            MoeSched S{(const bf16*)(ws + WS_ABUF), (const bf16*)(ws + WS_WDN) + (size_t)layer * NEXP * DM * DM, (const unsigned*)(ws + WS_ELIST), tab, 4, 1024, G, wg, 0};
            EpiDN E{(bf16*)(ws + WS_YBUF), A.in[I_BDN] + (size_t)layer * NEXP * DM, (const float*)(ws + WS_AGATE)};
            gemm_fast<EpiDN, MoeSched, true>(lds, S, E, wid0); __syncthreads(); SEAM(pb + 6);
        }
        if (IN(pb + 7)) { const Args A = load_args(); ph_combine_ln2(A, layer, wg, G, wid0); SEAM(pb + 7); }
}
__global__ void __launch_bounds__(NTHR, 2) k_main(Args A0) {
    extern __shared__ __attribute__((aligned(16))) unsigned char lds_raw[];
    LAS unsigned char* lds = (LAS unsigned char*)lds_raw;
    volatile LAS unsigned* MISC = (volatile LAS unsigned*)(lds + MISC_OFF);
    const int wid0 = __builtin_amdgcn_readfirstlane((int)threadIdx.x >> 6);
    const int G = gridDim.x, wg = blockIdx.x;
    const int lo = A0.p_lo, hi = A0.p_hi;
    if (threadIdx.x < 64) MISC[threadIdx.x] = 0u;
    __syncthreads();
    XcdBarrier bar; bar.bar = (unsigned*)(A0.ws + WS_CTL) + CW_BAR; bar.x = 0; bar.st = nullptr; bar.wid = wid0;
    if (hi - lo > 1) bar = xcd_barrier_post((unsigned*)(A0.ws + WS_CTL) + CW_BAR + (size_t)lo * XCD_BAR_WORDS, MISC + 8, wid0);
    if (IN(0)) { const Args A = load_args(); ph_convert(A, lds, wg, G, wid0); SEAM(0); }
    run_layer<0>(lds, wg, G, wid0, lo, hi, bar); run_layer<1>(lds, wg, G, wid0, lo, hi, bar); run_layer<2>(lds, wg, G, wid0, lo, hi, bar); run_layer<3>(lds, wg, G, wid0, lo, hi, bar);
#undef IN
#undef SEAM
}

#ifndef MK_ONE_LAUNCH
#define MK_ONE_LAUNCH 1
#endif
extern "C" void kernel_launch(void* const* d_in, const int* in_sizes, int n_in, void* d_out, int out_size, void* d_ws, size_t ws_size, hipStream_t stream) {
    static int grid = 0;
    if (grid == 0) {
        if (n_in != 17 || out_size != NTOK * DM || ws_size < WS_END) { fprintf(stderr, "kernel_launch: unexpected shapes (n_in %d out %d ws %zu, need %zu)\n", n_in, out_size, ws_size, (size_t)WS_END); grid = -1; return; }
        int dev = 0, cus = 0, per_cu = 0;
        if (hipGetDevice(&dev) != hipSuccess || hipDeviceGetAttribute(&cus, hipDeviceAttributeMultiprocessorCount, dev) != hipSuccess) { grid = -1; return; }
        if (hipFuncSetAttribute((const void*)k_main, hipFuncAttributeMaxDynamicSharedMemorySize, LDS_BYTES) != hipSuccess) { fprintf(stderr, "kernel_launch: hipFuncSetAttribute failed\n"); grid = -1; return; }
        if (hipOccupancyMaxActiveBlocksPerMultiprocessor(&per_cu, (const void*)k_main, NTHR, LDS_BYTES) != hipSuccess || per_cu < 1) { fprintf(stderr, "kernel_launch: occupancy query says %d\n", per_cu); }
        (void)hipGetLastError();
        grid = cus;
    }
    if (grid < 0) return;
    (void)hipMemsetAsync((char*)d_ws + WS_CTL, 0, CTL_ZERO_BYTES, stream);
    Args a{};
    for (int i = 0; i < 17; ++i) a.in[i] = (const float*)d_in[i];
    a.out = (float*)d_out; a.ws = (unsigned char*)d_ws;
#if MK_ONE_LAUNCH
    a.p_lo = 0; a.p_hi = NPHASE;
    hipLaunchKernelGGL(k_main, dim3(grid), dim3(NTHR), LDS_BYTES, stream, a);
#else
    for (int p = 0; p < NPHASE; ++p) { a.p_lo = p; a.p_hi = p + 1; hipLaunchKernelGGL(k_main, dim3(grid), dim3(NTHR), LDS_BYTES, stream, a); }
#endif
}
```

```cpp
#include <hip/hip_runtime.h>
#include <cstdio>
#include <cstdint>
#ifndef PROBE_ATT
#define PROBE_ATT 1
#endif
#ifndef PROBE_MOE
#define PROBE_MOE 1
#endif
#ifndef PROBE_CVT
#define PROBE_CVT 1
#endif
#ifndef PROBE_TIME
#define PROBE_TIME 0
#endif
#ifndef PROBE_INP
#define PROBE_INP 1
#endif

#define GAS __attribute__((address_space(1)))
#define LAS __attribute__((address_space(3)))
typedef unsigned short bf16;
typedef unsigned v4u __attribute__((ext_vector_type(4)));
typedef unsigned v2u __attribute__((ext_vector_type(2)));
typedef float f32x4 __attribute__((ext_vector_type(4)));
typedef short bf16x8 __attribute__((ext_vector_type(8)));

constexpr int NB = 4, SEQ = 8192, DM = 1024, NTOK = NB * SEQ;
constexpr int HS = 12, HMEM = 4, HD = 64, NMEM = 256, NPROJ = 2560, QM_COL = 2304, K_COL = 768, V_COL = 1536;
constexpr int NEXP = 32, TOPK = 4, DEPTH = 4, NASSIGN = NTOK * TOPK, DFF = 1024;
constexpr float ALPHA = 1.6817928305074290f, LN_EPS = 1e-5f, LOG2E = 1.4426950408889634f, C2 = 0.125f * 1.4426950408889634f;
constexpr float SW_LIMIT = 7.0f, SW_ALPHA = 1.702f;
constexpr int NWAVES = 8, NTHR = 512;

constexpr size_t MiB = 1u << 20;
constexpr size_t WS_CTL = 0, CTL_ZERO_BYTES = 2 * MiB;
constexpr size_t WS_KSUM = 1 * MiB;
constexpr size_t WS_WIN = 2 * MiB;
constexpr size_t WS_WFG = WS_WIN + (size_t)4 * NPROJ * DM * 2;
constexpr size_t WS_WMKV = WS_WFG + 1 * MiB;
constexpr size_t WS_WO = WS_WMKV + 1 * MiB;
constexpr size_t WS_WGU = WS_WO + 8 * MiB;
constexpr size_t WS_WDN = WS_WGU + 512 * MiB;
constexpr size_t WS_HB = WS_WDN + 256 * MiB;
constexpr size_t WS_MEMB = WS_HB + 64 * MiB;
constexpr size_t WS_MKV = WS_MEMB + 2 * MiB;
constexpr size_t WS_PROJ = WS_MKV + 1 * MiB;
constexpr size_t WS_CFOX = WS_PROJ + 160 * MiB;
constexpr size_t WS_LF = WS_CFOX + 2 * MiB;
constexpr size_t WS_KBAR = WS_LF + 2 * MiB;
constexpr size_t WS_ATT = WS_KBAR + 1 * MiB;
constexpr size_t WS_ELIST = WS_ATT + 64 * MiB;
constexpr size_t WS_AGATE = WS_ELIST + 8 * MiB;
constexpr size_t WS_ABUF = WS_AGATE + 1 * MiB;
constexpr size_t WS_YBUF = WS_ABUF + 288 * MiB;
constexpr size_t WS_END = WS_YBUF + 256 * MiB;

constexpr int CW_ECNT = 1024;
constexpr int CW_NORM = 1536;
constexpr int CW_AQ = 2560;
constexpr int CW_BAR = 4096;
constexpr int NPHASE = 1 + 8 * DEPTH;

constexpr int LDS_BYTES = 147456, SCR_BYTES = 146432, MISC_OFF = SCR_BYTES;

__device__ __forceinline__ unsigned f2bf(float f) { unsigned u = __float_as_uint(f); return (u + 0x7fffu + ((u >> 16) & 1u)) >> 16; }
typedef float f32x2_t __attribute__((ext_vector_type(2))); typedef __bf16 bf16x2_t __attribute__((ext_vector_type(2)));
__device__ __forceinline__ unsigned pk2(float lo, float hi) { const f32x2_t v = {lo, hi}; const bf16x2_t b = __builtin_convertvector(v, bf16x2_t); return __builtin_bit_cast(unsigned, b); }
__device__ __forceinline__ float bflo(unsigned w) { return __uint_as_float(w << 16); }
__device__ __forceinline__ float bfhi(unsigned w) { return __uint_as_float(w & 0xffff0000u); }
__device__ __forceinline__ float wave_sum(float v) {
    v += __builtin_bit_cast(float, __builtin_amdgcn_update_dpp(0, __builtin_bit_cast(int, v), 0xB1, 0xF, 0xF, false));
    v += __builtin_bit_cast(float, __builtin_amdgcn_update_dpp(0, __builtin_bit_cast(int, v), 0x4E, 0xF, 0xF, false));
    v += __builtin_bit_cast(float, __builtin_amdgcn_update_dpp(0, __builtin_bit_cast(int, v), 0x141, 0xF, 0xF, false));
    v += __builtin_bit_cast(float, __builtin_amdgcn_update_dpp(0, __builtin_bit_cast(int, v), 0x140, 0xF, 0xF, false));
    v += __builtin_bit_cast(float, __builtin_amdgcn_update_dpp(0, __builtin_bit_cast(int, v), 0x142, 0xA, 0xF, false));
    v += __builtin_bit_cast(float, __builtin_amdgcn_update_dpp(0, __builtin_bit_cast(int, v), 0x143, 0xC, 0xF, false));
    return __builtin_bit_cast(float, __builtin_amdgcn_readlane(__builtin_bit_cast(int, v), 63));
}
__device__ __forceinline__ void wave_sum4(float (&v)[4]) {
#define WS4_STEP(ctrl, rm) do { float t_[4]; _Pragma("unroll") for (int i_ = 0; i_ < 4; ++i_) t_[i_] = __builtin_bit_cast(float, __builtin_amdgcn_update_dpp(0, __builtin_bit_cast(int, v[i_]), ctrl, rm, 0xF, false)); \
        _Pragma("unroll") for (int i_ = 0; i_ < 4; ++i_) v[i_] += t_[i_]; } while (0)
    WS4_STEP(0xB1, 0xF); WS4_STEP(0x4E, 0xF); WS4_STEP(0x141, 0xF); WS4_STEP(0x140, 0xF); WS4_STEP(0x142, 0xA); WS4_STEP(0x143, 0xC);
#undef WS4_STEP
#pragma unroll
    for (int i = 0; i < 4; ++i) v[i] = __builtin_bit_cast(float, __builtin_amdgcn_readlane(__builtin_bit_cast(int, v[i]), 63));
}
__device__ __forceinline__ float row16_max(float v) {
    v = fmaxf(v, __builtin_bit_cast(float, __builtin_amdgcn_update_dpp(__builtin_bit_cast(int, v), __builtin_bit_cast(int, v), 0xB1, 0xF, 0xF, false)));
    v = fmaxf(v, __builtin_bit_cast(float, __builtin_amdgcn_update_dpp(__builtin_bit_cast(int, v), __builtin_bit_cast(int, v), 0x4E, 0xF, 0xF, false)));
    v = fmaxf(v, __builtin_bit_cast(float, __builtin_amdgcn_update_dpp(__builtin_bit_cast(int, v), __builtin_bit_cast(int, v), 0x141, 0xF, 0xF, false)));
    v = fmaxf(v, __builtin_bit_cast(float, __builtin_amdgcn_update_dpp(__builtin_bit_cast(int, v), __builtin_bit_cast(int, v), 0x140, 0xF, 0xF, false)));
    return v;
}
__device__ __forceinline__ float row16_sum(float v) {
    v += __builtin_bit_cast(float, __builtin_amdgcn_update_dpp(0, __builtin_bit_cast(int, v), 0xB1, 0xF, 0xF, false));
    v += __builtin_bit_cast(float, __builtin_amdgcn_update_dpp(0, __builtin_bit_cast(int, v), 0x4E, 0xF, 0xF, false));
    v += __builtin_bit_cast(float, __builtin_amdgcn_update_dpp(0, __builtin_bit_cast(int, v), 0x141, 0xF, 0xF, false));
    v += __builtin_bit_cast(float, __builtin_amdgcn_update_dpp(0, __builtin_bit_cast(int, v), 0x140, 0xF, 0xF, false));
    return v;
}
__device__ __forceinline__ float wave_max(float v) {
    v = row16_max(v);
    v = fmaxf(v, __builtin_bit_cast(float, __builtin_amdgcn_update_dpp(__builtin_bit_cast(int, v), __builtin_bit_cast(int, v), 0x142, 0xA, 0xF, false)));
    v = fmaxf(v, __builtin_bit_cast(float, __builtin_amdgcn_update_dpp(__builtin_bit_cast(int, v), __builtin_bit_cast(int, v), 0x143, 0xC, 0xF, false)));
    return __builtin_bit_cast(float, __builtin_amdgcn_readlane(__builtin_bit_cast(int, v), 63));
}
__device__ __forceinline__ float fexp2(float x) { return __builtin_amdgcn_exp2f(x); }
#define PH_IDS int lane; asm volatile("v_mbcnt_lo_u32_b32 %0, -1, 0\n\tv_mbcnt_hi_u32_b32 %0, -1, %0" : "=v"(lane)); const int wid = __builtin_amdgcn_readfirstlane(g_wid); const int tid = wid * 64 + lane; (void)tid

#define XB_TMO      128
#define XB_XCNT(j)  (256  + 64 * (j))
#define XB_XSUB(j)  (1280 + 64 * (j))
#define XB_XGEN(j)  (2304 + 64 * (j))
#define XB_TOP      3328
#define XB_TOPGEN   3392
#define XCD_BAR_WORDS 3456
#define XB_SPIN_CAP (1u << 22)
__device__ __forceinline__ unsigned xb_ld(unsigned* p)              { return __hip_atomic_load(p, __ATOMIC_RELAXED, __HIP_MEMORY_SCOPE_AGENT); }
__device__ __forceinline__ unsigned xb_add(unsigned* p, unsigned v) { return __hip_atomic_fetch_add(p, v, __ATOMIC_RELAXED, __HIP_MEMORY_SCOPE_AGENT); }
__device__ __forceinline__ unsigned xb_xcc_id() { return (unsigned)__builtin_amdgcn_s_getreg((3 << 11) | 20) & 0xFu; }
#define XB_SPIN(cond, bar) do { unsigned _sp = 0; while (cond) { __builtin_amdgcn_s_sleep(1); \
    if ((++_sp & 255u) == 0u) { if (xb_ld(&(bar)[XB_TMO])) break; if (_sp > XB_SPIN_CAP) { atomicAdd(&(bar)[XB_TMO], 1u); break; } } } } while (0)
struct XcdBarrier { unsigned* bar; unsigned x; volatile LAS unsigned* st; int wid; };
__device__ __forceinline__ bool xb_t0(int w) { int l; asm volatile("v_mbcnt_lo_u32_b32 %0, -1, 0\n\tv_mbcnt_hi_u32_b32 %0, -1, %0" : "=v"(l)); return w == 0 && l == 0; }
#define XB_T0(w) xb_t0(w)
__device__ __forceinline__ XcdBarrier xcd_barrier_post(unsigned* bar, volatile LAS unsigned* st, int wid) {
    XcdBarrier b; b.bar = bar; b.x = xb_xcc_id(); b.st = st; b.wid = wid;
    if (XB_T0(wid)) (void)xb_add(&bar[XB_XCNT(b.x)], 1u);
    return b;
}
__device__ __forceinline__ void xcd_barrier_complete(unsigned* bar, unsigned x, unsigned& nloc, unsigned& nx) {
    const unsigned G = gridDim.x * gridDim.y * gridDim.z;
    unsigned sum, cnt, mine, sp = 0u;
    for (;;) {
        sum = 0u; cnt = 0u; mine = 0u;
#pragma unroll
        for (unsigned j = 0; j < 16; ++j) { const unsigned c = xb_ld(&bar[XB_XCNT(j)]); sum += c; cnt += (c > 0u) ? 1u : 0u; mine = (j == x) ? c : mine; }
        if (sum == G) break;
        __builtin_amdgcn_s_sleep(1);
        if ((++sp & 255u) == 0u) { if (xb_ld(&bar[XB_TMO])) break; if (sp > XB_SPIN_CAP) { atomicAdd(&bar[XB_TMO], 1u); break; } }
    }
    nloc = mine > 0u ? mine : 1u; nx = cnt > 0u ? cnt : 1u;
}
__device__ __forceinline__ void xcd_barrier(const XcdBarrier& b) {
    asm volatile("s_waitcnt vmcnt(0)" ::: "memory");
    __syncthreads();
    if (XB_T0(b.wid)) {
        unsigned* bar = b.bar;
        __builtin_amdgcn_s_waitcnt(0);
        unsigned nloc = b.st[0], nx = b.st[1];
        if (nloc == 0u) { xcd_barrier_complete(bar, b.x, nloc, nx); b.st[0] = nloc; b.st[1] = nx; }
        const unsigned old = xb_add(&bar[XB_XSUB(b.x)], 1u);
        const unsigned gen = old / nloc;
        if (old + 1u == (gen + 1u) * nloc) {
            __builtin_amdgcn_fence(__ATOMIC_RELEASE, "agent");
            asm volatile("s_waitcnt vmcnt(0)" ::: "memory");
            const unsigned og = xb_add(&bar[XB_TOP], 1u);
            const unsigned tg = og / nx;
            if (og + 1u == (tg + 1u) * nx) xb_add(&bar[XB_TOPGEN], 1u);
            else XB_SPIN(xb_ld(&bar[XB_TOPGEN]) == tg, bar);
            __builtin_amdgcn_fence(__ATOMIC_ACQUIRE, "agent");
            xb_add(&bar[XB_XGEN(b.x)], 1u);
            asm volatile("s_waitcnt vmcnt(0)" ::: "memory");
        } else {
            XB_SPIN(xb_ld(&bar[XB_XGEN(b.x)]) == gen, bar);
            __builtin_amdgcn_fence(__ATOMIC_ACQUIRE, "agent");
            asm volatile("s_waitcnt vmcnt(0)" ::: "memory");
        }
    }
    __syncthreads();
}

struct Args { const float* in[17]; float* out; unsigned char* ws; int p_lo, p_hi; };
enum { I_X = 0, I_MEM, I_WIN_MOBA, I_WIN_FOX, I_BFG, I_WMKV, I_WO, I_LN1G, I_LN1B, I_RW, I_RB, I_WGU, I_BGU, I_WDN, I_BDN, I_LN2G, I_LN2B };

__device__ __forceinline__ Args load_args() {
#if defined(__HIP_DEVICE_COMPILE__)
    const __attribute__((address_space(4))) unsigned long long* p = (const __attribute__((address_space(4))) unsigned long long*)__builtin_amdgcn_kernarg_segment_ptr();
    asm volatile("" : "+s"(p));
    Args a;
#pragma unroll
    for (int i = 0; i < 17; ++i) a.in[i] = (const float*)(const GAS float*)p[i];
    a.out = (float*)(GAS float*)p[17]; a.ws = (unsigned char*)(GAS unsigned char*)p[18]; const unsigned long long w = p[19]; a.p_lo = (int)(unsigned)w; a.p_hi = (int)(unsigned)(w >> 32);
    return a;
#else
    return Args{};
#endif
}
struct CvtItem { const float* src; bf16* dst; int pitch; };
constexpr int CVT_I_IN = 16 * 40, CVT_I_MK = 16 * 8, CVT_I_O1 = 16 * 16, CVT_I_GU1 = 16 * 32, CVT_I_DN1 = 16 * 16;
constexpr int CVT_N_INIT = 4 * CVT_I_IN + CVT_I_MK + 4 * CVT_I_O1;
constexpr int CVT_N_MOE = NEXP * (CVT_I_GU1 + CVT_I_DN1), CVT_CHUNK = 32;
__device__ __forceinline__ bool cvt_decode(const Args& A, int it, CvtItem& c) {
    unsigned char* ws = A.ws;
    constexpr int N_IN = 4 * CVT_I_IN, N_MK = CVT_I_MK;
    if (it >= CVT_N_INIT) return false;
    int r = it;
    if (r < N_IN) { const int l = r / CVT_I_IN, q = r % CVT_I_IN, kb = q / 40, nb = q % 40, j = l >> 1; const int pitch = (l & 1) ? NPROJ + HS : NPROJ;
        const float* W = (l & 1) ? A.in[I_WIN_FOX] + (size_t)j * DM * (NPROJ + HS) : A.in[I_WIN_MOBA] + (size_t)j * DM * NPROJ;
        c.src = W + (size_t)(64 * kb) * pitch + 64 * nb; c.pitch = pitch; c.dst = (bf16*)(ws + WS_WIN) + ((size_t)l * NPROJ + 64 * nb) * DM + 64 * kb; return true; }
    r -= N_IN;
    if (r < N_MK) { const int kb = r / 8, nb = r % 8; c.src = A.in[I_WMKV] + (size_t)(64 * kb) * 512 + 64 * nb; c.pitch = 512; c.dst = (bf16*)(ws + WS_WMKV) + (size_t)(64 * nb) * DM + 64 * kb; return true; }
    r -= N_MK;
    { const int l = r / CVT_I_O1, q = r % CVT_I_O1, kb = q / 16, nb = q % 16; c.src = A.in[I_WO] + (size_t)l * DM * DM + (size_t)(64 * kb) * DM + 64 * nb; c.pitch = DM; c.dst = (bf16*)(ws + WS_WO) + ((size_t)l * DM + 64 * nb) * DM + 64 * kb; return true; }
}
__device__ __forceinline__ void cvt_decode_moe(const Args& A, int layer, int r, CvtItem& c) {
    unsigned char* ws = A.ws;
    if (r < NEXP * CVT_I_GU1) { const int le = layer * NEXP + r / CVT_I_GU1, q = r % CVT_I_GU1, kb = q / 32, nb = q % 32, col0 = 64 * nb;
        const int cc = col0 & 1023, drow0 = (cc >> 7) * 256 + (cc & 127) + ((col0 >= 1024) ? 128 : 0);
        c.src = A.in[I_WGU] + (size_t)le * DM * 2048 + (size_t)(64 * kb) * 2048 + col0; c.pitch = 2048; c.dst = (bf16*)(ws + WS_WGU) + ((size_t)le * 2048 + drow0) * DM + 64 * kb; return; }
    r -= NEXP * CVT_I_GU1;
    { const int le = layer * NEXP + r / CVT_I_DN1, q = r % CVT_I_DN1, kb = q / 16, nb = q % 16; c.src = A.in[I_WDN] + (size_t)le * DM * DM + (size_t)(64 * kb) * DM + 64 * nb; c.pitch = DM; c.dst = (bf16*)(ws + WS_WDN) + ((size_t)le * DM + 64 * nb) * DM + 64 * kb; }
}
__device__ __forceinline__ void cvt_load(const CvtItem& c, f32x4 (&v)[16], int lane) {
    const int a = lane >> 4, b4 = (lane & 15) * 4;
#pragma unroll
    for (int i = 0; i < 16; ++i) v[i] = __builtin_nontemporal_load((const f32x4*)(c.src + (size_t)(4 * i + a) * c.pitch + b4));
}
__device__ __forceinline__ void cvt_store(const CvtItem& c, const f32x4 (&v)[16], LAS float* scr, int lane) {
    const int a = lane >> 4, b4 = (lane & 15) * 4;
#pragma unroll
    for (int i = 0; i < 16; ++i) { LAS float* s = scr + (4 * i + a) * 65 + b4; s[0] = v[i].x; s[1] = v[i].y; s[2] = v[i].z; s[3] = v[i].w; }
    asm volatile("s_waitcnt lgkmcnt(0)" ::: "memory");
    const int cb = lane & 7;
#pragma unroll
    for (int j = 0; j < 8; ++j) {
        const int n = (lane >> 3) + 8 * j; const LAS float* s = scr + (8 * cb) * 65 + n;
        v4u o; o.x = pk2(s[0], s[65]); o.y = pk2(s[2 * 65], s[3 * 65]); o.z = pk2(s[4 * 65], s[5 * 65]); o.w = pk2(s[6 * 65], s[7 * 65]);
        *(v4u*)(c.dst + (size_t)n * DM + 8 * cb) = o;
    }
    asm volatile("s_waitcnt lgkmcnt(0)" ::: "memory");
}
__device__ __forceinline__ void cvt_moe_chunk(const Args& A, int layer, int chunk, LAS unsigned char* lds, int wid, int lane) {
    LAS float* scr = (LAS float*)(lds + wid * 16896);
    CvtItem c0, c1; f32x4 va[16], vb[16];
    const int r0 = chunk * CVT_CHUNK + wid * 4;
    cvt_decode_moe(A, layer, r0, c0); cvt_load(c0, va, lane);
    cvt_decode_moe(A, layer, r0 + 1, c1); cvt_load(c1, vb, lane);
    cvt_store(c0, va, scr, lane);
    cvt_decode_moe(A, layer, r0 + 2, c0); cvt_load(c0, va, lane);
    cvt_store(c1, vb, scr, lane);
    cvt_decode_moe(A, layer, r0 + 3, c1); cvt_load(c1, vb, lane);
    cvt_store(c0, va, scr, lane);
    cvt_store(c1, vb, scr, lane);
}
__device__ __forceinline__ void ph_convert(const Args& A, LAS unsigned char* lds, int wg, int G, int g_wid) {
    PH_IDS;
    unsigned char* ws = A.ws;
    LAS float* scr = (LAS float*)(lds + wid * 16896);
    const int gw = wg * NWAVES + wid, NGW = G * NWAVES;
    { CvtItem cur, nxt; f32x4 va[16], vb[16];
      bool okc = cvt_decode(A, gw, cur);
      if (okc) cvt_load(cur, va, lane);
      for (int it = gw; okc; it += 2 * NGW) {
          const bool okn = cvt_decode(A, it + NGW, nxt);
          if (okn) cvt_load(nxt, vb, lane);
          cvt_store(cur, va, scr, lane);
          if (!okn) break;
          okc = cvt_decode(A, it + 2 * NGW, cur);
          if (okc) cvt_load(cur, va, lane);
          cvt_store(nxt, vb, scr, lane);
      } }
    { const int gt = wg * NTHR + tid, NGT = G * NTHR;
      for (int i = gt; i < 2 * 16 * DM; i += NGT) { const int j = i / (16 * DM), hh = (i / DM) & 15, k = i % DM;
          const float v = hh < HS ? A.in[I_WIN_FOX][(size_t)j * DM * (NPROJ + HS) + (size_t)k * (NPROJ + HS) + NPROJ + hh] : 0.f;
          ((bf16*)(ws + WS_WFG))[i] = (bf16)f2bf(v); }
      { constexpr size_t NX = (size_t)NTOK * DM / 8; const f32x4* xs = (const f32x4*)A.in[I_X]; v4u* xd = (v4u*)(ws + WS_HB);
        size_t i = gt;
        for (; i + 3 * (size_t)NGT < NX; i += 4 * (size_t)NGT) {
            f32x4 a[4], b[4];
#pragma unroll
            for (int q = 0; q < 4; ++q) { a[q] = __builtin_nontemporal_load(xs + 2 * (i + q * (size_t)NGT)); b[q] = __builtin_nontemporal_load(xs + 2 * (i + q * (size_t)NGT) + 1); }
#pragma unroll
            for (int q = 0; q < 4; ++q) { v4u o; o.x = pk2(a[q].x, a[q].y); o.y = pk2(a[q].z, a[q].w); o.z = pk2(b[q].x, b[q].y); o.w = pk2(b[q].z, b[q].w); xd[i + q * (size_t)NGT] = o; } }
        for (; i < NX; i += NGT) { const f32x4 a = xs[2 * i], b = xs[2 * i + 1]; v4u o; o.x = pk2(a.x, a.y); o.y = pk2(a.z, a.w); o.z = pk2(b.x, b.y); o.w = pk2(b.z, b.w); xd[i] = o; } }
      for (size_t i = gt; i < (size_t)NB * NMEM * DM / 8; i += NGT) { const f32x4 a = ((const f32x4*)A.in[I_MEM])[2 * i], b = ((const f32x4*)A.in[I_MEM])[2 * i + 1];
          v4u o; o.x = pk2(a.x, a.y); o.y = pk2(a.z, a.w); o.z = pk2(b.x, b.y); o.w = pk2(b.z, b.w); ((v4u*)(ws + WS_MEMB))[i] = o; }
    }
}

__device__ __forceinline__ void glds16(const void* gsrc, unsigned lds_dst) { unsigned keep;
    asm volatile("s_mov_b32 %0, m0\n\ts_mov_b32 m0, %2\n\ts_nop 0\n\tglobal_load_lds_dwordx4 %1, off\n\ts_mov_b32 m0, %0" : "=&s"(keep) : "v"(gsrc), "s"(lds_dst) : "memory"); }
__device__ __forceinline__ void glds4(const void* gsrc, unsigned lds_dst) { unsigned keep;
    asm volatile("s_mov_b32 %0, m0\n\ts_mov_b32 m0, %2\n\ts_nop 0\n\tglobal_load_lds_dword %1, off\n\ts_mov_b32 m0, %0" : "=&s"(keep) : "v"(gsrc), "s"(lds_dst) : "memory"); }
struct Unit { int pm, pn, e, rows, pa; const bf16* B; const unsigned* list; const LAS unsigned char* ls; };
struct DenseSched {
    static constexpr bool GATHER = false, MOE = false;
    const bf16* A; const bf16* Bt; int nM, nN, G, c;
    __device__ __forceinline__ bool next(int i, Unit& u) const {
        if ((G & 7) == 0 && (nM & 7) == 0) { const int x = c & 7, l = i * (G >> 3) + (c >> 3); u.pm = (l / nN) * 8 + x; u.pn = l % nN; if (u.pm >= nM) return false; }
        else { const int L = i * G + c; if (L >= nM * nN) return false; u.pm = L / nN; u.pn = L % nN; }
        u.pa = u.pm; u.e = 0; u.rows = 256; u.B = Bt + (size_t)u.pn * 256 * DM; u.list = nullptr; return true; }
    __device__ __forceinline__ unsigned arow(const Unit& u, int r) const { return (unsigned)(u.pm * 256 + r); }
    __device__ __forceinline__ unsigned araw(const Unit& u, int r) const { return (unsigned)(u.pm * 256 + r); }
    __device__ __forceinline__ unsigned afin(unsigned x) const { return x; }
};
template <bool GATHER_>
struct MoeSchedT {
    static constexpr bool GATHER = GATHER_, MOE = true;
    const bf16* A; const bf16* Bt; const unsigned* elist; const LAS int* tab; int nN, ntot, G, c, shift;
    __device__ __forceinline__ bool next(int i, Unit& u) const {
        const int tot = __builtin_amdgcn_readfirstlane(tab[64 + 32]); int g;
        if ((G & 7) == 0) { const int x = c & 7, l = i * (G >> 3) + (c >> 3); g = (l / nN) * 8 + x; u.pn = l % nN; if (g >= tot) return false; }
        else { const int L = i * G + c; if (L >= tot * nN) return false; u.pn = L % nN; g = L / nN; }
        int ln; asm volatile("v_mbcnt_lo_u32_b32 %0, -1, 0\n\tv_mbcnt_hi_u32_b32 %0, -1, %0" : "=v"(ln));
        const int offv = tab[64 + (ln & 31)];
        const unsigned long long mk = __builtin_amdgcn_ballot_w64(ln < 32 && offv <= g);
        const int e = __builtin_popcountll(mk) - 1;
        u.e = e; u.pa = g; u.pm = g - __builtin_amdgcn_readfirstlane(tab[64 + e]); const int rem = __builtin_amdgcn_readfirstlane(tab[e]) - 256 * u.pm; u.rows = rem < 256 ? rem : 256;
        u.B = Bt + ((size_t)e * ntot + (size_t)u.pn * 256) * DM; u.list = elist + ((size_t)e * NTOK + 256 * u.pm) * 2; return true; }
    __device__ __forceinline__ unsigned arow(const Unit& u, int r) const { const unsigned rr = (unsigned)r < (unsigned)u.rows ? (unsigned)r : (unsigned)(u.rows - 1); return *(const unsigned*)((const char*)u.list + rr * 8u) >> shift; }
    __device__ __forceinline__ unsigned araw(const Unit& u, int r) const { const unsigned rr = (unsigned)r < (unsigned)u.rows ? (unsigned)r : (unsigned)(u.rows - 1); return *(const unsigned*)((const char*)u.list + rr * 8u); }
    __device__ __forceinline__ unsigned afin(unsigned x) const { return x >> shift; }
};
__device__ __forceinline__ void moe_tables(LAS int* tab, const unsigned* ecnt, int g_wid) {
    PH_IDS;
    if (tid == 0) { int acc = 0; for (int e = 0; e < 32; ++e) { const int c = (int)ecnt[e]; tab[e] = c; tab[64 + e] = acc; acc += (c + 255) >> 8; } tab[64 + 32] = acc; }
    __syncthreads();
}

template <bool NORMS, bool KSUM>
struct EpiProjT {   static constexpr int NSTAGE = 0; __device__ __forceinline__ const void* stage_src(const Unit&, int, int) const { return nullptr; }
    bf16* O; int ldc, q_end, qm_begin; unsigned* norm; float* ksum;
    __device__ __forceinline__ void operator()(const f32x4 (&acc)[2][2][4][2], const Unit& u, int wr, int wc, int fr, int fq) const {
        float nmax[2] = {0.f, 0.f};
#pragma unroll
        for (int ai = 0; ai < 2; ++ai) { float nsq[4][2];
#pragma unroll
            for (int m = 0; m < 4; ++m) { const int row = u.pm * 256 + ai * 128 + wr * 64 + m * 16 + fr;
#pragma unroll
                for (int bj = 0; bj < 2; ++bj) { const int col = u.pn * 256 + bj * 128 + wc * 32 + 8 * fq; const float sc = (col < q_end || col >= qm_begin) ? C2 : 1.f;
                    const f32x4 v0 = acc[ai][bj][m][0] * sc, v1 = acc[ai][bj][m][1] * sc;
                    if (NORMS) nsq[m][bj] = (v0.x * v0.x + v0.y * v0.y) + (v0.z * v0.z + v0.w * v0.w) + (v1.x * v1.x + v1.y * v1.y) + (v1.z * v1.z + v1.w * v1.w);
                    v4u w; w.x = pk2(v0.x, v0.y); w.y = pk2(v0.z, v0.w); w.z = pk2(v1.x, v1.y); w.w = pk2(v1.z, v1.w);
                    *(v4u*)((char*)O + (unsigned)(row * ldc + col) * 2u) = w; } }
            if (NORMS) { if (u.pn < 6) {
                const int ln_ = fq * 16 + fr;
#pragma unroll
                for (int st = 16; st <= 32; st <<= 1) { float t_[4][2];
#pragma unroll
                    for (int m = 0; m < 4; ++m)
#pragma unroll
                        for (int bj = 0; bj < 2; ++bj) t_[m][bj] = __builtin_bit_cast(float, __builtin_amdgcn_ds_bpermute((ln_ ^ st) << 2, __builtin_bit_cast(int, nsq[m][bj])));
#pragma unroll
                    for (int m = 0; m < 4; ++m)
#pragma unroll
                        for (int bj = 0; bj < 2; ++bj) nsq[m][bj] += t_[m][bj]; }
#pragma unroll
                for (int m = 0; m < 4; ++m)
#pragma unroll
                    for (int bj = 0; bj < 2; ++bj) nmax[bj] = fmaxf(nmax[bj], nsq[m][bj]); } } }
        if (NORMS) { if (u.pn < 6) {
            const int b = u.pm >> 5;
#pragma unroll
            for (int bj = 0; bj < 2; ++bj) { const float mx = wave_max(nmax[bj]); const int c = u.pn * 256 + bj * 128 + wc * 32; const int isk = c >= K_COL ? 1 : 0, cc = c - isk * K_COL;
                if (fr == 0 && fq == 0) __hip_atomic_fetch_max(norm + (((b * HS + (cc >> 6)) * 2 + ((cc >> 5) & 1)) * 2 + isk), __float_as_uint(mx), __ATOMIC_RELAXED, __HIP_MEMORY_SCOPE_AGENT); } } }
        if (KSUM) { if (u.pn >= 3 && u.pn < 6) {
            const int b = u.pm >> 5, jblk = u.pm & 31;
#pragma unroll
            for (int bj = 0; bj < 2; ++bj) { const int c = u.pn * 256 + bj * 128 + wc * 32 + 8 * fq - K_COL; float* dst = ksum + ((size_t)((b * HS + (c >> 6)) * 32 + jblk)) * 64 + (c & 63);
#pragma unroll
                for (int n = 0; n < 2; ++n) { f32x4 s = acc[0][bj][0][n];
#pragma unroll
                    for (int ai = 0; ai < 2; ++ai)
#pragma unroll
                        for (int m = 0; m < 4; ++m) if (ai + m) s += acc[ai][bj][m][n];
                    s.x = row16_sum(s.x); s.y = row16_sum(s.y); s.z = row16_sum(s.z); s.w = row16_sum(s.w);
                    if (fr == 0) { atomicAdd(dst + 4 * n, s.x); atomicAdd(dst + 4 * n + 1, s.y); atomicAdd(dst + 4 * n + 2, s.z); atomicAdd(dst + 4 * n + 3, s.w); } } } } }
    }
};
template <bool BASE_F32>
struct EpiOutT {    static constexpr int NSTAGE = 0; __device__ __forceinline__ const void* stage_src(const Unit&, int, int) const { return nullptr; }
    const void* base; bf16* out;
    __device__ __forceinline__ void operator()(const f32x4 (&acc)[2][2][4][2], const Unit& u, int wr, int wc, int fr, int fq) const {
#pragma unroll
        for (int ai = 0; ai < 2; ++ai) {
            f32x4 b0[4][2], b1[4][2];
#pragma unroll
            for (int m = 0; m < 4; ++m)
#pragma unroll
                for (int bj = 0; bj < 2; ++bj) { const unsigned eo = (unsigned)((u.pm * 256 + ai * 128 + wr * 64 + m * 16 + fr) * DM + u.pn * 256 + bj * 128 + wc * 32 + 8 * fq);
                    if (BASE_F32) { b0[m][bj] = *(const f32x4*)((const char*)base + eo * 4u); b1[m][bj] = *(const f32x4*)((const char*)base + eo * 4u + 16); }
                    else { const v4u w = *(const v4u*)((const char*)base + eo * 2u); b0[m][bj] = (f32x4){bflo(w.x), bfhi(w.x), bflo(w.y), bfhi(w.y)}; b1[m][bj] = (f32x4){bflo(w.z), bfhi(w.z), bflo(w.w), bfhi(w.w)}; } }
#pragma unroll
            for (int m = 0; m < 4; ++m)
#pragma unroll
                for (int bj = 0; bj < 2; ++bj) { const unsigned eo = (unsigned)((u.pm * 256 + ai * 128 + wr * 64 + m * 16 + fr) * DM + u.pn * 256 + bj * 128 + wc * 32 + 8 * fq);
                    const f32x4 o0 = b0[m][bj] * ALPHA + acc[ai][bj][m][0], o1 = b1[m][bj] * ALPHA + acc[ai][bj][m][1];
                    v4u w; w.x = pk2(o0.x, o0.y); w.y = pk2(o0.z, o0.w); w.z = pk2(o1.x, o1.y); w.w = pk2(o1.z, o1.w); *(v4u*)((char*)out + eo * 2u) = w; } }
    }
};
__device__ __forceinline__ float swiglu(float g, float uu) {
    g = fminf(g, SW_LIMIT); uu = fminf(fmaxf(uu, -SW_LIMIT), SW_LIMIT);
    const float sg = __builtin_amdgcn_rcpf(1.f + fexp2(-SW_ALPHA * LOG2E * g));
    return g * sg * (uu + 1.f);
}
__device__ __forceinline__ f32x2_t swiglu2(f32x2_t g, f32x2_t uu) {
    g = __builtin_elementwise_min(g, (f32x2_t){SW_LIMIT, SW_LIMIT}); uu = __builtin_elementwise_min(__builtin_elementwise_max(uu, (f32x2_t){-SW_LIMIT, -SW_LIMIT}), (f32x2_t){SW_LIMIT, SW_LIMIT});
    const f32x2_t z = g * (-SW_ALPHA * LOG2E); f32x2_t d; d.x = 1.f + fexp2(z.x); d.y = 1.f + fexp2(z.y);
    f32x2_t sg; sg.x = __builtin_amdgcn_rcpf(d.x); sg.y = __builtin_amdgcn_rcpf(d.y);
    return g * sg * (uu + 1.f);
}
struct EpiGU {
    static constexpr int NSTAGE = 1;
    bf16* abuf; const float* bgu;
    __device__ __forceinline__ const void* stage_src(const Unit& u, int, int lane) const { return bgu + (size_t)u.e * 2048 + (lane >= 32 ? 1024 : 0) + u.pn * 128 + (lane & 31) * 4; }
    __device__ __forceinline__ void operator()(const f32x4 (&acc)[2][2][4][2], const Unit& u, int wr, int wc, int fr, int fq) const { if (u.rows == 256) body<false>(acc, u, wr, wc, fr, fq); else body<true>(acc, u, wr, wc, fr, fq); }
    template <bool CHECK> __device__ __forceinline__ void body(const f32x4 (&acc)[2][2][4][2], const Unit& u, int wr, int wc, int fr, int fq) const {
        const int c0 = u.pn * 128 + wc * 32 + 8 * fq; const LAS float* bl = (const LAS float*)u.ls + wc * 32 + 8 * fq;
        const f32x4 g0 = *(const LAS f32x4*)bl, g1 = *(const LAS f32x4*)(bl + 4), u0 = *(const LAS f32x4*)(bl + 128), u1 = *(const LAS f32x4*)(bl + 132);
#pragma unroll
        for (int ai = 0; ai < 2; ++ai)
#pragma unroll
            for (int m = 0; m < 4; ++m) { const int r = ai * 128 + wr * 64 + m * 16 + fr;
                if (!CHECK || r < u.rows) {
                    const f32x4 ga = acc[ai][0][m][0] + g0, gb = acc[ai][0][m][1] + g1, ua = acc[ai][1][m][0] + u0, ub = acc[ai][1][m][1] + u1;
                    const f32x2_t s0 = swiglu2((f32x2_t){ga.x, ga.y}, (f32x2_t){ua.x, ua.y}), s1 = swiglu2((f32x2_t){ga.z, ga.w}, (f32x2_t){ua.z, ua.w});
                    const f32x2_t s2 = swiglu2((f32x2_t){gb.x, gb.y}, (f32x2_t){ub.x, ub.y}), s3 = swiglu2((f32x2_t){gb.z, gb.w}, (f32x2_t){ub.z, ub.w});
                    v4u w; w.x = pk2(s0.x, s0.y); w.y = pk2(s1.x, s1.y); w.z = pk2(s2.x, s2.y); w.w = pk2(s3.x, s3.y);
                    *(v4u*)((char*)abuf + ((unsigned)(u.pa * 256 + r) * (unsigned)DM + (unsigned)c0) * 2u) = w; } }
    }
};
constexpr float Y_SCALE = 16.f;
struct EpiDN {
    static constexpr int NSTAGE = 3;
    bf16* ybuf; const float* bdn;
    __device__ __forceinline__ const void* stage_src(const Unit& u, int p, int lane) const {
        return p == 0 ? (const void*)(bdn + (size_t)u.e * DM + u.pn * 256 + lane * 4) : (const void*)((const char*)u.list + (p - 1) * 1024 + lane * 16); }
    __device__ __forceinline__ void operator()(const f32x4 (&acc)[2][2][4][2], const Unit& u, int wr, int wc, int fr, int fq) const { if (u.rows == 256) body<false>(acc, u, wr, wc, fr, fq); else body<true>(acc, u, wr, wc, fr, fq); }
    template <bool CHECK> __device__ __forceinline__ void body(const f32x4 (&acc)[2][2][4][2], const Unit& u, int wr, int wc, int fr, int fq) const {
        f32x4 bv[2][2];
#pragma unroll
        for (int bj = 0; bj < 2; ++bj) { const LAS float* bp = (const LAS float*)u.ls + bj * 128 + wc * 32 + 8 * fq; bv[bj][0] = *(const LAS f32x4*)bp; bv[bj][1] = *(const LAS f32x4*)(bp + 4); }
#pragma unroll
        for (int ai = 0; ai < 2; ++ai)
#pragma unroll
            for (int m = 0; m < 4; ++m) { const int r = ai * 128 + wr * 64 + m * 16 + fr;
                if (!CHECK || r < u.rows) { const v2u ag = *(const LAS v2u*)(u.ls + 1024 + r * 8); const unsigned aid = ag.x; const float gt = __uint_as_float(ag.y);
#pragma unroll
                    for (int bj = 0; bj < 2; ++bj) { const float g16 = gt * Y_SCALE; f32x4 v0 = (acc[ai][bj][m][0] + bv[bj][0]) * g16, v1 = (acc[ai][bj][m][1] + bv[bj][1]) * g16;
                        v0.x = __builtin_amdgcn_fmed3f(v0.x, -448.f, 448.f); v0.y = __builtin_amdgcn_fmed3f(v0.y, -448.f, 448.f); v0.z = __builtin_amdgcn_fmed3f(v0.z, -448.f, 448.f); v0.w = __builtin_amdgcn_fmed3f(v0.w, -448.f, 448.f);
                        v1.x = __builtin_amdgcn_fmed3f(v1.x, -448.f, 448.f); v1.y = __builtin_amdgcn_fmed3f(v1.y, -448.f, 448.f); v1.z = __builtin_amdgcn_fmed3f(v1.z, -448.f, 448.f); v1.w = __builtin_amdgcn_fmed3f(v1.w, -448.f, 448.f);
                        int w0 = __builtin_amdgcn_cvt_pk_fp8_f32(v0.x, v0.y, 0, false); w0 = __builtin_amdgcn_cvt_pk_fp8_f32(v0.z, v0.w, w0, true);
                        int w1 = __builtin_amdgcn_cvt_pk_fp8_f32(v1.x, v1.y, 0, false); w1 = __builtin_amdgcn_cvt_pk_fp8_f32(v1.z, v1.w, w1, true);
                        *(v2u*)((char*)ybuf + (aid * (unsigned)DM + (unsigned)(u.pn * 256 + bj * 128 + wc * 32 + 8 * fq))) = (v2u){(unsigned)w0, (unsigned)w1}; } } }
    }
};
template <class Epi, class Sched>
__device__ __forceinline__ void gemm_simple(const Sched& S, const Epi& E, int g_wid) {
    PH_IDS;
    const int wr = wid >> 2, wc = wid & 3, fr = lane & 15, fq = lane >> 4;
    Unit u;
    for (int i = 0; S.next(i, u); ++i) {
        f32x4 acc[2][2][4][2];
#pragma unroll
        for (int a = 0; a < 2; ++a)
#pragma unroll
            for (int b = 0; b < 2; ++b)
#pragma unroll
                for (int m = 0; m < 4; ++m)
#pragma unroll
                    for (int n = 0; n < 2; ++n) acc[a][b][m][n] = (f32x4){0.f, 0.f, 0.f, 0.f};
        unsigned aoff[2][4], boff[2][2];
#pragma unroll
        for (int ai = 0; ai < 2; ++ai)
#pragma unroll
            for (int m = 0; m < 4; ++m) aoff[ai][m] = S.arow(u, ai * 128 + wr * 64 + m * 16 + fr) * DM + 8 * fq;
#pragma unroll
        for (int bj = 0; bj < 2; ++bj)
#pragma unroll
            for (int n = 0; n < 2; ++n) boff[bj][n] = (unsigned)(bj * 128 + wc * 32 + 8 * (fr >> 2) + 4 * n + (fr & 3)) * DM + 8 * fq;
#pragma unroll 1
        for (int k0 = 0; k0 < DM; k0 += 32) {
            bf16x8 b[2][2];
#pragma unroll
            for (int bj = 0; bj < 2; ++bj)
#pragma unroll
                for (int n = 0; n < 2; ++n) b[bj][n] = *(const bf16x8*)(u.B + boff[bj][n] + k0);
#pragma unroll
            for (int ai = 0; ai < 2; ++ai) {
                bf16x8 a[4];
#pragma unroll
                for (int m = 0; m < 4; ++m) a[m] = *(const bf16x8*)(S.A + aoff[ai][m] + k0);
#pragma unroll
                for (int bj = 0; bj < 2; ++bj)
#pragma unroll
                    for (int m = 0; m < 4; ++m)
#pragma unroll
                        for (int n = 0; n < 2; ++n) acc[ai][bj][m][n] = __builtin_amdgcn_mfma_f32_16x16x32_bf16(b[bj][n], a[m], acc[ai][bj][m][n], 0, 0, 0);
            }
        }
        E(acc, u, wr, wc, fr, fq);
    }
}


namespace pg8 {
constexpr int BM = 256, BK = 64, HALF = 128, HTB = HALF * BK * 2, STAGE_BYTES = 8 * HTB;
__device__ __forceinline__ int lds_byte(int r, int c) { const int st = (r >> 4) * 2 + (c >> 5), rr = r & 15, cc = c & 31, ob = rr * 64 + cc * 2; return st * 1024 + (ob ^ (((ob >> 9) & 1) << 5)); }
__device__ __forceinline__ void stage_rc(int b, int& R, int& C) { const int st = b / 1024, sb = b % 1024, swz = sb ^ (((sb >> 9) & 1) << 5); R = (st >> 1) * 16 + swz / 64; C = (st & 1) * 32 + (swz % 64) / 2; }
__device__ __forceinline__ int perm32(int rho) { const int n = rho >> 4, i = rho & 15; return 8 * (i >> 2) + 4 * n + (i & 3); }
}
template <class Epi, class Sched, bool ALIGN_EPI>
__device__ __forceinline__ void gemm_fast(LAS unsigned char* lds, const Sched& S, const Epi& E, int g_wid) {
    using namespace pg8;
    PH_IDS;
    const int wr = wid >> 2, wc = wid & 3, fr = lane & 15, fq = lane >> 4;
    constexpr int K = DM, nt = K / BK;
    int Rr[2], Cc[2]; unsigned voffB[2];
#pragma unroll
    for (int i = 0; i < 2; ++i) { int R, C; stage_rc(tid * 16 + i * 8192, R, C); Rr[i] = R; Cc[i] = C; const int Rb = (R & ~31) + perm32(R & 31); voffB[i] = (unsigned)(Rb * K + C) * 2u; }
    constexpr unsigned kstep = BK * 2, hstep = HALF * K * 2;
    const unsigned ldsw = (unsigned)wid * 1024u;
    const int aoff = lds_byte(wr * 64 + fr, fq * 8), boff = lds_byte(wc * 32 + fr, fq * 8);
    const char* Ab = (const char*)S.A;
#define PG8_SA(b, h) (((b) * 2 + (h)) * HTB)
#define PG8_SB(b, h) ((4 + (b) * 2 + (h)) * HTB)
#define PG8_STAGEB(bufoff, gbase) do { const char* _ub = (const char*)(gbase); asm volatile("" : "+s"(_ub)); _Pragma("unroll") for (int _i = 0; _i < 2; ++_i) \
        __builtin_amdgcn_global_load_lds((const unsigned*)(_ub + voffB[_i]), (LAS unsigned*)(lds + (bufoff) + ldsw + _i * 8192), 16, 0, 0); } while (0)
#define PG8_STAGEA(bufoff, kb, vo, sb) do { const char* _ub = (sb) + (size_t)(kb); asm volatile("" : "+s"(_ub)); _Pragma("unroll") for (int _i = 0; _i < 2; ++_i) \
        __builtin_amdgcn_global_load_lds((const unsigned*)(_ub + (vo)[_i]), (LAS unsigned*)(lds + (bufoff) + ldsw + _i * 8192), 16, 0, 0); } while (0)
#define PG8_VA(h) (Sched::GATHER ? vA[h] : laneA)
#define PG8_VN(h) (Sched::GATHER ? vN[h] : laneA)
#define PG8_BA(h) (Sched::GATHER ? Ab : cAb + (h) * hstep)
#define PG8_BN(h) (Sched::GATHER ? Ab : nAb + (h) * hstep)
#define PG8_LDA(dst, b, h) do { _Pragma("unroll") for (int m = 0; m < 4; ++m) _Pragma("unroll") for (int k = 0; k < 2; ++k) dst[m][k] = *(const LAS bf16x8*)(lds + PG8_SA(b, h) + aoff + m * 2048 + k * 1024); } while (0)
#define PG8_LDB(dst, b, h) do { _Pragma("unroll") for (int n = 0; n < 2; ++n) _Pragma("unroll") for (int k = 0; k < 2; ++k) dst[n][k] = *(const LAS bf16x8*)(lds + PG8_SB(b, h) + boff + n * 2048 + k * 1024); } while (0)
#define PG8_MMA(ai, bj, At, Bt) do { __builtin_amdgcn_s_setprio(1); _Pragma("unroll") for (int m = 0; m < 4; ++m) _Pragma("unroll") for (int n = 0; n < 2; ++n) _Pragma("unroll") for (int k = 0; k < 2; ++k) \
        acc[ai][bj][m][n] = __builtin_amdgcn_mfma_f32_16x16x32_bf16(Bt[n][k], At[m][k], acc[ai][bj][m][n], 0, 0, 0); __builtin_amdgcn_s_setprio(0); } while (0)
#define PG8_WAIT_V(n) asm volatile("s_waitcnt vmcnt(" #n ")" ::: "memory")
#define PG8_WAIT_L(n) asm volatile("s_waitcnt lgkmcnt(" #n ")" ::: "memory")
#define PG8_BAR __builtin_amdgcn_s_barrier()
#define PG8_SCHED __builtin_amdgcn_sched_barrier(0)
#define PG8_OFFS_RAW(dst, un) do { _Pragma("unroll") for (int _h = 0; _h < 2; ++_h) _Pragma("unroll") for (int _i = 0; _i < 2; ++_i) dst[_h][_i] = S.araw(un, _h * 128 + Rr[_i]); } while (0)
#define PG8_OFFS_FIN(dst, raw) do { _Pragma("unroll") for (int _h = 0; _h < 2; ++_h) _Pragma("unroll") for (int _i = 0; _i < 2; ++_i) dst[_h][_i] = (S.afin(raw[_h][_i]) * (unsigned)K + (unsigned)Cc[_i]) * 2u; } while (0)
#define PG8_OFFS(dst, un) do { _Pragma("unroll") for (int _h = 0; _h < 2; ++_h) _Pragma("unroll") for (int _i = 0; _i < 2; ++_i) dst[_h][_i] = (S.arow(un, _h * 128 + Rr[_i]) * (unsigned)K + (unsigned)Cc[_i]) * 2u; } while (0)
    Unit cur, nxt, nn; int ui = 0;
    if (!S.next(0, cur)) return;
    f32x4 acc[2][2][4][2];
#pragma unroll
    for (int a = 0; a < 2; ++a)
#pragma unroll
        for (int b = 0; b < 2; ++b)
#pragma unroll
            for (int m = 0; m < 4; ++m)
#pragma unroll
                for (int n = 0; n < 2; ++n) acc[a][b][m][n] = (f32x4){0.f, 0.f, 0.f, 0.f};
    bf16x8 At[4][2], B0[2][2], B1[2][2];
    unsigned vA[2][2], vN[2][2], laneA[2];
#pragma unroll
    for (int i = 0; i < 2; ++i) laneA[i] = (unsigned)(Rr[i] * K + Cc[i]) * 2u;
    if constexpr (Sched::GATHER) { PG8_OFFS(vA, cur); }
    const char* cAb = Ab + (size_t)cur.pa * (2 * hstep); const char* nAb = cAb;
    const char* cB = (const char*)cur.B;
#define PG8_KROT(un) (((Sched::GATHER || Sched::MOE ? 0 : (un).pa * 5) + (un).pn * 3) & (nt - 1))
    int kc = PG8_KROT(cur), kn = kc;
    { const unsigned o0_ = (unsigned)kc * kstep, o1_ = (unsigned)((kc + 1) & (nt - 1)) * kstep;
    PG8_STAGEB(PG8_SB(0, 0), cB + o0_); PG8_STAGEB(PG8_SB(0, 1), cB + hstep + o0_); PG8_STAGEA(PG8_SA(0, 0), o0_, PG8_VA(0), PG8_BA(0)); PG8_STAGEA(PG8_SA(0, 1), o0_, PG8_VA(1), PG8_BA(1));
    if (wr == 1) PG8_BAR;
    PG8_WAIT_V(2); PG8_BAR;
    PG8_STAGEB(PG8_SB(1, 0), cB + o1_); PG8_STAGEA(PG8_SA(1, 0), o1_, PG8_VA(0), PG8_BA(0)); PG8_STAGEB(PG8_SB(1, 1), cB + hstep + o1_);
    PG8_WAIT_V(6); PG8_BAR; }
    bool has_next = S.next(1, nxt);
    unsigned rawN[2][2] = {{0u, 0u}, {0u, 0u}};
    if constexpr (Sched::GATHER) { if (has_next) { PG8_OFFS_RAW(rawN, nxt); } }
    for (;;) {
        if constexpr (Epi::NSTAGE > 0) {
            cur.ls = lds + STAGE_BYTES + (ui & 1) * 4096;
            if (wid == 0) {
#pragma unroll
                for (int p = 0; p < Epi::NSTAGE; ++p) glds16(E.stage_src(cur, p, lane), (unsigned)__builtin_amdgcn_readfirstlane((unsigned)(uintptr_t)cur.ls + p * 1024)); } }
        if constexpr (Sched::GATHER) {
            if (has_next) { PG8_OFFS_FIN(vN, rawN); } else {
#pragma unroll
                for (int h = 0; h < 2; ++h)
#pragma unroll
                    for (int i = 0; i < 2; ++i) vN[h][i] = vA[h][i]; } }
        else nAb = has_next ? Ab + (size_t)nxt.pa * (2 * hstep) : cAb;
        const char* nB = has_next ? (const char*)nxt.B : cB;
        kn = has_next ? PG8_KROT(nxt) : kc;
#define PG8_KSTEP(LAST, t) do { \
            const unsigned kb1 = (unsigned)(((t) + 1 + kc) & (nt - 1)) * kstep, kb2 = (LAST) ? (unsigned)kn * kstep : (unsigned)(((t) + 2 + kc) & (nt - 1)) * kstep, kb3 = (LAST) ? (unsigned)((kn + 1) & (nt - 1)) * kstep : (unsigned)(((t) + 3 + kc) & (nt - 1)) * kstep; \
            const char* b2 = ((LAST) ? nB : cB) + kb2; const char* b3 = ((LAST) ? nB : cB) + kb3; \
            PG8_LDB(B0, 0, 0); PG8_LDB(B1, 0, 1); PG8_SCHED; PG8_LDA(At, 0, 0); PG8_STAGEA(PG8_SA(1, 1), kb1, PG8_VA(1), PG8_BA(1)); \
            PG8_WAIT_V(8); PG8_WAIT_L(0); PG8_BAR; PG8_MMA(0, 0, At, B0); PG8_MMA(0, 1, At, B1); PG8_BAR; PG8_SCHED; \
            PG8_LDA(At, 0, 1); PG8_STAGEB(PG8_SB(0, 0), b2); PG8_STAGEB(PG8_SB(0, 1), b2 + hstep); if (LAST) { PG8_STAGEA(PG8_SA(0, 0), kb2, PG8_VN(0), PG8_BN(0)); } else { PG8_STAGEA(PG8_SA(0, 0), kb2, PG8_VA(0), PG8_BA(0)); } \
            PG8_WAIT_V(8); PG8_WAIT_L(0); PG8_BAR; PG8_MMA(1, 0, At, B0); PG8_MMA(1, 1, At, B1); PG8_BAR; PG8_SCHED; \
            PG8_LDB(B0, 1, 0); PG8_LDB(B1, 1, 1); PG8_SCHED; PG8_LDA(At, 1, 0); if (LAST) { PG8_STAGEA(PG8_SA(0, 1), kb2, PG8_VN(1), PG8_BN(1)); } else { PG8_STAGEA(PG8_SA(0, 1), kb2, PG8_VA(1), PG8_BA(1)); } \
            PG8_WAIT_V(8); PG8_WAIT_L(0); PG8_BAR; PG8_MMA(0, 0, At, B0); PG8_MMA(0, 1, At, B1); PG8_BAR; PG8_SCHED; \
            PG8_LDA(At, 1, 1); PG8_STAGEB(PG8_SB(1, 0), b3); PG8_STAGEB(PG8_SB(1, 1), b3 + hstep); if (LAST) { PG8_STAGEA(PG8_SA(1, 0), kb3, PG8_VN(0), PG8_BN(0)); } else { PG8_STAGEA(PG8_SA(1, 0), kb3, PG8_VA(0), PG8_BA(0)); } \
            PG8_WAIT_V(8); PG8_WAIT_L(0); PG8_BAR; PG8_MMA(1, 0, At, B0); PG8_MMA(1, 1, At, B1); PG8_BAR; PG8_SCHED; } while (0)
        for (int t = 0; t < nt - 2; t += 2) PG8_KSTEP(false, t);
        PG8_KSTEP(true, nt - 2);
#undef PG8_KSTEP
        if constexpr (ALIGN_EPI) { if (wr == 0) PG8_BAR; }
        bool has_nn = false; unsigned rawNN[2][2] = {{0u, 0u}, {0u, 0u}};
        if (has_next) { has_nn = S.next(ui + 2, nn); if constexpr (Sched::GATHER) { if (has_nn) { PG8_OFFS_RAW(rawNN, nn); } } }
        { int fr_e = fr, fq_e = fq; asm volatile("" : "+v"(fr_e), "+v"(fq_e));
          E(acc, cur, wr, wc, fr_e, fq_e); }
        if (!has_next) break;
#pragma unroll
        for (int a = 0; a < 2; ++a)
#pragma unroll
            for (int b = 0; b < 2; ++b)
#pragma unroll
                for (int m = 0; m < 4; ++m)
#pragma unroll
                    for (int n = 0; n < 2; ++n) acc[a][b][m][n] = (f32x4){0.f, 0.f, 0.f, 0.f};
        cur = nxt; nxt = nn; has_next = has_nn; cB = nB; cAb = nAb; kc = kn; ++ui;
#pragma unroll
        for (int h = 0; h < 2; ++h)
#pragma unroll
            for (int i = 0; i < 2; ++i) rawN[h][i] = rawNN[h][i];
        if constexpr (Sched::GATHER) {
#pragma unroll
            for (int h = 0; h < 2; ++h)
#pragma unroll
                for (int i = 0; i < 2; ++i) vA[h][i] = vN[h][i]; }
        if constexpr (ALIGN_EPI) { if (wr == 1) PG8_BAR; }
    }
    PG8_WAIT_V(0);
    if constexpr (!ALIGN_EPI) { if (wr == 0) PG8_BAR; }
    PG8_BAR;
#undef PG8_SA
#undef PG8_SB
#undef PG8_STAGEA
#undef PG8_VA
#undef PG8_VN
#undef PG8_BA
#undef PG8_BN
#undef PG8_STAGEB
#undef PG8_LDA
#undef PG8_LDB
#undef PG8_MMA
#undef PG8_WAIT_V
#undef PG8_WAIT_L
#undef PG8_BAR
#undef PG8_SCHED
#undef PG8_OFFS
#undef PG8_KROT
#undef PG8_OFFS_RAW
#undef PG8_OFFS_FIN
}

__device__ __forceinline__ void ph_fox_gate(const Args& A, int j, int wg, int G, int g_wid) {
    PH_IDS;
    const bf16* hb = (const bf16*)(A.ws + WS_HB); const bf16* wfg = (const bf16*)(A.ws + WS_WFG) + (size_t)j * 16 * DM; float* lf = (float*)(A.ws + WS_LF);
    const float* bfg = A.in[I_BFG] + j * HS;
    const int gw = wg * NWAVES + wid, NGW = G * NWAVES;
    v4u wv[HS][2];
#pragma unroll
    for (int hh = 0; hh < HS; ++hh) { const v4u* wp = (const v4u*)(wfg + (size_t)hh * DM + 16 * lane); wv[hh][0] = wp[0]; wv[hh][1] = wp[1]; }
    v4u p0 = {0u, 0u, 0u, 0u}, p1 = {0u, 0u, 0u, 0u};
    if (gw < NTOK) { const v4u* hp = (const v4u*)(hb + (size_t)gw * DM + 16 * lane); p0 = hp[0]; p1 = hp[1]; }
    for (int n = gw; n < NTOK; n += NGW) {
        const v4u h0 = p0, h1 = p1;
        if (n + NGW < NTOK) { const v4u* hp = (const v4u*)(hb + (size_t)(n + NGW) * DM + 16 * lane); p0 = hp[0]; p1 = hp[1]; }
        float hv[16] = {bflo(h0.x), bfhi(h0.x), bflo(h0.y), bfhi(h0.y), bflo(h0.z), bfhi(h0.z), bflo(h0.w), bfhi(h0.w), bflo(h1.x), bfhi(h1.x), bflo(h1.y), bfhi(h1.y), bflo(h1.z), bfhi(h1.z), bflo(h1.w), bfhi(h1.w)};
        float mine = 0.f;
#pragma unroll
        for (int hh = 0; hh < HS; ++hh) {
            const v4u w0 = wv[hh][0], w1 = wv[hh][1];
            float s = hv[0] * bflo(w0.x) + hv[1] * bfhi(w0.x) + hv[2] * bflo(w0.y) + hv[3] * bfhi(w0.y) + hv[4] * bflo(w0.z) + hv[5] * bfhi(w0.z) + hv[6] * bflo(w0.w) + hv[7] * bfhi(w0.w)
                    + hv[8] * bflo(w1.x) + hv[9] * bfhi(w1.x) + hv[10] * bflo(w1.y) + hv[11] * bfhi(w1.y) + hv[12] * bflo(w1.z) + hv[13] * bfhi(w1.z) + hv[14] * bflo(w1.w) + hv[15] * bfhi(w1.w);
            s = wave_sum(s);
            if (lane == hh) mine = s;
        }
        if (lane < HS) { const float z = mine + bfg[lane];
            const float ls = fminf(z, 0.f) - __builtin_amdgcn_logf(1.f + fexp2(-fabsf(z) * LOG2E)) * 0.6931471805599453f;
            const int b = n >> 13, t = n & (SEQ - 1); lf[((size_t)(b * HS + lane)) * SEQ + t] = ls; }
    }
}
__device__ __forceinline__ void ph_fox_scan(const Args& A, LAS unsigned char* lds, int wg, int G, int g_wid) {
    PH_IDS;
    const float* lf = (const float*)(A.ws + WS_LF); float* c2 = (float*)(A.ws + WS_CFOX); LAS float* part = (LAS float*)lds;
    for (int s = wg; s < NB * HS; s += G) {
        const float* src = lf + (size_t)s * SEQ + tid * 16; float v[16]; float run = 0.f;
#pragma unroll
        for (int i = 0; i < 16; ++i) { run += src[i]; v[i] = run; }
        part[tid] = run; __syncthreads();
        if (tid == 0) { float acc = 0.f; for (int i = 0; i < NTHR; ++i) { const float x = part[i]; part[i] = acc; acc += x; } }
        __syncthreads();
        const float base = part[tid]; float* dst = c2 + (size_t)s * SEQ + tid * 16;
#pragma unroll
        for (int i = 0; i < 16; ++i) dst[i] = (base + v[i]) * LOG2E;
        __syncthreads();
    }
}
__device__ __forceinline__ void ph_kbar(const Args& A, LAS unsigned char* lds, int wg, int G, int g_wid) {
    PH_IDS;
    const bf16* proj = (const bf16*)(A.ws + WS_PROJ); float* kbar = (float*)(A.ws + WS_KBAR); LAS float* part = (LAS float*)lds;
    const int d = tid & 63, r8 = tid >> 6;
    for (int uidx = wg; uidx < NB * HS * 32; uidx += G) {
        const int j = uidx & 31, bh = uidx >> 5, b = bh / HS, h = bh % HS;
        const bf16* kp = proj + ((size_t)(b * SEQ + j * 256 + r8 * 32)) * NPROJ + K_COL + h * 64 + d;
        float s = 0.f;
        for (int r = 0; r < 32; ++r) s += __uint_as_float((unsigned)kp[(size_t)r * NPROJ] << 16);
        part[tid] = s; __syncthreads();
        if (tid < 64) { float t = 0.f;
#pragma unroll
            for (int q = 0; q < 8; ++q) t += part[q * 64 + tid];
            kbar[(size_t)uidx * 64 + tid] = t * (1.f / 256.f); ((bf16*)(A.ws + WS_KBAR + 512 * 1024))[(size_t)uidx * 64 + tid] = (bf16)f2bf(t * (1.f / 256.f)); }
        __syncthreads();
    }
}

__device__ __forceinline__ float alibi_slope(int h) { return h < 8 ? exp2f(-(float)(h + 1)) : exp2f(-(0.5f + (float)(h - 8))); }
#define ROW8(w, base, arr) do { arr[base + 0] = bflo(w.x); arr[base + 1] = bfhi(w.x); arr[base + 2] = bflo(w.y); arr[base + 3] = bfhi(w.y); arr[base + 4] = bflo(w.z); arr[base + 5] = bfhi(w.z); arr[base + 6] = bflo(w.w); arr[base + 7] = bfhi(w.w); } while (0)
__device__ __forceinline__ float dot_row64(const float (&q)[64], const bf16* p) {
    const v4u* p4 = (const v4u*)p; float s0 = 0.f, s1 = 0.f;
#pragma unroll
    for (int i = 0; i < 8; ++i) { if (i == 4) asm volatile("" ::: "memory"); const v4u w = p4[i];
        s0 += q[8 * i + 0] * bflo(w.x); s1 += q[8 * i + 1] * bfhi(w.x); s0 += q[8 * i + 2] * bflo(w.y); s1 += q[8 * i + 3] * bfhi(w.y);
        s0 += q[8 * i + 4] * bflo(w.z); s1 += q[8 * i + 5] * bfhi(w.z); s0 += q[8 * i + 6] * bflo(w.w); s1 += q[8 * i + 7] * bfhi(w.w); }
    return s0 + s1;
}
__device__ __forceinline__ void att_upd(float x, const bf16* vrow, float& m, float& l, float (&o)[64]) {
    const float mn = fmaxf(m, x), al = fexp2(m - mn), pp = fexp2(x - mn); m = mn; l = l * al + pp;
    const v4u* p4 = (const v4u*)vrow; asm volatile("" ::: "memory");
#pragma unroll
    for (int i = 0; i < 8; ++i) { if ((i & 1) == 0) asm volatile("" ::: "memory"); const v4u w = p4[i];
        o[8 * i + 0] = o[8 * i + 0] * al + pp * bflo(w.x); o[8 * i + 1] = o[8 * i + 1] * al + pp * bfhi(w.x); o[8 * i + 2] = o[8 * i + 2] * al + pp * bflo(w.y); o[8 * i + 3] = o[8 * i + 3] * al + pp * bfhi(w.y);
        o[8 * i + 4] = o[8 * i + 4] * al + pp * bflo(w.z); o[8 * i + 5] = o[8 * i + 5] * al + pp * bfhi(w.z); o[8 * i + 6] = o[8 * i + 6] * al + pp * bflo(w.w); o[8 * i + 7] = o[8 * i + 7] * al + pp * bfhi(w.w); }
}
template <int MODE, int H_LO = 0, int H_HI = 16>
__device__ __forceinline__ void ph_attn_naive(const Args& A, int wg, int G, int g_wid) {
    PH_IDS;
    const bf16* proj = (const bf16*)(A.ws + WS_PROJ); const bf16* mkv = (const bf16*)(A.ws + WS_MKV); bf16* att = (bf16*)(A.ws + WS_ATT);
    const float* kbar = (const float*)(A.ws + WS_KBAR); const float* cfox = (const float*)(A.ws + WS_CFOX);
    constexpr int NIT = 16 * (NTOK / 64);
    const int gw = wg * NWAVES + wid, NGW = G * NWAVES;
    for (int base = 0, rnd = 0; base < NIT; base += NGW, ++rnd) {
        const int it = base + ((rnd & 1) ? (NGW - 1 - gw) : gw);
        if (it >= NIT) continue;
        const int hh = it & 15, tg = it >> 4, n = tg * 64 + lane, b = n >> 13, t = n & (SEQ - 1);
        if (hh < H_LO || hh >= H_HI) continue;
        float q[64];
        { const v4u* p4 = (const v4u*)(proj + (size_t)n * NPROJ + (hh < HS ? hh * 64 : QM_COL + (hh - HS) * 64));
#pragma unroll
          for (int i = 0; i < 8; ++i) { const v4u w = p4[i]; ROW8(w, 8 * i, q); } }
        float m = -1e30f, l = 0.f; float o[64];
#pragma unroll
        for (int i = 0; i < 64; ++i) o[i] = 0.f;
        if (hh < HS) {
            const bf16* Kb = proj + (size_t)(b * SEQ) * NPROJ + K_COL + hh * 64; const bf16* Vb = Kb + (V_COL - K_COL);
            if (MODE == 0) {
                const float slope2 = alibi_slope(hh) * LOG2E; const int qb = t >> 8;
                const float* kb = kbar + (size_t)((b * HS + hh) * 32) * 64;
                float g0 = -INFINITY, g1 = -INFINITY, g2 = -INFINITY; int i0 = -1, i1 = -1, i2 = -1;
                for (int j = 0; j < qb; ++j) { float s0 = 0.f, s1 = 0.f;
#pragma unroll
                    for (int d = 0; d < 64; d += 2) { s0 += q[d] * kb[j * 64 + d]; s1 += q[d + 1] * kb[j * 64 + d + 1]; }
                    const float g = s0 + s1;
                    if (g > g0) { g2 = g1; i2 = i1; g1 = g0; i1 = i0; g0 = g; i0 = j; } else if (g > g1) { g2 = g1; i2 = i1; g1 = g; i1 = j; } else if (g > g2) { g2 = g; i2 = j; } }
                const int tend = (t | 63);
                for (int s = qb * 256; s <= tend; ++s) { if (s <= t) { const float x = dot_row64(q, Kb + (size_t)s * NPROJ) - slope2 * (float)(t - s); att_upd(x, Vb + (size_t)s * NPROJ, m, l, o); } }
                for (int sl = 0; sl < 3; ++sl) { const int jb = sl == 0 ? i0 : (sl == 1 ? i1 : i2);
                    if (jb >= 0) for (int s = 0; s < 256; ++s) { const int key = jb * 256 + s; const float x = dot_row64(q, Kb + (size_t)key * NPROJ) - slope2 * (float)(t - key); att_upd(x, Vb + (size_t)key * NPROJ, m, l, o); } }
            } else {
                const float* c2 = cfox + (size_t)(b * HS + hh) * SEQ; const float cq = c2[t]; const int tend = (t | 63);
                for (int s = 0; s <= tend; ++s) { if (s <= t) { const float x = dot_row64(q, Kb + (size_t)s * NPROJ) + (cq - c2[s]); att_upd(x, Vb + (size_t)s * NPROJ, m, l, o); } }
            }
        } else {
            const bf16* Kb = mkv + (size_t)(b * NMEM) * 512 + (hh - HS) * 64; const bf16* Vb = Kb + 256;
            for (int s = 0; s < NMEM; ++s) { const float x = dot_row64(q, Kb + (size_t)s * 512); att_upd(x, Vb + (size_t)s * 512, m, l, o); }
        }
        const float rl = 1.f / l; v4u* op = (v4u*)(att + (size_t)n * DM + hh * 64);
#pragma unroll
        for (int i = 0; i < 8; ++i) { v4u w; w.x = pk2(o[8 * i] * rl, o[8 * i + 1] * rl); w.y = pk2(o[8 * i + 2] * rl, o[8 * i + 3] * rl); w.z = pk2(o[8 * i + 4] * rl, o[8 * i + 5] * rl); w.w = pk2(o[8 * i + 6] * rl, o[8 * i + 7] * rl); op[i] = w; }
    }
}


__device__ __forceinline__ void ph_norms(const Args& A, int layer, LAS unsigned char* lds, int wg, int G, int g_wid) {
    PH_IDS;
    const bf16* proj = (const bf16*)(A.ws + WS_PROJ); unsigned* gn = (unsigned*)(A.ws + WS_CTL) + CW_NORM + layer * 128;
    LAS unsigned* ln = (LAS unsigned*)(lds + 65536);
    if (tid < 128) ln[tid] = 0u;
    __syncthreads();
    const int gt = wg * NTHR + tid, NGT = G * NTHR;
    for (int it = gt; it < NTOK * 4; it += NGT) {
        const int n = it >> 2, part = it & 3, b = n >> 13;
#pragma unroll
        for (int hq = 0; hq < 3; ++hq) { const int hh = part * 3 + hq;
#pragma unroll
            for (int kq = 0; kq < 2; ++kq) { const v4u* p4 = (const v4u*)(proj + (size_t)n * NPROJ + kq * K_COL + hh * 64); float s = 0.f;
#pragma unroll
                for (int i = 0; i < 8; ++i) { const v4u w = p4[i]; const float a0 = bflo(w.x), a1 = bfhi(w.x), a2 = bflo(w.y), a3 = bfhi(w.y), a4 = bflo(w.z), a5 = bfhi(w.z), a6 = bflo(w.w), a7 = bfhi(w.w);
                    s += (a0 * a0 + a1 * a1) + (a2 * a2 + a3 * a3) + (a4 * a4 + a5 * a5) + (a6 * a6 + a7 * a7); }
                atomicMax((unsigned*)ln + (b * HS + hh) * 2 + kq, __float_as_uint(s)); } }
    }
    __syncthreads();
    if (tid < 96) { const unsigned v = ln[tid]; if (v) __hip_atomic_fetch_max(gn + tid, v, __ATOMIC_RELAXED, __HIP_MEMORY_SCOPE_AGENT); }
    __syncthreads();
}

typedef float f32x16 __attribute__((ext_vector_type(16)));
typedef short s16x4 __attribute__((ext_vector_type(4)));
__device__ __forceinline__ int crow(int r, int hi) { return (r & 3) + 8 * (r >> 2) + 4 * hi; }
#define ATT_WAIT_BAR() asm volatile("s_waitcnt vmcnt(0) lgkmcnt(0)\n\ts_barrier" ::: "memory")
constexpr int ATT_K = 0, ATT_V = 16384, ATT_CK = 32768;
constexpr float ATT_THR = 8.0f, ATT_THETA = 45.0f;
__device__ __forceinline__ float max3f(float a, float b, float c) { float r; asm("v_max3_f32 %0, %1, %2, %3" : "=v"(r) : "v"(a), "v"(b), "v"(c)); return r; }
__device__ __forceinline__ float max2f(float a, float b) { float r; asm("v_max_f32_e32 %0, %1, %2" : "=v"(r) : "v"(a), "v"(b)); return r; }
__device__ __forceinline__ float swap_other(float v, int hi) { auto rr = __builtin_amdgcn_permlane32_swap(__float_as_uint(v), __float_as_uint(v), false, false); return __uint_as_float(hi ? rr[0] : rr[1]); }
__device__ __forceinline__ int swap_other_i(int v, int hi) { auto rr = __builtin_amdgcn_permlane32_swap((unsigned)v, (unsigned)v, false, false); return (int)(hi ? rr[0] : rr[1]); }

template <int MODE>
__device__ __forceinline__ void attn_unit(const Args& A, LAS unsigned char* lds, const int layer, const int b, const int h, const int qb, const int wid, const int lane) {
    const int r32 = lane & 31, hi = lane >> 5, q0 = qb * 256, wrow0 = q0 + wid * 32, trow = wrow0 + r32;
    const bf16* proj = (const bf16*)(A.ws + WS_PROJ);
    constexpr int pitch = (MODE == 2) ? 512 : NPROJ;
    const bf16* Kb = (MODE == 2) ? (const bf16*)(A.ws + WS_MKV) + (size_t)(b * NMEM) * 512 + h * 64 : proj + (size_t)(b * SEQ) * NPROJ + K_COL + h * 64;
    const bf16* Vb = (MODE == 2) ? Kb + 256 : Kb + (V_COL - K_COL);
    const bf16* Qrow = proj + (size_t)(b * SEQ + trow) * NPROJ + ((MODE == 2) ? QM_COL : 0) + h * 64;
    bf16x8 qr[4];
#pragma unroll
    for (int d0 = 0; d0 < 4; ++d0) qr[d0] = *(const bf16x8*)(Qrow + 16 * d0 + 8 * hi);
    const unsigned ldsb = (unsigned)(uintptr_t)lds;
    const bf16* ksrc = Kb + (size_t)lane * pitch + wid * 8;
    const bf16* vsrc = Vb + (size_t)(16 * (wid & 3) + (lane >> 2)) * pitch + (wid >> 2) * 32 + (lane & 3) * 8;
    float cq = 0.f, slope2 = 0.f; const float* c2 = nullptr;
    if (MODE == 1) { c2 = (const float*)(A.ws + WS_CFOX) + (size_t)(b * HS + h) * SEQ; cq = c2[trow]; }
    if (MODE == 0) { slope2 = alibi_slope(h) * LOG2E; cq = -slope2 * (float)(trow - q0); }
#define ATT_STAGE(kt, buf) do { glds16(ksrc + (size_t)(kt) * 64 * pitch, (unsigned)__builtin_amdgcn_readfirstlane(ldsb + ATT_K + (buf) * 8192 + wid * 1024)); \
        glds16(vsrc + (size_t)(kt) * 64 * pitch, (unsigned)__builtin_amdgcn_readfirstlane(ldsb + ATT_V + (buf) * 8192 + wid * 1024)); \
        if (MODE == 1 && wid == 0) glds4(c2 + (kt) * 64 + lane, (unsigned)__builtin_amdgcn_readfirstlane(ldsb + ATT_CK + (buf) * 256)); \
        if (MODE == 0 && wid == 0) ((LAS float*)(lds + ATT_CK + (buf) * 256))[lane] = -slope2 * (float)((kt) * 64 + lane - q0); } while (0)
    unsigned gnv[4] = {0u, 0u, 0u, 0u}; float cA = 0.f, cB = 0.f, cq0 = 0.f;
    if (MODE != 2) { const unsigned* gn = (const unsigned*)(A.ws + WS_CTL) + CW_NORM + layer * 256 + (b * HS + h) * 4; gnv[0] = gn[0]; gnv[1] = gn[1]; gnv[2] = gn[2]; gnv[3] = gn[3]; }
    const int ktA = 4 * qb - 1 - lane, ktB = ktA - 64;
    if (MODE == 1) { if (qb > 0) { cq0 = c2[q0]; if (ktA >= 0) cA = c2[64 * ktA + 63]; if (ktB >= 0) cB = c2[64 * ktB + 63]; } }
    f32x4 kv[4][2];
    if (MODE == 0) { if (qb > 0) { const float* kbp = (const float*)(A.ws + WS_KSUM) + (size_t)(layer >> 1) * (NB * HS * 32 * 64) + ((size_t)((b * HS + h) * 32 + r32)) * 64 + 8 * hi;
#pragma unroll
        for (int d0 = 0; d0 < 4; ++d0) { kv[d0][0] = *(const f32x4*)(kbp + 16 * d0); kv[d0][1] = *(const f32x4*)(kbp + 16 * d0 + 4); } } }
    ATT_STAGE((MODE == 2) ? 3 : 4 * qb + 3, 0);
    unsigned selmask = 0u;
    if (MODE == 0) { if (qb > 0) {
        f32x16 g;
#pragma unroll
        for (int i = 0; i < 16; ++i) g[i] = 0.f;
#pragma unroll
        for (int d0 = 0; d0 < 4; ++d0) { const f32x4 ka = kv[d0][0] * (1.f / 256.f), kc = kv[d0][1] * (1.f / 256.f);
            v4u kw; kw.x = pk2(ka.x, ka.y); kw.y = pk2(ka.z, ka.w); kw.z = pk2(kc.x, kc.y); kw.w = pk2(kc.z, kc.w);
            g = __builtin_amdgcn_mfma_f32_32x32x16_bf16(__builtin_bit_cast(bf16x8, kw), qr[d0], g, 0, 0, 0); }
#pragma unroll
        for (int i = 0; i < 16; ++i) if (crow(i, hi) >= qb) g[i] = -INFINITY;
#pragma unroll
        for (int pick = 0; pick < 3; ++pick) {
            float bv = -INFINITY; int bj = 64;
#pragma unroll
            for (int i = 0; i < 16; ++i) if (g[i] > bv) { bv = g[i]; bj = crow(i, hi); }
            const float pv = swap_other(bv, hi); const int pj = swap_other_i(bj, hi);
            if (pv > bv || (pv == bv && pj < bj)) { bv = pv; bj = pj; }
            if (bv > -INFINITY) { selmask |= 1u << bj;
#pragma unroll
                for (int i = 0; i < 16; ++i) if (crow(i, hi) == bj) g[i] = -INFINITY; }
        } } }
    float SKIP = -INFINITY, SKIPW = -INFINITY; int klo = 0;
    if (MODE != 2) {
        const float kmax2 = __uint_as_float(gnv[1]) + __uint_as_float(gnv[3]);
        const float Bq = sqrtf((__uint_as_float(gnv[0]) + __uint_as_float(gnv[2])) * kmax2); SKIP = -(ATT_THETA + 2.02f * Bq + 0.01f);
        float q2 = 0.f;
#pragma unroll
        for (int d0 = 0; d0 < 4; ++d0) { const v4u w = __builtin_bit_cast(v4u, qr[d0]); const float a0 = bflo(w.x), a1 = bfhi(w.x), a2 = bflo(w.y), a3 = bfhi(w.y), a4 = bflo(w.z), a5 = bfhi(w.z), a6 = bflo(w.w), a7 = bfhi(w.w);
            q2 += (a0 * a0 + a1 * a1) + (a2 * a2 + a3 * a3) + (a4 * a4 + a5 * a5) + (a6 * a6 + a7 * a7); }
        q2 += swap_other(q2, hi);
        SKIPW = -(ATT_THETA + 2.02f * sqrtf(wave_max(q2) * kmax2) + 0.01f); }
    if (MODE == 0) { if (qb > 0) { const float fl = ((float)(q0 - 63) + SKIP / slope2) * (1.f / 64.f); klo = fl <= 0.f ? 0 : (int)ceilf(fl); if (klo > 4 * qb) klo = 4 * qb; } }
    if (MODE == 1) { if (qb > 0) {
        const unsigned long long mkA = __builtin_amdgcn_ballot_w64(ktA >= 0 && (cq0 - cA) < SKIP);
        if (mkA) klo = 4 * qb - 1 - (int)__builtin_ctzll(mkA) + 1;
        else { const unsigned long long mkB = __builtin_amdgcn_ballot_w64(ktB >= 0 && (cq0 - cB) < SKIP); if (mkB) klo = 4 * qb - 1 - 64 - (int)__builtin_ctzll(mkB) + 1; } } }
    const float cw = __builtin_bit_cast(float, __builtin_amdgcn_readfirstlane(__builtin_bit_cast(int, cq)));
    const int ktop = (MODE == 2) ? 3 : 4 * qb + 3, ntile = ktop - klo + 1;
    float mhat = 0.f, lsum = 0.f; bool started = false;
    f32x16 o0, o1;
#pragma unroll
    for (int i = 0; i < 16; ++i) { o0[i] = 0.f; o1[i] = 0.f; }
    const LAS unsigned char* vp0 = lds + ATT_V + ((lane >> 4) & 1) * 32 + (lane & 3) * 8 + (4 * hi + ((lane & 15) >> 2)) * 64;
    for (int it = 0; it < ntile; ++it) {
        const int kt = ktop - it, buf = it & 1;
        ATT_WAIT_BAR();
        if (it + 1 < ntile) ATT_STAGE(kt - 1, buf ^ 1);
        bool active = true, diag = false, selv = true;
        if (MODE != 2) {
            if (kt * 64 > wrow0 + 31) active = false;
            diag = (kt * 64 + 63 > wrow0);
            if (MODE == 0) { const int j = kt >> 2; if (j < qb) { selv = ((selmask >> j) & 1u) != 0u; if (__builtin_amdgcn_ballot_w64(selv) == 0ull) active = false; } }
            if (active && kt * 64 + 63 < wrow0) {
                if (MODE == 0) { if (-slope2 * (float)(wrow0 - kt * 64 - 63) < SKIPW) active = false; }
                if (MODE == 1) { const float cke = __builtin_bit_cast(float, __builtin_amdgcn_readfirstlane(__builtin_bit_cast(int, ((const LAS float*)(lds + ATT_CK + buf * 256))[63]))); if (cw - cke < SKIPW) active = false; } }
        }
        if (active) {
            f32x16 p0, p1;
            const float bs = (MODE == 2) ? -mhat : (selv ? cq - mhat : -INFINITY);
            if (MODE == 2) {
#pragma unroll
                for (int r = 0; r < 16; ++r) { p0[r] = bs; p1[r] = bs; }
            } else {
                const LAS f32x4* ckp = (const LAS f32x4*)(lds + ATT_CK + buf * 256);
#pragma unroll
                for (int g = 0; g < 4; ++g) { const f32x4 c = ckp[2 * g + hi], d = ckp[8 + 2 * g + hi];
                    p0[4 * g] = bs - c.x; p0[4 * g + 1] = bs - c.y; p0[4 * g + 2] = bs - c.z; p0[4 * g + 3] = bs - c.w;
                    p1[4 * g] = bs - d.x; p1[4 * g + 1] = bs - d.y; p1[4 * g + 2] = bs - d.z; p1[4 * g + 3] = bs - d.w; }
            }
            const LAS unsigned char* kb = lds + ATT_K + buf * 8192 + hi * 1024 + r32 * 16;
#pragma unroll
            for (int d0 = 0; d0 < 4; ++d0) { const bf16x8 k0 = *(const LAS bf16x8*)(kb + d0 * 2048), k1 = *(const LAS bf16x8*)(kb + d0 * 2048 + 512);
                p0 = __builtin_amdgcn_mfma_f32_32x32x16_bf16(k0, qr[d0], p0, 0, 0, 0); p1 = __builtin_amdgcn_mfma_f32_32x32x16_bf16(k1, qr[d0], p1, 0, 0, 0); }
            asm volatile("s_nop 15\n\ts_nop 7" : "+v"(p0), "+v"(p1));
            if (diag) {
#pragma unroll
                for (int r = 0; r < 16; ++r) { const int kv = kt * 64 + crow(r, hi); if (kv > trow) p0[r] = -INFINITY; if (kv + 32 > trow) p1[r] = -INFINITY; }
            }
            float rm;
            { float a_ = max3f(p0[0], p0[1], p1[0]), b_ = max3f(p0[2], p0[3], p1[1]); a_ = max3f(a_, p1[2], p1[3]);
#pragma unroll
              for (int r = 4; r < 16; r += 4) { a_ = max3f(a_, p0[r], p0[r + 1]); b_ = max3f(b_, p0[r + 2], p0[r + 3]); a_ = max3f(a_, p1[r], p1[r + 1]); b_ = max3f(b_, p1[r + 2], p1[r + 3]); }
              rm = max2f(a_, b_); }
            rm = max2f(rm, swap_other(rm, hi));
            const bool need = started ? (__builtin_amdgcn_ballot_w64(rm > ATT_THR) != 0ull) : true;
            if (need) { const float dl = started ? fmaxf(rm, 0.f) : rm; mhat += dl;
#pragma unroll
                for (int r = 0; r < 16; ++r) { p0[r] -= dl; p1[r] -= dl; }
                if (started) { const float f = fexp2(-dl); lsum *= f;
#pragma unroll
                    for (int r = 0; r < 16; ++r) { o0[r] *= f; o1[r] *= f; } }
                started = true; }
            float s0 = 0.f, s1 = 0.f;
#pragma unroll
            for (int r = 0; r < 16; ++r) { p0[r] = fexp2(p0[r]); p1[r] = fexp2(p1[r]); s0 += p0[r]; s1 += p1[r]; }
            lsum += s0 + s1;
            bf16x8 pa[4];
#pragma unroll
            for (int ks = 0; ks < 4; ++ks) { v4u w;
                if (ks < 2) { w.x = pk2(p0[8 * ks], p0[8 * ks + 1]); w.y = pk2(p0[8 * ks + 2], p0[8 * ks + 3]); w.z = pk2(p0[8 * ks + 4], p0[8 * ks + 5]); w.w = pk2(p0[8 * ks + 6], p0[8 * ks + 7]); }
                else { const int k2 = ks - 2; w.x = pk2(p1[8 * k2], p1[8 * k2 + 1]); w.y = pk2(p1[8 * k2 + 2], p1[8 * k2 + 3]); w.z = pk2(p1[8 * k2 + 4], p1[8 * k2 + 5]); w.w = pk2(p1[8 * k2 + 6], p1[8 * k2 + 7]); }
                pa[ks] = __builtin_bit_cast(bf16x8, w); }
            const LAS unsigned char* vp = vp0 + buf * 8192;
#pragma unroll
            for (int ks = 0; ks < 4; ++ks) {
#pragma unroll
                for (int d0 = 0; d0 < 2; ++d0) {
                    const s16x4 lo = __builtin_bit_cast(s16x4, __builtin_amdgcn_ds_read_tr16_b64_v4i16((LAS s16x4*)(vp + d0 * 4096 + ks * 1024)));
                    const s16x4 hh = __builtin_bit_cast(s16x4, __builtin_amdgcn_ds_read_tr16_b64_v4i16((LAS s16x4*)(vp + d0 * 4096 + ks * 1024 + 512)));
                    const bf16x8 vf = (bf16x8){lo[0], lo[1], lo[2], lo[3], hh[0], hh[1], hh[2], hh[3]};
                    if (d0 == 0) o0 = __builtin_amdgcn_mfma_f32_32x32x16_bf16(vf, pa[ks], o0, 0, 0, 0); else o1 = __builtin_amdgcn_mfma_f32_32x32x16_bf16(vf, pa[ks], o1, 0, 0, 0); } }
        }
    }
    ATT_WAIT_BAR();
    lsum += swap_other(lsum, hi);
    const float rl = 1.f / lsum;
    bf16* Op = (bf16*)(A.ws + WS_ATT) + (size_t)(b * SEQ + trow) * DM + ((MODE == 2) ? HS * 64 : 0) + h * 64 + 4 * hi;
#pragma unroll
    for (int g = 0; g < 4; ++g) {
        v2u w0, w1; w0.x = pk2(o0[4 * g] * rl, o0[4 * g + 1] * rl); w0.y = pk2(o0[4 * g + 2] * rl, o0[4 * g + 3] * rl);
        w1.x = pk2(o1[4 * g] * rl, o1[4 * g + 1] * rl); w1.y = pk2(o1[4 * g + 2] * rl, o1[4 * g + 3] * rl);
        *(v2u*)(Op + 8 * g) = w0; *(v2u*)(Op + 32 + 8 * g) = w1; }
#undef ATT_STAGE
}
template <int MODE01>
__device__ __forceinline__ void ph_attn_fast(const Args& A, int layer, int rep, LAS unsigned char* lds, int wg, int G, int g_wid) {
    PH_IDS;
    constexpr int NSELF = NB * HS * 32, NU = NSELF + NB * HMEM * 32;
    unsigned* qh = (unsigned*)(A.ws + WS_CTL) + CW_AQ + layer * 64 + rep;
    volatile LAS int* qs = (volatile LAS int*)(lds + MISC_OFF) + 32;
    constexpr int NCH = CVT_N_MOE / CVT_CHUNK;
    unsigned* ch = qh + 16;
    if (tid == 0) { qs[0] = (int)__hip_atomic_fetch_add(qh, 1u, __ATOMIC_RELAXED, __HIP_MEMORY_SCOPE_AGENT); qs[1] = (rep == 0) ? (int)__hip_atomic_fetch_add(ch, 1u, __ATOMIC_RELAXED, __HIP_MEMORY_SCOPE_AGENT) : NCH; }
    __syncthreads();
    int L = __builtin_amdgcn_readfirstlane(qs[0]), C = __builtin_amdgcn_readfirstlane(qs[1]);
    __syncthreads();
    while (L < NU || C < NCH) {
        if (L < NU) {
            int nxt = 0;
            if (tid == 0) nxt = (int)__hip_atomic_fetch_add(qh, 1u, __ATOMIC_RELAXED, __HIP_MEMORY_SCOPE_AGENT);
            if (L < NSELF) { const int qb = 31 - L / (NB * HS), bh = L % (NB * HS); attn_unit<MODE01>(A, lds, layer, bh / HS, bh % HS, qb, wid, lane); }
            else { const int m = L - NSELF, qb = m & 31, bhm = m >> 5; attn_unit<2>(A, lds, layer, bhm >> 2, bhm & 3, qb, wid, lane); }
            if (tid == 0) qs[0] = nxt;
            __syncthreads();
            L = __builtin_amdgcn_readfirstlane(qs[0]);
            __syncthreads();
        }
        if (C < NCH) {
            int nxt = 0;
            if (tid == 0) nxt = (int)__hip_atomic_fetch_add(ch, 1u, __ATOMIC_RELAXED, __HIP_MEMORY_SCOPE_AGENT);
            cvt_moe_chunk(A, layer, C, lds, wid, lane);
            if (tid == 0) qs[1] = nxt;
            __syncthreads();
            C = __builtin_amdgcn_readfirstlane(qs[1]);
            __syncthreads();
        }
    }
}

__device__ __forceinline__ void ph_ln1_router(const Args& A, int layer, LAS unsigned char* lds, int wg, int G, int g_wid) {
    PH_IDS;
    bf16* hb = (bf16*)(A.ws + WS_HB); unsigned* elist = (unsigned*)(A.ws + WS_ELIST);
    unsigned* ecnt = (unsigned*)(A.ws + WS_CTL) + CW_ECNT + layer * 64;
    const float* rw = A.in[I_RW] + (size_t)layer * DM * NEXP; const float* rb = A.in[I_RB] + layer * NEXP;
    const float* g1 = A.in[I_LN1G] + layer * DM; const float* b1 = A.in[I_LN1B] + layer * DM;
    constexpr int RP = 1028;
    LAS float* rwT = (LAS float*)lds; LAS int* lcnt = (LAS int*)(lds + 32 * RP * 4); LAS int* gbase = lcnt + 32; LAS unsigned* rec = (LAS unsigned*)(lds + 32 * RP * 4 + 512);
    const int RPW = (NTOK + G - 1) / G;
    for (int i = tid; i < DM * NEXP; i += NTHR) rwT[(i & 31) * RP + (i >> 5)] = rw[i];
    if (tid < 32) lcnt[tid] = 0;
    __syncthreads();
    const int row0 = wg * RPW, row1 = (row0 + RPW < NTOK) ? row0 + RPW : NTOK;
    const float rbl = rb[lane & 31];
    v2u raw[4][4], rawn[4][4];
#define LN1_LOAD(nb_, R) do { _Pragma("unroll") for (int r = 0; r < 4; ++r) { const int n_ = ((nb_) + r < row1) ? (nb_) + r : row1 - 1; _Pragma("unroll") for (int j = 0; j < 4; ++j) R[r][j] = *(const v2u*)(hb + (size_t)n_ * DM + 4 * lane + 256 * j); } } while (0)
    if (row0 + wid * 4 < row1) LN1_LOAD(row0 + wid * 4, raw);
    for (int nb = row0 + wid * 4; nb < row1; nb += NWAVES * 4) {
        if (nb + NWAVES * 4 < row1) LN1_LOAD(nb + NWAVES * 4, rawn);
        f32x4 v[4][4];
#pragma unroll
        for (int r = 0; r < 4; ++r) { const int n = (nb + r < row1) ? nb + r : row1 - 1; float s = 0.f;
#pragma unroll
            for (int j = 0; j < 4; ++j) { const v2u w = raw[r][j]; v[r][j] = (f32x4){bflo(w.x), bfhi(w.x), bflo(w.y), bfhi(w.y)}; s += (v[r][j].x + v[r][j].y) + (v[r][j].z + v[r][j].w); }
            const float mean = wave_sum(s) * (1.f / DM); float s2 = 0.f;
#pragma unroll
            for (int j = 0; j < 4; ++j) { v[r][j] = v[r][j] - mean; s2 += (v[r][j].x * v[r][j].x + v[r][j].y * v[r][j].y) + (v[r][j].z * v[r][j].z + v[r][j].w * v[r][j].w); }
            const float rstd = 1.f / sqrtf(wave_sum(s2) * (1.f / DM) + LN_EPS);
#pragma unroll
            for (int j = 0; j < 4; ++j) { const f32x4 gg = *(const f32x4*)(g1 + 4 * lane + 256 * j), bb = *(const f32x4*)(b1 + 4 * lane + 256 * j);
                v[r][j] = v[r][j] * rstd * gg + bb;
                v2u w; w.x = pk2(v[r][j].x, v[r][j].y); w.y = pk2(v[r][j].z, v[r][j].w); *(v2u*)(hb + (size_t)n * DM + 4 * lane + 256 * j) = w; } }
        float mine[4] = {0.f, 0.f, 0.f, 0.f};
#pragma unroll
        for (int e = 0; e < 32; ++e) { f32x4 r4[4];
#pragma unroll
            for (int j = 0; j < 4; ++j) r4[j] = *(const LAS f32x4*)(rwT + e * RP + 4 * lane + 256 * j);
            float p[4];
#pragma unroll
            for (int r = 0; r < 4; ++r) { f32x2_t a2 = {0.f, 0.f};
#pragma unroll
                for (int j = 0; j < 4; ++j) { a2 += (f32x2_t){v[r][j].x, v[r][j].y} * (f32x2_t){r4[j].x, r4[j].y}; a2 += (f32x2_t){v[r][j].z, v[r][j].w} * (f32x2_t){r4[j].z, r4[j].w}; }
                p[r] = a2.x + a2.y; }
            wave_sum4(p);
#pragma unroll
            for (int r = 0; r < 4; ++r) mine[r] = (lane == e) ? p[r] : mine[r];
            asm volatile("" ::: "memory"); }
        { const float rbv = rbl;
#pragma unroll
          for (int r = 0; r < 4; ++r) mine[r] += rbv; }
#pragma unroll
        for (int r = 0; r < 4; ++r) { float x = (lane < 32) ? mine[r] : -INFINITY; float tv[4]; int ti[4];
#pragma unroll
            for (int k = 0; k < 4; ++k) { const float mx = wave_max(x); const unsigned long long mk = __builtin_amdgcn_ballot_w64(x == mx); const int idx = (int)__builtin_ctzll(mk);
                tv[k] = mx; ti[k] = idx; if (lane == idx) x = -INFINITY; }
            const float e1 = expf(tv[1] - tv[0]), e2 = expf(tv[2] - tv[0]), e3 = expf(tv[3] - tv[0]); const float inv = 1.f / (1.f + e1 + e2 + e3);
            if (lane < 4 && nb + r < row1) { const int ek = lane == 0 ? ti[0] : lane == 1 ? ti[1] : lane == 2 ? ti[2] : ti[3]; const float gk = (lane == 0 ? 1.f : lane == 1 ? e1 : lane == 2 ? e2 : e3) * inv;
                const int lp = atomicAdd((int*)lcnt + ek, 1);
                const int ri = (nb + r - row0) * 4 + lane; rec[2 * ri] = (unsigned)ek | ((unsigned)lp << 8); rec[2 * ri + 1] = __float_as_uint(gk); } }
#pragma unroll
        for (int r = 0; r < 4; ++r)
#pragma unroll
            for (int j = 0; j < 4; ++j) raw[r][j] = rawn[r][j];
    }
#undef LN1_LOAD
    __syncthreads();
    if (tid < 32) gbase[tid] = (int)__hip_atomic_fetch_add(ecnt + tid, (unsigned)lcnt[tid], __ATOMIC_RELAXED, __HIP_MEMORY_SCOPE_AGENT);
    __syncthreads();
    for (int ri = tid; ri < (row1 - row0) * 4; ri += NTHR) { const unsigned w = rec[2 * ri]; const int e = w & 31, lp = w >> 8; const unsigned aid = (unsigned)(row0 * 4 + ri);
        *(v2u*)(elist + ((size_t)e * NTOK + gbase[e] + lp) * 2) = (v2u){aid, rec[2 * ri + 1]}; }
    __syncthreads();
}

template <bool LAST>
__device__ __forceinline__ void ph_combine_ln2(const Args& A, int layer, int wg, int G, int g_wid) {
    PH_IDS;
    bf16* hb = (bf16*)(A.ws + WS_HB); const unsigned char* ybuf = (const unsigned char*)(A.ws + WS_YBUF);
    const float* g2 = A.in[I_LN2G] + layer * DM; const float* b2 = A.in[I_LN2B] + layer * DM;
    const int gw = wg * NWAVES + wid, NGW = G * NWAVES;
    f32x4 gv[4], bv[4];
#pragma unroll
    for (int j = 0; j < 2; ++j) { gv[2 * j] = *(const f32x4*)(g2 + 8 * lane + 512 * j); gv[2 * j + 1] = *(const f32x4*)(g2 + 8 * lane + 512 * j + 4); bv[2 * j] = *(const f32x4*)(b2 + 8 * lane + 512 * j); bv[2 * j + 1] = *(const f32x4*)(b2 + 8 * lane + 512 * j + 4); }
    v4u hw[2], hn[2]; v2u yw[4][2], yn[4][2];
#define CMB_LOAD(n_, H, Y) do { _Pragma("unroll") for (int j = 0; j < 2; ++j) H[j] = *(const v4u*)(hb + (size_t)(n_) * DM + 8 * lane + 512 * j); \
        _Pragma("unroll") for (int k = 0; k < 4; ++k) _Pragma("unroll") for (int j = 0; j < 2; ++j) Y[k][j] = *(const v2u*)(ybuf + ((size_t)(n_) * 4 + k) * DM + 8 * lane + 512 * j); } while (0)
    if (gw < NTOK) CMB_LOAD(gw, hw, yw);
    for (int n = gw; n < NTOK; n += NGW) {
        const int nn = n + NGW;
        if (nn < NTOK) CMB_LOAD(nn, hn, yn);
        float v[16]; float s = 0.f;
#pragma unroll
        for (int j = 0; j < 2; ++j) { const v4u w = hw[j];
            v[8 * j + 0] = bflo(w.x) * ALPHA; v[8 * j + 1] = bfhi(w.x) * ALPHA; v[8 * j + 2] = bflo(w.y) * ALPHA; v[8 * j + 3] = bfhi(w.y) * ALPHA;
            v[8 * j + 4] = bflo(w.z) * ALPHA; v[8 * j + 5] = bfhi(w.z) * ALPHA; v[8 * j + 6] = bflo(w.w) * ALPHA; v[8 * j + 7] = bfhi(w.w) * ALPHA; }
#pragma unroll
        for (int k = 0; k < 4; ++k)
#pragma unroll
            for (int j = 0; j < 2; ++j) { const v2u w = yw[k][j];
                const f32x2_t a = __builtin_amdgcn_cvt_pk_f32_fp8((int)w.x, false), b = __builtin_amdgcn_cvt_pk_f32_fp8((int)w.x, true), c = __builtin_amdgcn_cvt_pk_f32_fp8((int)w.y, false), d = __builtin_amdgcn_cvt_pk_f32_fp8((int)w.y, true);
                v[8 * j + 0] += a.x * (1.f / Y_SCALE); v[8 * j + 1] += a.y * (1.f / Y_SCALE); v[8 * j + 2] += b.x * (1.f / Y_SCALE); v[8 * j + 3] += b.y * (1.f / Y_SCALE);
                v[8 * j + 4] += c.x * (1.f / Y_SCALE); v[8 * j + 5] += c.y * (1.f / Y_SCALE); v[8 * j + 6] += d.x * (1.f / Y_SCALE); v[8 * j + 7] += d.y * (1.f / Y_SCALE); }
#pragma unroll
        for (int i = 0; i < 16; ++i) s += v[i];
        const float mean = wave_sum(s) * (1.f / DM); float s2 = 0.f;
#pragma unroll
        for (int i = 0; i < 16; ++i) { v[i] -= mean; s2 += v[i] * v[i]; }
        const float rstd = 1.f / sqrtf(wave_sum(s2) * (1.f / DM) + LN_EPS);
#pragma unroll
        for (int j = 0; j < 2; ++j) {
            const f32x4 oa = (f32x4){v[8 * j], v[8 * j + 1], v[8 * j + 2], v[8 * j + 3]} * rstd * gv[2 * j] + bv[2 * j], ob = (f32x4){v[8 * j + 4], v[8 * j + 5], v[8 * j + 6], v[8 * j + 7]} * rstd * gv[2 * j + 1] + bv[2 * j + 1];
            if (LAST) { float* o = A.out + (size_t)n * DM + 8 * lane + 512 * j; *(f32x4*)o = oa; *(f32x4*)(o + 4) = ob; }
            else { v4u w; w.x = pk2(oa.x, oa.y); w.y = pk2(oa.z, oa.w); w.z = pk2(ob.x, ob.y); w.w = pk2(ob.z, ob.w); *(v4u*)(hb + (size_t)n * DM + 8 * lane + 512 * j) = w; } }
#pragma unroll
        for (int j = 0; j < 2; ++j) hw[j] = hn[j];
#pragma unroll
        for (int k = 0; k < 4; ++k)
#pragma unroll
            for (int j = 0; j < 2; ++j) yw[k][j] = yn[k][j];
    }
#undef CMB_LOAD
}

#define IN(k) (lo <= (k) && (k) < hi)
#ifndef PROBE_BAR
#define PROBE_BAR 0
#endif
#define SEAM(k) do { if ((k) + 1 < hi) { xcd_barrier(bar); for (int pb_ = 0; pb_ < PROBE_BAR; ++pb_) xcd_barrier(bar); } } while (0)
#if PROBE_TIME
#define PT0(k) if ((k) == PROBE_TIME && xb_t0(wid0)) { volatile LAS unsigned* pm_ = (volatile LAS unsigned*)(lds + MISC_OFF) + 40; pm_[1] = (unsigned)__builtin_amdgcn_s_memrealtime(); }
#define PT1(k) if ((k) == PROBE_TIME && xb_t0(wid0)) { volatile LAS unsigned* pm_ = (volatile LAS unsigned*)(lds + MISC_OFF) + 40; pm_[0] = pm_[0] + ((unsigned)__builtin_amdgcn_s_memrealtime() - pm_[1]); }
#else
#define PT0(k)
#define PT1(k)
#endif
template <int layer>
__device__ __forceinline__ void run_layer(LAS unsigned char* lds, const int wg, const int G, const int wid0, const int lo, const int hi, const XcdBarrier& bar) {
        constexpr int pb = 1 + 8 * layer; constexpr bool fox = (layer & 1) != 0;
        if (IN(pb + 0)) { PT0(0)
            { const Args A = load_args(); unsigned char* ws = A.ws;
              DenseSched S{(const bf16*)(ws + WS_HB), (const bf16*)(ws + WS_WIN) + (size_t)layer * NPROJ * DM, NTOK / 256, NPROJ / 256, G, wg};
              EpiProjT<true, !fox> E{(bf16*)(ws + WS_PROJ), NPROJ, K_COL, QM_COL, (unsigned*)(ws + WS_CTL) + CW_NORM + layer * 256, (float*)(ws + WS_KSUM) + (size_t)(layer >> 1) * (NB * HS * 32 * 64)};
              gemm_fast<EpiProjT<true, !fox>, DenseSched, true>(lds, S, E, wid0); }
            if constexpr (layer == 0) { const Args A = load_args(); unsigned char* ws = A.ws;
              DenseSched S{(const bf16*)(ws + WS_MEMB), (const bf16*)(ws + WS_WMKV), NB * NMEM / 256, 2, G, wg};
              EpiProjT<false, false> E{(bf16*)(ws + WS_MKV), 512, 0, 1 << 30, nullptr, nullptr};
              gemm_fast<EpiProjT<false, false>, DenseSched, true>(lds, S, E, wid0); }
            if constexpr (fox) { const Args A = load_args(); ph_fox_gate(A, layer >> 1, wg, G, wid0); }
            SEAM(pb + 0); PT1(0)
        }
        if constexpr (fox) { if (IN(pb + 1)) { const Args A = load_args(); ph_fox_scan(A, lds, wg, G, wid0); SEAM(pb + 1); } }
        if (IN(pb + 2)) { PT0(2) const Args A = load_args(); for (int rep = 0; rep < PROBE_ATT; ++rep) ph_attn_fast<fox ? 1 : 0>(A, layer, rep, lds, wg, G, wid0); SEAM(pb + 2); PT1(2) }
        if (IN(pb + 3)) { PT0(3)
            const Args A = load_args(); unsigned char* ws = A.ws;
            DenseSched S{(const bf16*)(ws + WS_ATT), (const bf16*)(ws + WS_WO) + (size_t)layer * DM * DM, NTOK / 256, DM / 256, G, wg};
            EpiOutT<layer == 0> E{layer == 0 ? (const void*)A.in[I_X] : (const void*)(ws + WS_HB), (bf16*)(ws + WS_HB)};
            gemm_fast<EpiOutT<layer == 0>, DenseSched, true>(lds, S, E, wid0); SEAM(pb + 3); PT1(3)
        }
        if (IN(pb + 4)) { PT0(4) const Args A = load_args(); ph_ln1_router(A, layer, lds, wg, G, wid0); SEAM(pb + 4); PT1(4) }
        if (IN(pb + 5)) { PT0(5)
            const Args A = load_args(); unsigned char* ws = A.ws;
            LAS int* tab = (LAS int*)(lds + MISC_OFF) + 64; moe_tables(tab, (unsigned*)(ws + WS_CTL) + CW_ECNT + layer * 64, wid0);
            MoeSchedT<true> S{(const bf16*)(ws + WS_HB), (const bf16*)(ws + WS_WGU) + (size_t)layer * NEXP * 2048 * DM, (const unsigned*)(ws + WS_ELIST), tab, 8, 2048, G, wg, 2};
            EpiGU E{(bf16*)(ws + WS_ABUF), A.in[I_BGU] + (size_t)layer * NEXP * 2048};
            gemm_fast<EpiGU, MoeSchedT<true>, true>(lds, S, E, wid0); __syncthreads();
#if PROBE_MOE > 1
            gemm_fast<EpiGU, MoeSchedT<true>, true>(lds, S, E, wid0); __syncthreads();
#endif
            SEAM(pb + 5); PT1(5)
        }
        if (IN(pb + 6)) { PT0(6)
            const Args A = load_args(); unsigned char* ws = A.ws;
            LAS int* tab = (LAS int*)(lds + MISC_OFF) + 64; moe_tables(tab, (unsigned*)(ws + WS_CTL) + CW_ECNT + layer * 64, wid0);
            MoeSchedT<false> S{(const bf16*)(ws + WS_ABUF), (const bf16*)(ws + WS_WDN) + (size_t)layer * NEXP * DM * DM, (const unsigned*)(ws + WS_ELIST), tab, 4, 1024, G, wg, 0};
            EpiDN E{(bf16*)(ws + WS_YBUF), A.in[I_BDN] + (size_t)layer * NEXP * DM};
            gemm_fast<EpiDN, MoeSchedT<false>, true>(lds, S, E, wid0); __syncthreads();
#if PROBE_MOE > 1
            gemm_fast<EpiDN, MoeSchedT<false>, true>(lds, S, E, wid0); __syncthreads();
#endif
            SEAM(pb + 6); PT1(6)
        }
        if (IN(pb + 7)) { PT0(7) const Args A = load_args(); ph_combine_ln2<layer == DEPTH - 1>(A, layer, wg, G, wid0); SEAM(pb + 7); PT1(7) }
}
__global__ void __launch_bounds__(NTHR, 2) k_main(Args A0) {
    extern __shared__ __attribute__((aligned(16))) unsigned char lds_raw[];
    LAS unsigned char* lds = (LAS unsigned char*)lds_raw;
    volatile LAS unsigned* MISC = (volatile LAS unsigned*)(lds + MISC_OFF);
    const int wid0 = __builtin_amdgcn_readfirstlane((int)threadIdx.x >> 6);
    const int G = gridDim.x, wg = blockIdx.x;
    const int lo = A0.p_lo, hi = A0.p_hi;
    if (threadIdx.x < 64) MISC[threadIdx.x] = 0u;
    __syncthreads();
    XcdBarrier bar; bar.bar = (unsigned*)(A0.ws + WS_CTL) + CW_BAR; bar.x = 0; bar.st = nullptr; bar.wid = wid0;
    if (hi - lo > 1) bar = xcd_barrier_post((unsigned*)(A0.ws + WS_CTL) + CW_BAR + (size_t)lo * XCD_BAR_WORDS, MISC + 8, wid0);
    if (IN(0)) { const Args A = load_args(); for (int rep = 0; rep < PROBE_CVT; ++rep) ph_convert(A, lds, wg, G, wid0); SEAM(0); }
    run_layer<0>(lds, wg, G, wid0, lo, hi, bar); run_layer<1>(lds, wg, G, wid0, lo, hi, bar); run_layer<2>(lds, wg, G, wid0, lo, hi, bar); run_layer<3>(lds, wg, G, wid0, lo, hi, bar);
#if PROBE_TIME
    { const Args A = load_args(); unsigned* pw = (unsigned*)(A.ws + WS_CTL) + 3000; volatile LAS unsigned* pm_ = (volatile LAS unsigned*)(lds + MISC_OFF) + 40;
      if (blockIdx.x == 0 && xb_t0(wid0)) __hip_atomic_store(pw, pm_[0], __ATOMIC_RELAXED, __HIP_MEMORY_SCOPE_AGENT);
      xcd_barrier(bar);
      const float us = (float)__hip_atomic_load(pw, __ATOMIC_RELAXED, __HIP_MEMORY_SCOPE_AGENT) * 0.01f; const float v = log2f(us + 1.f) * 0.25f;
      { int ln_; asm volatile("v_mbcnt_lo_u32_b32 %0, -1, 0\n\tv_mbcnt_hi_u32_b32 %0, -1, %0" : "=v"(ln_)); for (size_t i = (size_t)blockIdx.x * NTHR + wid0 * 64 + ln_; i < (size_t)NTOK * DM; i += (size_t)gridDim.x * NTHR) A.out[i] = v; } }
#endif
#undef IN
#undef SEAM
}

#ifndef MK_ONE_LAUNCH
#define MK_ONE_LAUNCH 1
#endif
extern "C" void kernel_launch(void* const* d_in, const int* in_sizes, int n_in, void* d_out, int out_size, void* d_ws, size_t ws_size, hipStream_t stream) {
    static int grid = 0;
    if (grid == 0) {
        if (n_in != 17 || out_size != NTOK * DM || ws_size < WS_END) { fprintf(stderr, "kernel_launch: unexpected shapes (n_in %d out %d ws %zu, need %zu)\n", n_in, out_size, ws_size, (size_t)WS_END); grid = -1; return; }
        int dev = 0, cus = 0, per_cu = 0;
        if (hipGetDevice(&dev) != hipSuccess || hipDeviceGetAttribute(&cus, hipDeviceAttributeMultiprocessorCount, dev) != hipSuccess) { grid = -1; return; }
        if (hipFuncSetAttribute((const void*)k_main, hipFuncAttributeMaxDynamicSharedMemorySize, LDS_BYTES) != hipSuccess) { fprintf(stderr, "kernel_launch: hipFuncSetAttribute failed\n"); grid = -1; return; }
        if (hipOccupancyMaxActiveBlocksPerMultiprocessor(&per_cu, (const void*)k_main, NTHR, LDS_BYTES) != hipSuccess || per_cu < 1) { fprintf(stderr, "kernel_launch: occupancy query says %d\n", per_cu); }
        (void)hipGetLastError();
        grid = cus;
    }
    if (grid < 0) return;
    (void)hipMemsetAsync((char*)d_ws + WS_CTL, 0, CTL_ZERO_BYTES, stream);
    Args a{};
    for (int i = 0; i < 17; ++i) a.in[i] = (const float*)d_in[i];
    a.out = (float*)d_out; a.ws = (unsigned char*)d_ws;
#if MK_ONE_LAUNCH
    a.p_lo = 0; a.p_hi = NPHASE;
    hipLaunchKernelGGL(k_main, dim3(grid), dim3(NTHR), LDS_BYTES, stream, a);
#else
    for (int p = 0; p < NPHASE; ++p) { a.p_lo = p; a.p_hi = p + 1; hipLaunchKernelGGL(k_main, dim3(grid), dim3(NTHR), LDS_BYTES, stream, a); }
#endif
}
```

```cpp
#include <hip/hip_runtime.h>
#include <cstdio>
#include <cstdint>
#ifndef PROBE_ATT
#define PROBE_ATT 1
#endif
#ifndef PROBE_MOE
#define PROBE_MOE 1
#endif
#ifndef PROBE_CVT
#define PROBE_CVT 1
#endif
#ifndef PROBE_TIME
#define PROBE_TIME 0
#endif
#ifndef PROBE_INP
#define PROBE_INP 1
#endif

#define GAS __attribute__((address_space(1)))
#define LAS __attribute__((address_space(3)))
typedef unsigned short bf16;
typedef unsigned v4u __attribute__((ext_vector_type(4)));
typedef unsigned v2u __attribute__((ext_vector_type(2)));
typedef float f32x4 __attribute__((ext_vector_type(4)));
typedef short bf16x8 __attribute__((ext_vector_type(8)));

constexpr int NB = 4, SEQ = 8192, DM = 1024, NTOK = NB * SEQ;
constexpr int HS = 12, HMEM = 4, HD = 64, NMEM = 256, NPROJ = 2560, QM_COL = 2304, K_COL = 768, V_COL = 1536;
constexpr int NEXP = 32, TOPK = 4, DEPTH = 4, NASSIGN = NTOK * TOPK, DFF = 1024;
constexpr float ALPHA = 1.6817928305074290f, LN_EPS = 1e-5f, LOG2E = 1.4426950408889634f, C2 = 0.125f * 1.4426950408889634f;
constexpr float SW_LIMIT = 7.0f, SW_ALPHA = 1.702f;
constexpr int NWAVES = 8, NTHR = 512;

constexpr size_t MiB = 1u << 20;
constexpr size_t WS_CTL = 0, CTL_ZERO_BYTES = 2 * MiB;
constexpr size_t WS_KSUM = 1 * MiB;
constexpr size_t WS_WIN = 2 * MiB;
constexpr size_t WS_WFG = WS_WIN + (size_t)4 * NPROJ * DM * 2;
constexpr size_t WS_WMKV = WS_WFG + 1 * MiB;
constexpr size_t WS_WO = WS_WMKV + 1 * MiB;
constexpr size_t WS_WGU = WS_WO + 8 * MiB;
constexpr size_t WS_WDN = WS_WGU + 512 * MiB;
constexpr size_t WS_HB = WS_WDN + 256 * MiB;
constexpr size_t WS_MEMB = WS_HB + 64 * MiB;
constexpr size_t WS_MKV = WS_MEMB + 2 * MiB;
constexpr size_t WS_PROJ = WS_MKV + 1 * MiB;
constexpr size_t WS_CFOX = WS_PROJ + 160 * MiB;
constexpr size_t WS_LF = WS_CFOX + 2 * MiB;
constexpr size_t WS_KBAR = WS_LF + 2 * MiB;
constexpr size_t WS_ATT = WS_KBAR + 1 * MiB;
constexpr size_t WS_ELIST = WS_ATT + 64 * MiB;
constexpr size_t WS_AGATE = WS_ELIST + 8 * MiB;
constexpr size_t WS_ABUF = WS_AGATE + 1 * MiB;
constexpr size_t WS_YBUF = WS_ABUF + 288 * MiB;
constexpr size_t WS_END = WS_YBUF + 256 * MiB;

constexpr int CW_ECNT = 1024;
constexpr int CW_NORM = 1536;
constexpr int CW_AQ = 2560;
constexpr int CW_BAR = 4096;
constexpr int NPHASE = 1 + 8 * DEPTH;

constexpr int LDS_BYTES = 147456, SCR_BYTES = 146432, MISC_OFF = SCR_BYTES;

__device__ __forceinline__ unsigned f2bf(float f) { unsigned u = __float_as_uint(f); return (u + 0x7fffu + ((u >> 16) & 1u)) >> 16; }
typedef float f32x2_t __attribute__((ext_vector_type(2))); typedef __bf16 bf16x2_t __attribute__((ext_vector_type(2)));
__device__ __forceinline__ unsigned pk2(float lo, float hi) { const f32x2_t v = {lo, hi}; const bf16x2_t b = __builtin_convertvector(v, bf16x2_t); return __builtin_bit_cast(unsigned, b); }
__device__ __forceinline__ float bflo(unsigned w) { return __uint_as_float(w << 16); }
__device__ __forceinline__ float bfhi(unsigned w) { return __uint_as_float(w & 0xffff0000u); }
__device__ __forceinline__ float wave_sum(float v) {
    v += __builtin_bit_cast(float, __builtin_amdgcn_update_dpp(0, __builtin_bit_cast(int, v), 0xB1, 0xF, 0xF, false));
    v += __builtin_bit_cast(float, __builtin_amdgcn_update_dpp(0, __builtin_bit_cast(int, v), 0x4E, 0xF, 0xF, false));
    v += __builtin_bit_cast(float, __builtin_amdgcn_update_dpp(0, __builtin_bit_cast(int, v), 0x141, 0xF, 0xF, false));
    v += __builtin_bit_cast(float, __builtin_amdgcn_update_dpp(0, __builtin_bit_cast(int, v), 0x140, 0xF, 0xF, false));
    v += __builtin_bit_cast(float, __builtin_amdgcn_update_dpp(0, __builtin_bit_cast(int, v), 0x142, 0xA, 0xF, false));
    v += __builtin_bit_cast(float, __builtin_amdgcn_update_dpp(0, __builtin_bit_cast(int, v), 0x143, 0xC, 0xF, false));
    return __builtin_bit_cast(float, __builtin_amdgcn_readlane(__builtin_bit_cast(int, v), 63));
}
__device__ __forceinline__ void wave_sum4(float (&v)[4]) {
#define WS4_STEP(ctrl, rm) do { float t_[4]; _Pragma("unroll") for (int i_ = 0; i_ < 4; ++i_) t_[i_] = __builtin_bit_cast(float, __builtin_amdgcn_update_dpp(0, __builtin_bit_cast(int, v[i_]), ctrl, rm, 0xF, false)); \
        _Pragma("unroll") for (int i_ = 0; i_ < 4; ++i_) v[i_] += t_[i_]; } while (0)
    WS4_STEP(0xB1, 0xF); WS4_STEP(0x4E, 0xF); WS4_STEP(0x141, 0xF); WS4_STEP(0x140, 0xF); WS4_STEP(0x142, 0xA); WS4_STEP(0x143, 0xC);
#undef WS4_STEP
#pragma unroll
    for (int i = 0; i < 4; ++i) v[i] = __builtin_bit_cast(float, __builtin_amdgcn_readlane(__builtin_bit_cast(int, v[i]), 63));
}
__device__ __forceinline__ void wave_max4(float (&v)[4]) {
#define WM4_STEP(ctrl, rm) do { float t_[4]; _Pragma("unroll") for (int i_ = 0; i_ < 4; ++i_) t_[i_] = __builtin_bit_cast(float, __builtin_amdgcn_update_dpp(__builtin_bit_cast(int, v[i_]), __builtin_bit_cast(int, v[i_]), ctrl, rm, 0xF, false)); \
        _Pragma("unroll") for (int i_ = 0; i_ < 4; ++i_) v[i_] = fmaxf(v[i_], t_[i_]); } while (0)
    WM4_STEP(0xB1, 0xF); WM4_STEP(0x4E, 0xF); WM4_STEP(0x141, 0xF); WM4_STEP(0x140, 0xF); WM4_STEP(0x142, 0xA); WM4_STEP(0x143, 0xC);
#undef WM4_STEP
#pragma unroll
    for (int i = 0; i < 4; ++i) v[i] = __builtin_bit_cast(float, __builtin_amdgcn_readlane(__builtin_bit_cast(int, v[i]), 63));
}
__device__ __forceinline__ float row16_max(float v) {
    v = fmaxf(v, __builtin_bit_cast(float, __builtin_amdgcn_update_dpp(__builtin_bit_cast(int, v), __builtin_bit_cast(int, v), 0xB1, 0xF, 0xF, false)));
    v = fmaxf(v, __builtin_bit_cast(float, __builtin_amdgcn_update_dpp(__builtin_bit_cast(int, v), __builtin_bit_cast(int, v), 0x4E, 0xF, 0xF, false)));
    v = fmaxf(v, __builtin_bit_cast(float, __builtin_amdgcn_update_dpp(__builtin_bit_cast(int, v), __builtin_bit_cast(int, v), 0x141, 0xF, 0xF, false)));
    v = fmaxf(v, __builtin_bit_cast(float, __builtin_amdgcn_update_dpp(__builtin_bit_cast(int, v), __builtin_bit_cast(int, v), 0x140, 0xF, 0xF, false)));
    return v;
}
__device__ __forceinline__ float row16_sum(float v) {
    v += __builtin_bit_cast(float, __builtin_amdgcn_update_dpp(0, __builtin_bit_cast(int, v), 0xB1, 0xF, 0xF, false));
    v += __builtin_bit_cast(float, __builtin_amdgcn_update_dpp(0, __builtin_bit_cast(int, v), 0x4E, 0xF, 0xF, false));
    v += __builtin_bit_cast(float, __builtin_amdgcn_update_dpp(0, __builtin_bit_cast(int, v), 0x141, 0xF, 0xF, false));
    v += __builtin_bit_cast(float, __builtin_amdgcn_update_dpp(0, __builtin_bit_cast(int, v), 0x140, 0xF, 0xF, false));
    return v;
}
__device__ __forceinline__ float wave_max(float v) {
    v = row16_max(v);
    v = fmaxf(v, __builtin_bit_cast(float, __builtin_amdgcn_update_dpp(__builtin_bit_cast(int, v), __builtin_bit_cast(int, v), 0x142, 0xA, 0xF, false)));
    v = fmaxf(v, __builtin_bit_cast(float, __builtin_amdgcn_update_dpp(__builtin_bit_cast(int, v), __builtin_bit_cast(int, v), 0x143, 0xC, 0xF, false)));
    return __builtin_bit_cast(float, __builtin_amdgcn_readlane(__builtin_bit_cast(int, v), 63));
}
__device__ __forceinline__ float fexp2(float x) { return __builtin_amdgcn_exp2f(x); }
#define PH_IDS int lane; asm volatile("v_mbcnt_lo_u32_b32 %0, -1, 0\n\tv_mbcnt_hi_u32_b32 %0, -1, %0" : "=v"(lane)); const int wid = __builtin_amdgcn_readfirstlane(g_wid); const int tid = wid * 64 + lane; (void)tid

#define XB_TMO      128
#define XB_XCNT(j)  (256  + 64 * (j))
#define XB_XSUB(j)  (1280 + 64 * (j))
#define XB_XGEN(j)  (2304 + 64 * (j))
#define XB_TOP      3328
#define XB_TOPGEN   3392
#define XCD_BAR_WORDS 3456
#define XB_SPIN_CAP (1u << 22)
__device__ __forceinline__ unsigned xb_ld(unsigned* p)              { return __hip_atomic_load(p, __ATOMIC_RELAXED, __HIP_MEMORY_SCOPE_AGENT); }
__device__ __forceinline__ unsigned xb_add(unsigned* p, unsigned v) { return __hip_atomic_fetch_add(p, v, __ATOMIC_RELAXED, __HIP_MEMORY_SCOPE_AGENT); }
__device__ __forceinline__ unsigned xb_xcc_id() { return (unsigned)__builtin_amdgcn_s_getreg((3 << 11) | 20) & 0xFu; }
#define XB_SPIN(cond, bar) do { unsigned _sp = 0; while (cond) { __builtin_amdgcn_s_sleep(1); \
    if ((++_sp & 255u) == 0u) { if (xb_ld(&(bar)[XB_TMO])) break; if (_sp > XB_SPIN_CAP) { atomicAdd(&(bar)[XB_TMO], 1u); break; } } } } while (0)
struct XcdBarrier { unsigned* bar; unsigned x; volatile LAS unsigned* st; int wid; };
__device__ __forceinline__ bool xb_t0(int w) { int l; asm volatile("v_mbcnt_lo_u32_b32 %0, -1, 0\n\tv_mbcnt_hi_u32_b32 %0, -1, %0" : "=v"(l)); return w == 0 && l == 0; }
#define XB_T0(w) xb_t0(w)
__device__ __forceinline__ XcdBarrier xcd_barrier_post(unsigned* bar, volatile LAS unsigned* st, int wid) {
    XcdBarrier b; b.bar = bar; b.x = xb_xcc_id(); b.st = st; b.wid = wid;
    if (XB_T0(wid)) (void)xb_add(&bar[XB_XCNT(b.x)], 1u);
    return b;
}
__device__ __forceinline__ void xcd_barrier_complete(unsigned* bar, unsigned x, unsigned& nloc, unsigned& nx) {
    const unsigned G = gridDim.x * gridDim.y * gridDim.z;
    unsigned sum, cnt, mine, sp = 0u;
    for (;;) {
        sum = 0u; cnt = 0u; mine = 0u;
#pragma unroll
        for (unsigned j = 0; j < 16; ++j) { const unsigned c = xb_ld(&bar[XB_XCNT(j)]); sum += c; cnt += (c > 0u) ? 1u : 0u; mine = (j == x) ? c : mine; }
        if (sum == G) break;
        __builtin_amdgcn_s_sleep(1);
        if ((++sp & 255u) == 0u) { if (xb_ld(&bar[XB_TMO])) break; if (sp > XB_SPIN_CAP) { atomicAdd(&bar[XB_TMO], 1u); break; } }
    }
    nloc = mine > 0u ? mine : 1u; nx = cnt > 0u ? cnt : 1u;
}
__device__ __forceinline__ void xcd_barrier(const XcdBarrier& b) {
    asm volatile("s_waitcnt vmcnt(0)" ::: "memory");
    __syncthreads();
    if (XB_T0(b.wid)) {
        unsigned* bar = b.bar;
        __builtin_amdgcn_s_waitcnt(0);
        unsigned nloc = b.st[0], nx = b.st[1];
        if (nloc == 0u) { xcd_barrier_complete(bar, b.x, nloc, nx); b.st[0] = nloc; b.st[1] = nx; }
        const unsigned old = xb_add(&bar[XB_XSUB(b.x)], 1u);
        const unsigned gen = old / nloc;
        if (old + 1u == (gen + 1u) * nloc) {
            __builtin_amdgcn_fence(__ATOMIC_RELEASE, "agent");
            asm volatile("s_waitcnt vmcnt(0)" ::: "memory");
            const unsigned og = xb_add(&bar[XB_TOP], 1u);
            const unsigned tg = og / nx;
            if (og + 1u == (tg + 1u) * nx) xb_add(&bar[XB_TOPGEN], 1u);
            else XB_SPIN(xb_ld(&bar[XB_TOPGEN]) == tg, bar);
            __builtin_amdgcn_fence(__ATOMIC_ACQUIRE, "agent");
            xb_add(&bar[XB_XGEN(b.x)], 1u);
            asm volatile("s_waitcnt vmcnt(0)" ::: "memory");
        } else {
            XB_SPIN(xb_ld(&bar[XB_XGEN(b.x)]) == gen, bar);
            __builtin_amdgcn_fence(__ATOMIC_ACQUIRE, "agent");
            asm volatile("s_waitcnt vmcnt(0)" ::: "memory");
        }
    }
    __syncthreads();
}

struct Args { const float* in[17]; float* out; unsigned char* ws; int p_lo, p_hi; };
enum { I_X = 0, I_MEM, I_WIN_MOBA, I_WIN_FOX, I_BFG, I_WMKV, I_WO, I_LN1G, I_LN1B, I_RW, I_RB, I_WGU, I_BGU, I_WDN, I_BDN, I_LN2G, I_LN2B };

__device__ __forceinline__ Args load_args() {
#if defined(__HIP_DEVICE_COMPILE__)
    const __attribute__((address_space(4))) unsigned long long* p = (const __attribute__((address_space(4))) unsigned long long*)__builtin_amdgcn_kernarg_segment_ptr();
    asm volatile("" : "+s"(p));
    Args a;
#pragma unroll
    for (int i = 0; i < 17; ++i) a.in[i] = (const float*)(const GAS float*)p[i];
    a.out = (float*)(GAS float*)p[17]; a.ws = (unsigned char*)(GAS unsigned char*)p[18]; const unsigned long long w = p[19]; a.p_lo = (int)(unsigned)w; a.p_hi = (int)(unsigned)(w >> 32);
    return a;
#else
    return Args{};
#endif
}
struct CvtItem { const float* src; bf16* dst; int pitch; };
constexpr int CVT_I_IN = 16 * 40, CVT_I_MK = 16 * 8, CVT_I_O1 = 16 * 16, CVT_I_GU1 = 16 * 32, CVT_I_DN1 = 16 * 16;
constexpr int CVT_N_INIT = 4 * CVT_I_IN + CVT_I_MK + 4 * CVT_I_O1;
constexpr int CVT_N_MOE = NEXP * (CVT_I_GU1 + CVT_I_DN1), CVT_CHUNK = 32;
__device__ __forceinline__ bool cvt_decode(const Args& A, int it, CvtItem& c) {
    unsigned char* ws = A.ws;
    constexpr int N_IN = 4 * CVT_I_IN, N_MK = CVT_I_MK;
    if (it >= CVT_N_INIT) return false;
    int r = it;
    if (r < N_IN) { const int l = r / CVT_I_IN, q = r % CVT_I_IN, kb = q / 40, nb = q % 40, j = l >> 1; const int pitch = (l & 1) ? NPROJ + HS : NPROJ;
        const float* W = (l & 1) ? A.in[I_WIN_FOX] + (size_t)j * DM * (NPROJ + HS) : A.in[I_WIN_MOBA] + (size_t)j * DM * NPROJ;
        c.src = W + (size_t)(64 * kb) * pitch + 64 * nb; c.pitch = pitch; c.dst = (bf16*)(ws + WS_WIN) + ((size_t)l * NPROJ + 64 * nb) * DM + 64 * kb; return true; }
    r -= N_IN;
    if (r < N_MK) { const int kb = r / 8, nb = r % 8; c.src = A.in[I_WMKV] + (size_t)(64 * kb) * 512 + 64 * nb; c.pitch = 512; c.dst = (bf16*)(ws + WS_WMKV) + (size_t)(64 * nb) * DM + 64 * kb; return true; }
    r -= N_MK;
    { const int l = r / CVT_I_O1, q = r % CVT_I_O1, kb = q / 16, nb = q % 16; c.src = A.in[I_WO] + (size_t)l * DM * DM + (size_t)(64 * kb) * DM + 64 * nb; c.pitch = DM; c.dst = (bf16*)(ws + WS_WO) + ((size_t)l * DM + 64 * nb) * DM + 64 * kb; return true; }
}
__device__ __forceinline__ void cvt_decode_moe(const Args& A, int layer, int r, CvtItem& c) {
    unsigned char* ws = A.ws;
    if (r < NEXP * CVT_I_GU1) { const int le = layer * NEXP + r / CVT_I_GU1, q = r % CVT_I_GU1, kb = q / 32, nb = q % 32, col0 = 64 * nb;
        const int cc = col0 & 1023, drow0 = (cc >> 7) * 256 + (cc & 127) + ((col0 >= 1024) ? 128 : 0);
        c.src = A.in[I_WGU] + (size_t)le * DM * 2048 + (size_t)(64 * kb) * 2048 + col0; c.pitch = 2048; c.dst = (bf16*)(ws + WS_WGU) + ((size_t)le * 2048 + drow0) * DM + 64 * kb; return; }
    r -= NEXP * CVT_I_GU1;
    { const int le = layer * NEXP + r / CVT_I_DN1, q = r % CVT_I_DN1, kb = q / 16, nb = q % 16; c.src = A.in[I_WDN] + (size_t)le * DM * DM + (size_t)(64 * kb) * DM + 64 * nb; c.pitch = DM; c.dst = (bf16*)(ws + WS_WDN) + ((size_t)le * DM + 64 * nb) * DM + 64 * kb; }
}
__device__ __forceinline__ void cvt_load(const CvtItem& c, f32x4 (&v)[16], int lane) {
    const int a = lane >> 4, b4 = (lane & 15) * 4;
#pragma unroll
    for (int i = 0; i < 16; ++i) v[i] = __builtin_nontemporal_load((const f32x4*)(c.src + (size_t)(4 * i + a) * c.pitch + b4));
}
__device__ __forceinline__ void cvt_store(const CvtItem& c, const f32x4 (&v)[16], LAS float* scr, int lane) {
    const int a = lane >> 4, b4 = (lane & 15) * 4;
#pragma unroll
    for (int i = 0; i < 16; ++i) { LAS float* s = scr + (4 * i + a) * 65 + b4; s[0] = v[i].x; s[1] = v[i].y; s[2] = v[i].z; s[3] = v[i].w; }
    asm volatile("s_waitcnt lgkmcnt(0)" ::: "memory");
    const int cb = lane & 7;
#pragma unroll
    for (int j = 0; j < 8; ++j) {
        const int n = (lane >> 3) + 8 * j; const LAS float* s = scr + (8 * cb) * 65 + n;
        v4u o; o.x = pk2(s[0], s[65]); o.y = pk2(s[2 * 65], s[3 * 65]); o.z = pk2(s[4 * 65], s[5 * 65]); o.w = pk2(s[6 * 65], s[7 * 65]);
        *(v4u*)(c.dst + (size_t)n * DM + 8 * cb) = o;
    }
    asm volatile("s_waitcnt lgkmcnt(0)" ::: "memory");
}
__device__ __forceinline__ void cvt_moe_chunk(const Args& A, int layer, int chunk, LAS unsigned char* lds, int wid, int lane) {
    LAS float* scr = (LAS float*)(lds + wid * 16896);
    CvtItem c0, c1; f32x4 va[16], vb[16];
    const int r0 = chunk * CVT_CHUNK + wid * 4;
    cvt_decode_moe(A, layer, r0, c0); cvt_load(c0, va, lane);
    cvt_decode_moe(A, layer, r0 + 1, c1); cvt_load(c1, vb, lane);
    cvt_store(c0, va, scr, lane);
    cvt_decode_moe(A, layer, r0 + 2, c0); cvt_load(c0, va, lane);
    cvt_store(c1, vb, scr, lane);
    cvt_decode_moe(A, layer, r0 + 3, c1); cvt_load(c1, vb, lane);
    cvt_store(c0, va, scr, lane);
    cvt_store(c1, vb, scr, lane);
}
__device__ __forceinline__ void ph_convert(const Args& A, LAS unsigned char* lds, int wg, int G, int g_wid) {
    PH_IDS;
    unsigned char* ws = A.ws;
    LAS float* scr = (LAS float*)(lds + wid * 16896);
    const int gw = wg * NWAVES + wid, NGW = G * NWAVES;
    { CvtItem cur, nxt; f32x4 va[16], vb[16];
      bool okc = cvt_decode(A, gw, cur);
      if (okc) cvt_load(cur, va, lane);
      for (int it = gw; okc; it += 2 * NGW) {
          const bool okn = cvt_decode(A, it + NGW, nxt);
          if (okn) cvt_load(nxt, vb, lane);
          cvt_store(cur, va, scr, lane);
          if (!okn) break;
          okc = cvt_decode(A, it + 2 * NGW, cur);
          if (okc) cvt_load(cur, va, lane);
          cvt_store(nxt, vb, scr, lane);
      } }
    { const int gt = wg * NTHR + tid, NGT = G * NTHR;
      for (int i = gt; i < 2 * 16 * DM; i += NGT) { const int j = i / (16 * DM), hh = (i / DM) & 15, k = i % DM;
          const float v = hh < HS ? A.in[I_WIN_FOX][(size_t)j * DM * (NPROJ + HS) + (size_t)k * (NPROJ + HS) + NPROJ + hh] : 0.f;
          ((bf16*)(ws + WS_WFG))[i] = (bf16)f2bf(v); }
      { constexpr size_t NX = (size_t)NTOK * DM / 8; const f32x4* xs = (const f32x4*)A.in[I_X]; v4u* xd = (v4u*)(ws + WS_HB);
        size_t i = gt;
        for (; i + 3 * (size_t)NGT < NX; i += 4 * (size_t)NGT) {
            f32x4 a[4], b[4];
#pragma unroll
            for (int q = 0; q < 4; ++q) { a[q] = __builtin_nontemporal_load(xs + 2 * (i + q * (size_t)NGT)); b[q] = __builtin_nontemporal_load(xs + 2 * (i + q * (size_t)NGT) + 1); }
#pragma unroll
            for (int q = 0; q < 4; ++q) { v4u o; o.x = pk2(a[q].x, a[q].y); o.y = pk2(a[q].z, a[q].w); o.z = pk2(b[q].x, b[q].y); o.w = pk2(b[q].z, b[q].w); xd[i + q * (size_t)NGT] = o; } }
        for (; i < NX; i += NGT) { const f32x4 a = xs[2 * i], b = xs[2 * i + 1]; v4u o; o.x = pk2(a.x, a.y); o.y = pk2(a.z, a.w); o.z = pk2(b.x, b.y); o.w = pk2(b.z, b.w); xd[i] = o; } }
      for (size_t i = gt; i < (size_t)NB * NMEM * DM / 8; i += NGT) { const f32x4 a = ((const f32x4*)A.in[I_MEM])[2 * i], b = ((const f32x4*)A.in[I_MEM])[2 * i + 1];
          v4u o; o.x = pk2(a.x, a.y); o.y = pk2(a.z, a.w); o.z = pk2(b.x, b.y); o.w = pk2(b.z, b.w); ((v4u*)(ws + WS_MEMB))[i] = o; }
    }
}

__device__ __forceinline__ void glds16(const void* gsrc, unsigned lds_dst) { unsigned keep;
    asm volatile("s_mov_b32 %0, m0\n\ts_mov_b32 m0, %2\n\ts_nop 0\n\tglobal_load_lds_dwordx4 %1, off\n\ts_mov_b32 m0, %0" : "=&s"(keep) : "v"(gsrc), "s"(lds_dst) : "memory"); }
__device__ __forceinline__ void glds4(const void* gsrc, unsigned lds_dst) { unsigned keep;
    asm volatile("s_mov_b32 %0, m0\n\ts_mov_b32 m0, %2\n\ts_nop 0\n\tglobal_load_lds_dword %1, off\n\ts_mov_b32 m0, %0" : "=&s"(keep) : "v"(gsrc), "s"(lds_dst) : "memory"); }
struct Unit { int pm, pn, e, rows, pa; const bf16* B; const unsigned* list; const LAS unsigned char* ls; };
struct DenseSched {
    static constexpr bool GATHER = false;
    const bf16* A; const bf16* Bt; int nM, nN, G, c;
    __device__ __forceinline__ bool next(int i, Unit& u) const {
        if ((G & 7) == 0 && (nM & 7) == 0) { const int x = c & 7, l = i * (G >> 3) + (c >> 3); u.pm = (l / nN) * 8 + x; u.pn = l % nN; if (u.pm >= nM) return false; }
        else { const int L = i * G + c; if (L >= nM * nN) return false; u.pm = L / nN; u.pn = L % nN; }
        u.pa = u.pm; u.e = 0; u.rows = 256; u.B = Bt + (size_t)u.pn * 256 * DM; u.list = nullptr; return true; }
    __device__ __forceinline__ unsigned arow(const Unit& u, int r) const { return (unsigned)(u.pm * 256 + r); }
    __device__ __forceinline__ unsigned araw(const Unit& u, int r) const { return (unsigned)(u.pm * 256 + r); }
    __device__ __forceinline__ unsigned afin(unsigned x) const { return x; }
};
template <bool GATHER_>
struct MoeSchedT {
    static constexpr bool GATHER = GATHER_;
    const bf16* A; const bf16* Bt; const unsigned* elist; const LAS int* tab; int nN, ntot, G, c, shift;
    __device__ __forceinline__ bool next(int i, Unit& u) const {
        const int tot = __builtin_amdgcn_readfirstlane(tab[64 + 32]); int g;
        if ((G & 7) == 0) { const int x = c & 7, l = i * (G >> 3) + (c >> 3); g = (l / nN) * 8 + x; u.pn = l % nN; if (g >= tot) return false; }
        else { const int L = i * G + c; if (L >= tot * nN) return false; u.pn = L % nN; g = L / nN; }
        int ln; asm volatile("v_mbcnt_lo_u32_b32 %0, -1, 0\n\tv_mbcnt_hi_u32_b32 %0, -1, %0" : "=v"(ln));
        const int offv = tab[64 + (ln & 31)];
        const unsigned long long mk = __builtin_amdgcn_ballot_w64(ln < 32 && offv <= g);
        const int e = __builtin_popcountll(mk) - 1;
        u.e = e; u.pa = g; u.pm = g - __builtin_amdgcn_readfirstlane(tab[64 + e]); const int rem = __builtin_amdgcn_readfirstlane(tab[e]) - 256 * u.pm; u.rows = rem < 256 ? rem : 256;
        u.B = Bt + ((size_t)e * ntot + (size_t)u.pn * 256) * DM; u.list = elist + ((size_t)e * NTOK + 256 * u.pm) * 2; return true; }
    __device__ __forceinline__ unsigned arow(const Unit& u, int r) const { const unsigned rr = (unsigned)r < (unsigned)u.rows ? (unsigned)r : (unsigned)(u.rows - 1); return *(const unsigned*)((const char*)u.list + rr * 8u) >> shift; }
    __device__ __forceinline__ unsigned araw(const Unit& u, int r) const { const unsigned rr = (unsigned)r < (unsigned)u.rows ? (unsigned)r : (unsigned)(u.rows - 1); return *(const unsigned*)((const char*)u.list + rr * 8u); }
    __device__ __forceinline__ unsigned afin(unsigned x) const { return x >> shift; }
};
__device__ __forceinline__ void moe_tables(LAS int* tab, const unsigned* ecnt, int g_wid) {
    PH_IDS;
    if (tid == 0) { int acc = 0; for (int e = 0; e < 32; ++e) { const int c = (int)ecnt[e]; tab[e] = c; tab[64 + e] = acc; acc += (c + 255) >> 8; } tab[64 + 32] = acc; }
    __syncthreads();
}

template <bool NORMS, bool KSUM>
struct EpiProjT {   static constexpr int NSTAGE = 0; __device__ __forceinline__ const void* stage_src(const Unit&, int, int) const { return nullptr; }
    bf16* O; int ldc, q_end, qm_begin; unsigned* norm; float* ksum;
    __device__ __forceinline__ void operator()(const f32x4 (&acc)[2][2][4][2], const Unit& u, int wr, int wc, int fr, int fq) const {
        float nmax[2] = {0.f, 0.f};
#pragma unroll
        for (int ai = 0; ai < 2; ++ai) { float nsq[4][2];
#pragma unroll
            for (int m = 0; m < 4; ++m) { const int row = u.pm * 256 + ai * 128 + wr * 64 + m * 16 + fr;
#pragma unroll
                for (int bj = 0; bj < 2; ++bj) { const int col = u.pn * 256 + bj * 128 + wc * 32 + 8 * fq; const float sc = (col < q_end || col >= qm_begin) ? C2 : 1.f;
                    const f32x4 v0 = acc[ai][bj][m][0] * sc, v1 = acc[ai][bj][m][1] * sc;
                    if (NORMS) nsq[m][bj] = (v0.x * v0.x + v0.y * v0.y) + (v0.z * v0.z + v0.w * v0.w) + (v1.x * v1.x + v1.y * v1.y) + (v1.z * v1.z + v1.w * v1.w);
                    v4u w; w.x = pk2(v0.x, v0.y); w.y = pk2(v0.z, v0.w); w.z = pk2(v1.x, v1.y); w.w = pk2(v1.z, v1.w);
                    *(v4u*)((char*)O + (unsigned)(row * ldc + col) * 2u) = w; } }
            if (NORMS) { if (u.pn < 6) {
                const int ln_ = fq * 16 + fr;
#pragma unroll
                for (int st = 16; st <= 32; st <<= 1) { float t_[4][2];
#pragma unroll
                    for (int m = 0; m < 4; ++m)
#pragma unroll
                        for (int bj = 0; bj < 2; ++bj) t_[m][bj] = __builtin_bit_cast(float, __builtin_amdgcn_ds_bpermute((ln_ ^ st) << 2, __builtin_bit_cast(int, nsq[m][bj])));
#pragma unroll
                    for (int m = 0; m < 4; ++m)
#pragma unroll
                        for (int bj = 0; bj < 2; ++bj) nsq[m][bj] += t_[m][bj]; }
#pragma unroll
                for (int m = 0; m < 4; ++m)
#pragma unroll
                    for (int bj = 0; bj < 2; ++bj) nmax[bj] = fmaxf(nmax[bj], nsq[m][bj]); } } }
        if (NORMS) { if (u.pn < 6) {
            const int b = u.pm >> 5;
#pragma unroll
            for (int bj = 0; bj < 2; ++bj) { const float mx = wave_max(nmax[bj]); const int c = u.pn * 256 + bj * 128 + wc * 32; const int isk = c >= K_COL ? 1 : 0, cc = c - isk * K_COL;
                if (fr == 0 && fq == 0) __hip_atomic_fetch_max(norm + (((b * HS + (cc >> 6)) * 2 + ((cc >> 5) & 1)) * 2 + isk), __float_as_uint(mx), __ATOMIC_RELAXED, __HIP_MEMORY_SCOPE_AGENT); } } }
        if (KSUM) { if (u.pn >= 3 && u.pn < 6) {
            const int b = u.pm >> 5, jblk = u.pm & 31;
#pragma unroll
            for (int bj = 0; bj < 2; ++bj) { const int c = u.pn * 256 + bj * 128 + wc * 32 + 8 * fq - K_COL; float* dst = ksum + ((size_t)((b * HS + (c >> 6)) * 32 + jblk)) * 64 + (c & 63);
#pragma unroll
                for (int n = 0; n < 2; ++n) { f32x4 s = acc[0][bj][0][n];
#pragma unroll
                    for (int ai = 0; ai < 2; ++ai)
#pragma unroll
                        for (int m = 0; m < 4; ++m) if (ai + m) s += acc[ai][bj][m][n];
                    s.x = row16_sum(s.x); s.y = row16_sum(s.y); s.z = row16_sum(s.z); s.w = row16_sum(s.w);
                    if (fr == 0) { atomicAdd(dst + 4 * n, s.x); atomicAdd(dst + 4 * n + 1, s.y); atomicAdd(dst + 4 * n + 2, s.z); atomicAdd(dst + 4 * n + 3, s.w); } } } } }
    }
};
template <bool BASE_F32>
struct EpiOutT {    static constexpr int NSTAGE = 0; __device__ __forceinline__ const void* stage_src(const Unit&, int, int) const { return nullptr; }
    const void* base; bf16* out;
    __device__ __forceinline__ void operator()(const f32x4 (&acc)[2][2][4][2], const Unit& u, int wr, int wc, int fr, int fq) const {
#pragma unroll
        for (int ai = 0; ai < 2; ++ai) {
            f32x4 b0[4][2], b1[4][2];
#pragma unroll
            for (int m = 0; m < 4; ++m)
#pragma unroll
                for (int bj = 0; bj < 2; ++bj) { const unsigned eo = (unsigned)((u.pm * 256 + ai * 128 + wr * 64 + m * 16 + fr) * DM + u.pn * 256 + bj * 128 + wc * 32 + 8 * fq);
                    if (BASE_F32) { b0[m][bj] = *(const f32x4*)((const char*)base + eo * 4u); b1[m][bj] = *(const f32x4*)((const char*)base + eo * 4u + 16); }
                    else { const v4u w = *(const v4u*)((const char*)base + eo * 2u); b0[m][bj] = (f32x4){bflo(w.x), bfhi(w.x), bflo(w.y), bfhi(w.y)}; b1[m][bj] = (f32x4){bflo(w.z), bfhi(w.z), bflo(w.w), bfhi(w.w)}; } }
#pragma unroll
            for (int m = 0; m < 4; ++m)
#pragma unroll
                for (int bj = 0; bj < 2; ++bj) { const unsigned eo = (unsigned)((u.pm * 256 + ai * 128 + wr * 64 + m * 16 + fr) * DM + u.pn * 256 + bj * 128 + wc * 32 + 8 * fq);
                    const f32x4 o0 = b0[m][bj] * ALPHA + acc[ai][bj][m][0], o1 = b1[m][bj] * ALPHA + acc[ai][bj][m][1];
                    v4u w; w.x = pk2(o0.x, o0.y); w.y = pk2(o0.z, o0.w); w.z = pk2(o1.x, o1.y); w.w = pk2(o1.z, o1.w); *(v4u*)((char*)out + eo * 2u) = w; } }
    }
};
__device__ __forceinline__ float swiglu(float g, float uu) {
    g = fminf(g, SW_LIMIT); uu = fminf(fmaxf(uu, -SW_LIMIT), SW_LIMIT);
    const float sg = __builtin_amdgcn_rcpf(1.f + fexp2(-SW_ALPHA * LOG2E * g));
    return g * sg * (uu + 1.f);
}
__device__ __forceinline__ f32x2_t swiglu2(f32x2_t g, f32x2_t uu) {
    g = __builtin_elementwise_min(g, (f32x2_t){SW_LIMIT, SW_LIMIT}); uu = __builtin_elementwise_min(__builtin_elementwise_max(uu, (f32x2_t){-SW_LIMIT, -SW_LIMIT}), (f32x2_t){SW_LIMIT, SW_LIMIT});
    const f32x2_t z = g * (-SW_ALPHA * LOG2E); f32x2_t d; d.x = 1.f + fexp2(z.x); d.y = 1.f + fexp2(z.y);
    f32x2_t sg; sg.x = __builtin_amdgcn_rcpf(d.x); sg.y = __builtin_amdgcn_rcpf(d.y);
    return g * sg * (uu + 1.f);
}
struct EpiGU {
    static constexpr int NSTAGE = 1;
    bf16* abuf; const float* bgu;
    __device__ __forceinline__ const void* stage_src(const Unit& u, int, int lane) const { return bgu + (size_t)u.e * 2048 + (lane >= 32 ? 1024 : 0) + u.pn * 128 + (lane & 31) * 4; }
    __device__ __forceinline__ void operator()(const f32x4 (&acc)[2][2][4][2], const Unit& u, int wr, int wc, int fr, int fq) const { if (u.rows == 256) body<false>(acc, u, wr, wc, fr, fq); else body<true>(acc, u, wr, wc, fr, fq); }
    template <bool CHECK> __device__ __forceinline__ void body(const f32x4 (&acc)[2][2][4][2], const Unit& u, int wr, int wc, int fr, int fq) const {
        const int c0 = u.pn * 128 + wc * 32 + 8 * fq; const LAS float* bl = (const LAS float*)u.ls + wc * 32 + 8 * fq;
        const f32x4 g0 = *(const LAS f32x4*)bl, g1 = *(const LAS f32x4*)(bl + 4), u0 = *(const LAS f32x4*)(bl + 128), u1 = *(const LAS f32x4*)(bl + 132);
#pragma unroll
        for (int ai = 0; ai < 2; ++ai)
#pragma unroll
            for (int m = 0; m < 4; ++m) { const int r = ai * 128 + wr * 64 + m * 16 + fr;
                if (!CHECK || r < u.rows) {
                    const f32x4 ga = acc[ai][0][m][0] + g0, gb = acc[ai][0][m][1] + g1, ua = acc[ai][1][m][0] + u0, ub = acc[ai][1][m][1] + u1;
                    const f32x2_t s0 = swiglu2((f32x2_t){ga.x, ga.y}, (f32x2_t){ua.x, ua.y}), s1 = swiglu2((f32x2_t){ga.z, ga.w}, (f32x2_t){ua.z, ua.w});
                    const f32x2_t s2 = swiglu2((f32x2_t){gb.x, gb.y}, (f32x2_t){ub.x, ub.y}), s3 = swiglu2((f32x2_t){gb.z, gb.w}, (f32x2_t){ub.z, ub.w});
                    v4u w; w.x = pk2(s0.x, s0.y); w.y = pk2(s1.x, s1.y); w.z = pk2(s2.x, s2.y); w.w = pk2(s3.x, s3.y);
                    *(v4u*)((char*)abuf + ((unsigned)(u.pa * 256 + r) * (unsigned)DM + (unsigned)c0) * 2u) = w; } }
    }
};
constexpr float Y_SCALE = 16.f;
struct EpiDN {
    static constexpr int NSTAGE = 3;
    bf16* ybuf; const float* bdn;
    __device__ __forceinline__ const void* stage_src(const Unit& u, int p, int lane) const {
        return p == 0 ? (const void*)(bdn + (size_t)u.e * DM + u.pn * 256 + lane * 4) : (const void*)((const char*)u.list + (p - 1) * 1024 + lane * 16); }
    __device__ __forceinline__ void operator()(const f32x4 (&acc)[2][2][4][2], const Unit& u, int wr, int wc, int fr, int fq) const { if (u.rows == 256) body<false>(acc, u, wr, wc, fr, fq); else body<true>(acc, u, wr, wc, fr, fq); }
    template <bool CHECK> __device__ __forceinline__ void body(const f32x4 (&acc)[2][2][4][2], const Unit& u, int wr, int wc, int fr, int fq) const {
        f32x4 bv[2][2];
#pragma unroll
        for (int bj = 0; bj < 2; ++bj) { const LAS float* bp = (const LAS float*)u.ls + bj * 128 + wc * 32 + 8 * fq; bv[bj][0] = *(const LAS f32x4*)bp; bv[bj][1] = *(const LAS f32x4*)(bp + 4); }
#pragma unroll
        for (int ai = 0; ai < 2; ++ai)
#pragma unroll
            for (int m = 0; m < 4; ++m) { const int r = ai * 128 + wr * 64 + m * 16 + fr;
                if (!CHECK || r < u.rows) { const v2u ag = *(const LAS v2u*)(u.ls + 1024 + r * 8); const unsigned aid = ag.x; const float gt = __uint_as_float(ag.y);
#pragma unroll
                    for (int bj = 0; bj < 2; ++bj) { const float g16 = gt * Y_SCALE; f32x4 v0 = (acc[ai][bj][m][0] + bv[bj][0]) * g16, v1 = (acc[ai][bj][m][1] + bv[bj][1]) * g16;
                        v0.x = __builtin_amdgcn_fmed3f(v0.x, -448.f, 448.f); v0.y = __builtin_amdgcn_fmed3f(v0.y, -448.f, 448.f); v0.z = __builtin_amdgcn_fmed3f(v0.z, -448.f, 448.f); v0.w = __builtin_amdgcn_fmed3f(v0.w, -448.f, 448.f);
                        v1.x = __builtin_amdgcn_fmed3f(v1.x, -448.f, 448.f); v1.y = __builtin_amdgcn_fmed3f(v1.y, -448.f, 448.f); v1.z = __builtin_amdgcn_fmed3f(v1.z, -448.f, 448.f); v1.w = __builtin_amdgcn_fmed3f(v1.w, -448.f, 448.f);
                        int w0 = __builtin_amdgcn_cvt_pk_fp8_f32(v0.x, v0.y, 0, false); w0 = __builtin_amdgcn_cvt_pk_fp8_f32(v0.z, v0.w, w0, true);
                        int w1 = __builtin_amdgcn_cvt_pk_fp8_f32(v1.x, v1.y, 0, false); w1 = __builtin_amdgcn_cvt_pk_fp8_f32(v1.z, v1.w, w1, true);
                        *(v2u*)((char*)ybuf + (aid * (unsigned)DM + (unsigned)(u.pn * 256 + bj * 128 + wc * 32 + 8 * fq))) = (v2u){(unsigned)w0, (unsigned)w1}; } } }
    }
};
template <class Epi, class Sched>
__device__ __forceinline__ void gemm_simple(const Sched& S, const Epi& E, int g_wid) {
    PH_IDS;
    const int wr = wid >> 2, wc = wid & 3, fr = lane & 15, fq = lane >> 4;
    Unit u;
    for (int i = 0; S.next(i, u); ++i) {
        f32x4 acc[2][2][4][2];
#pragma unroll
        for (int a = 0; a < 2; ++a)
#pragma unroll
            for (int b = 0; b < 2; ++b)
#pragma unroll
                for (int m = 0; m < 4; ++m)
#pragma unroll
                    for (int n = 0; n < 2; ++n) acc[a][b][m][n] = (f32x4){0.f, 0.f, 0.f, 0.f};
        unsigned aoff[2][4], boff[2][2];
#pragma unroll
        for (int ai = 0; ai < 2; ++ai)
#pragma unroll
            for (int m = 0; m < 4; ++m) aoff[ai][m] = S.arow(u, ai * 128 + wr * 64 + m * 16 + fr) * DM + 8 * fq;
#pragma unroll
        for (int bj = 0; bj < 2; ++bj)
#pragma unroll
            for (int n = 0; n < 2; ++n) boff[bj][n] = (unsigned)(bj * 128 + wc * 32 + 8 * (fr >> 2) + 4 * n + (fr & 3)) * DM + 8 * fq;
#pragma unroll 1
        for (int k0 = 0; k0 < DM; k0 += 32) {
            bf16x8 b[2][2];
#pragma unroll
            for (int bj = 0; bj < 2; ++bj)
#pragma unroll
                for (int n = 0; n < 2; ++n) b[bj][n] = *(const bf16x8*)(u.B + boff[bj][n] + k0);
#pragma unroll
            for (int ai = 0; ai < 2; ++ai) {
                bf16x8 a[4];
#pragma unroll
                for (int m = 0; m < 4; ++m) a[m] = *(const bf16x8*)(S.A + aoff[ai][m] + k0);
#pragma unroll
                for (int bj = 0; bj < 2; ++bj)
#pragma unroll
                    for (int m = 0; m < 4; ++m)
#pragma unroll
                        for (int n = 0; n < 2; ++n) acc[ai][bj][m][n] = __builtin_amdgcn_mfma_f32_16x16x32_bf16(b[bj][n], a[m], acc[ai][bj][m][n], 0, 0, 0);
            }
        }
        E(acc, u, wr, wc, fr, fq);
    }
}


namespace pg8 {
constexpr int BM = 256, BK = 64, HALF = 128, HTB = HALF * BK * 2, STAGE_BYTES = 8 * HTB;
__device__ __forceinline__ int lds_byte(int r, int c) { const int st = (r >> 4) * 2 + (c >> 5), rr = r & 15, cc = c & 31, ob = rr * 64 + cc * 2; return st * 1024 + (ob ^ (((ob >> 9) & 1) << 5)); }
__device__ __forceinline__ void stage_rc(int b, int& R, int& C) { const int st = b / 1024, sb = b % 1024, swz = sb ^ (((sb >> 9) & 1) << 5); R = (st >> 1) * 16 + swz / 64; C = (st & 1) * 32 + (swz % 64) / 2; }
__device__ __forceinline__ int perm32(int rho) { const int n = rho >> 4, i = rho & 15; return 8 * (i >> 2) + 4 * n + (i & 3); }
}
template <class Epi, class Sched, bool ALIGN_EPI>
__device__ __forceinline__ void gemm_fast(LAS unsigned char* lds, const Sched& S, const Epi& E, int g_wid) {
    using namespace pg8;
    PH_IDS;
    const int wr = wid >> 2, wc = wid & 3, fr = lane & 15, fq = lane >> 4;
    constexpr int K = DM, nt = K / BK;
    int Rr[2], Cc[2]; unsigned voffB[2];
#pragma unroll
    for (int i = 0; i < 2; ++i) { int R, C; stage_rc(tid * 16 + i * 8192, R, C); Rr[i] = R; Cc[i] = C; const int Rb = (R & ~31) + perm32(R & 31); voffB[i] = (unsigned)(Rb * K + C) * 2u; }
    constexpr unsigned kstep = BK * 2, hstep = HALF * K * 2;
    const unsigned ldsw = (unsigned)wid * 1024u;
    const int aoff = lds_byte(wr * 64 + fr, fq * 8), boff = lds_byte(wc * 32 + fr, fq * 8);
    const char* Ab = (const char*)S.A;
#define PG8_SA(b, h) (((b) * 2 + (h)) * HTB)
#define PG8_SB(b, h) ((4 + (b) * 2 + (h)) * HTB)
#define PG8_STAGEB(bufoff, gbase) do { const char* _ub = (const char*)(gbase); asm volatile("" : "+s"(_ub)); _Pragma("unroll") for (int _i = 0; _i < 2; ++_i) \
        __builtin_amdgcn_global_load_lds((const unsigned*)(_ub + voffB[_i]), (LAS unsigned*)(lds + (bufoff) + ldsw + _i * 8192), 16, 0, 0); } while (0)
#define PG8_STAGEA(bufoff, kb, vo, sb) do { const char* _ub = (sb) + (size_t)(kb); asm volatile("" : "+s"(_ub)); _Pragma("unroll") for (int _i = 0; _i < 2; ++_i) \
        __builtin_amdgcn_global_load_lds((const unsigned*)(_ub + (vo)[_i]), (LAS unsigned*)(lds + (bufoff) + ldsw + _i * 8192), 16, 0, 0); } while (0)
#define PG8_VA(h) (Sched::GATHER ? vA[h] : laneA)
#define PG8_VN(h) (Sched::GATHER ? vN[h] : laneA)
#define PG8_BA(h) (Sched::GATHER ? Ab : cAb + (h) * hstep)
#define PG8_BN(h) (Sched::GATHER ? Ab : nAb + (h) * hstep)
#define PG8_LDA(dst, b, h) do { _Pragma("unroll") for (int m = 0; m < 4; ++m) _Pragma("unroll") for (int k = 0; k < 2; ++k) dst[m][k] = *(const LAS bf16x8*)(lds + PG8_SA(b, h) + aoff + m * 2048 + k * 1024); } while (0)
#define PG8_LDB(dst, b, h) do { _Pragma("unroll") for (int n = 0; n < 2; ++n) _Pragma("unroll") for (int k = 0; k < 2; ++k) dst[n][k] = *(const LAS bf16x8*)(lds + PG8_SB(b, h) + boff + n * 2048 + k * 1024); } while (0)
#define PG8_MMA(ai, bj, At, Bt) do { __builtin_amdgcn_s_setprio(1); _Pragma("unroll") for (int m = 0; m < 4; ++m) _Pragma("unroll") for (int n = 0; n < 2; ++n) _Pragma("unroll") for (int k = 0; k < 2; ++k) \
        acc[ai][bj][m][n] = __builtin_amdgcn_mfma_f32_16x16x32_bf16(Bt[n][k], At[m][k], acc[ai][bj][m][n], 0, 0, 0); __builtin_amdgcn_s_setprio(0); } while (0)
#define PG8_WAIT_V(n) asm volatile("s_waitcnt vmcnt(" #n ")" ::: "memory")
#define PG8_WAIT_L(n) asm volatile("s_waitcnt lgkmcnt(" #n ")" ::: "memory")
#define PG8_BAR __builtin_amdgcn_s_barrier()
#define PG8_SCHED __builtin_amdgcn_sched_barrier(0)
#define PG8_OFFS_RAW(dst, un) do { _Pragma("unroll") for (int _h = 0; _h < 2; ++_h) _Pragma("unroll") for (int _i = 0; _i < 2; ++_i) dst[_h][_i] = S.araw(un, _h * 128 + Rr[_i]); } while (0)
#define PG8_OFFS_FIN(dst, raw) do { _Pragma("unroll") for (int _h = 0; _h < 2; ++_h) _Pragma("unroll") for (int _i = 0; _i < 2; ++_i) dst[_h][_i] = (S.afin(raw[_h][_i]) * (unsigned)K + (unsigned)Cc[_i]) * 2u; } while (0)
#define PG8_OFFS(dst, un) do { _Pragma("unroll") for (int _h = 0; _h < 2; ++_h) _Pragma("unroll") for (int _i = 0; _i < 2; ++_i) dst[_h][_i] = (S.arow(un, _h * 128 + Rr[_i]) * (unsigned)K + (unsigned)Cc[_i]) * 2u; } while (0)
    Unit cur, nxt, nn; int ui = 0;
    if (!S.next(0, cur)) return;
    f32x4 acc[2][2][4][2];
#pragma unroll
    for (int a = 0; a < 2; ++a)
#pragma unroll
        for (int b = 0; b < 2; ++b)
#pragma unroll
            for (int m = 0; m < 4; ++m)
#pragma unroll
                for (int n = 0; n < 2; ++n) acc[a][b][m][n] = (f32x4){0.f, 0.f, 0.f, 0.f};
    bf16x8 At[4][2], B0[2][2], B1[2][2];
    unsigned vA[2][2], vN[2][2], laneA[2];
#pragma unroll
    for (int i = 0; i < 2; ++i) laneA[i] = (unsigned)(Rr[i] * K + Cc[i]) * 2u;
    if constexpr (Sched::GATHER) { PG8_OFFS(vA, cur); }
    const char* cAb = Ab + (size_t)cur.pa * (2 * hstep); const char* nAb = cAb;
    const char* cB = (const char*)cur.B;
    PG8_STAGEB(PG8_SB(0, 0), cB); PG8_STAGEB(PG8_SB(0, 1), cB + hstep); PG8_STAGEA(PG8_SA(0, 0), 0, PG8_VA(0), PG8_BA(0)); PG8_STAGEA(PG8_SA(0, 1), 0, PG8_VA(1), PG8_BA(1));
    if (wr == 1) PG8_BAR;
    PG8_WAIT_V(2); PG8_BAR;
    PG8_STAGEB(PG8_SB(1, 0), cB + kstep); PG8_STAGEA(PG8_SA(1, 0), kstep, PG8_VA(0), PG8_BA(0)); PG8_STAGEB(PG8_SB(1, 1), cB + hstep + kstep);
    PG8_WAIT_V(6); PG8_BAR;
    bool has_next = S.next(1, nxt);
    unsigned rawN[2][2] = {{0u, 0u}, {0u, 0u}};
    if constexpr (Sched::GATHER) { if (has_next) { PG8_OFFS_RAW(rawN, nxt); } }
    for (;;) {
        if constexpr (Epi::NSTAGE > 0) {
            cur.ls = lds + STAGE_BYTES + (ui & 1) * 4096;
            if (wid == 0) {
#pragma unroll
                for (int p = 0; p < Epi::NSTAGE; ++p) glds16(E.stage_src(cur, p, lane), (unsigned)__builtin_amdgcn_readfirstlane((unsigned)(uintptr_t)cur.ls + p * 1024)); } }
        if constexpr (Sched::GATHER) {
            if (has_next) { PG8_OFFS_FIN(vN, rawN); } else {
#pragma unroll
                for (int h = 0; h < 2; ++h)
#pragma unroll
                    for (int i = 0; i < 2; ++i) vN[h][i] = vA[h][i]; } }
        else nAb = has_next ? Ab + (size_t)nxt.pa * (2 * hstep) : cAb;
        const char* nB = has_next ? (const char*)nxt.B : cB;
#define PG8_KSTEP(LAST, t) do { \
            const unsigned kb1 = (unsigned)((t) + 1) * kstep, kb2 = (LAST) ? 0u : (unsigned)((t) + 2) * kstep, kb3 = kb2 + kstep; \
            const char* b2 = (LAST) ? nB : cB + (size_t)((t) + 2) * kstep; const char* b3 = b2 + kstep; \
            PG8_LDB(B0, 0, 0); PG8_LDB(B1, 0, 1); PG8_SCHED; PG8_LDA(At, 0, 0); PG8_STAGEA(PG8_SA(1, 1), kb1, PG8_VA(1), PG8_BA(1)); \
            PG8_WAIT_V(8); PG8_WAIT_L(0); PG8_BAR; PG8_MMA(0, 0, At, B0); PG8_MMA(0, 1, At, B1); PG8_BAR; PG8_SCHED; \
            PG8_LDA(At, 0, 1); PG8_STAGEB(PG8_SB(0, 0), b2); PG8_STAGEB(PG8_SB(0, 1), b2 + hstep); if (LAST) { PG8_STAGEA(PG8_SA(0, 0), kb2, PG8_VN(0), PG8_BN(0)); } else { PG8_STAGEA(PG8_SA(0, 0), kb2, PG8_VA(0), PG8_BA(0)); } \
            PG8_WAIT_V(8); PG8_WAIT_L(0); PG8_BAR; PG8_MMA(1, 0, At, B0); PG8_MMA(1, 1, At, B1); PG8_BAR; PG8_SCHED; \
            PG8_LDB(B0, 1, 0); PG8_LDB(B1, 1, 1); PG8_SCHED; PG8_LDA(At, 1, 0); if (LAST) { PG8_STAGEA(PG8_SA(0, 1), kb2, PG8_VN(1), PG8_BN(1)); } else { PG8_STAGEA(PG8_SA(0, 1), kb2, PG8_VA(1), PG8_BA(1)); } \
            PG8_WAIT_V(8); PG8_WAIT_L(0); PG8_BAR; PG8_MMA(0, 0, At, B0); PG8_MMA(0, 1, At, B1); PG8_BAR; PG8_SCHED; \
            PG8_LDA(At, 1, 1); PG8_STAGEB(PG8_SB(1, 0), b3); PG8_STAGEB(PG8_SB(1, 1), b3 + hstep); if (LAST) { PG8_STAGEA(PG8_SA(1, 0), kb3, PG8_VN(0), PG8_BN(0)); } else { PG8_STAGEA(PG8_SA(1, 0), kb3, PG8_VA(0), PG8_BA(0)); } \
            PG8_WAIT_V(8); PG8_WAIT_L(0); PG8_BAR; PG8_MMA(1, 0, At, B0); PG8_MMA(1, 1, At, B1); PG8_BAR; PG8_SCHED; } while (0)
        for (int t = 0; t < nt - 2; t += 2) PG8_KSTEP(false, t);
        PG8_KSTEP(true, nt - 2);
#undef PG8_KSTEP
        if constexpr (ALIGN_EPI) { if (wr == 0) PG8_BAR; }
        bool has_nn = false; unsigned rawNN[2][2] = {{0u, 0u}, {0u, 0u}};
        if (has_next) { has_nn = S.next(ui + 2, nn); if constexpr (Sched::GATHER) { if (has_nn) { PG8_OFFS_RAW(rawNN, nn); } } }
        { int fr_e = fr, fq_e = fq; asm volatile("" : "+v"(fr_e), "+v"(fq_e));
          E(acc, cur, wr, wc, fr_e, fq_e); }
        if (!has_next) break;
#pragma unroll
        for (int a = 0; a < 2; ++a)
#pragma unroll
            for (int b = 0; b < 2; ++b)
#pragma unroll
                for (int m = 0; m < 4; ++m)
#pragma unroll
                    for (int n = 0; n < 2; ++n) acc[a][b][m][n] = (f32x4){0.f, 0.f, 0.f, 0.f};
        cur = nxt; nxt = nn; has_next = has_nn; cB = nB; cAb = nAb; ++ui;
#pragma unroll
        for (int h = 0; h < 2; ++h)
#pragma unroll
            for (int i = 0; i < 2; ++i) rawN[h][i] = rawNN[h][i];
        if constexpr (Sched::GATHER) {
#pragma unroll
            for (int h = 0; h < 2; ++h)
#pragma unroll
                for (int i = 0; i < 2; ++i) vA[h][i] = vN[h][i]; }
        if constexpr (ALIGN_EPI) { if (wr == 1) PG8_BAR; }
    }
    PG8_WAIT_V(0);
    if constexpr (!ALIGN_EPI) { if (wr == 0) PG8_BAR; }
    PG8_BAR;
#undef PG8_SA
#undef PG8_SB
#undef PG8_STAGEA
#undef PG8_VA
#undef PG8_VN
#undef PG8_BA
#undef PG8_BN
#undef PG8_STAGEB
#undef PG8_LDA
#undef PG8_LDB
#undef PG8_MMA
#undef PG8_WAIT_V
#undef PG8_WAIT_L
#undef PG8_BAR
#undef PG8_SCHED
#undef PG8_OFFS
#undef PG8_OFFS_RAW
#undef PG8_OFFS_FIN
}

__device__ __forceinline__ void ph_fox_gate(const Args& A, int j, int wg, int G, int g_wid) {
    PH_IDS;
    const bf16* hb = (const bf16*)(A.ws + WS_HB); const bf16* wfg = (const bf16*)(A.ws + WS_WFG) + (size_t)j * 16 * DM; float* lf = (float*)(A.ws + WS_LF);
    const float* bfg = A.in[I_BFG] + j * HS;
    const int gw = wg * NWAVES + wid, NGW = G * NWAVES;
    v4u wv[HS][2];
#pragma unroll
    for (int hh = 0; hh < HS; ++hh) { const v4u* wp = (const v4u*)(wfg + (size_t)hh * DM + 16 * lane); wv[hh][0] = wp[0]; wv[hh][1] = wp[1]; }
    v4u p0 = {0u, 0u, 0u, 0u}, p1 = {0u, 0u, 0u, 0u};
    if (gw < NTOK) { const v4u* hp = (const v4u*)(hb + (size_t)gw * DM + 16 * lane); p0 = hp[0]; p1 = hp[1]; }
    for (int n = gw; n < NTOK; n += NGW) {
        const v4u h0 = p0, h1 = p1;
        if (n + NGW < NTOK) { const v4u* hp = (const v4u*)(hb + (size_t)(n + NGW) * DM + 16 * lane); p0 = hp[0]; p1 = hp[1]; }
        float hv[16] = {bflo(h0.x), bfhi(h0.x), bflo(h0.y), bfhi(h0.y), bflo(h0.z), bfhi(h0.z), bflo(h0.w), bfhi(h0.w), bflo(h1.x), bfhi(h1.x), bflo(h1.y), bfhi(h1.y), bflo(h1.z), bfhi(h1.z), bflo(h1.w), bfhi(h1.w)};
        float mine = 0.f;
#pragma unroll
        for (int hh = 0; hh < HS; ++hh) {
            const v4u w0 = wv[hh][0], w1 = wv[hh][1];
            float s = hv[0] * bflo(w0.x) + hv[1] * bfhi(w0.x) + hv[2] * bflo(w0.y) + hv[3] * bfhi(w0.y) + hv[4] * bflo(w0.z) + hv[5] * bfhi(w0.z) + hv[6] * bflo(w0.w) + hv[7] * bfhi(w0.w)
                    + hv[8] * bflo(w1.x) + hv[9] * bfhi(w1.x) + hv[10] * bflo(w1.y) + hv[11] * bfhi(w1.y) + hv[12] * bflo(w1.z) + hv[13] * bfhi(w1.z) + hv[14] * bflo(w1.w) + hv[15] * bfhi(w1.w);
            s = wave_sum(s);
            if (lane == hh) mine = s;
        }
        if (lane < HS) { const float z = mine + bfg[lane];
            const float ls = fminf(z, 0.f) - __builtin_amdgcn_logf(1.f + fexp2(-fabsf(z) * LOG2E)) * 0.6931471805599453f;
            const int b = n >> 13, t = n & (SEQ - 1); lf[((size_t)(b * HS + lane)) * SEQ + t] = ls; }
    }
}
__device__ __forceinline__ void ph_fox_scan(const Args& A, LAS unsigned char* lds, int wg, int G, int g_wid) {
    PH_IDS;
    const float* lf = (const float*)(A.ws + WS_LF); float* c2 = (float*)(A.ws + WS_CFOX); LAS float* part = (LAS float*)lds;
    for (int s = wg; s < NB * HS; s += G) {
        const float* src = lf + (size_t)s * SEQ + tid * 16; float v[16]; float run = 0.f;
#pragma unroll
        for (int i = 0; i < 16; ++i) { run += src[i]; v[i] = run; }
        part[tid] = run; __syncthreads();
        if (tid == 0) { float acc = 0.f; for (int i = 0; i < NTHR; ++i) { const float x = part[i]; part[i] = acc; acc += x; } }
        __syncthreads();
        const float base = part[tid]; float* dst = c2 + (size_t)s * SEQ + tid * 16;
#pragma unroll
        for (int i = 0; i < 16; ++i) dst[i] = (base + v[i]) * LOG2E;
        __syncthreads();
    }
}
__device__ __forceinline__ void ph_kbar(const Args& A, LAS unsigned char* lds, int wg, int G, int g_wid) {
    PH_IDS;
    const bf16* proj = (const bf16*)(A.ws + WS_PROJ); float* kbar = (float*)(A.ws + WS_KBAR); LAS float* part = (LAS float*)lds;
    const int d = tid & 63, r8 = tid >> 6;
    for (int uidx = wg; uidx < NB * HS * 32; uidx += G) {
        const int j = uidx & 31, bh = uidx >> 5, b = bh / HS, h = bh % HS;
        const bf16* kp = proj + ((size_t)(b * SEQ + j * 256 + r8 * 32)) * NPROJ + K_COL + h * 64 + d;
        float s = 0.f;
        for (int r = 0; r < 32; ++r) s += __uint_as_float((unsigned)kp[(size_t)r * NPROJ] << 16);
        part[tid] = s; __syncthreads();
        if (tid < 64) { float t = 0.f;
#pragma unroll
            for (int q = 0; q < 8; ++q) t += part[q * 64 + tid];
            kbar[(size_t)uidx * 64 + tid] = t * (1.f / 256.f); ((bf16*)(A.ws + WS_KBAR + 512 * 1024))[(size_t)uidx * 64 + tid] = (bf16)f2bf(t * (1.f / 256.f)); }
        __syncthreads();
    }
}

__device__ __forceinline__ float alibi_slope(int h) { return h < 8 ? exp2f(-(float)(h + 1)) : exp2f(-(0.5f + (float)(h - 8))); }
#define ROW8(w, base, arr) do { arr[base + 0] = bflo(w.x); arr[base + 1] = bfhi(w.x); arr[base + 2] = bflo(w.y); arr[base + 3] = bfhi(w.y); arr[base + 4] = bflo(w.z); arr[base + 5] = bfhi(w.z); arr[base + 6] = bflo(w.w); arr[base + 7] = bfhi(w.w); } while (0)
__device__ __forceinline__ float dot_row64(const float (&q)[64], const bf16* p) {
    const v4u* p4 = (const v4u*)p; float s0 = 0.f, s1 = 0.f;
#pragma unroll
    for (int i = 0; i < 8; ++i) { if (i == 4) asm volatile("" ::: "memory"); const v4u w = p4[i];
        s0 += q[8 * i + 0] * bflo(w.x); s1 += q[8 * i + 1] * bfhi(w.x); s0 += q[8 * i + 2] * bflo(w.y); s1 += q[8 * i + 3] * bfhi(w.y);
        s0 += q[8 * i + 4] * bflo(w.z); s1 += q[8 * i + 5] * bfhi(w.z); s0 += q[8 * i + 6] * bflo(w.w); s1 += q[8 * i + 7] * bfhi(w.w); }
    return s0 + s1;
}
__device__ __forceinline__ void att_upd(float x, const bf16* vrow, float& m, float& l, float (&o)[64]) {
    const float mn = fmaxf(m, x), al = fexp2(m - mn), pp = fexp2(x - mn); m = mn; l = l * al + pp;
    const v4u* p4 = (const v4u*)vrow; asm volatile("" ::: "memory");
#pragma unroll
    for (int i = 0; i < 8; ++i) { if ((i & 1) == 0) asm volatile("" ::: "memory"); const v4u w = p4[i];
        o[8 * i + 0] = o[8 * i + 0] * al + pp * bflo(w.x); o[8 * i + 1] = o[8 * i + 1] * al + pp * bfhi(w.x); o[8 * i + 2] = o[8 * i + 2] * al + pp * bflo(w.y); o[8 * i + 3] = o[8 * i + 3] * al + pp * bfhi(w.y);
        o[8 * i + 4] = o[8 * i + 4] * al + pp * bflo(w.z); o[8 * i + 5] = o[8 * i + 5] * al + pp * bfhi(w.z); o[8 * i + 6] = o[8 * i + 6] * al + pp * bflo(w.w); o[8 * i + 7] = o[8 * i + 7] * al + pp * bfhi(w.w); }
}
template <int MODE, int H_LO = 0, int H_HI = 16>
__device__ __forceinline__ void ph_attn_naive(const Args& A, int wg, int G, int g_wid) {
    PH_IDS;
    const bf16* proj = (const bf16*)(A.ws + WS_PROJ); const bf16* mkv = (const bf16*)(A.ws + WS_MKV); bf16* att = (bf16*)(A.ws + WS_ATT);
    const float* kbar = (const float*)(A.ws + WS_KBAR); const float* cfox = (const float*)(A.ws + WS_CFOX);
    constexpr int NIT = 16 * (NTOK / 64);
    const int gw = wg * NWAVES + wid, NGW = G * NWAVES;
    for (int base = 0, rnd = 0; base < NIT; base += NGW, ++rnd) {
        const int it = base + ((rnd & 1) ? (NGW - 1 - gw) : gw);
        if (it >= NIT) continue;
        const int hh = it & 15, tg = it >> 4, n = tg * 64 + lane, b = n >> 13, t = n & (SEQ - 1);
        if (hh < H_LO || hh >= H_HI) continue;
        float q[64];
        { const v4u* p4 = (const v4u*)(proj + (size_t)n * NPROJ + (hh < HS ? hh * 64 : QM_COL + (hh - HS) * 64));
#pragma unroll
          for (int i = 0; i < 8; ++i) { const v4u w = p4[i]; ROW8(w, 8 * i, q); } }
        float m = -1e30f, l = 0.f; float o[64];
#pragma unroll
        for (int i = 0; i < 64; ++i) o[i] = 0.f;
        if (hh < HS) {
            const bf16* Kb = proj + (size_t)(b * SEQ) * NPROJ + K_COL + hh * 64; const bf16* Vb = Kb + (V_COL - K_COL);
            if (MODE == 0) {
                const float slope2 = alibi_slope(hh) * LOG2E; const int qb = t >> 8;
                const float* kb = kbar + (size_t)((b * HS + hh) * 32) * 64;
                float g0 = -INFINITY, g1 = -INFINITY, g2 = -INFINITY; int i0 = -1, i1 = -1, i2 = -1;
                for (int j = 0; j < qb; ++j) { float s0 = 0.f, s1 = 0.f;
#pragma unroll
                    for (int d = 0; d < 64; d += 2) { s0 += q[d] * kb[j * 64 + d]; s1 += q[d + 1] * kb[j * 64 + d + 1]; }
                    const float g = s0 + s1;
                    if (g > g0) { g2 = g1; i2 = i1; g1 = g0; i1 = i0; g0 = g; i0 = j; } else if (g > g1) { g2 = g1; i2 = i1; g1 = g; i1 = j; } else if (g > g2) { g2 = g; i2 = j; } }
                const int tend = (t | 63);
                for (int s = qb * 256; s <= tend; ++s) { if (s <= t) { const float x = dot_row64(q, Kb + (size_t)s * NPROJ) - slope2 * (float)(t - s); att_upd(x, Vb + (size_t)s * NPROJ, m, l, o); } }
                for (int sl = 0; sl < 3; ++sl) { const int jb = sl == 0 ? i0 : (sl == 1 ? i1 : i2);
                    if (jb >= 0) for (int s = 0; s < 256; ++s) { const int key = jb * 256 + s; const float x = dot_row64(q, Kb + (size_t)key * NPROJ) - slope2 * (float)(t - key); att_upd(x, Vb + (size_t)key * NPROJ, m, l, o); } }
            } else {
                const float* c2 = cfox + (size_t)(b * HS + hh) * SEQ; const float cq = c2[t]; const int tend = (t | 63);
                for (int s = 0; s <= tend; ++s) { if (s <= t) { const float x = dot_row64(q, Kb + (size_t)s * NPROJ) + (cq - c2[s]); att_upd(x, Vb + (size_t)s * NPROJ, m, l, o); } }
            }
        } else {
            const bf16* Kb = mkv + (size_t)(b * NMEM) * 512 + (hh - HS) * 64; const bf16* Vb = Kb + 256;
            for (int s = 0; s < NMEM; ++s) { const float x = dot_row64(q, Kb + (size_t)s * 512); att_upd(x, Vb + (size_t)s * 512, m, l, o); }
        }
        const float rl = 1.f / l; v4u* op = (v4u*)(att + (size_t)n * DM + hh * 64);
#pragma unroll
        for (int i = 0; i < 8; ++i) { v4u w; w.x = pk2(o[8 * i] * rl, o[8 * i + 1] * rl); w.y = pk2(o[8 * i + 2] * rl, o[8 * i + 3] * rl); w.z = pk2(o[8 * i + 4] * rl, o[8 * i + 5] * rl); w.w = pk2(o[8 * i + 6] * rl, o[8 * i + 7] * rl); op[i] = w; }
    }
}


__device__ __forceinline__ void ph_norms(const Args& A, int layer, LAS unsigned char* lds, int wg, int G, int g_wid) {
    PH_IDS;
    const bf16* proj = (const bf16*)(A.ws + WS_PROJ); unsigned* gn = (unsigned*)(A.ws + WS_CTL) + CW_NORM + layer * 128;
    LAS unsigned* ln = (LAS unsigned*)(lds + 65536);
    if (tid < 128) ln[tid] = 0u;
    __syncthreads();
    const int gt = wg * NTHR + tid, NGT = G * NTHR;
    for (int it = gt; it < NTOK * 4; it += NGT) {
        const int n = it >> 2, part = it & 3, b = n >> 13;
#pragma unroll
        for (int hq = 0; hq < 3; ++hq) { const int hh = part * 3 + hq;
#pragma unroll
            for (int kq = 0; kq < 2; ++kq) { const v4u* p4 = (const v4u*)(proj + (size_t)n * NPROJ + kq * K_COL + hh * 64); float s = 0.f;
#pragma unroll
                for (int i = 0; i < 8; ++i) { const v4u w = p4[i]; const float a0 = bflo(w.x), a1 = bfhi(w.x), a2 = bflo(w.y), a3 = bfhi(w.y), a4 = bflo(w.z), a5 = bfhi(w.z), a6 = bflo(w.w), a7 = bfhi(w.w);
                    s += (a0 * a0 + a1 * a1) + (a2 * a2 + a3 * a3) + (a4 * a4 + a5 * a5) + (a6 * a6 + a7 * a7); }
                atomicMax((unsigned*)ln + (b * HS + hh) * 2 + kq, __float_as_uint(s)); } }
    }
    __syncthreads();
    if (tid < 96) { const unsigned v = ln[tid]; if (v) __hip_atomic_fetch_max(gn + tid, v, __ATOMIC_RELAXED, __HIP_MEMORY_SCOPE_AGENT); }
    __syncthreads();
}

typedef float f32x16 __attribute__((ext_vector_type(16)));
typedef short s16x4 __attribute__((ext_vector_type(4)));
__device__ __forceinline__ int crow(int r, int hi) { return (r & 3) + 8 * (r >> 2) + 4 * hi; }
#define ATT_WAIT_BAR() asm volatile("s_waitcnt vmcnt(0) lgkmcnt(0)\n\ts_barrier" ::: "memory")
constexpr int ATT_K = 0, ATT_V = 16384, ATT_CK = 32768;
constexpr float ATT_THR = 8.0f, ATT_THETA = 45.0f;
__device__ __forceinline__ float max3f(float a, float b, float c) { float r; asm("v_max3_f32 %0, %1, %2, %3" : "=v"(r) : "v"(a), "v"(b), "v"(c)); return r; }
__device__ __forceinline__ float max2f(float a, float b) { float r; asm("v_max_f32_e32 %0, %1, %2" : "=v"(r) : "v"(a), "v"(b)); return r; }
__device__ __forceinline__ float swap_other(float v, int hi) { auto rr = __builtin_amdgcn_permlane32_swap(__float_as_uint(v), __float_as_uint(v), false, false); return __uint_as_float(hi ? rr[0] : rr[1]); }
__device__ __forceinline__ int swap_other_i(int v, int hi) { auto rr = __builtin_amdgcn_permlane32_swap((unsigned)v, (unsigned)v, false, false); return (int)(hi ? rr[0] : rr[1]); }

template <int MODE>
__device__ __forceinline__ void attn_unit(const Args& A, LAS unsigned char* lds, const int layer, const int b, const int h, const int qb, const int wid, const int lane) {
    const int r32 = lane & 31, hi = lane >> 5, q0 = qb * 256, wrow0 = q0 + wid * 32, trow = wrow0 + r32;
    const bf16* proj = (const bf16*)(A.ws + WS_PROJ);
    constexpr int pitch = (MODE == 2) ? 512 : NPROJ;
    const bf16* Kb = (MODE == 2) ? (const bf16*)(A.ws + WS_MKV) + (size_t)(b * NMEM) * 512 + h * 64 : proj + (size_t)(b * SEQ) * NPROJ + K_COL + h * 64;
    const bf16* Vb = (MODE == 2) ? Kb + 256 : Kb + (V_COL - K_COL);
    const bf16* Qrow = proj + (size_t)(b * SEQ + trow) * NPROJ + ((MODE == 2) ? QM_COL : 0) + h * 64;
    bf16x8 qr[4];
#pragma unroll
    for (int d0 = 0; d0 < 4; ++d0) qr[d0] = *(const bf16x8*)(Qrow + 16 * d0 + 8 * hi);
    const unsigned ldsb = (unsigned)(uintptr_t)lds;
    const bf16* ksrc = Kb + (size_t)lane * pitch + wid * 8;
    const bf16* vsrc = Vb + (size_t)(16 * (wid & 3) + (lane >> 2)) * pitch + (wid >> 2) * 32 + (lane & 3) * 8;
    float cq = 0.f, slope2 = 0.f; const float* c2 = nullptr;
    if (MODE == 1) { c2 = (const float*)(A.ws + WS_CFOX) + (size_t)(b * HS + h) * SEQ; cq = c2[trow]; }
    if (MODE == 0) { slope2 = alibi_slope(h) * LOG2E; cq = -slope2 * (float)(trow - q0); }
#define ATT_STAGE(kt, buf) do { glds16(ksrc + (size_t)(kt) * 64 * pitch, (unsigned)__builtin_amdgcn_readfirstlane(ldsb + ATT_K + (buf) * 8192 + wid * 1024)); \
        glds16(vsrc + (size_t)(kt) * 64 * pitch, (unsigned)__builtin_amdgcn_readfirstlane(ldsb + ATT_V + (buf) * 8192 + wid * 1024)); \
        if (MODE == 1 && wid == 0) glds4(c2 + (kt) * 64 + lane, (unsigned)__builtin_amdgcn_readfirstlane(ldsb + ATT_CK + (buf) * 256)); \
        if (MODE == 0 && wid == 0) ((LAS float*)(lds + ATT_CK + (buf) * 256))[lane] = -slope2 * (float)((kt) * 64 + lane - q0); } while (0)
    unsigned gnv[4] = {0u, 0u, 0u, 0u}; float cA = 0.f, cB = 0.f, cq0 = 0.f;
    if (MODE != 2) { const unsigned* gn = (const unsigned*)(A.ws + WS_CTL) + CW_NORM + layer * 256 + (b * HS + h) * 4; gnv[0] = gn[0]; gnv[1] = gn[1]; gnv[2] = gn[2]; gnv[3] = gn[3]; }
    const int ktA = 4 * qb - 1 - lane, ktB = ktA - 64;
    if (MODE == 1) { if (qb > 0) { cq0 = c2[q0]; if (ktA >= 0) cA = c2[64 * ktA + 63]; if (ktB >= 0) cB = c2[64 * ktB + 63]; } }
    f32x4 kv[4][2];
    if (MODE == 0) { if (qb > 0) { const float* kbp = (const float*)(A.ws + WS_KSUM) + (size_t)(layer >> 1) * (NB * HS * 32 * 64) + ((size_t)((b * HS + h) * 32 + r32)) * 64 + 8 * hi;
#pragma unroll
        for (int d0 = 0; d0 < 4; ++d0) { kv[d0][0] = *(const f32x4*)(kbp + 16 * d0); kv[d0][1] = *(const f32x4*)(kbp + 16 * d0 + 4); } } }
    ATT_STAGE((MODE == 2) ? 3 : 4 * qb + 3, 0);
    unsigned selmask = 0u;
    if (MODE == 0) { if (qb > 0) {
        f32x16 g;
#pragma unroll
        for (int i = 0; i < 16; ++i) g[i] = 0.f;
#pragma unroll
        for (int d0 = 0; d0 < 4; ++d0) { const f32x4 ka = kv[d0][0] * (1.f / 256.f), kc = kv[d0][1] * (1.f / 256.f);
            v4u kw; kw.x = pk2(ka.x, ka.y); kw.y = pk2(ka.z, ka.w); kw.z = pk2(kc.x, kc.y); kw.w = pk2(kc.z, kc.w);
            g = __builtin_amdgcn_mfma_f32_32x32x16_bf16(__builtin_bit_cast(bf16x8, kw), qr[d0], g, 0, 0, 0); }
#pragma unroll
        for (int i = 0; i < 16; ++i) if (crow(i, hi) >= qb) g[i] = -INFINITY;
#pragma unroll
        for (int pick = 0; pick < 3; ++pick) {
            float bv = -INFINITY; int bj = 64;
#pragma unroll
            for (int i = 0; i < 16; ++i) if (g[i] > bv) { bv = g[i]; bj = crow(i, hi); }
            const float pv = swap_other(bv, hi); const int pj = swap_other_i(bj, hi);
            if (pv > bv || (pv == bv && pj < bj)) { bv = pv; bj = pj; }
            if (bv > -INFINITY) { selmask |= 1u << bj;
#pragma unroll
                for (int i = 0; i < 16; ++i) if (crow(i, hi) == bj) g[i] = -INFINITY; }
        } } }
    float SKIP = -INFINITY, SKIPW = -INFINITY; int klo = 0;
    if (MODE != 2) {
        const float kmax2 = __uint_as_float(gnv[1]) + __uint_as_float(gnv[3]);
        const float Bq = sqrtf((__uint_as_float(gnv[0]) + __uint_as_float(gnv[2])) * kmax2); SKIP = -(ATT_THETA + 2.02f * Bq + 0.01f);
        float q2 = 0.f;
#pragma unroll
        for (int d0 = 0; d0 < 4; ++d0) { const v4u w = __builtin_bit_cast(v4u, qr[d0]); const float a0 = bflo(w.x), a1 = bfhi(w.x), a2 = bflo(w.y), a3 = bfhi(w.y), a4 = bflo(w.z), a5 = bfhi(w.z), a6 = bflo(w.w), a7 = bfhi(w.w);
            q2 += (a0 * a0 + a1 * a1) + (a2 * a2 + a3 * a3) + (a4 * a4 + a5 * a5) + (a6 * a6 + a7 * a7); }
        q2 += swap_other(q2, hi);
        SKIPW = -(ATT_THETA + 2.02f * sqrtf(wave_max(q2) * kmax2) + 0.01f); }
    if (MODE == 0) { if (qb > 0) { const float fl = ((float)(q0 - 63) + SKIP / slope2) * (1.f / 64.f); klo = fl <= 0.f ? 0 : (int)ceilf(fl); if (klo > 4 * qb) klo = 4 * qb; } }
    if (MODE == 1) { if (qb > 0) {
        const unsigned long long mkA = __builtin_amdgcn_ballot_w64(ktA >= 0 && (cq0 - cA) < SKIP);
        if (mkA) klo = 4 * qb - 1 - (int)__builtin_ctzll(mkA) + 1;
        else { const unsigned long long mkB = __builtin_amdgcn_ballot_w64(ktB >= 0 && (cq0 - cB) < SKIP); if (mkB) klo = 4 * qb - 1 - 64 - (int)__builtin_ctzll(mkB) + 1; } } }
    const float cw = __builtin_bit_cast(float, __builtin_amdgcn_readfirstlane(__builtin_bit_cast(int, cq)));
    const int ktop = (MODE == 2) ? 3 : 4 * qb + 3, ntile = ktop - klo + 1;
    float mhat = 0.f, lsum = 0.f; bool started = false;
    f32x16 o0, o1;
#pragma unroll
    for (int i = 0; i < 16; ++i) { o0[i] = 0.f; o1[i] = 0.f; }
    const LAS unsigned char* vp0 = lds + ATT_V + ((lane >> 4) & 1) * 32 + (lane & 3) * 8 + (4 * hi + ((lane & 15) >> 2)) * 64;
    for (int it = 0; it < ntile; ++it) {
        const int kt = ktop - it, buf = it & 1;
        ATT_WAIT_BAR();
        if (it + 1 < ntile) ATT_STAGE(kt - 1, buf ^ 1);
        bool active = true, diag = false, selv = true;
        if (MODE != 2) {
            if (kt * 64 > wrow0 + 31) active = false;
            diag = (kt * 64 + 63 > wrow0);
            if (MODE == 0) { const int j = kt >> 2; if (j < qb) { selv = ((selmask >> j) & 1u) != 0u; if (__builtin_amdgcn_ballot_w64(selv) == 0ull) active = false; } }
            if (active && kt * 64 + 63 < wrow0) {
                if (MODE == 0) { if (-slope2 * (float)(wrow0 - kt * 64 - 63) < SKIPW) active = false; }
                if (MODE == 1) { const float cke = __builtin_bit_cast(float, __builtin_amdgcn_readfirstlane(__builtin_bit_cast(int, ((const LAS float*)(lds + ATT_CK + buf * 256))[63]))); if (cw - cke < SKIPW) active = false; } }
        }
        if (active) {
            f32x16 p0, p1;
            const float bs = (MODE == 2) ? -mhat : (selv ? cq - mhat : -INFINITY);
            if (MODE == 2) {
#pragma unroll
                for (int r = 0; r < 16; ++r) { p0[r] = bs; p1[r] = bs; }
            } else {
                const LAS f32x4* ckp = (const LAS f32x4*)(lds + ATT_CK + buf * 256);
#pragma unroll
                for (int g = 0; g < 4; ++g) { const f32x4 c = ckp[2 * g + hi], d = ckp[8 + 2 * g + hi];
                    p0[4 * g] = bs - c.x; p0[4 * g + 1] = bs - c.y; p0[4 * g + 2] = bs - c.z; p0[4 * g + 3] = bs - c.w;
                    p1[4 * g] = bs - d.x; p1[4 * g + 1] = bs - d.y; p1[4 * g + 2] = bs - d.z; p1[4 * g + 3] = bs - d.w; }
            }
            const LAS unsigned char* kb = lds + ATT_K + buf * 8192 + hi * 1024 + r32 * 16;
#pragma unroll
            for (int d0 = 0; d0 < 4; ++d0) { const bf16x8 k0 = *(const LAS bf16x8*)(kb + d0 * 2048), k1 = *(const LAS bf16x8*)(kb + d0 * 2048 + 512);
                p0 = __builtin_amdgcn_mfma_f32_32x32x16_bf16(k0, qr[d0], p0, 0, 0, 0); p1 = __builtin_amdgcn_mfma_f32_32x32x16_bf16(k1, qr[d0], p1, 0, 0, 0); }
            asm volatile("s_nop 15\n\ts_nop 7" : "+v"(p0), "+v"(p1));
            if (diag) {
#pragma unroll
                for (int r = 0; r < 16; ++r) { const int kv = kt * 64 + crow(r, hi); if (kv > trow) p0[r] = -INFINITY; if (kv + 32 > trow) p1[r] = -INFINITY; }
            }
            float rm;
            { float a_ = max3f(p0[0], p0[1], p1[0]), b_ = max3f(p0[2], p0[3], p1[1]); a_ = max3f(a_, p1[2], p1[3]);
#pragma unroll
              for (int r = 4; r < 16; r += 4) { a_ = max3f(a_, p0[r], p0[r + 1]); b_ = max3f(b_, p0[r + 2], p0[r + 3]); a_ = max3f(a_, p1[r], p1[r + 1]); b_ = max3f(b_, p1[r + 2], p1[r + 3]); }
              rm = max2f(a_, b_); }
            rm = max2f(rm, swap_other(rm, hi));
            const bool need = started ? (__builtin_amdgcn_ballot_w64(rm > ATT_THR) != 0ull) : true;
            if (need) { const float dl = started ? fmaxf(rm, 0.f) : rm; mhat += dl;
#pragma unroll
                for (int r = 0; r < 16; ++r) { p0[r] -= dl; p1[r] -= dl; }
                if (started) { const float f = fexp2(-dl); lsum *= f;
#pragma unroll
                    for (int r = 0; r < 16; ++r) { o0[r] *= f; o1[r] *= f; } }
                started = true; }
            float s0 = 0.f, s1 = 0.f;
#pragma unroll
            for (int r = 0; r < 16; ++r) { p0[r] = fexp2(p0[r]); p1[r] = fexp2(p1[r]); s0 += p0[r]; s1 += p1[r]; }
            lsum += s0 + s1;
            bf16x8 pa[4];
#pragma unroll
            for (int ks = 0; ks < 4; ++ks) { v4u w;
                if (ks < 2) { w.x = pk2(p0[8 * ks], p0[8 * ks + 1]); w.y = pk2(p0[8 * ks + 2], p0[8 * ks + 3]); w.z = pk2(p0[8 * ks + 4], p0[8 * ks + 5]); w.w = pk2(p0[8 * ks + 6], p0[8 * ks + 7]); }
                else { const int k2 = ks - 2; w.x = pk2(p1[8 * k2], p1[8 * k2 + 1]); w.y = pk2(p1[8 * k2 + 2], p1[8 * k2 + 3]); w.z = pk2(p1[8 * k2 + 4], p1[8 * k2 + 5]); w.w = pk2(p1[8 * k2 + 6], p1[8 * k2 + 7]); }
                pa[ks] = __builtin_bit_cast(bf16x8, w); }
            const LAS unsigned char* vp = vp0 + buf * 8192;
#pragma unroll
            for (int ks = 0; ks < 4; ++ks) {
#pragma unroll
                for (int d0 = 0; d0 < 2; ++d0) {
                    const s16x4 lo = __builtin_bit_cast(s16x4, __builtin_amdgcn_ds_read_tr16_b64_v4i16((LAS s16x4*)(vp + d0 * 4096 + ks * 1024)));
                    const s16x4 hh = __builtin_bit_cast(s16x4, __builtin_amdgcn_ds_read_tr16_b64_v4i16((LAS s16x4*)(vp + d0 * 4096 + ks * 1024 + 512)));
                    const bf16x8 vf = (bf16x8){lo[0], lo[1], lo[2], lo[3], hh[0], hh[1], hh[2], hh[3]};
                    if (d0 == 0) o0 = __builtin_amdgcn_mfma_f32_32x32x16_bf16(vf, pa[ks], o0, 0, 0, 0); else o1 = __builtin_amdgcn_mfma_f32_32x32x16_bf16(vf, pa[ks], o1, 0, 0, 0); } }
        }
    }
    ATT_WAIT_BAR();
    lsum += swap_other(lsum, hi);
    const float rl = 1.f / lsum;
    bf16* Op = (bf16*)(A.ws + WS_ATT) + (size_t)(b * SEQ + trow) * DM + ((MODE == 2) ? HS * 64 : 0) + h * 64 + 4 * hi;
#pragma unroll
    for (int g = 0; g < 4; ++g) {
        v2u w0, w1; w0.x = pk2(o0[4 * g] * rl, o0[4 * g + 1] * rl); w0.y = pk2(o0[4 * g + 2] * rl, o0[4 * g + 3] * rl);
        w1.x = pk2(o1[4 * g] * rl, o1[4 * g + 1] * rl); w1.y = pk2(o1[4 * g + 2] * rl, o1[4 * g + 3] * rl);
        *(v2u*)(Op + 8 * g) = w0; *(v2u*)(Op + 32 + 8 * g) = w1; }
#undef ATT_STAGE
}
template <int MODE01>
__device__ __forceinline__ void ph_attn_fast(const Args& A, int layer, int rep, LAS unsigned char* lds, int wg, int G, int g_wid) {
    PH_IDS;
    constexpr int NSELF = NB * HS * 32, NU = NSELF + NB * HMEM * 32;
    unsigned* qh = (unsigned*)(A.ws + WS_CTL) + CW_AQ + layer * 64 + rep;
    volatile LAS int* qs = (volatile LAS int*)(lds + MISC_OFF) + 32;
    constexpr int NCH = CVT_N_MOE / CVT_CHUNK;
    unsigned* ch = qh + 16;
    if (tid == 0) { qs[0] = (int)__hip_atomic_fetch_add(qh, 1u, __ATOMIC_RELAXED, __HIP_MEMORY_SCOPE_AGENT); qs[1] = (rep == 0) ? (int)__hip_atomic_fetch_add(ch, 1u, __ATOMIC_RELAXED, __HIP_MEMORY_SCOPE_AGENT) : NCH; }
    __syncthreads();
    int L = __builtin_amdgcn_readfirstlane(qs[0]), C = __builtin_amdgcn_readfirstlane(qs[1]);
    __syncthreads();
    while (L < NU || C < NCH) {
        if (L < NU) {
            int nxt = 0;
            if (tid == 0) nxt = (int)__hip_atomic_fetch_add(qh, 1u, __ATOMIC_RELAXED, __HIP_MEMORY_SCOPE_AGENT);
            if (L < NSELF) { const int qb = 31 - L / (NB * HS), bh = L % (NB * HS); attn_unit<MODE01>(A, lds, layer, bh / HS, bh % HS, qb, wid, lane); }
            else { const int m = L - NSELF, qb = m & 31, bhm = m >> 5; attn_unit<2>(A, lds, layer, bhm >> 2, bhm & 3, qb, wid, lane); }
            if (tid == 0) qs[0] = nxt;
            __syncthreads();
            L = __builtin_amdgcn_readfirstlane(qs[0]);
            __syncthreads();
        }
        if (C < NCH) {
            int nxt = 0;
            if (tid == 0) nxt = (int)__hip_atomic_fetch_add(ch, 1u, __ATOMIC_RELAXED, __HIP_MEMORY_SCOPE_AGENT);
            cvt_moe_chunk(A, layer, C, lds, wid, lane);
            if (tid == 0) qs[1] = nxt;
            __syncthreads();
            C = __builtin_amdgcn_readfirstlane(qs[1]);
            __syncthreads();
        }
    }
}

__device__ __forceinline__ void ph_ln1_router(const Args& A, int layer, LAS unsigned char* lds, int wg, int G, int g_wid) {
    PH_IDS;
    bf16* hb = (bf16*)(A.ws + WS_HB); unsigned* elist = (unsigned*)(A.ws + WS_ELIST);
    unsigned* ecnt = (unsigned*)(A.ws + WS_CTL) + CW_ECNT + layer * 64;
    const float* rw = A.in[I_RW] + (size_t)layer * DM * NEXP; const float* rb = A.in[I_RB] + layer * NEXP;
    const float* g1 = A.in[I_LN1G] + layer * DM; const float* b1 = A.in[I_LN1B] + layer * DM;
    constexpr int RP = 1028;
    LAS float* rwT = (LAS float*)lds; LAS int* lcnt = (LAS int*)(lds + 32 * RP * 4); LAS int* gbase = lcnt + 32; LAS unsigned* rec = (LAS unsigned*)(lds + 32 * RP * 4 + 512);
    const int RPW = (NTOK + G - 1) / G;
    for (int i = tid; i < DM * NEXP; i += NTHR) rwT[(i & 31) * RP + (i >> 5)] = rw[i];
    if (tid < 32) lcnt[tid] = 0;
    __syncthreads();
    const int row0 = wg * RPW, row1 = (row0 + RPW < NTOK) ? row0 + RPW : NTOK;
    const float rbl = rb[lane & 31];
    v2u raw[4][4], rawn[4][4];
#define LN1_LOAD(nb_, R) do { _Pragma("unroll") for (int r = 0; r < 4; ++r) { const int n_ = ((nb_) + r < row1) ? (nb_) + r : row1 - 1; _Pragma("unroll") for (int j = 0; j < 4; ++j) R[r][j] = *(const v2u*)(hb + (size_t)n_ * DM + 4 * lane + 256 * j); } } while (0)
    if (row0 + wid * 4 < row1) LN1_LOAD(row0 + wid * 4, raw);
    for (int nb = row0 + wid * 4; nb < row1; nb += NWAVES * 4) {
        if (nb + NWAVES * 4 < row1) LN1_LOAD(nb + NWAVES * 4, rawn);
        f32x4 v[4][4];
#pragma unroll
        for (int r = 0; r < 4; ++r) { const int n = (nb + r < row1) ? nb + r : row1 - 1; float s = 0.f;
#pragma unroll
            for (int j = 0; j < 4; ++j) { const v2u w = raw[r][j]; v[r][j] = (f32x4){bflo(w.x), bfhi(w.x), bflo(w.y), bfhi(w.y)}; s += (v[r][j].x + v[r][j].y) + (v[r][j].z + v[r][j].w); }
            const float mean = wave_sum(s) * (1.f / DM); float s2 = 0.f;
#pragma unroll
            for (int j = 0; j < 4; ++j) { v[r][j] = v[r][j] - mean; s2 += (v[r][j].x * v[r][j].x + v[r][j].y * v[r][j].y) + (v[r][j].z * v[r][j].z + v[r][j].w * v[r][j].w); }
            const float rstd = 1.f / sqrtf(wave_sum(s2) * (1.f / DM) + LN_EPS);
#pragma unroll
            for (int j = 0; j < 4; ++j) { const f32x4 gg = *(const f32x4*)(g1 + 4 * lane + 256 * j), bb = *(const f32x4*)(b1 + 4 * lane + 256 * j);
                v[r][j] = v[r][j] * rstd * gg + bb;
                v2u w; w.x = pk2(v[r][j].x, v[r][j].y); w.y = pk2(v[r][j].z, v[r][j].w); *(v2u*)(hb + (size_t)n * DM + 4 * lane + 256 * j) = w; } }
        float mine[4] = {0.f, 0.f, 0.f, 0.f};
#pragma unroll
        for (int e = 0; e < 32; ++e) { f32x4 r4[4];
#pragma unroll
            for (int j = 0; j < 4; ++j) r4[j] = *(const LAS f32x4*)(rwT + e * RP + 4 * lane + 256 * j);
            float p[4];
#pragma unroll
            for (int r = 0; r < 4; ++r) { f32x2_t a2 = {0.f, 0.f};
#pragma unroll
                for (int j = 0; j < 4; ++j) { a2 += (f32x2_t){v[r][j].x, v[r][j].y} * (f32x2_t){r4[j].x, r4[j].y}; a2 += (f32x2_t){v[r][j].z, v[r][j].w} * (f32x2_t){r4[j].z, r4[j].w}; }
                p[r] = a2.x + a2.y; }
            wave_sum4(p);
#pragma unroll
            for (int r = 0; r < 4; ++r) mine[r] = (lane == e) ? p[r] : mine[r];
            asm volatile("" ::: "memory"); }
        { const float rbv = rbl;
#pragma unroll
          for (int r = 0; r < 4; ++r) mine[r] += rbv; }
        float xx[4], tv[4][4]; int ti[4][4];
#pragma unroll
        for (int r = 0; r < 4; ++r) xx[r] = (lane < 32) ? mine[r] : -INFINITY;
#pragma unroll
        for (int k = 0; k < 4; ++k) { float mx[4];
#pragma unroll
            for (int r = 0; r < 4; ++r) mx[r] = xx[r];
            wave_max4(mx);
#pragma unroll
            for (int r = 0; r < 4; ++r) { const unsigned long long mk = __builtin_amdgcn_ballot_w64(xx[r] == mx[r]); const int idx = (int)__builtin_ctzll(mk);
                tv[r][k] = mx[r]; ti[r][k] = idx; if (lane == idx) xx[r] = -INFINITY; } }
#pragma unroll
        for (int r = 0; r < 4; ++r) {
            const float e1 = expf(tv[r][1] - tv[r][0]), e2 = expf(tv[r][2] - tv[r][0]), e3 = expf(tv[r][3] - tv[r][0]); const float inv = 1.f / (1.f + e1 + e2 + e3);
            if (lane < 4 && nb + r < row1) { const int ek = lane == 0 ? ti[r][0] : lane == 1 ? ti[r][1] : lane == 2 ? ti[r][2] : ti[r][3]; const float gk = (lane == 0 ? 1.f : lane == 1 ? e1 : lane == 2 ? e2 : e3) * inv;
                const int lp = atomicAdd((int*)lcnt + ek, 1);
                const int ri = (nb + r - row0) * 4 + lane; rec[2 * ri] = (unsigned)ek | ((unsigned)lp << 8); rec[2 * ri + 1] = __float_as_uint(gk); } }
#pragma unroll
        for (int r = 0; r < 4; ++r)
#pragma unroll
            for (int j = 0; j < 4; ++j) raw[r][j] = rawn[r][j];
    }
#undef LN1_LOAD
    __syncthreads();
    if (tid < 32) gbase[tid] = (int)__hip_atomic_fetch_add(ecnt + tid, (unsigned)lcnt[tid], __ATOMIC_RELAXED, __HIP_MEMORY_SCOPE_AGENT);
    __syncthreads();
    for (int ri = tid; ri < (row1 - row0) * 4; ri += NTHR) { const unsigned w = rec[2 * ri]; const int e = w & 31, lp = w >> 8; const unsigned aid = (unsigned)(row0 * 4 + ri);
        *(v2u*)(elist + ((size_t)e * NTOK + gbase[e] + lp) * 2) = (v2u){aid, rec[2 * ri + 1]}; }
    __syncthreads();
}

template <bool LAST>
__device__ __forceinline__ void ph_combine_ln2(const Args& A, int layer, int wg, int G, int g_wid) {
    PH_IDS;
    bf16* hb = (bf16*)(A.ws + WS_HB); const unsigned char* ybuf = (const unsigned char*)(A.ws + WS_YBUF);
    const float* g2 = A.in[I_LN2G] + layer * DM; const float* b2 = A.in[I_LN2B] + layer * DM;
    const int gw = wg * NWAVES + wid, NGW = G * NWAVES;
    f32x4 gv[4], bv[4];
#pragma unroll
    for (int j = 0; j < 2; ++j) { gv[2 * j] = *(const f32x4*)(g2 + 8 * lane + 512 * j); gv[2 * j + 1] = *(const f32x4*)(g2 + 8 * lane + 512 * j + 4); bv[2 * j] = *(const f32x4*)(b2 + 8 * lane + 512 * j); bv[2 * j + 1] = *(const f32x4*)(b2 + 8 * lane + 512 * j + 4); }
    v4u hw[2], hn[2]; v2u yw[4][2], yn[4][2];
#define CMB_LOAD(n_, H, Y) do { _Pragma("unroll") for (int j = 0; j < 2; ++j) H[j] = *(const v4u*)(hb + (size_t)(n_) * DM + 8 * lane + 512 * j); \
        _Pragma("unroll") for (int k = 0; k < 4; ++k) _Pragma("unroll") for (int j = 0; j < 2; ++j) Y[k][j] = *(const v2u*)(ybuf + ((size_t)(n_) * 4 + k) * DM + 8 * lane + 512 * j); } while (0)
    if (gw < NTOK) CMB_LOAD(gw, hw, yw);
    for (int n = gw; n < NTOK; n += NGW) {
        const int nn = n + NGW;
        if (nn < NTOK) CMB_LOAD(nn, hn, yn);
        float v[16]; float s = 0.f;
#pragma unroll
        for (int j = 0; j < 2; ++j) { const v4u w = hw[j];
            v[8 * j + 0] = bflo(w.x) * ALPHA; v[8 * j + 1] = bfhi(w.x) * ALPHA; v[8 * j + 2] = bflo(w.y) * ALPHA; v[8 * j + 3] = bfhi(w.y) * ALPHA;
            v[8 * j + 4] = bflo(w.z) * ALPHA; v[8 * j + 5] = bfhi(w.z) * ALPHA; v[8 * j + 6] = bflo(w.w) * ALPHA; v[8 * j + 7] = bfhi(w.w) * ALPHA; }
#pragma unroll
        for (int k = 0; k < 4; ++k)
#pragma unroll
            for (int j = 0; j < 2; ++j) { const v2u w = yw[k][j];
                const f32x2_t a = __builtin_amdgcn_cvt_pk_f32_fp8((int)w.x, false), b = __builtin_amdgcn_cvt_pk_f32_fp8((int)w.x, true), c = __builtin_amdgcn_cvt_pk_f32_fp8((int)w.y, false), d = __builtin_amdgcn_cvt_pk_f32_fp8((int)w.y, true);
                v[8 * j + 0] += a.x * (1.f / Y_SCALE); v[8 * j + 1] += a.y * (1.f / Y_SCALE); v[8 * j + 2] += b.x * (1.f / Y_SCALE); v[8 * j + 3] += b.y * (1.f / Y_SCALE);
                v[8 * j + 4] += c.x * (1.f / Y_SCALE); v[8 * j + 5] += c.y * (1.f / Y_SCALE); v[8 * j + 6] += d.x * (1.f / Y_SCALE); v[8 * j + 7] += d.y * (1.f / Y_SCALE); }
#pragma unroll
        for (int i = 0; i < 16; ++i) s += v[i];
        const float mean = wave_sum(s) * (1.f / DM); float s2 = 0.f;
#pragma unroll
        for (int i = 0; i < 16; ++i) { v[i] -= mean; s2 += v[i] * v[i]; }
        const float rstd = 1.f / sqrtf(wave_sum(s2) * (1.f / DM) + LN_EPS);
#pragma unroll
        for (int j = 0; j < 2; ++j) {
            const f32x4 oa = (f32x4){v[8 * j], v[8 * j + 1], v[8 * j + 2], v[8 * j + 3]} * rstd * gv[2 * j] + bv[2 * j], ob = (f32x4){v[8 * j + 4], v[8 * j + 5], v[8 * j + 6], v[8 * j + 7]} * rstd * gv[2 * j + 1] + bv[2 * j + 1];
            if (LAST) { float* o = A.out + (size_t)n * DM + 8 * lane + 512 * j; *(f32x4*)o = oa; *(f32x4*)(o + 4) = ob; }
            else { v4u w; w.x = pk2(oa.x, oa.y); w.y = pk2(oa.z, oa.w); w.z = pk2(ob.x, ob.y); w.w = pk2(ob.z, ob.w); *(v4u*)(hb + (size_t)n * DM + 8 * lane + 512 * j) = w; } }
#pragma unroll
        for (int j = 0; j < 2; ++j) hw[j] = hn[j];
#pragma unroll
        for (int k = 0; k < 4; ++k)
#pragma unroll
            for (int j = 0; j < 2; ++j) yw[k][j] = yn[k][j];
    }
#undef CMB_LOAD
}

#define IN(k) (lo <= (k) && (k) < hi)
#ifndef PROBE_BAR
#define PROBE_BAR 0
#endif
#define SEAM(k) do { if ((k) + 1 < hi) { xcd_barrier(bar); for (int pb_ = 0; pb_ < PROBE_BAR; ++pb_) xcd_barrier(bar); } } while (0)
#if PROBE_TIME
#define PT0(k) if ((k) == PROBE_TIME && xb_t0(wid0)) { volatile LAS unsigned* pm_ = (volatile LAS unsigned*)(lds + MISC_OFF) + 40; pm_[1] = (unsigned)__builtin_amdgcn_s_memrealtime(); }
#define PT1(k) if ((k) == PROBE_TIME && xb_t0(wid0)) { volatile LAS unsigned* pm_ = (volatile LAS unsigned*)(lds + MISC_OFF) + 40; pm_[0] = pm_[0] + ((unsigned)__builtin_amdgcn_s_memrealtime() - pm_[1]); }
#else
#define PT0(k)
#define PT1(k)
#endif
template <int layer>
__device__ __forceinline__ void run_layer(LAS unsigned char* lds, const int wg, const int G, const int wid0, const int lo, const int hi, const XcdBarrier& bar) {
        constexpr int pb = 1 + 8 * layer; constexpr bool fox = (layer & 1) != 0;
        if (IN(pb + 0)) { PT0(0)
            { const Args A = load_args(); unsigned char* ws = A.ws;
              DenseSched S{(const bf16*)(ws + WS_HB), (const bf16*)(ws + WS_WIN) + (size_t)layer * NPROJ * DM, NTOK / 256, NPROJ / 256, G, wg};
              EpiProjT<true, !fox> E{(bf16*)(ws + WS_PROJ), NPROJ, K_COL, QM_COL, (unsigned*)(ws + WS_CTL) + CW_NORM + layer * 256, (float*)(ws + WS_KSUM) + (size_t)(layer >> 1) * (NB * HS * 32 * 64)};
              gemm_fast<EpiProjT<true, !fox>, DenseSched, true>(lds, S, E, wid0); }
            if constexpr (layer == 0) { const Args A = load_args(); unsigned char* ws = A.ws;
              DenseSched S{(const bf16*)(ws + WS_MEMB), (const bf16*)(ws + WS_WMKV), NB * NMEM / 256, 2, G, wg};
              EpiProjT<false, false> E{(bf16*)(ws + WS_MKV), 512, 0, 1 << 30, nullptr, nullptr};
              gemm_fast<EpiProjT<false, false>, DenseSched, true>(lds, S, E, wid0); }
            if constexpr (fox) { const Args A = load_args(); ph_fox_gate(A, layer >> 1, wg, G, wid0); }
            SEAM(pb + 0); PT1(0)
        }
        if constexpr (fox) { if (IN(pb + 1)) { const Args A = load_args(); ph_fox_scan(A, lds, wg, G, wid0); SEAM(pb + 1); } }
        if (IN(pb + 2)) { PT0(2) const Args A = load_args(); for (int rep = 0; rep < PROBE_ATT; ++rep) ph_attn_fast<fox ? 1 : 0>(A, layer, rep, lds, wg, G, wid0); SEAM(pb + 2); PT1(2) }
        if (IN(pb + 3)) { PT0(3)
            const Args A = load_args(); unsigned char* ws = A.ws;
            DenseSched S{(const bf16*)(ws + WS_ATT), (const bf16*)(ws + WS_WO) + (size_t)layer * DM * DM, NTOK / 256, DM / 256, G, wg};
            EpiOutT<layer == 0> E{layer == 0 ? (const void*)A.in[I_X] : (const void*)(ws + WS_HB), (bf16*)(ws + WS_HB)};
            gemm_fast<EpiOutT<layer == 0>, DenseSched, true>(lds, S, E, wid0); SEAM(pb + 3); PT1(3)
        }
        if (IN(pb + 4)) { PT0(4) const Args A = load_args(); ph_ln1_router(A, layer, lds, wg, G, wid0); SEAM(pb + 4); PT1(4) }
        if (IN(pb + 5)) { PT0(5)
            const Args A = load_args(); unsigned char* ws = A.ws;
            LAS int* tab = (LAS int*)(lds + MISC_OFF) + 64; moe_tables(tab, (unsigned*)(ws + WS_CTL) + CW_ECNT + layer * 64, wid0);
            MoeSchedT<true> S{(const bf16*)(ws + WS_HB), (const bf16*)(ws + WS_WGU) + (size_t)layer * NEXP * 2048 * DM, (const unsigned*)(ws + WS_ELIST), tab, 8, 2048, G, wg, 2};
            EpiGU E{(bf16*)(ws + WS_ABUF), A.in[I_BGU] + (size_t)layer * NEXP * 2048};
            gemm_fast<EpiGU, MoeSchedT<true>, true>(lds, S, E, wid0); __syncthreads();
#if PROBE_MOE > 1
            gemm_fast<EpiGU, MoeSchedT<true>, true>(lds, S, E, wid0); __syncthreads();
#endif
            SEAM(pb + 5); PT1(5)
        }
        if (IN(pb + 6)) { PT0(6)
            const Args A = load_args(); unsigned char* ws = A.ws;
            LAS int* tab = (LAS int*)(lds + MISC_OFF) + 64; moe_tables(tab, (unsigned*)(ws + WS_CTL) + CW_ECNT + layer * 64, wid0);
            MoeSchedT<false> S{(const bf16*)(ws + WS_ABUF), (const bf16*)(ws + WS_WDN) + (size_t)layer * NEXP * DM * DM, (const unsigned*)(ws + WS_ELIST), tab, 4, 1024, G, wg, 0};
            EpiDN E{(bf16*)(ws + WS_YBUF), A.in[I_BDN] + (size_t)layer * NEXP * DM};
            gemm_fast<EpiDN, MoeSchedT<false>, true>(lds, S, E, wid0); __syncthreads();
#if PROBE_MOE > 1
            gemm_fast<EpiDN, MoeSchedT<false>, true>(lds, S, E, wid0); __syncthreads();
#endif
            SEAM(pb + 6); PT1(6)
        }
        if (IN(pb + 7)) { PT0(7) const Args A = load_args(); ph_combine_ln2<layer == DEPTH - 1>(A, layer, wg, G, wid0); SEAM(pb + 7); PT1(7) }
}
__global__ void __launch_bounds__(NTHR, 2) k_main(Args A0) {
    extern __shared__ __attribute__((aligned(16))) unsigned char lds_raw[];
    LAS unsigned char* lds = (LAS unsigned char*)lds_raw;
    volatile LAS unsigned* MISC = (volatile LAS unsigned*)(lds + MISC_OFF);
    const int wid0 = __builtin_amdgcn_readfirstlane((int)threadIdx.x >> 6);
    const int G = gridDim.x, wg = blockIdx.x;
    const int lo = A0.p_lo, hi = A0.p_hi;
    if (threadIdx.x < 64) MISC[threadIdx.x] = 0u;
    __syncthreads();
    XcdBarrier bar; bar.bar = (unsigned*)(A0.ws + WS_CTL) + CW_BAR; bar.x = 0; bar.st = nullptr; bar.wid = wid0;
    if (hi - lo > 1) bar = xcd_barrier_post((unsigned*)(A0.ws + WS_CTL) + CW_BAR + (size_t)lo * XCD_BAR_WORDS, MISC + 8, wid0);
    if (IN(0)) { const Args A = load_args(); for (int rep = 0; rep < PROBE_CVT; ++rep) ph_convert(A, lds, wg, G, wid0); SEAM(0); }
    run_layer<0>(lds, wg, G, wid0, lo, hi, bar); run_layer<1>(lds, wg, G, wid0, lo, hi, bar); run_layer<2>(lds, wg, G, wid0, lo, hi, bar); run_layer<3>(lds, wg, G, wid0, lo, hi, bar);
#if PROBE_TIME
    { const Args A = load_args(); unsigned* pw = (unsigned*)(A.ws + WS_CTL) + 3000; volatile LAS unsigned* pm_ = (volatile LAS unsigned*)(lds + MISC_OFF) + 40;
      if (blockIdx.x == 0 && xb_t0(wid0)) __hip_atomic_store(pw, pm_[0], __ATOMIC_RELAXED, __HIP_MEMORY_SCOPE_AGENT);
      xcd_barrier(bar);
      const float us = (float)__hip_atomic_load(pw, __ATOMIC_RELAXED, __HIP_MEMORY_SCOPE_AGENT) * 0.01f; const float v = log2f(us + 1.f) * 0.25f;
      { int ln_; asm volatile("v_mbcnt_lo_u32_b32 %0, -1, 0\n\tv_mbcnt_hi_u32_b32 %0, -1, %0" : "=v"(ln_)); for (size_t i = (size_t)blockIdx.x * NTHR + wid0 * 64 + ln_; i < (size_t)NTOK * DM; i += (size_t)gridDim.x * NTHR) A.out[i] = v; } }
#endif
#undef IN
#undef SEAM
}

#ifndef MK_ONE_LAUNCH
#define MK_ONE_LAUNCH 1
#endif
extern "C" void kernel_launch(void* const* d_in, const int* in_sizes, int n_in, void* d_out, int out_size, void* d_ws, size_t ws_size, hipStream_t stream) {
    static int grid = 0;
    if (grid == 0) {
        if (n_in != 17 || out_size != NTOK * DM || ws_size < WS_END) { fprintf(stderr, "kernel_launch: unexpected shapes (n_in %d out %d ws %zu, need %zu)\n", n_in, out_size, ws_size, (size_t)WS_END); grid = -1; return; }
        int dev = 0, cus = 0, per_cu = 0;
        if (hipGetDevice(&dev) != hipSuccess || hipDeviceGetAttribute(&cus, hipDeviceAttributeMultiprocessorCount, dev) != hipSuccess) { grid = -1; return; }
        if (hipFuncSetAttribute((const void*)k_main, hipFuncAttributeMaxDynamicSharedMemorySize, LDS_BYTES) != hipSuccess) { fprintf(stderr, "kernel_launch: hipFuncSetAttribute failed\n"); grid = -1; return; }
        if (hipOccupancyMaxActiveBlocksPerMultiprocessor(&per_cu, (const void*)k_main, NTHR, LDS_BYTES) != hipSuccess || per_cu < 1) { fprintf(stderr, "kernel_launch: occupancy query says %d\n", per_cu); }
        (void)hipGetLastError();
        grid = cus;
    }
    if (grid < 0) return;
    (void)hipMemsetAsync((char*)d_ws + WS_CTL, 0, CTL_ZERO_BYTES, stream);
    Args a{};
    for (int i = 0; i < 17; ++i) a.in[i] = (const float*)d_in[i];
    a.out = (float*)d_out; a.ws = (unsigned char*)d_ws;
#if MK_ONE_LAUNCH
    a.p_lo = 0; a.p_hi = NPHASE;
    hipLaunchKernelGGL(k_main, dim3(grid), dim3(NTHR), LDS_BYTES, stream, a);
#else
    for (int p = 0; p < NPHASE; ++p) { a.p_lo = p; a.p_hi = p + 1; hipLaunchKernelGGL(k_main, dim3(grid), dim3(NTHR), LDS_BYTES, stream, a); }
#endif
}
```

```cpp
#include <hip/hip_runtime.h>
#include <cstdio>
#include <cstdint>
#ifndef PROBE_ATT
#define PROBE_ATT 1
#endif
#ifndef PROBE_MOE
#define PROBE_MOE 1
#endif
#ifndef PROBE_CVT
#define PROBE_CVT 1
#endif
#ifndef PROBE_TIME
#define PROBE_TIME 0
#endif
#ifndef PROBE_INP
#define PROBE_INP 1
#endif

#define GAS __attribute__((address_space(1)))
#define LAS __attribute__((address_space(3)))
typedef unsigned short bf16;
typedef unsigned v4u __attribute__((ext_vector_type(4)));
typedef unsigned v2u __attribute__((ext_vector_type(2)));
typedef float f32x4 __attribute__((ext_vector_type(4)));
typedef short bf16x8 __attribute__((ext_vector_type(8)));

constexpr int NB = 4, SEQ = 8192, DM = 1024, NTOK = NB * SEQ;
constexpr int HS = 12, HMEM = 4, HD = 64, NMEM = 256, NPROJ = 2560, QM_COL = 2304, K_COL = 768, V_COL = 1536;
constexpr int NEXP = 32, TOPK = 4, DEPTH = 4, NASSIGN = NTOK * TOPK, DFF = 1024;
constexpr float ALPHA = 1.6817928305074290f, LN_EPS = 1e-5f, LOG2E = 1.4426950408889634f, C2 = 0.125f * 1.4426950408889634f;
constexpr float SW_LIMIT = 7.0f, SW_ALPHA = 1.702f;
constexpr int NWAVES = 8, NTHR = 512;

constexpr size_t MiB = 1u << 20;
constexpr size_t WS_CTL = 0, CTL_ZERO_BYTES = 2 * MiB;
constexpr size_t WS_KSUM = 1 * MiB;
constexpr size_t WS_WIN = 2 * MiB;
constexpr size_t WS_WFG = WS_WIN + (size_t)4 * NPROJ * DM * 2;
constexpr size_t WS_WMKV = WS_WFG + 1 * MiB;
constexpr size_t WS_WO = WS_WMKV + 1 * MiB;
constexpr size_t WS_WGU = WS_WO + 8 * MiB;
constexpr size_t WS_WDN = WS_WGU + 512 * MiB;
constexpr size_t WS_HB = WS_WDN + 256 * MiB;
constexpr size_t WS_MEMB = WS_HB + 64 * MiB;
constexpr size_t WS_MKV = WS_MEMB + 2 * MiB;
constexpr size_t WS_PROJ = WS_MKV + 1 * MiB;
constexpr size_t WS_CFOX = WS_PROJ + 160 * MiB;
constexpr size_t WS_LF = WS_CFOX + 2 * MiB;
constexpr size_t WS_KBAR = WS_LF + 2 * MiB;
constexpr size_t WS_ATT = WS_KBAR + 1 * MiB;
constexpr size_t WS_ELIST = WS_ATT + 64 * MiB;
constexpr size_t WS_AGATE = WS_ELIST + 8 * MiB;
constexpr size_t WS_ABUF = WS_AGATE + 1 * MiB;
constexpr size_t WS_YBUF = WS_ABUF + 288 * MiB;
constexpr size_t WS_END = WS_YBUF + 256 * MiB;

constexpr int CW_ECNT = 1024;
constexpr int CW_NORM = 1536;
constexpr int CW_AQ = 2560;
constexpr int CW_BAR = 4096;
constexpr int NPHASE = 1 + 8 * DEPTH;

constexpr int LDS_BYTES = 147456, SCR_BYTES = 146432, MISC_OFF = SCR_BYTES;

__device__ __forceinline__ unsigned f2bf(float f) { unsigned u = __float_as_uint(f); return (u + 0x7fffu + ((u >> 16) & 1u)) >> 16; }
typedef float f32x2_t __attribute__((ext_vector_type(2))); typedef __bf16 bf16x2_t __attribute__((ext_vector_type(2)));
__device__ __forceinline__ unsigned pk2(float lo, float hi) { const f32x2_t v = {lo, hi}; const bf16x2_t b = __builtin_convertvector(v, bf16x2_t); return __builtin_bit_cast(unsigned, b); }
__device__ __forceinline__ float bflo(unsigned w) { return __uint_as_float(w << 16); }
__device__ __forceinline__ float bfhi(unsigned w) { return __uint_as_float(w & 0xffff0000u); }
__device__ __forceinline__ float wave_sum(float v) {
    v += __builtin_bit_cast(float, __builtin_amdgcn_update_dpp(0, __builtin_bit_cast(int, v), 0xB1, 0xF, 0xF, false));
    v += __builtin_bit_cast(float, __builtin_amdgcn_update_dpp(0, __builtin_bit_cast(int, v), 0x4E, 0xF, 0xF, false));
    v += __builtin_bit_cast(float, __builtin_amdgcn_update_dpp(0, __builtin_bit_cast(int, v), 0x141, 0xF, 0xF, false));
    v += __builtin_bit_cast(float, __builtin_amdgcn_update_dpp(0, __builtin_bit_cast(int, v), 0x140, 0xF, 0xF, false));
    v += __builtin_bit_cast(float, __builtin_amdgcn_update_dpp(0, __builtin_bit_cast(int, v), 0x142, 0xA, 0xF, false));
    v += __builtin_bit_cast(float, __builtin_amdgcn_update_dpp(0, __builtin_bit_cast(int, v), 0x143, 0xC, 0xF, false));
    return __builtin_bit_cast(float, __builtin_amdgcn_readlane(__builtin_bit_cast(int, v), 63));
}
__device__ __forceinline__ void wave_sum4(float (&v)[4]) {
#define WS4_STEP(ctrl, rm) do { float t_[4]; _Pragma("unroll") for (int i_ = 0; i_ < 4; ++i_) t_[i_] = __builtin_bit_cast(float, __builtin_amdgcn_update_dpp(0, __builtin_bit_cast(int, v[i_]), ctrl, rm, 0xF, false)); \
        _Pragma("unroll") for (int i_ = 0; i_ < 4; ++i_) v[i_] += t_[i_]; } while (0)
    WS4_STEP(0xB1, 0xF); WS4_STEP(0x4E, 0xF); WS4_STEP(0x141, 0xF); WS4_STEP(0x140, 0xF); WS4_STEP(0x142, 0xA); WS4_STEP(0x143, 0xC);
#undef WS4_STEP
#pragma unroll
    for (int i = 0; i < 4; ++i) v[i] = __builtin_bit_cast(float, __builtin_amdgcn_readlane(__builtin_bit_cast(int, v[i]), 63));
}
__device__ __forceinline__ float row16_max(float v) {
    v = fmaxf(v, __builtin_bit_cast(float, __builtin_amdgcn_update_dpp(__builtin_bit_cast(int, v), __builtin_bit_cast(int, v), 0xB1, 0xF, 0xF, false)));
    v = fmaxf(v, __builtin_bit_cast(float, __builtin_amdgcn_update_dpp(__builtin_bit_cast(int, v), __builtin_bit_cast(int, v), 0x4E, 0xF, 0xF, false)));
    v = fmaxf(v, __builtin_bit_cast(float, __builtin_amdgcn_update_dpp(__builtin_bit_cast(int, v), __builtin_bit_cast(int, v), 0x141, 0xF, 0xF, false)));
    v = fmaxf(v, __builtin_bit_cast(float, __builtin_amdgcn_update_dpp(__builtin_bit_cast(int, v), __builtin_bit_cast(int, v), 0x140, 0xF, 0xF, false)));
    return v;
}
__device__ __forceinline__ float row16_sum(float v) {
    v += __builtin_bit_cast(float, __builtin_amdgcn_update_dpp(0, __builtin_bit_cast(int, v), 0xB1, 0xF, 0xF, false));
    v += __builtin_bit_cast(float, __builtin_amdgcn_update_dpp(0, __builtin_bit_cast(int, v), 0x4E, 0xF, 0xF, false));
    v += __builtin_bit_cast(float, __builtin_amdgcn_update_dpp(0, __builtin_bit_cast(int, v), 0x141, 0xF, 0xF, false));
    v += __builtin_bit_cast(float, __builtin_amdgcn_update_dpp(0, __builtin_bit_cast(int, v), 0x140, 0xF, 0xF, false));
    return v;
}
__device__ __forceinline__ float wave_max(float v) {
    v = row16_max(v);
    v = fmaxf(v, __builtin_bit_cast(float, __builtin_amdgcn_update_dpp(__builtin_bit_cast(int, v), __builtin_bit_cast(int, v), 0x142, 0xA, 0xF, false)));
    v = fmaxf(v, __builtin_bit_cast(float, __builtin_amdgcn_update_dpp(__builtin_bit_cast(int, v), __builtin_bit_cast(int, v), 0x143, 0xC, 0xF, false)));
    return __builtin_bit_cast(float, __builtin_amdgcn_readlane(__builtin_bit_cast(int, v), 63));
}
__device__ __forceinline__ float fexp2(float x) { return __builtin_amdgcn_exp2f(x); }
#define PH_IDS int lane; asm volatile("v_mbcnt_lo_u32_b32 %0, -1, 0\n\tv_mbcnt_hi_u32_b32 %0, -1, %0" : "=v"(lane)); const int wid = __builtin_amdgcn_readfirstlane(g_wid); const int tid = wid * 64 + lane; (void)tid

#define XB_TMO      128
#define XB_XCNT(j)  (256  + 64 * (j))
#define XB_XSUB(j)  (1280 + 64 * (j))
#define XB_XGEN(j)  (2304 + 64 * (j))
#define XB_TOP      3328
#define XB_TOPGEN   3392
#define XCD_BAR_WORDS 3456
#define XB_SPIN_CAP (1u << 22)
__device__ __forceinline__ unsigned xb_ld(unsigned* p)              { return __hip_atomic_load(p, __ATOMIC_RELAXED, __HIP_MEMORY_SCOPE_AGENT); }
__device__ __forceinline__ unsigned xb_add(unsigned* p, unsigned v) { return __hip_atomic_fetch_add(p, v, __ATOMIC_RELAXED, __HIP_MEMORY_SCOPE_AGENT); }
__device__ __forceinline__ unsigned xb_xcc_id() { return (unsigned)__builtin_amdgcn_s_getreg((3 << 11) | 20) & 0xFu; }
#define XB_SPIN(cond, bar) do { unsigned _sp = 0; while (cond) { __builtin_amdgcn_s_sleep(1); \
    if ((++_sp & 255u) == 0u) { if (xb_ld(&(bar)[XB_TMO])) break; if (_sp > XB_SPIN_CAP) { atomicAdd(&(bar)[XB_TMO], 1u); break; } } } } while (0)
struct XcdBarrier { unsigned* bar; unsigned x; volatile LAS unsigned* st; int wid; };
__device__ __forceinline__ bool xb_t0(int w) { int l; asm volatile("v_mbcnt_lo_u32_b32 %0, -1, 0\n\tv_mbcnt_hi_u32_b32 %0, -1, %0" : "=v"(l)); return w == 0 && l == 0; }
#define XB_T0(w) xb_t0(w)
__device__ __forceinline__ XcdBarrier xcd_barrier_post(unsigned* bar, volatile LAS unsigned* st, int wid) {
    XcdBarrier b; b.bar = bar; b.x = xb_xcc_id(); b.st = st; b.wid = wid;
    if (XB_T0(wid)) (void)xb_add(&bar[XB_XCNT(b.x)], 1u);
    return b;
}
__device__ __forceinline__ void xcd_barrier_complete(unsigned* bar, unsigned x, unsigned& nloc, unsigned& nx) {
    const unsigned G = gridDim.x * gridDim.y * gridDim.z;
    unsigned sum, cnt, mine, sp = 0u;
    for (;;) {
        sum = 0u; cnt = 0u; mine = 0u;
#pragma unroll
        for (unsigned j = 0; j < 16; ++j) { const unsigned c = xb_ld(&bar[XB_XCNT(j)]); sum += c; cnt += (c > 0u) ? 1u : 0u; mine = (j == x) ? c : mine; }
        if (sum == G) break;
        __builtin_amdgcn_s_sleep(1);
        if ((++sp & 255u) == 0u) { if (xb_ld(&bar[XB_TMO])) break; if (sp > XB_SPIN_CAP) { atomicAdd(&bar[XB_TMO], 1u); break; } }
    }
    nloc = mine > 0u ? mine : 1u; nx = cnt > 0u ? cnt : 1u;
}
__device__ __forceinline__ void xcd_barrier(const XcdBarrier& b) {
    asm volatile("s_waitcnt vmcnt(0)" ::: "memory");
    __syncthreads();
    if (XB_T0(b.wid)) {
        unsigned* bar = b.bar;
        __builtin_amdgcn_s_waitcnt(0);
        unsigned nloc = b.st[0], nx = b.st[1];
        if (nloc == 0u) { xcd_barrier_complete(bar, b.x, nloc, nx); b.st[0] = nloc; b.st[1] = nx; }
        const unsigned old = xb_add(&bar[XB_XSUB(b.x)], 1u);
        const unsigned gen = old / nloc;
        if (old + 1u == (gen + 1u) * nloc) {
            __builtin_amdgcn_fence(__ATOMIC_RELEASE, "agent");
            asm volatile("s_waitcnt vmcnt(0)" ::: "memory");
            const unsigned og = xb_add(&bar[XB_TOP], 1u);
            const unsigned tg = og / nx;
            if (og + 1u == (tg + 1u) * nx) xb_add(&bar[XB_TOPGEN], 1u);
            else XB_SPIN(xb_ld(&bar[XB_TOPGEN]) == tg, bar);
            __builtin_amdgcn_fence(__ATOMIC_ACQUIRE, "agent");
            xb_add(&bar[XB_XGEN(b.x)], 1u);
            asm volatile("s_waitcnt vmcnt(0)" ::: "memory");
        } else {
            XB_SPIN(xb_ld(&bar[XB_XGEN(b.x)]) == gen, bar);
            __builtin_amdgcn_fence(__ATOMIC_ACQUIRE, "agent");
            asm volatile("s_waitcnt vmcnt(0)" ::: "memory");
        }
    }
    __syncthreads();
}

struct Args { const float* in[17]; float* out; unsigned char* ws; int p_lo, p_hi; };
enum { I_X = 0, I_MEM, I_WIN_MOBA, I_WIN_FOX, I_BFG, I_WMKV, I_WO, I_LN1G, I_LN1B, I_RW, I_RB, I_WGU, I_BGU, I_WDN, I_BDN, I_LN2G, I_LN2B };

__device__ __forceinline__ Args load_args() {
#if defined(__HIP_DEVICE_COMPILE__)
    const __attribute__((address_space(4))) unsigned long long* p = (const __attribute__((address_space(4))) unsigned long long*)__builtin_amdgcn_kernarg_segment_ptr();
    asm volatile("" : "+s"(p));
    Args a;
#pragma unroll
    for (int i = 0; i < 17; ++i) a.in[i] = (const float*)(const GAS float*)p[i];
    a.out = (float*)(GAS float*)p[17]; a.ws = (unsigned char*)(GAS unsigned char*)p[18]; const unsigned long long w = p[19]; a.p_lo = (int)(unsigned)w; a.p_hi = (int)(unsigned)(w >> 32);
    return a;
#else
    return Args{};
#endif
}
struct CvtItem { const float* src; bf16* dst; int pitch; };
constexpr int CVT_I_IN = 16 * 40, CVT_I_MK = 16 * 8, CVT_I_O1 = 16 * 16, CVT_I_GU1 = 16 * 32, CVT_I_DN1 = 16 * 16;
constexpr int CVT_N_INIT = 4 * CVT_I_IN + CVT_I_MK + 4 * CVT_I_O1;
constexpr int CVT_N_MOE = NEXP * (CVT_I_GU1 + CVT_I_DN1), CVT_CHUNK = 32;
__device__ __forceinline__ bool cvt_decode(const Args& A, int it, CvtItem& c) {
    unsigned char* ws = A.ws;
    constexpr int N_IN = 4 * CVT_I_IN, N_MK = CVT_I_MK;
    if (it >= CVT_N_INIT) return false;
    int r = it;
    if (r < N_IN) { const int l = r / CVT_I_IN, q = r % CVT_I_IN, kb = q / 40, nb = q % 40, j = l >> 1; const int pitch = (l & 1) ? NPROJ + HS : NPROJ;
        const float* W = (l & 1) ? A.in[I_WIN_FOX] + (size_t)j * DM * (NPROJ + HS) : A.in[I_WIN_MOBA] + (size_t)j * DM * NPROJ;
        c.src = W + (size_t)(64 * kb) * pitch + 64 * nb; c.pitch = pitch; c.dst = (bf16*)(ws + WS_WIN) + ((size_t)l * NPROJ + 64 * nb) * DM + 64 * kb; return true; }
    r -= N_IN;
    if (r < N_MK) { const int kb = r / 8, nb = r % 8; c.src = A.in[I_WMKV] + (size_t)(64 * kb) * 512 + 64 * nb; c.pitch = 512; c.dst = (bf16*)(ws + WS_WMKV) + (size_t)(64 * nb) * DM + 64 * kb; return true; }
    r -= N_MK;
    { const int l = r / CVT_I_O1, q = r % CVT_I_O1, kb = q / 16, nb = q % 16; c.src = A.in[I_WO] + (size_t)l * DM * DM + (size_t)(64 * kb) * DM + 64 * nb; c.pitch = DM; c.dst = (bf16*)(ws + WS_WO) + ((size_t)l * DM + 64 * nb) * DM + 64 * kb; return true; }
}
__device__ __forceinline__ void cvt_decode_moe(const Args& A, int layer, int r, CvtItem& c) {
    unsigned char* ws = A.ws;
    if (r < NEXP * CVT_I_GU1) { const int le = layer * NEXP + r / CVT_I_GU1, q = r % CVT_I_GU1, kb = q / 32, nb = q % 32, col0 = 64 * nb;
        const int cc = col0 & 1023, drow0 = (cc >> 7) * 256 + (cc & 127) + ((col0 >= 1024) ? 128 : 0);
        c.src = A.in[I_WGU] + (size_t)le * DM * 2048 + (size_t)(64 * kb) * 2048 + col0; c.pitch = 2048; c.dst = (bf16*)(ws + WS_WGU) + ((size_t)le * 2048 + drow0) * DM + 64 * kb; return; }
    r -= NEXP * CVT_I_GU1;
    { const int le = layer * NEXP + r / CVT_I_DN1, q = r % CVT_I_DN1, kb = q / 16, nb = q % 16; c.src = A.in[I_WDN] + (size_t)le * DM * DM + (size_t)(64 * kb) * DM + 64 * nb; c.pitch = DM; c.dst = (bf16*)(ws + WS_WDN) + ((size_t)le * DM + 64 * nb) * DM + 64 * kb; }
}
__device__ __forceinline__ void cvt_load(const CvtItem& c, f32x4 (&v)[16], int lane) {
    const int a = lane >> 4, b4 = (lane & 15) * 4;
#pragma unroll
    for (int i = 0; i < 16; ++i) v[i] = __builtin_nontemporal_load((const f32x4*)(c.src + (size_t)(4 * i + a) * c.pitch + b4));
}
__device__ __forceinline__ void cvt_store(const CvtItem& c, const f32x4 (&v)[16], LAS float* scr, int lane) {
    const int a = lane >> 4, b4 = (lane & 15) * 4;
#pragma unroll
    for (int i = 0; i < 16; ++i) { LAS float* s = scr + (4 * i + a) * 65 + b4; s[0] = v[i].x; s[1] = v[i].y; s[2] = v[i].z; s[3] = v[i].w; }
    asm volatile("s_waitcnt lgkmcnt(0)" ::: "memory");
    const int cb = lane & 7;
#pragma unroll
    for (int j = 0; j < 8; ++j) {
        const int n = (lane >> 3) + 8 * j; const LAS float* s = scr + (8 * cb) * 65 + n;
        v4u o; o.x = pk2(s[0], s[65]); o.y = pk2(s[2 * 65], s[3 * 65]); o.z = pk2(s[4 * 65], s[5 * 65]); o.w = pk2(s[6 * 65], s[7 * 65]);
        __builtin_nontemporal_store(o, (v4u*)(c.dst + (size_t)n * DM + 8 * cb));
    }
    asm volatile("s_waitcnt lgkmcnt(0)" ::: "memory");
}
__device__ __forceinline__ void cvt_moe_chunk(const Args& A, int layer, int chunk, LAS unsigned char* lds, int wid, int lane) {
    LAS float* scr = (LAS float*)(lds + wid * 16896);
    CvtItem c0, c1; f32x4 va[16], vb[16];
    const int r0 = chunk * CVT_CHUNK + wid * 4;
    cvt_decode_moe(A, layer, r0, c0); cvt_load(c0, va, lane);
    cvt_decode_moe(A, layer, r0 + 1, c1); cvt_load(c1, vb, lane);
    cvt_store(c0, va, scr, lane);
    cvt_decode_moe(A, layer, r0 + 2, c0); cvt_load(c0, va, lane);
    cvt_store(c1, vb, scr, lane);
    cvt_decode_moe(A, layer, r0 + 3, c1); cvt_load(c1, vb, lane);
    cvt_store(c0, va, scr, lane);
    cvt_store(c1, vb, scr, lane);
}
__device__ __forceinline__ void ph_convert(const Args& A, LAS unsigned char* lds, int wg, int G, int g_wid) {
    PH_IDS;
    unsigned char* ws = A.ws;
    LAS float* scr = (LAS float*)(lds + wid * 16896);
    const int gw = wg * NWAVES + wid, NGW = G * NWAVES;
    { CvtItem cur, nxt; f32x4 va[16], vb[16];
      bool okc = cvt_decode(A, gw, cur);
      if (okc) cvt_load(cur, va, lane);
      for (int it = gw; okc; it += 2 * NGW) {
          const bool okn = cvt_decode(A, it + NGW, nxt);
          if (okn) cvt_load(nxt, vb, lane);
          cvt_store(cur, va, scr, lane);
          if (!okn) break;
          okc = cvt_decode(A, it + 2 * NGW, cur);
          if (okc) cvt_load(cur, va, lane);
          cvt_store(nxt, vb, scr, lane);
      } }
    { const int gt = wg * NTHR + tid, NGT = G * NTHR;
      for (int i = gt; i < 2 * 16 * DM; i += NGT) { const int j = i / (16 * DM), hh = (i / DM) & 15, k = i % DM;
          const float v = hh < HS ? A.in[I_WIN_FOX][(size_t)j * DM * (NPROJ + HS) + (size_t)k * (NPROJ + HS) + NPROJ + hh] : 0.f;
          ((bf16*)(ws + WS_WFG))[i] = (bf16)f2bf(v); }
      { constexpr size_t NX = (size_t)NTOK * DM / 8; const f32x4* xs = (const f32x4*)A.in[I_X]; v4u* xd = (v4u*)(ws + WS_HB);
        size_t i = gt;
        for (; i + 3 * (size_t)NGT < NX; i += 4 * (size_t)NGT) {
            f32x4 a[4], b[4];
#pragma unroll
            for (int q = 0; q < 4; ++q) { a[q] = __builtin_nontemporal_load(xs + 2 * (i + q * (size_t)NGT)); b[q] = __builtin_nontemporal_load(xs + 2 * (i + q * (size_t)NGT) + 1); }
#pragma unroll
            for (int q = 0; q < 4; ++q) { v4u o; o.x = pk2(a[q].x, a[q].y); o.y = pk2(a[q].z, a[q].w); o.z = pk2(b[q].x, b[q].y); o.w = pk2(b[q].z, b[q].w); xd[i + q * (size_t)NGT] = o; } }
        for (; i < NX; i += NGT) { const f32x4 a = xs[2 * i], b = xs[2 * i + 1]; v4u o; o.x = pk2(a.x, a.y); o.y = pk2(a.z, a.w); o.z = pk2(b.x, b.y); o.w = pk2(b.z, b.w); xd[i] = o; } }
      for (size_t i = gt; i < (size_t)NB * NMEM * DM / 8; i += NGT) { const f32x4 a = ((const f32x4*)A.in[I_MEM])[2 * i], b = ((const f32x4*)A.in[I_MEM])[2 * i + 1];
          v4u o; o.x = pk2(a.x, a.y); o.y = pk2(a.z, a.w); o.z = pk2(b.x, b.y); o.w = pk2(b.z, b.w); ((v4u*)(ws + WS_MEMB))[i] = o; }
    }
}

__device__ __forceinline__ void glds16(const void* gsrc, unsigned lds_dst) { unsigned keep;
    asm volatile("s_mov_b32 %0, m0\n\ts_mov_b32 m0, %2\n\ts_nop 0\n\tglobal_load_lds_dwordx4 %1, off\n\ts_mov_b32 m0, %0" : "=&s"(keep) : "v"(gsrc), "s"(lds_dst) : "memory"); }
__device__ __forceinline__ void glds4(const void* gsrc, unsigned lds_dst) { unsigned keep;
    asm volatile("s_mov_b32 %0, m0\n\ts_mov_b32 m0, %2\n\ts_nop 0\n\tglobal_load_lds_dword %1, off\n\ts_mov_b32 m0, %0" : "=&s"(keep) : "v"(gsrc), "s"(lds_dst) : "memory"); }
struct Unit { int pm, pn, e, rows, pa; const bf16* B; const unsigned* list; const LAS unsigned char* ls; };
struct DenseSched {
    static constexpr bool GATHER = false;
    const bf16* A; const bf16* Bt; int nM, nN, G, c;
    __device__ __forceinline__ bool next(int i, Unit& u) const {
        if ((G & 7) == 0 && (nM & 7) == 0) { const int x = c & 7, l = i * (G >> 3) + (c >> 3); u.pm = (l / nN) * 8 + x; u.pn = l % nN; if (u.pm >= nM) return false; }
        else { const int L = i * G + c; if (L >= nM * nN) return false; u.pm = L / nN; u.pn = L % nN; }
        u.pa = u.pm; u.e = 0; u.rows = 256; u.B = Bt + (size_t)u.pn * 256 * DM; u.list = nullptr; return true; }
    __device__ __forceinline__ unsigned arow(const Unit& u, int r) const { return (unsigned)(u.pm * 256 + r); }
    __device__ __forceinline__ unsigned araw(const Unit& u, int r) const { return (unsigned)(u.pm * 256 + r); }
    __device__ __forceinline__ unsigned afin(unsigned x) const { return x; }
};
template <bool GATHER_>
struct MoeSchedT {
    static constexpr bool GATHER = GATHER_;
    const bf16* A; const bf16* Bt; const unsigned* elist; const LAS int* tab; int nN, ntot, G, c, shift;
    __device__ __forceinline__ bool next(int i, Unit& u) const {
        const int tot = __builtin_amdgcn_readfirstlane(tab[64 + 32]); int g;
        if ((G & 7) == 0) { const int x = c & 7, l = i * (G >> 3) + (c >> 3); g = (l / nN) * 8 + x; u.pn = l % nN; if (g >= tot) return false; }
        else { const int L = i * G + c; if (L >= tot * nN) return false; u.pn = L % nN; g = L / nN; }
        int ln; asm volatile("v_mbcnt_lo_u32_b32 %0, -1, 0\n\tv_mbcnt_hi_u32_b32 %0, -1, %0" : "=v"(ln));
        const int offv = tab[64 + (ln & 31)];
        const unsigned long long mk = __builtin_amdgcn_ballot_w64(ln < 32 && offv <= g);
        const int e = __builtin_popcountll(mk) - 1;
        u.e = e; u.pa = g; u.pm = g - __builtin_amdgcn_readfirstlane(tab[64 + e]); const int rem = __builtin_amdgcn_readfirstlane(tab[e]) - 256 * u.pm; u.rows = rem < 256 ? rem : 256;
        u.B = Bt + ((size_t)e * ntot + (size_t)u.pn * 256) * DM; u.list = elist + ((size_t)e * NTOK + 256 * u.pm) * 2; return true; }
    __device__ __forceinline__ unsigned arow(const Unit& u, int r) const { const unsigned rr = (unsigned)r < (unsigned)u.rows ? (unsigned)r : (unsigned)(u.rows - 1); return *(const unsigned*)((const char*)u.list + rr * 8u) >> shift; }
    __device__ __forceinline__ unsigned araw(const Unit& u, int r) const { const unsigned rr = (unsigned)r < (unsigned)u.rows ? (unsigned)r : (unsigned)(u.rows - 1); return *(const unsigned*)((const char*)u.list + rr * 8u); }
    __device__ __forceinline__ unsigned afin(unsigned x) const { return x >> shift; }
};
__device__ __forceinline__ void moe_tables(LAS int* tab, const unsigned* ecnt, int g_wid) {
    PH_IDS;
    if (tid == 0) { int acc = 0; for (int e = 0; e < 32; ++e) { const int c = (int)ecnt[e]; tab[e] = c; tab[64 + e] = acc; acc += (c + 255) >> 8; } tab[64 + 32] = acc; }
    __syncthreads();
}

template <bool NORMS, bool KSUM>
struct EpiProjT {   static constexpr int NSTAGE = 0; __device__ __forceinline__ const void* stage_src(const Unit&, int, int) const { return nullptr; }
    bf16* O; int ldc, q_end, qm_begin; unsigned* norm; float* ksum;
    __device__ __forceinline__ void operator()(const f32x4 (&acc)[2][2][4][2], const Unit& u, int wr, int wc, int fr, int fq) const {
        float nmax[2] = {0.f, 0.f};
#pragma unroll
        for (int ai = 0; ai < 2; ++ai) { float nsq[4][2];
#pragma unroll
            for (int m = 0; m < 4; ++m) { const int row = u.pm * 256 + ai * 128 + wr * 64 + m * 16 + fr;
#pragma unroll
                for (int bj = 0; bj < 2; ++bj) { const int col = u.pn * 256 + bj * 128 + wc * 32 + 8 * fq; const float sc = (col < q_end || col >= qm_begin) ? C2 : 1.f;
                    const f32x4 v0 = acc[ai][bj][m][0] * sc, v1 = acc[ai][bj][m][1] * sc;
                    if (NORMS) nsq[m][bj] = (v0.x * v0.x + v0.y * v0.y) + (v0.z * v0.z + v0.w * v0.w) + (v1.x * v1.x + v1.y * v1.y) + (v1.z * v1.z + v1.w * v1.w);
                    v4u w; w.x = pk2(v0.x, v0.y); w.y = pk2(v0.z, v0.w); w.z = pk2(v1.x, v1.y); w.w = pk2(v1.z, v1.w);
                    *(v4u*)((char*)O + (unsigned)(row * ldc + col) * 2u) = w; } }
            if (NORMS) { if (u.pn < 6) {
                const int ln_ = fq * 16 + fr;
#pragma unroll
                for (int st = 16; st <= 32; st <<= 1) { float t_[4][2];
#pragma unroll
                    for (int m = 0; m < 4; ++m)
#pragma unroll
                        for (int bj = 0; bj < 2; ++bj) t_[m][bj] = __builtin_bit_cast(float, __builtin_amdgcn_ds_bpermute((ln_ ^ st) << 2, __builtin_bit_cast(int, nsq[m][bj])));
#pragma unroll
                    for (int m = 0; m < 4; ++m)
#pragma unroll
                        for (int bj = 0; bj < 2; ++bj) nsq[m][bj] += t_[m][bj]; }
#pragma unroll
                for (int m = 0; m < 4; ++m)
#pragma unroll
                    for (int bj = 0; bj < 2; ++bj) nmax[bj] = fmaxf(nmax[bj], nsq[m][bj]); } } }
        if (NORMS) { if (u.pn < 6) {
            const int b = u.pm >> 5;
#pragma unroll
            for (int bj = 0; bj < 2; ++bj) { const float mx = wave_max(nmax[bj]); const int c = u.pn * 256 + bj * 128 + wc * 32; const int isk = c >= K_COL ? 1 : 0, cc = c - isk * K_COL;
                if (fr == 0 && fq == 0) __hip_atomic_fetch_max(norm + (((b * HS + (cc >> 6)) * 2 + ((cc >> 5) & 1)) * 2 + isk), __float_as_uint(mx), __ATOMIC_RELAXED, __HIP_MEMORY_SCOPE_AGENT); } } }
        if (KSUM) { if (u.pn >= 3 && u.pn < 6) {
            const int b = u.pm >> 5, jblk = u.pm & 31;
#pragma unroll
            for (int bj = 0; bj < 2; ++bj) { const int c = u.pn * 256 + bj * 128 + wc * 32 + 8 * fq - K_COL; float* dst = ksum + ((size_t)((b * HS + (c >> 6)) * 32 + jblk)) * 64 + (c & 63);
#pragma unroll
                for (int n = 0; n < 2; ++n) { f32x4 s = acc[0][bj][0][n];
#pragma unroll
                    for (int ai = 0; ai < 2; ++ai)
#pragma unroll
                        for (int m = 0; m < 4; ++m) if (ai + m) s += acc[ai][bj][m][n];
                    s.x = row16_sum(s.x); s.y = row16_sum(s.y); s.z = row16_sum(s.z); s.w = row16_sum(s.w);
                    if (fr == 0) { atomicAdd(dst + 4 * n, s.x); atomicAdd(dst + 4 * n + 1, s.y); atomicAdd(dst + 4 * n + 2, s.z); atomicAdd(dst + 4 * n + 3, s.w); } } } } }
    }
};
template <bool BASE_F32>
struct EpiOutT {    static constexpr int NSTAGE = 0; __device__ __forceinline__ const void* stage_src(const Unit&, int, int) const { return nullptr; }
    const void* base; bf16* out;
    __device__ __forceinline__ void operator()(const f32x4 (&acc)[2][2][4][2], const Unit& u, int wr, int wc, int fr, int fq) const {
#pragma unroll
        for (int ai = 0; ai < 2; ++ai) {
            f32x4 b0[4][2], b1[4][2];
#pragma unroll
            for (int m = 0; m < 4; ++m)
#pragma unroll
                for (int bj = 0; bj < 2; ++bj) { const unsigned eo = (unsigned)((u.pm * 256 + ai * 128 + wr * 64 + m * 16 + fr) * DM + u.pn * 256 + bj * 128 + wc * 32 + 8 * fq);
                    if (BASE_F32) { b0[m][bj] = *(const f32x4*)((const char*)base + eo * 4u); b1[m][bj] = *(const f32x4*)((const char*)base + eo * 4u + 16); }
                    else { const v4u w = *(const v4u*)((const char*)base + eo * 2u); b0[m][bj] = (f32x4){bflo(w.x), bfhi(w.x), bflo(w.y), bfhi(w.y)}; b1[m][bj] = (f32x4){bflo(w.z), bfhi(w.z), bflo(w.w), bfhi(w.w)}; } }
#pragma unroll
            for (int m = 0; m < 4; ++m)
#pragma unroll
                for (int bj = 0; bj < 2; ++bj) { const unsigned eo = (unsigned)((u.pm * 256 + ai * 128 + wr * 64 + m * 16 + fr) * DM + u.pn * 256 + bj * 128 + wc * 32 + 8 * fq);
                    const f32x4 o0 = b0[m][bj] * ALPHA + acc[ai][bj][m][0], o1 = b1[m][bj] * ALPHA + acc[ai][bj][m][1];
                    v4u w; w.x = pk2(o0.x, o0.y); w.y = pk2(o0.z, o0.w); w.z = pk2(o1.x, o1.y); w.w = pk2(o1.z, o1.w); *(v4u*)((char*)out + eo * 2u) = w; } }
    }
};
__device__ __forceinline__ float swiglu(float g, float uu) {
    g = fminf(g, SW_LIMIT); uu = fminf(fmaxf(uu, -SW_LIMIT), SW_LIMIT);
    const float sg = __builtin_amdgcn_rcpf(1.f + fexp2(-SW_ALPHA * LOG2E * g));
    return g * sg * (uu + 1.f);
}
__device__ __forceinline__ f32x2_t swiglu2(f32x2_t g, f32x2_t uu) {
    g = __builtin_elementwise_min(g, (f32x2_t){SW_LIMIT, SW_LIMIT}); uu = __builtin_elementwise_min(__builtin_elementwise_max(uu, (f32x2_t){-SW_LIMIT, -SW_LIMIT}), (f32x2_t){SW_LIMIT, SW_LIMIT});
    const f32x2_t z = g * (-SW_ALPHA * LOG2E); f32x2_t d; d.x = 1.f + fexp2(z.x); d.y = 1.f + fexp2(z.y);
    f32x2_t sg; sg.x = __builtin_amdgcn_rcpf(d.x); sg.y = __builtin_amdgcn_rcpf(d.y);
    return g * sg * (uu + 1.f);
}
struct EpiGU {
    static constexpr int NSTAGE = 1;
    bf16* abuf; const float* bgu;
    __device__ __forceinline__ const void* stage_src(const Unit& u, int, int lane) const { return bgu + (size_t)u.e * 2048 + (lane >= 32 ? 1024 : 0) + u.pn * 128 + (lane & 31) * 4; }
    __device__ __forceinline__ void operator()(const f32x4 (&acc)[2][2][4][2], const Unit& u, int wr, int wc, int fr, int fq) const { if (u.rows == 256) body<false>(acc, u, wr, wc, fr, fq); else body<true>(acc, u, wr, wc, fr, fq); }
    template <bool CHECK> __device__ __forceinline__ void body(const f32x4 (&acc)[2][2][4][2], const Unit& u, int wr, int wc, int fr, int fq) const {
        const int c0 = u.pn * 128 + wc * 32 + 8 * fq; const LAS float* bl = (const LAS float*)u.ls + wc * 32 + 8 * fq;
        const f32x4 g0 = *(const LAS f32x4*)bl, g1 = *(const LAS f32x4*)(bl + 4), u0 = *(const LAS f32x4*)(bl + 128), u1 = *(const LAS f32x4*)(bl + 132);
#pragma unroll
        for (int ai = 0; ai < 2; ++ai)
#pragma unroll
            for (int m = 0; m < 4; ++m) { const int r = ai * 128 + wr * 64 + m * 16 + fr;
                if (!CHECK || r < u.rows) {
                    const f32x4 ga = acc[ai][0][m][0] + g0, gb = acc[ai][0][m][1] + g1, ua = acc[ai][1][m][0] + u0, ub = acc[ai][1][m][1] + u1;
                    const f32x2_t s0 = swiglu2((f32x2_t){ga.x, ga.y}, (f32x2_t){ua.x, ua.y}), s1 = swiglu2((f32x2_t){ga.z, ga.w}, (f32x2_t){ua.z, ua.w});
                    const f32x2_t s2 = swiglu2((f32x2_t){gb.x, gb.y}, (f32x2_t){ub.x, ub.y}), s3 = swiglu2((f32x2_t){gb.z, gb.w}, (f32x2_t){ub.z, ub.w});
                    v4u w; w.x = pk2(s0.x, s0.y); w.y = pk2(s1.x, s1.y); w.z = pk2(s2.x, s2.y); w.w = pk2(s3.x, s3.y);
                    *(v4u*)((char*)abuf + ((unsigned)(u.pa * 256 + r) * (unsigned)DM + (unsigned)c0) * 2u) = w; } }
    }
};
constexpr float Y_SCALE = 16.f;
struct EpiDN {
    static constexpr int NSTAGE = 3;
    bf16* ybuf; const float* bdn;
    __device__ __forceinline__ const void* stage_src(const Unit& u, int p, int lane) const {
        return p == 0 ? (const void*)(bdn + (size_t)u.e * DM + u.pn * 256 + lane * 4) : (const void*)((const char*)u.list + (p - 1) * 1024 + lane * 16); }
    __device__ __forceinline__ void operator()(const f32x4 (&acc)[2][2][4][2], const Unit& u, int wr, int wc, int fr, int fq) const { if (u.rows == 256) body<false>(acc, u, wr, wc, fr, fq); else body<true>(acc, u, wr, wc, fr, fq); }
    template <bool CHECK> __device__ __forceinline__ void body(const f32x4 (&acc)[2][2][4][2], const Unit& u, int wr, int wc, int fr, int fq) const {
        f32x4 bv[2][2];
#pragma unroll
        for (int bj = 0; bj < 2; ++bj) { const LAS float* bp = (const LAS float*)u.ls + bj * 128 + wc * 32 + 8 * fq; bv[bj][0] = *(const LAS f32x4*)bp; bv[bj][1] = *(const LAS f32x4*)(bp + 4); }
#pragma unroll
        for (int ai = 0; ai < 2; ++ai)
#pragma unroll
            for (int m = 0; m < 4; ++m) { const int r = ai * 128 + wr * 64 + m * 16 + fr;
                if (!CHECK || r < u.rows) { const v2u ag = *(const LAS v2u*)(u.ls + 1024 + r * 8); const unsigned aid = ag.x; const float gt = __uint_as_float(ag.y);
#pragma unroll
                    for (int bj = 0; bj < 2; ++bj) { const float g16 = gt * Y_SCALE; f32x4 v0 = (acc[ai][bj][m][0] + bv[bj][0]) * g16, v1 = (acc[ai][bj][m][1] + bv[bj][1]) * g16;
                        v0.x = __builtin_amdgcn_fmed3f(v0.x, -448.f, 448.f); v0.y = __builtin_amdgcn_fmed3f(v0.y, -448.f, 448.f); v0.z = __builtin_amdgcn_fmed3f(v0.z, -448.f, 448.f); v0.w = __builtin_amdgcn_fmed3f(v0.w, -448.f, 448.f);
                        v1.x = __builtin_amdgcn_fmed3f(v1.x, -448.f, 448.f); v1.y = __builtin_amdgcn_fmed3f(v1.y, -448.f, 448.f); v1.z = __builtin_amdgcn_fmed3f(v1.z, -448.f, 448.f); v1.w = __builtin_amdgcn_fmed3f(v1.w, -448.f, 448.f);
                        int w0 = __builtin_amdgcn_cvt_pk_fp8_f32(v0.x, v0.y, 0, false); w0 = __builtin_amdgcn_cvt_pk_fp8_f32(v0.z, v0.w, w0, true);
                        int w1 = __builtin_amdgcn_cvt_pk_fp8_f32(v1.x, v1.y, 0, false); w1 = __builtin_amdgcn_cvt_pk_fp8_f32(v1.z, v1.w, w1, true);
                        *(v2u*)((char*)ybuf + (aid * (unsigned)DM + (unsigned)(u.pn * 256 + bj * 128 + wc * 32 + 8 * fq))) = (v2u){(unsigned)w0, (unsigned)w1}; } } }
    }
};
template <class Epi, class Sched>
__device__ __forceinline__ void gemm_simple(const Sched& S, const Epi& E, int g_wid) {
    PH_IDS;
    const int wr = wid >> 2, wc = wid & 3, fr = lane & 15, fq = lane >> 4;
    Unit u;
    for (int i = 0; S.next(i, u); ++i) {
        f32x4 acc[2][2][4][2];
#pragma unroll
        for (int a = 0; a < 2; ++a)
#pragma unroll
            for (int b = 0; b < 2; ++b)
#pragma unroll
                for (int m = 0; m < 4; ++m)
#pragma unroll
                    for (int n = 0; n < 2; ++n) acc[a][b][m][n] = (f32x4){0.f, 0.f, 0.f, 0.f};
        unsigned aoff[2][4], boff[2][2];
#pragma unroll
        for (int ai = 0; ai < 2; ++ai)
#pragma unroll
            for (int m = 0; m < 4; ++m) aoff[ai][m] = S.arow(u, ai * 128 + wr * 64 + m * 16 + fr) * DM + 8 * fq;
#pragma unroll
        for (int bj = 0; bj < 2; ++bj)
#pragma unroll
            for (int n = 0; n < 2; ++n) boff[bj][n] = (unsigned)(bj * 128 + wc * 32 + 8 * (fr >> 2) + 4 * n + (fr & 3)) * DM + 8 * fq;
#pragma unroll 1
        for (int k0 = 0; k0 < DM; k0 += 32) {
            bf16x8 b[2][2];
#pragma unroll
            for (int bj = 0; bj < 2; ++bj)
#pragma unroll
                for (int n = 0; n < 2; ++n) b[bj][n] = *(const bf16x8*)(u.B + boff[bj][n] + k0);
#pragma unroll
            for (int ai = 0; ai < 2; ++ai) {
                bf16x8 a[4];
#pragma unroll
                for (int m = 0; m < 4; ++m) a[m] = *(const bf16x8*)(S.A + aoff[ai][m] + k0);
#pragma unroll
                for (int bj = 0; bj < 2; ++bj)
#pragma unroll
                    for (int m = 0; m < 4; ++m)
#pragma unroll
                        for (int n = 0; n < 2; ++n) acc[ai][bj][m][n] = __builtin_amdgcn_mfma_f32_16x16x32_bf16(b[bj][n], a[m], acc[ai][bj][m][n], 0, 0, 0);
            }
        }
        E(acc, u, wr, wc, fr, fq);
    }
}


namespace pg8 {
constexpr int BM = 256, BK = 64, HALF = 128, HTB = HALF * BK * 2, STAGE_BYTES = 8 * HTB;
__device__ __forceinline__ int lds_byte(int r, int c) { const int st = (r >> 4) * 2 + (c >> 5), rr = r & 15, cc = c & 31, ob = rr * 64 + cc * 2; return st * 1024 + (ob ^ (((ob >> 9) & 1) << 5)); }
__device__ __forceinline__ void stage_rc(int b, int& R, int& C) { const int st = b / 1024, sb = b % 1024, swz = sb ^ (((sb >> 9) & 1) << 5); R = (st >> 1) * 16 + swz / 64; C = (st & 1) * 32 + (swz % 64) / 2; }
__device__ __forceinline__ int perm32(int rho) { const int n = rho >> 4, i = rho & 15; return 8 * (i >> 2) + 4 * n + (i & 3); }
}
template <class Epi, class Sched, bool ALIGN_EPI>
__device__ __forceinline__ void gemm_fast(LAS unsigned char* lds, const Sched& S, const Epi& E, int g_wid) {
    using namespace pg8;
    PH_IDS;
    const int wr = wid >> 2, wc = wid & 3, fr = lane & 15, fq = lane >> 4;
    constexpr int K = DM, nt = K / BK;
    int Rr[2], Cc[2]; unsigned voffB[2];
#pragma unroll
    for (int i = 0; i < 2; ++i) { int R, C; stage_rc(tid * 16 + i * 8192, R, C); Rr[i] = R; Cc[i] = C; const int Rb = (R & ~31) + perm32(R & 31); voffB[i] = (unsigned)(Rb * K + C) * 2u; }
    constexpr unsigned kstep = BK * 2, hstep = HALF * K * 2;
    const unsigned ldsw = (unsigned)wid * 1024u;
    const int aoff = lds_byte(wr * 64 + fr, fq * 8), boff = lds_byte(wc * 32 + fr, fq * 8);
    const char* Ab = (const char*)S.A;
#define PG8_SA(b, h) (((b) * 2 + (h)) * HTB)
#define PG8_SB(b, h) ((4 + (b) * 2 + (h)) * HTB)
#define PG8_STAGEB(bufoff, gbase) do { const char* _ub = (const char*)(gbase); asm volatile("" : "+s"(_ub)); _Pragma("unroll") for (int _i = 0; _i < 2; ++_i) \
        __builtin_amdgcn_global_load_lds((const unsigned*)(_ub + voffB[_i]), (LAS unsigned*)(lds + (bufoff) + ldsw + _i * 8192), 16, 0, 0); } while (0)
#define PG8_STAGEA(bufoff, kb, vo, sb) do { const char* _ub = (sb) + (size_t)(kb); asm volatile("" : "+s"(_ub)); _Pragma("unroll") for (int _i = 0; _i < 2; ++_i) \
        __builtin_amdgcn_global_load_lds((const unsigned*)(_ub + (vo)[_i]), (LAS unsigned*)(lds + (bufoff) + ldsw + _i * 8192), 16, 0, 0); } while (0)
#define PG8_VA(h) (Sched::GATHER ? vA[h] : laneA)
#define PG8_VN(h) (Sched::GATHER ? vN[h] : laneA)
#define PG8_BA(h) (Sched::GATHER ? Ab : cAb + (h) * hstep)
#define PG8_BN(h) (Sched::GATHER ? Ab : nAb + (h) * hstep)
#define PG8_LDA(dst, b, h) do { _Pragma("unroll") for (int m = 0; m < 4; ++m) _Pragma("unroll") for (int k = 0; k < 2; ++k) dst[m][k] = *(const LAS bf16x8*)(lds + PG8_SA(b, h) + aoff + m * 2048 + k * 1024); } while (0)
#define PG8_LDB(dst, b, h) do { _Pragma("unroll") for (int n = 0; n < 2; ++n) _Pragma("unroll") for (int k = 0; k < 2; ++k) dst[n][k] = *(const LAS bf16x8*)(lds + PG8_SB(b, h) + boff + n * 2048 + k * 1024); } while (0)
#define PG8_MMA(ai, bj, At, Bt) do { __builtin_amdgcn_s_setprio(1); _Pragma("unroll") for (int m = 0; m < 4; ++m) _Pragma("unroll") for (int n = 0; n < 2; ++n) _Pragma("unroll") for (int k = 0; k < 2; ++k) \
        acc[ai][bj][m][n] = __builtin_amdgcn_mfma_f32_16x16x32_bf16(Bt[n][k], At[m][k], acc[ai][bj][m][n], 0, 0, 0); __builtin_amdgcn_s_setprio(0); } while (0)
#define PG8_WAIT_V(n) asm volatile("s_waitcnt vmcnt(" #n ")" ::: "memory")
#define PG8_WAIT_L(n) asm volatile("s_waitcnt lgkmcnt(" #n ")" ::: "memory")
#define PG8_BAR __builtin_amdgcn_s_barrier()
#define PG8_SCHED __builtin_amdgcn_sched_barrier(0)
#define PG8_OFFS_RAW(dst, un) do { _Pragma("unroll") for (int _h = 0; _h < 2; ++_h) _Pragma("unroll") for (int _i = 0; _i < 2; ++_i) dst[_h][_i] = S.araw(un, _h * 128 + Rr[_i]); } while (0)
#define PG8_OFFS_FIN(dst, raw) do { _Pragma("unroll") for (int _h = 0; _h < 2; ++_h) _Pragma("unroll") for (int _i = 0; _i < 2; ++_i) dst[_h][_i] = (S.afin(raw[_h][_i]) * (unsigned)K + (unsigned)Cc[_i]) * 2u; } while (0)
#define PG8_OFFS(dst, un) do { _Pragma("unroll") for (int _h = 0; _h < 2; ++_h) _Pragma("unroll") for (int _i = 0; _i < 2; ++_i) dst[_h][_i] = (S.arow(un, _h * 128 + Rr[_i]) * (unsigned)K + (unsigned)Cc[_i]) * 2u; } while (0)
    Unit cur, nxt, nn; int ui = 0;
    if (!S.next(0, cur)) return;
    f32x4 acc[2][2][4][2];
#pragma unroll
    for (int a = 0; a < 2; ++a)
#pragma unroll
        for (int b = 0; b < 2; ++b)
#pragma unroll
            for (int m = 0; m < 4; ++m)
#pragma unroll
                for (int n = 0; n < 2; ++n) acc[a][b][m][n] = (f32x4){0.f, 0.f, 0.f, 0.f};
    bf16x8 At[4][2], B0[2][2], B1[2][2];
    unsigned vA[2][2], vN[2][2], laneA[2];
#pragma unroll
    for (int i = 0; i < 2; ++i) laneA[i] = (unsigned)(Rr[i] * K + Cc[i]) * 2u;
    if constexpr (Sched::GATHER) { PG8_OFFS(vA, cur); }
    const char* cAb = Ab + (size_t)cur.pa * (2 * hstep); const char* nAb = cAb;
    const char* cB = (const char*)cur.B;
    PG8_STAGEB(PG8_SB(0, 0), cB); PG8_STAGEB(PG8_SB(0, 1), cB + hstep); PG8_STAGEA(PG8_SA(0, 0), 0, PG8_VA(0), PG8_BA(0)); PG8_STAGEA(PG8_SA(0, 1), 0, PG8_VA(1), PG8_BA(1));
    if (wr == 1) PG8_BAR;
    PG8_WAIT_V(2); PG8_BAR;
    PG8_STAGEB(PG8_SB(1, 0), cB + kstep); PG8_STAGEA(PG8_SA(1, 0), kstep, PG8_VA(0), PG8_BA(0)); PG8_STAGEB(PG8_SB(1, 1), cB + hstep + kstep);
    PG8_WAIT_V(6); PG8_BAR;
    bool has_next = S.next(1, nxt);
    unsigned rawN[2][2] = {{0u, 0u}, {0u, 0u}};
    if constexpr (Sched::GATHER) { if (has_next) { PG8_OFFS_RAW(rawN, nxt); } }
    for (;;) {
        if constexpr (Epi::NSTAGE > 0) {
            cur.ls = lds + STAGE_BYTES + (ui & 1) * 4096;
            if (wid == 0) {
#pragma unroll
                for (int p = 0; p < Epi::NSTAGE; ++p) glds16(E.stage_src(cur, p, lane), (unsigned)__builtin_amdgcn_readfirstlane((unsigned)(uintptr_t)cur.ls + p * 1024)); } }
        if constexpr (Sched::GATHER) {
            if (has_next) { PG8_OFFS_FIN(vN, rawN); } else {
#pragma unroll
                for (int h = 0; h < 2; ++h)
#pragma unroll
                    for (int i = 0; i < 2; ++i) vN[h][i] = vA[h][i]; } }
        else nAb = has_next ? Ab + (size_t)nxt.pa * (2 * hstep) : cAb;
        const char* nB = has_next ? (const char*)nxt.B : cB;
#define PG8_KSTEP(LAST, t) do { \
            const unsigned kb1 = (unsigned)((t) + 1) * kstep, kb2 = (LAST) ? 0u : (unsigned)((t) + 2) * kstep, kb3 = kb2 + kstep; \
            const char* b2 = (LAST) ? nB : cB + (size_t)((t) + 2) * kstep; const char* b3 = b2 + kstep; \
            PG8_LDB(B0, 0, 0); PG8_LDB(B1, 0, 1); PG8_SCHED; PG8_LDA(At, 0, 0); PG8_STAGEA(PG8_SA(1, 1), kb1, PG8_VA(1), PG8_BA(1)); \
            PG8_WAIT_V(8); PG8_WAIT_L(0); PG8_BAR; PG8_MMA(0, 0, At, B0); PG8_MMA(0, 1, At, B1); PG8_BAR; PG8_SCHED; \
            PG8_LDA(At, 0, 1); PG8_STAGEB(PG8_SB(0, 0), b2); PG8_STAGEB(PG8_SB(0, 1), b2 + hstep); if (LAST) { PG8_STAGEA(PG8_SA(0, 0), kb2, PG8_VN(0), PG8_BN(0)); } else { PG8_STAGEA(PG8_SA(0, 0), kb2, PG8_VA(0), PG8_BA(0)); } \
            PG8_WAIT_V(8); PG8_WAIT_L(0); PG8_BAR; PG8_MMA(1, 0, At, B0); PG8_MMA(1, 1, At, B1); PG8_BAR; PG8_SCHED; \
            PG8_LDB(B0, 1, 0); PG8_LDB(B1, 1, 1); PG8_SCHED; PG8_LDA(At, 1, 0); if (LAST) { PG8_STAGEA(PG8_SA(0, 1), kb2, PG8_VN(1), PG8_BN(1)); } else { PG8_STAGEA(PG8_SA(0, 1), kb2, PG8_VA(1), PG8_BA(1)); } \
            PG8_WAIT_V(8); PG8_WAIT_L(0); PG8_BAR; PG8_MMA(0, 0, At, B0); PG8_MMA(0, 1, At, B1); PG8_BAR; PG8_SCHED; \
            PG8_LDA(At, 1, 1); PG8_STAGEB(PG8_SB(1, 0), b3); PG8_STAGEB(PG8_SB(1, 1), b3 + hstep); if (LAST) { PG8_STAGEA(PG8_SA(1, 0), kb3, PG8_VN(0), PG8_BN(0)); } else { PG8_STAGEA(PG8_SA(1, 0), kb3, PG8_VA(0), PG8_BA(0)); } \
            PG8_WAIT_V(8); PG8_WAIT_L(0); PG8_BAR; PG8_MMA(1, 0, At, B0); PG8_MMA(1, 1, At, B1); PG8_BAR; PG8_SCHED; } while (0)
        for (int t = 0; t < nt - 2; t += 2) PG8_KSTEP(false, t);
        PG8_KSTEP(true, nt - 2);
#undef PG8_KSTEP
        if constexpr (ALIGN_EPI) { if (wr == 0) PG8_BAR; }
        bool has_nn = false; unsigned rawNN[2][2] = {{0u, 0u}, {0u, 0u}};
        if (has_next) { has_nn = S.next(ui + 2, nn); if constexpr (Sched::GATHER) { if (has_nn) { PG8_OFFS_RAW(rawNN, nn); } } }
        { int fr_e = fr, fq_e = fq; asm volatile("" : "+v"(fr_e), "+v"(fq_e));
          E(acc, cur, wr, wc, fr_e, fq_e); }
        if (!has_next) break;
#pragma unroll
        for (int a = 0; a < 2; ++a)
#pragma unroll
            for (int b = 0; b < 2; ++b)
#pragma unroll
                for (int m = 0; m < 4; ++m)
#pragma unroll
                    for (int n = 0; n < 2; ++n) acc[a][b][m][n] = (f32x4){0.f, 0.f, 0.f, 0.f};
        cur = nxt; nxt = nn; has_next = has_nn; cB = nB; cAb = nAb; ++ui;
#pragma unroll
        for (int h = 0; h < 2; ++h)
#pragma unroll
            for (int i = 0; i < 2; ++i) rawN[h][i] = rawNN[h][i];
        if constexpr (Sched::GATHER) {
#pragma unroll
            for (int h = 0; h < 2; ++h)
#pragma unroll
                for (int i = 0; i < 2; ++i) vA[h][i] = vN[h][i]; }
        if constexpr (ALIGN_EPI) { if (wr == 1) PG8_BAR; }
    }
    PG8_WAIT_V(0);
    if constexpr (!ALIGN_EPI) { if (wr == 0) PG8_BAR; }
    PG8_BAR;
#undef PG8_SA
#undef PG8_SB
#undef PG8_STAGEA
#undef PG8_VA
#undef PG8_VN
#undef PG8_BA
#undef PG8_BN
#undef PG8_STAGEB
#undef PG8_LDA
#undef PG8_LDB
#undef PG8_MMA
#undef PG8_WAIT_V
#undef PG8_WAIT_L
#undef PG8_BAR
#undef PG8_SCHED
#undef PG8_OFFS
#undef PG8_OFFS_RAW
#undef PG8_OFFS_FIN
}

__device__ __forceinline__ void ph_fox_gate(const Args& A, int j, int wg, int G, int g_wid) {
    PH_IDS;
    const bf16* hb = (const bf16*)(A.ws + WS_HB); const bf16* wfg = (const bf16*)(A.ws + WS_WFG) + (size_t)j * 16 * DM; float* lf = (float*)(A.ws + WS_LF);
    const float* bfg = A.in[I_BFG] + j * HS;
    const int gw = wg * NWAVES + wid, NGW = G * NWAVES;
    v4u wv[HS][2];
#pragma unroll
    for (int hh = 0; hh < HS; ++hh) { const v4u* wp = (const v4u*)(wfg + (size_t)hh * DM + 16 * lane); wv[hh][0] = wp[0]; wv[hh][1] = wp[1]; }
    v4u p0 = {0u, 0u, 0u, 0u}, p1 = {0u, 0u, 0u, 0u};
    if (gw < NTOK) { const v4u* hp = (const v4u*)(hb + (size_t)gw * DM + 16 * lane); p0 = hp[0]; p1 = hp[1]; }
    for (int n = gw; n < NTOK; n += NGW) {
        const v4u h0 = p0, h1 = p1;
        if (n + NGW < NTOK) { const v4u* hp = (const v4u*)(hb + (size_t)(n + NGW) * DM + 16 * lane); p0 = hp[0]; p1 = hp[1]; }
        float hv[16] = {bflo(h0.x), bfhi(h0.x), bflo(h0.y), bfhi(h0.y), bflo(h0.z), bfhi(h0.z), bflo(h0.w), bfhi(h0.w), bflo(h1.x), bfhi(h1.x), bflo(h1.y), bfhi(h1.y), bflo(h1.z), bfhi(h1.z), bflo(h1.w), bfhi(h1.w)};
        float mine = 0.f;
#pragma unroll
        for (int hh = 0; hh < HS; ++hh) {
            const v4u w0 = wv[hh][0], w1 = wv[hh][1];
            float s = hv[0] * bflo(w0.x) + hv[1] * bfhi(w0.x) + hv[2] * bflo(w0.y) + hv[3] * bfhi(w0.y) + hv[4] * bflo(w0.z) + hv[5] * bfhi(w0.z) + hv[6] * bflo(w0.w) + hv[7] * bfhi(w0.w)
                    + hv[8] * bflo(w1.x) + hv[9] * bfhi(w1.x) + hv[10] * bflo(w1.y) + hv[11] * bfhi(w1.y) + hv[12] * bflo(w1.z) + hv[13] * bfhi(w1.z) + hv[14] * bflo(w1.w) + hv[15] * bfhi(w1.w);
            s = wave_sum(s);
            if (lane == hh) mine = s;
        }
        if (lane < HS) { const float z = mine + bfg[lane];
            const float ls = fminf(z, 0.f) - __builtin_amdgcn_logf(1.f + fexp2(-fabsf(z) * LOG2E)) * 0.6931471805599453f;
            const int b = n >> 13, t = n & (SEQ - 1); lf[((size_t)(b * HS + lane)) * SEQ + t] = ls; }
    }
}
__device__ __forceinline__ void ph_fox_scan(const Args& A, LAS unsigned char* lds, int wg, int G, int g_wid) {
    PH_IDS;
    const float* lf = (const float*)(A.ws + WS_LF); float* c2 = (float*)(A.ws + WS_CFOX); LAS float* part = (LAS float*)lds;
    for (int s = wg; s < NB * HS; s += G) {
        const float* src = lf + (size_t)s * SEQ + tid * 16; float v[16]; float run = 0.f;
#pragma unroll
        for (int i = 0; i < 16; ++i) { run += src[i]; v[i] = run; }
        part[tid] = run; __syncthreads();
        if (tid == 0) { float acc = 0.f; for (int i = 0; i < NTHR; ++i) { const float x = part[i]; part[i] = acc; acc += x; } }
        __syncthreads();
        const float base = part[tid]; float* dst = c2 + (size_t)s * SEQ + tid * 16;
#pragma unroll
        for (int i = 0; i < 16; ++i) dst[i] = (base + v[i]) * LOG2E;
        __syncthreads();
    }
}
__device__ __forceinline__ void ph_kbar(const Args& A, LAS unsigned char* lds, int wg, int G, int g_wid) {
    PH_IDS;
    const bf16* proj = (const bf16*)(A.ws + WS_PROJ); float* kbar = (float*)(A.ws + WS_KBAR); LAS float* part = (LAS float*)lds;
    const int d = tid & 63, r8 = tid >> 6;
    for (int uidx = wg; uidx < NB * HS * 32; uidx += G) {
        const int j = uidx & 31, bh = uidx >> 5, b = bh / HS, h = bh % HS;
        const bf16* kp = proj + ((size_t)(b * SEQ + j * 256 + r8 * 32)) * NPROJ + K_COL + h * 64 + d;
        float s = 0.f;
        for (int r = 0; r < 32; ++r) s += __uint_as_float((unsigned)kp[(size_t)r * NPROJ] << 16);
        part[tid] = s; __syncthreads();
        if (tid < 64) { float t = 0.f;
#pragma unroll
            for (int q = 0; q < 8; ++q) t += part[q * 64 + tid];
            kbar[(size_t)uidx * 64 + tid] = t * (1.f / 256.f); ((bf16*)(A.ws + WS_KBAR + 512 * 1024))[(size_t)uidx * 64 + tid] = (bf16)f2bf(t * (1.f / 256.f)); }
        __syncthreads();
    }
}

__device__ __forceinline__ float alibi_slope(int h) { return h < 8 ? exp2f(-(float)(h + 1)) : exp2f(-(0.5f + (float)(h - 8))); }
#define ROW8(w, base, arr) do { arr[base + 0] = bflo(w.x); arr[base + 1] = bfhi(w.x); arr[base + 2] = bflo(w.y); arr[base + 3] = bfhi(w.y); arr[base + 4] = bflo(w.z); arr[base + 5] = bfhi(w.z); arr[base + 6] = bflo(w.w); arr[base + 7] = bfhi(w.w); } while (0)
__device__ __forceinline__ float dot_row64(const float (&q)[64], const bf16* p) {
    const v4u* p4 = (const v4u*)p; float s0 = 0.f, s1 = 0.f;
#pragma unroll
    for (int i = 0; i < 8; ++i) { if (i == 4) asm volatile("" ::: "memory"); const v4u w = p4[i];
        s0 += q[8 * i + 0] * bflo(w.x); s1 += q[8 * i + 1] * bfhi(w.x); s0 += q[8 * i + 2] * bflo(w.y); s1 += q[8 * i + 3] * bfhi(w.y);
        s0 += q[8 * i + 4] * bflo(w.z); s1 += q[8 * i + 5] * bfhi(w.z); s0 += q[8 * i + 6] * bflo(w.w); s1 += q[8 * i + 7] * bfhi(w.w); }
    return s0 + s1;
}
__device__ __forceinline__ void att_upd(float x, const bf16* vrow, float& m, float& l, float (&o)[64]) {
    const float mn = fmaxf(m, x), al = fexp2(m - mn), pp = fexp2(x - mn); m = mn; l = l * al + pp;
    const v4u* p4 = (const v4u*)vrow; asm volatile("" ::: "memory");
#pragma unroll
    for (int i = 0; i < 8; ++i) { if ((i & 1) == 0) asm volatile("" ::: "memory"); const v4u w = p4[i];
        o[8 * i + 0] = o[8 * i + 0] * al + pp * bflo(w.x); o[8 * i + 1] = o[8 * i + 1] * al + pp * bfhi(w.x); o[8 * i + 2] = o[8 * i + 2] * al + pp * bflo(w.y); o[8 * i + 3] = o[8 * i + 3] * al + pp * bfhi(w.y);
        o[8 * i + 4] = o[8 * i + 4] * al + pp * bflo(w.z); o[8 * i + 5] = o[8 * i + 5] * al + pp * bfhi(w.z); o[8 * i + 6] = o[8 * i + 6] * al + pp * bflo(w.w); o[8 * i + 7] = o[8 * i + 7] * al + pp * bfhi(w.w); }
}
template <int MODE, int H_LO = 0, int H_HI = 16>
__device__ __forceinline__ void ph_attn_naive(const Args& A, int wg, int G, int g_wid) {
    PH_IDS;
    const bf16* proj = (const bf16*)(A.ws + WS_PROJ); const bf16* mkv = (const bf16*)(A.ws + WS_MKV); bf16* att = (bf16*)(A.ws + WS_ATT);
    const float* kbar = (const float*)(A.ws + WS_KBAR); const float* cfox = (const float*)(A.ws + WS_CFOX);
    constexpr int NIT = 16 * (NTOK / 64);
    const int gw = wg * NWAVES + wid, NGW = G * NWAVES;
    for (int base = 0, rnd = 0; base < NIT; base += NGW, ++rnd) {
        const int it = base + ((rnd & 1) ? (NGW - 1 - gw) : gw);
        if (it >= NIT) continue;
        const int hh = it & 15, tg = it >> 4, n = tg * 64 + lane, b = n >> 13, t = n & (SEQ - 1);
        if (hh < H_LO || hh >= H_HI) continue;
        float q[64];
        { const v4u* p4 = (const v4u*)(proj + (size_t)n * NPROJ + (hh < HS ? hh * 64 : QM_COL + (hh - HS) * 64));
#pragma unroll
          for (int i = 0; i < 8; ++i) { const v4u w = p4[i]; ROW8(w, 8 * i, q); } }
        float m = -1e30f, l = 0.f; float o[64];
#pragma unroll
        for (int i = 0; i < 64; ++i) o[i] = 0.f;
        if (hh < HS) {
            const bf16* Kb = proj + (size_t)(b * SEQ) * NPROJ + K_COL + hh * 64; const bf16* Vb = Kb + (V_COL - K_COL);
            if (MODE == 0) {
                const float slope2 = alibi_slope(hh) * LOG2E; const int qb = t >> 8;
                const float* kb = kbar + (size_t)((b * HS + hh) * 32) * 64;
                float g0 = -INFINITY, g1 = -INFINITY, g2 = -INFINITY; int i0 = -1, i1 = -1, i2 = -1;
                for (int j = 0; j < qb; ++j) { float s0 = 0.f, s1 = 0.f;
#pragma unroll
                    for (int d = 0; d < 64; d += 2) { s0 += q[d] * kb[j * 64 + d]; s1 += q[d + 1] * kb[j * 64 + d + 1]; }
                    const float g = s0 + s1;
                    if (g > g0) { g2 = g1; i2 = i1; g1 = g0; i1 = i0; g0 = g; i0 = j; } else if (g > g1) { g2 = g1; i2 = i1; g1 = g; i1 = j; } else if (g > g2) { g2 = g; i2 = j; } }
                const int tend = (t | 63);
                for (int s = qb * 256; s <= tend; ++s) { if (s <= t) { const float x = dot_row64(q, Kb + (size_t)s * NPROJ) - slope2 * (float)(t - s); att_upd(x, Vb + (size_t)s * NPROJ, m, l, o); } }
                for (int sl = 0; sl < 3; ++sl) { const int jb = sl == 0 ? i0 : (sl == 1 ? i1 : i2);
                    if (jb >= 0) for (int s = 0; s < 256; ++s) { const int key = jb * 256 + s; const float x = dot_row64(q, Kb + (size_t)key * NPROJ) - slope2 * (float)(t - key); att_upd(x, Vb + (size_t)key * NPROJ, m, l, o); } }
            } else {
                const float* c2 = cfox + (size_t)(b * HS + hh) * SEQ; const float cq = c2[t]; const int tend = (t | 63);
                for (int s = 0; s <= tend; ++s) { if (s <= t) { const float x = dot_row64(q, Kb + (size_t)s * NPROJ) + (cq - c2[s]); att_upd(x, Vb + (size_t)s * NPROJ, m, l, o); } }
            }
        } else {
            const bf16* Kb = mkv + (size_t)(b * NMEM) * 512 + (hh - HS) * 64; const bf16* Vb = Kb + 256;
            for (int s = 0; s < NMEM; ++s) { const float x = dot_row64(q, Kb + (size_t)s * 512); att_upd(x, Vb + (size_t)s * 512, m, l, o); }
        }
        const float rl = 1.f / l; v4u* op = (v4u*)(att + (size_t)n * DM + hh * 64);
#pragma unroll
        for (int i = 0; i < 8; ++i) { v4u w; w.x = pk2(o[8 * i] * rl, o[8 * i + 1] * rl); w.y = pk2(o[8 * i + 2] * rl, o[8 * i + 3] * rl); w.z = pk2(o[8 * i + 4] * rl, o[8 * i + 5] * rl); w.w = pk2(o[8 * i + 6] * rl, o[8 * i + 7] * rl); op[i] = w; }
    }
}


__device__ __forceinline__ void ph_norms(const Args& A, int layer, LAS unsigned char* lds, int wg, int G, int g_wid) {
    PH_IDS;
    const bf16* proj = (const bf16*)(A.ws + WS_PROJ); unsigned* gn = (unsigned*)(A.ws + WS_CTL) + CW_NORM + layer * 128;
    LAS unsigned* ln = (LAS unsigned*)(lds + 65536);
    if (tid < 128) ln[tid] = 0u;
    __syncthreads();
    const int gt = wg * NTHR + tid, NGT = G * NTHR;
    for (int it = gt; it < NTOK * 4; it += NGT) {
        const int n = it >> 2, part = it & 3, b = n >> 13;
#pragma unroll
        for (int hq = 0; hq < 3; ++hq) { const int hh = part * 3 + hq;
#pragma unroll
            for (int kq = 0; kq < 2; ++kq) { const v4u* p4 = (const v4u*)(proj + (size_t)n * NPROJ + kq * K_COL + hh * 64); float s = 0.f;
#pragma unroll
                for (int i = 0; i < 8; ++i) { const v4u w = p4[i]; const float a0 = bflo(w.x), a1 = bfhi(w.x), a2 = bflo(w.y), a3 = bfhi(w.y), a4 = bflo(w.z), a5 = bfhi(w.z), a6 = bflo(w.w), a7 = bfhi(w.w);
                    s += (a0 * a0 + a1 * a1) + (a2 * a2 + a3 * a3) + (a4 * a4 + a5 * a5) + (a6 * a6 + a7 * a7); }
                atomicMax((unsigned*)ln + (b * HS + hh) * 2 + kq, __float_as_uint(s)); } }
    }
    __syncthreads();
    if (tid < 96) { const unsigned v = ln[tid]; if (v) __hip_atomic_fetch_max(gn + tid, v, __ATOMIC_RELAXED, __HIP_MEMORY_SCOPE_AGENT); }
    __syncthreads();
}

typedef float f32x16 __attribute__((ext_vector_type(16)));
typedef short s16x4 __attribute__((ext_vector_type(4)));
__device__ __forceinline__ int crow(int r, int hi) { return (r & 3) + 8 * (r >> 2) + 4 * hi; }
#define ATT_WAIT_BAR() asm volatile("s_waitcnt vmcnt(0) lgkmcnt(0)\n\ts_barrier" ::: "memory")
constexpr int ATT_K = 0, ATT_V = 16384, ATT_CK = 32768;
constexpr float ATT_THR = 8.0f, ATT_THETA = 45.0f;
__device__ __forceinline__ float max3f(float a, float b, float c) { float r; asm("v_max3_f32 %0, %1, %2, %3" : "=v"(r) : "v"(a), "v"(b), "v"(c)); return r; }
__device__ __forceinline__ float max2f(float a, float b) { float r; asm("v_max_f32_e32 %0, %1, %2" : "=v"(r) : "v"(a), "v"(b)); return r; }
__device__ __forceinline__ float swap_other(float v, int hi) { auto rr = __builtin_amdgcn_permlane32_swap(__float_as_uint(v), __float_as_uint(v), false, false); return __uint_as_float(hi ? rr[0] : rr[1]); }
__device__ __forceinline__ int swap_other_i(int v, int hi) { auto rr = __builtin_amdgcn_permlane32_swap((unsigned)v, (unsigned)v, false, false); return (int)(hi ? rr[0] : rr[1]); }

template <int MODE>
__device__ __forceinline__ void attn_unit(const Args& A, LAS unsigned char* lds, const int layer, const int b, const int h, const int qb, const int wid, const int lane) {
    const int r32 = lane & 31, hi = lane >> 5, q0 = qb * 256, wrow0 = q0 + wid * 32, trow = wrow0 + r32;
    const bf16* proj = (const bf16*)(A.ws + WS_PROJ);
    constexpr int pitch = (MODE == 2) ? 512 : NPROJ;
    const bf16* Kb = (MODE == 2) ? (const bf16*)(A.ws + WS_MKV) + (size_t)(b * NMEM) * 512 + h * 64 : proj + (size_t)(b * SEQ) * NPROJ + K_COL + h * 64;
    const bf16* Vb = (MODE == 2) ? Kb + 256 : Kb + (V_COL - K_COL);
    const bf16* Qrow = proj + (size_t)(b * SEQ + trow) * NPROJ + ((MODE == 2) ? QM_COL : 0) + h * 64;
    bf16x8 qr[4];
#pragma unroll
    for (int d0 = 0; d0 < 4; ++d0) qr[d0] = *(const bf16x8*)(Qrow + 16 * d0 + 8 * hi);
    const unsigned ldsb = (unsigned)(uintptr_t)lds;
    const bf16* ksrc = Kb + (size_t)lane * pitch + wid * 8;
    const bf16* vsrc = Vb + (size_t)(16 * (wid & 3) + (lane >> 2)) * pitch + (wid >> 2) * 32 + (lane & 3) * 8;
    float cq = 0.f, slope2 = 0.f; const float* c2 = nullptr;
    if (MODE == 1) { c2 = (const float*)(A.ws + WS_CFOX) + (size_t)(b * HS + h) * SEQ; cq = c2[trow]; }
    if (MODE == 0) { slope2 = alibi_slope(h) * LOG2E; cq = -slope2 * (float)(trow - q0); }
#define ATT_STAGE(kt, buf) do { glds16(ksrc + (size_t)(kt) * 64 * pitch, (unsigned)__builtin_amdgcn_readfirstlane(ldsb + ATT_K + (buf) * 8192 + wid * 1024)); \
        glds16(vsrc + (size_t)(kt) * 64 * pitch, (unsigned)__builtin_amdgcn_readfirstlane(ldsb + ATT_V + (buf) * 8192 + wid * 1024)); \
        if (MODE == 1 && wid == 0) glds4(c2 + (kt) * 64 + lane, (unsigned)__builtin_amdgcn_readfirstlane(ldsb + ATT_CK + (buf) * 256)); \
        if (MODE == 0 && wid == 0) ((LAS float*)(lds + ATT_CK + (buf) * 256))[lane] = -slope2 * (float)((kt) * 64 + lane - q0); } while (0)
    unsigned gnv[4] = {0u, 0u, 0u, 0u}; float cA = 0.f, cB = 0.f, cq0 = 0.f;
    if (MODE != 2) { const unsigned* gn = (const unsigned*)(A.ws + WS_CTL) + CW_NORM + layer * 256 + (b * HS + h) * 4; gnv[0] = gn[0]; gnv[1] = gn[1]; gnv[2] = gn[2]; gnv[3] = gn[3]; }
    const int ktA = 4 * qb - 1 - lane, ktB = ktA - 64;
    if (MODE == 1) { if (qb > 0) { cq0 = c2[q0]; if (ktA >= 0) cA = c2[64 * ktA + 63]; if (ktB >= 0) cB = c2[64 * ktB + 63]; } }
    f32x4 kv[4][2];
    if (MODE == 0) { if (qb > 0) { const float* kbp = (const float*)(A.ws + WS_KSUM) + (size_t)(layer >> 1) * (NB * HS * 32 * 64) + ((size_t)((b * HS + h) * 32 + r32)) * 64 + 8 * hi;
#pragma unroll
        for (int d0 = 0; d0 < 4; ++d0) { kv[d0][0] = *(const f32x4*)(kbp + 16 * d0); kv[d0][1] = *(const f32x4*)(kbp + 16 * d0 + 4); } } }
    ATT_STAGE((MODE == 2) ? 3 : 4 * qb + 3, 0);
    unsigned selmask = 0u;
    if (MODE == 0) { if (qb > 0) {
        f32x16 g;
#pragma unroll
        for (int i = 0; i < 16; ++i) g[i] = 0.f;
#pragma unroll
        for (int d0 = 0; d0 < 4; ++d0) { const f32x4 ka = kv[d0][0] * (1.f / 256.f), kc = kv[d0][1] * (1.f / 256.f);
            v4u kw; kw.x = pk2(ka.x, ka.y); kw.y = pk2(ka.z, ka.w); kw.z = pk2(kc.x, kc.y); kw.w = pk2(kc.z, kc.w);
            g = __builtin_amdgcn_mfma_f32_32x32x16_bf16(__builtin_bit_cast(bf16x8, kw), qr[d0], g, 0, 0, 0); }
#pragma unroll
        for (int i = 0; i < 16; ++i) if (crow(i, hi) >= qb) g[i] = -INFINITY;
#pragma unroll
        for (int pick = 0; pick < 3; ++pick) {
            float bv = -INFINITY; int bj = 64;
#pragma unroll
            for (int i = 0; i < 16; ++i) if (g[i] > bv) { bv = g[i]; bj = crow(i, hi); }
            const float pv = swap_other(bv, hi); const int pj = swap_other_i(bj, hi);
            if (pv > bv || (pv == bv && pj < bj)) { bv = pv; bj = pj; }
            if (bv > -INFINITY) { selmask |= 1u << bj;
#pragma unroll
                for (int i = 0; i < 16; ++i) if (crow(i, hi) == bj) g[i] = -INFINITY; }
        } } }
    float SKIP = -INFINITY, SKIPW = -INFINITY; int klo = 0;
    if (MODE != 2) {
        const float kmax2 = __uint_as_float(gnv[1]) + __uint_as_float(gnv[3]);
        const float Bq = sqrtf((__uint_as_float(gnv[0]) + __uint_as_float(gnv[2])) * kmax2); SKIP = -(ATT_THETA + 2.02f * Bq + 0.01f);
        float q2 = 0.f;
#pragma unroll
        for (int d0 = 0; d0 < 4; ++d0) { const v4u w = __builtin_bit_cast(v4u, qr[d0]); const float a0 = bflo(w.x), a1 = bfhi(w.x), a2 = bflo(w.y), a3 = bfhi(w.y), a4 = bflo(w.z), a5 = bfhi(w.z), a6 = bflo(w.w), a7 = bfhi(w.w);
            q2 += (a0 * a0 + a1 * a1) + (a2 * a2 + a3 * a3) + (a4 * a4 + a5 * a5) + (a6 * a6 + a7 * a7); }
        q2 += swap_other(q2, hi);
        SKIPW = -(ATT_THETA + 2.02f * sqrtf(wave_max(q2) * kmax2) + 0.01f); }
    if (MODE == 0) { if (qb > 0) { const float fl = ((float)(q0 - 63) + SKIP / slope2) * (1.f / 64.f); klo = fl <= 0.f ? 0 : (int)ceilf(fl); if (klo > 4 * qb) klo = 4 * qb; } }
    if (MODE == 1) { if (qb > 0) {
        const unsigned long long mkA = __builtin_amdgcn_ballot_w64(ktA >= 0 && (cq0 - cA) < SKIP);
        if (mkA) klo = 4 * qb - 1 - (int)__builtin_ctzll(mkA) + 1;
        else { const unsigned long long mkB = __builtin_amdgcn_ballot_w64(ktB >= 0 && (cq0 - cB) < SKIP); if (mkB) klo = 4 * qb - 1 - 64 - (int)__builtin_ctzll(mkB) + 1; } } }
    const float cw = __builtin_bit_cast(float, __builtin_amdgcn_readfirstlane(__builtin_bit_cast(int, cq)));
    const int ktop = (MODE == 2) ? 3 : 4 * qb + 3, ntile = ktop - klo + 1;
    float mhat = 0.f, lsum = 0.f; bool started = false;
    f32x16 o0, o1;
#pragma unroll
    for (int i = 0; i < 16; ++i) { o0[i] = 0.f; o1[i] = 0.f; }
    const LAS unsigned char* vp0 = lds + ATT_V + ((lane >> 4) & 1) * 32 + (lane & 3) * 8 + (4 * hi + ((lane & 15) >> 2)) * 64;
    for (int it = 0; it < ntile; ++it) {
        const int kt = ktop - it, buf = it & 1;
        ATT_WAIT_BAR();
        if (it + 1 < ntile) ATT_STAGE(kt - 1, buf ^ 1);
        bool active = true, diag = false, selv = true;
        if (MODE != 2) {
            if (kt * 64 > wrow0 + 31) active = false;
            diag = (kt * 64 + 63 > wrow0);
            if (MODE == 0) { const int j = kt >> 2; if (j < qb) { selv = ((selmask >> j) & 1u) != 0u; if (__builtin_amdgcn_ballot_w64(selv) == 0ull) active = false; } }
            if (active && kt * 64 + 63 < wrow0) {
                if (MODE == 0) { if (-slope2 * (float)(wrow0 - kt * 64 - 63) < SKIPW) active = false; }
                if (MODE == 1) { const float cke = __builtin_bit_cast(float, __builtin_amdgcn_readfirstlane(__builtin_bit_cast(int, ((const LAS float*)(lds + ATT_CK + buf * 256))[63]))); if (cw - cke < SKIPW) active = false; } }
        }
        if (active) {
            f32x16 p0, p1;
            const float bs = (MODE == 2) ? -mhat : (selv ? cq - mhat : -INFINITY);
            if (MODE == 2) {
#pragma unroll
                for (int r = 0; r < 16; ++r) { p0[r] = bs; p1[r] = bs; }
            } else {
                const LAS f32x4* ckp = (const LAS f32x4*)(lds + ATT_CK + buf * 256);
#pragma unroll
                for (int g = 0; g < 4; ++g) { const f32x4 c = ckp[2 * g + hi], d = ckp[8 + 2 * g + hi];
                    p0[4 * g] = bs - c.x; p0[4 * g + 1] = bs - c.y; p0[4 * g + 2] = bs - c.z; p0[4 * g + 3] = bs - c.w;
                    p1[4 * g] = bs - d.x; p1[4 * g + 1] = bs - d.y; p1[4 * g + 2] = bs - d.z; p1[4 * g + 3] = bs - d.w; }
            }
            const LAS unsigned char* kb = lds + ATT_K + buf * 8192 + hi * 1024 + r32 * 16;
#pragma unroll
            for (int d0 = 0; d0 < 4; ++d0) { const bf16x8 k0 = *(const LAS bf16x8*)(kb + d0 * 2048), k1 = *(const LAS bf16x8*)(kb + d0 * 2048 + 512);
                p0 = __builtin_amdgcn_mfma_f32_32x32x16_bf16(k0, qr[d0], p0, 0, 0, 0); p1 = __builtin_amdgcn_mfma_f32_32x32x16_bf16(k1, qr[d0], p1, 0, 0, 0); }
            asm volatile("s_nop 15\n\ts_nop 7" : "+v"(p0), "+v"(p1));
            if (diag) {
#pragma unroll
                for (int r = 0; r < 16; ++r) { const int kv = kt * 64 + crow(r, hi); if (kv > trow) p0[r] = -INFINITY; if (kv + 32 > trow) p1[r] = -INFINITY; }
            }
            float rm;
            { float a_ = max3f(p0[0], p0[1], p1[0]), b_ = max3f(p0[2], p0[3], p1[1]); a_ = max3f(a_, p1[2], p1[3]);
#pragma unroll
              for (int r = 4; r < 16; r += 4) { a_ = max3f(a_, p0[r], p0[r + 1]); b_ = max3f(b_, p0[r + 2], p0[r + 3]); a_ = max3f(a_, p1[r], p1[r + 1]); b_ = max3f(b_, p1[r + 2], p1[r + 3]); }
              rm = max2f(a_, b_); }
            rm = max2f(rm, swap_other(rm, hi));
            const bool need = started ? (__builtin_amdgcn_ballot_w64(rm > ATT_THR) != 0ull) : true;
            if (need) { const float dl = started ? fmaxf(rm, 0.f) : rm; mhat += dl;
#pragma unroll
                for (int r = 0; r < 16; ++r) { p0[r] -= dl; p1[r] -= dl; }
                if (started) { const float f = fexp2(-dl); lsum *= f;
#pragma unroll
                    for (int r = 0; r < 16; ++r) { o0[r] *= f; o1[r] *= f; } }
                started = true; }
            float s0 = 0.f, s1 = 0.f;
#pragma unroll
            for (int r = 0; r < 16; ++r) { p0[r] = fexp2(p0[r]); p1[r] = fexp2(p1[r]); s0 += p0[r]; s1 += p1[r]; }
            lsum += s0 + s1;
            bf16x8 pa[4];
#pragma unroll
            for (int ks = 0; ks < 4; ++ks) { v4u w;
                if (ks < 2) { w.x = pk2(p0[8 * ks], p0[8 * ks + 1]); w.y = pk2(p0[8 * ks + 2], p0[8 * ks + 3]); w.z = pk2(p0[8 * ks + 4], p0[8 * ks + 5]); w.w = pk2(p0[8 * ks + 6], p0[8 * ks + 7]); }
                else { const int k2 = ks - 2; w.x = pk2(p1[8 * k2], p1[8 * k2 + 1]); w.y = pk2(p1[8 * k2 + 2], p1[8 * k2 + 3]); w.z = pk2(p1[8 * k2 + 4], p1[8 * k2 + 5]); w.w = pk2(p1[8 * k2 + 6], p1[8 * k2 + 7]); }
                pa[ks] = __builtin_bit_cast(bf16x8, w); }
            const LAS unsigned char* vp = vp0 + buf * 8192;
#pragma unroll
            for (int ks = 0; ks < 4; ++ks) {
#pragma unroll
                for (int d0 = 0; d0 < 2; ++d0) {
                    const s16x4 lo = __builtin_bit_cast(s16x4, __builtin_amdgcn_ds_read_tr16_b64_v4i16((LAS s16x4*)(vp + d0 * 4096 + ks * 1024)));
                    const s16x4 hh = __builtin_bit_cast(s16x4, __builtin_amdgcn_ds_read_tr16_b64_v4i16((LAS s16x4*)(vp + d0 * 4096 + ks * 1024 + 512)));
                    const bf16x8 vf = (bf16x8){lo[0], lo[1], lo[2], lo[3], hh[0], hh[1], hh[2], hh[3]};
                    if (d0 == 0) o0 = __builtin_amdgcn_mfma_f32_32x32x16_bf16(vf, pa[ks], o0, 0, 0, 0); else o1 = __builtin_amdgcn_mfma_f32_32x32x16_bf16(vf, pa[ks], o1, 0, 0, 0); } }
        }
    }
    ATT_WAIT_BAR();
    lsum += swap_other(lsum, hi);
    const float rl = 1.f / lsum;
    bf16* Op = (bf16*)(A.ws + WS_ATT) + (size_t)(b * SEQ + trow) * DM + ((MODE == 2) ? HS * 64 : 0) + h * 64 + 4 * hi;
#pragma unroll
    for (int g = 0; g < 4; ++g) {
        v2u w0, w1; w0.x = pk2(o0[4 * g] * rl, o0[4 * g + 1] * rl); w0.y = pk2(o0[4 * g + 2] * rl, o0[4 * g + 3] * rl);
        w1.x = pk2(o1[4 * g] * rl, o1[4 * g + 1] * rl); w1.y = pk2(o1[4 * g + 2] * rl, o1[4 * g + 3] * rl);
        *(v2u*)(Op + 8 * g) = w0; *(v2u*)(Op + 32 + 8 * g) = w1; }
#undef ATT_STAGE
}
template <int MODE01>
__device__ __forceinline__ void ph_attn_fast(const Args& A, int layer, int rep, LAS unsigned char* lds, int wg, int G, int g_wid) {
    PH_IDS;
    constexpr int NSELF = NB * HS * 32, NU = NSELF + NB * HMEM * 32;
    unsigned* qh = (unsigned*)(A.ws + WS_CTL) + CW_AQ + layer * 64 + rep;
    volatile LAS int* qs = (volatile LAS int*)(lds + MISC_OFF) + 32;
    constexpr int NCH = CVT_N_MOE / CVT_CHUNK;
    unsigned* ch = qh + 16;
    if (tid == 0) { qs[0] = (int)__hip_atomic_fetch_add(qh, 1u, __ATOMIC_RELAXED, __HIP_MEMORY_SCOPE_AGENT); qs[1] = (rep == 0) ? (int)__hip_atomic_fetch_add(ch, 1u, __ATOMIC_RELAXED, __HIP_MEMORY_SCOPE_AGENT) : NCH; }
    __syncthreads();
    int L = __builtin_amdgcn_readfirstlane(qs[0]), C = __builtin_amdgcn_readfirstlane(qs[1]);
    __syncthreads();
    while (L < NU || C < NCH) {
        if (L < NU) {
            int nxt = 0;
            if (tid == 0) nxt = (int)__hip_atomic_fetch_add(qh, 1u, __ATOMIC_RELAXED, __HIP_MEMORY_SCOPE_AGENT);
            if (L < NSELF) { const int qb = 31 - L / (NB * HS), bh = L % (NB * HS); attn_unit<MODE01>(A, lds, layer, bh / HS, bh % HS, qb, wid, lane); }
            else { const int m = L - NSELF, qb = m & 31, bhm = m >> 5; attn_unit<2>(A, lds, layer, bhm >> 2, bhm & 3, qb, wid, lane); }
            if (tid == 0) qs[0] = nxt;
            __syncthreads();
            L = __builtin_amdgcn_readfirstlane(qs[0]);
            __syncthreads();
        }
        if (C < NCH) {
            int nxt = 0;
            if (tid == 0) nxt = (int)__hip_atomic_fetch_add(ch, 1u, __ATOMIC_RELAXED, __HIP_MEMORY_SCOPE_AGENT);
            cvt_moe_chunk(A, layer, C, lds, wid, lane);
            if (tid == 0) qs[1] = nxt;
            __syncthreads();
            C = __builtin_amdgcn_readfirstlane(qs[1]);
            __syncthreads();
        }
    }
}

__device__ __forceinline__ void ph_ln1_router(const Args& A, int layer, LAS unsigned char* lds, int wg, int G, int g_wid) {
    PH_IDS;
    bf16* hb = (bf16*)(A.ws + WS_HB); unsigned* elist = (unsigned*)(A.ws + WS_ELIST);
    unsigned* ecnt = (unsigned*)(A.ws + WS_CTL) + CW_ECNT + layer * 64;
    const float* rw = A.in[I_RW] + (size_t)layer * DM * NEXP; const float* rb = A.in[I_RB] + layer * NEXP;
    const float* g1 = A.in[I_LN1G] + layer * DM; const float* b1 = A.in[I_LN1B] + layer * DM;
    constexpr int RP = 1028;
    LAS float* rwT = (LAS float*)lds; LAS int* lcnt = (LAS int*)(lds + 32 * RP * 4); LAS int* gbase = lcnt + 32; LAS unsigned* rec = (LAS unsigned*)(lds + 32 * RP * 4 + 512);
    const int RPW = (NTOK + G - 1) / G;
    for (int i = tid; i < DM * NEXP; i += NTHR) rwT[(i & 31) * RP + (i >> 5)] = rw[i];
    if (tid < 32) lcnt[tid] = 0;
    __syncthreads();
    const int row0 = wg * RPW, row1 = (row0 + RPW < NTOK) ? row0 + RPW : NTOK;
    const float rbl = rb[lane & 31];
    v2u raw[4][4], rawn[4][4];
#define LN1_LOAD(nb_, R) do { _Pragma("unroll") for (int r = 0; r < 4; ++r) { const int n_ = ((nb_) + r < row1) ? (nb_) + r : row1 - 1; _Pragma("unroll") for (int j = 0; j < 4; ++j) R[r][j] = *(const v2u*)(hb + (size_t)n_ * DM + 4 * lane + 256 * j); } } while (0)
    if (row0 + wid * 4 < row1) LN1_LOAD(row0 + wid * 4, raw);
    for (int nb = row0 + wid * 4; nb < row1; nb += NWAVES * 4) {
        if (nb + NWAVES * 4 < row1) LN1_LOAD(nb + NWAVES * 4, rawn);
        f32x4 v[4][4];
#pragma unroll
        for (int r = 0; r < 4; ++r) { const int n = (nb + r < row1) ? nb + r : row1 - 1; float s = 0.f;
#pragma unroll
            for (int j = 0; j < 4; ++j) { const v2u w = raw[r][j]; v[r][j] = (f32x4){bflo(w.x), bfhi(w.x), bflo(w.y), bfhi(w.y)}; s += (v[r][j].x + v[r][j].y) + (v[r][j].z + v[r][j].w); }
            const float mean = wave_sum(s) * (1.f / DM); float s2 = 0.f;
#pragma unroll
            for (int j = 0; j < 4; ++j) { v[r][j] = v[r][j] - mean; s2 += (v[r][j].x * v[r][j].x + v[r][j].y * v[r][j].y) + (v[r][j].z * v[r][j].z + v[r][j].w * v[r][j].w); }
            const float rstd = 1.f / sqrtf(wave_sum(s2) * (1.f / DM) + LN_EPS);
#pragma unroll
            for (int j = 0; j < 4; ++j) { const f32x4 gg = *(const f32x4*)(g1 + 4 * lane + 256 * j), bb = *(const f32x4*)(b1 + 4 * lane + 256 * j);
                v[r][j] = v[r][j] * rstd * gg + bb;
                v2u w; w.x = pk2(v[r][j].x, v[r][j].y); w.y = pk2(v[r][j].z, v[r][j].w); *(v2u*)(hb + (size_t)n * DM + 4 * lane + 256 * j) = w; } }
        float mine[4] = {0.f, 0.f, 0.f, 0.f};
#pragma unroll
        for (int e = 0; e < 32; ++e) { f32x4 r4[4];
#pragma unroll
            for (int j = 0; j < 4; ++j) r4[j] = *(const LAS f32x4*)(rwT + e * RP + 4 * lane + 256 * j);
            float p[4];
#pragma unroll
            for (int r = 0; r < 4; ++r) { f32x2_t a2 = {0.f, 0.f};
#pragma unroll
                for (int j = 0; j < 4; ++j) { a2 += (f32x2_t){v[r][j].x, v[r][j].y} * (f32x2_t){r4[j].x, r4[j].y}; a2 += (f32x2_t){v[r][j].z, v[r][j].w} * (f32x2_t){r4[j].z, r4[j].w}; }
                p[r] = a2.x + a2.y; }
            wave_sum4(p);
#pragma unroll
            for (int r = 0; r < 4; ++r) mine[r] = (lane == e) ? p[r] : mine[r];
            asm volatile("" ::: "memory"); }
        { const float rbv = rbl;
#pragma unroll
          for (int r = 0; r < 4; ++r) mine[r] += rbv; }
#pragma unroll
        for (int r = 0; r < 4; ++r) { float x = (lane < 32) ? mine[r] : -INFINITY; float tv[4]; int ti[4];
#pragma unroll
            for (int k = 0; k < 4; ++k) { const float mx = wave_max(x); const unsigned long long mk = __builtin_amdgcn_ballot_w64(x == mx); const int idx = (int)__builtin_ctzll(mk);
                tv[k] = mx; ti[k] = idx; if (lane == idx) x = -INFINITY; }
            const float e1 = expf(tv[1] - tv[0]), e2 = expf(tv[2] - tv[0]), e3 = expf(tv[3] - tv[0]); const float inv = 1.f / (1.f + e1 + e2 + e3);
            if (lane < 4 && nb + r < row1) { const int ek = lane == 0 ? ti[0] : lane == 1 ? ti[1] : lane == 2 ? ti[2] : ti[3]; const float gk = (lane == 0 ? 1.f : lane == 1 ? e1 : lane == 2 ? e2 : e3) * inv;
                const int lp = atomicAdd((int*)lcnt + ek, 1);
                const int ri = (nb + r - row0) * 4 + lane; rec[2 * ri] = (unsigned)ek | ((unsigned)lp << 8); rec[2 * ri + 1] = __float_as_uint(gk); } }
#pragma unroll
        for (int r = 0; r < 4; ++r)
#pragma unroll
            for (int j = 0; j < 4; ++j) raw[r][j] = rawn[r][j];
    }
#undef LN1_LOAD
    __syncthreads();
    if (tid < 32) gbase[tid] = (int)__hip_atomic_fetch_add(ecnt + tid, (unsigned)lcnt[tid], __ATOMIC_RELAXED, __HIP_MEMORY_SCOPE_AGENT);
    __syncthreads();
    for (int ri = tid; ri < (row1 - row0) * 4; ri += NTHR) { const unsigned w = rec[2 * ri]; const int e = w & 31, lp = w >> 8; const unsigned aid = (unsigned)(row0 * 4 + ri);
        *(v2u*)(elist + ((size_t)e * NTOK + gbase[e] + lp) * 2) = (v2u){aid, rec[2 * ri + 1]}; }
    __syncthreads();
}

template <bool LAST>
__device__ __forceinline__ void ph_combine_ln2(const Args& A, int layer, int wg, int G, int g_wid) {
    PH_IDS;
    bf16* hb = (bf16*)(A.ws + WS_HB); const unsigned char* ybuf = (const unsigned char*)(A.ws + WS_YBUF);
    const float* g2 = A.in[I_LN2G] + layer * DM; const float* b2 = A.in[I_LN2B] + layer * DM;
    const int gw = wg * NWAVES + wid, NGW = G * NWAVES;
    f32x4 gv[4], bv[4];
#pragma unroll
    for (int j = 0; j < 2; ++j) { gv[2 * j] = *(const f32x4*)(g2 + 8 * lane + 512 * j); gv[2 * j + 1] = *(const f32x4*)(g2 + 8 * lane + 512 * j + 4); bv[2 * j] = *(const f32x4*)(b2 + 8 * lane + 512 * j); bv[2 * j + 1] = *(const f32x4*)(b2 + 8 * lane + 512 * j + 4); }
    v4u hw[2], hn[2]; v2u yw[4][2], yn[4][2];
#define CMB_LOAD(n_, H, Y) do { _Pragma("unroll") for (int j = 0; j < 2; ++j) H[j] = *(const v4u*)(hb + (size_t)(n_) * DM + 8 * lane + 512 * j); \
        _Pragma("unroll") for (int k = 0; k < 4; ++k) _Pragma("unroll") for (int j = 0; j < 2; ++j) Y[k][j] = *(const v2u*)(ybuf + ((size_t)(n_) * 4 + k) * DM + 8 * lane + 512 * j); } while (0)
    if (gw < NTOK) CMB_LOAD(gw, hw, yw);
    for (int n = gw; n < NTOK; n += NGW) {
        const int nn = n + NGW;
        if (nn < NTOK) CMB_LOAD(nn, hn, yn);
        float v[16]; float s = 0.f;
#pragma unroll
        for (int j = 0; j < 2; ++j) { const v4u w = hw[j];
            v[8 * j + 0] = bflo(w.x) * ALPHA; v[8 * j + 1] = bfhi(w.x) * ALPHA; v[8 * j + 2] = bflo(w.y) * ALPHA; v[8 * j + 3] = bfhi(w.y) * ALPHA;
            v[8 * j + 4] = bflo(w.z) * ALPHA; v[8 * j + 5] = bfhi(w.z) * ALPHA; v[8 * j + 6] = bflo(w.w) * ALPHA; v[8 * j + 7] = bfhi(w.w) * ALPHA; }
#pragma unroll
        for (int k = 0; k < 4; ++k)
#pragma unroll
            for (int j = 0; j < 2; ++j) { const v2u w = yw[k][j];
                const f32x2_t a = __builtin_amdgcn_cvt_pk_f32_fp8((int)w.x, false), b = __builtin_amdgcn_cvt_pk_f32_fp8((int)w.x, true), c = __builtin_amdgcn_cvt_pk_f32_fp8((int)w.y, false), d = __builtin_amdgcn_cvt_pk_f32_fp8((int)w.y, true);
                v[8 * j + 0] += a.x * (1.f / Y_SCALE); v[8 * j + 1] += a.y * (1.f / Y_SCALE); v[8 * j + 2] += b.x * (1.f / Y_SCALE); v[8 * j + 3] += b.y * (1.f / Y_SCALE);
                v[8 * j + 4] += c.x * (1.f / Y_SCALE); v[8 * j + 5] += c.y * (1.f / Y_SCALE); v[8 * j + 6] += d.x * (1.f / Y_SCALE); v[8 * j + 7] += d.y * (1.f / Y_SCALE); }
#pragma unroll
        for (int i = 0; i < 16; ++i) s += v[i];
        const float mean = wave_sum(s) * (1.f / DM); float s2 = 0.f;
#pragma unroll
        for (int i = 0; i < 16; ++i) { v[i] -= mean; s2 += v[i] * v[i]; }
        const float rstd = 1.f / sqrtf(wave_sum(s2) * (1.f / DM) + LN_EPS);
#pragma unroll
        for (int j = 0; j < 2; ++j) {
            const f32x4 oa = (f32x4){v[8 * j], v[8 * j + 1], v[8 * j + 2], v[8 * j + 3]} * rstd * gv[2 * j] + bv[2 * j], ob = (f32x4){v[8 * j + 4], v[8 * j + 5], v[8 * j + 6], v[8 * j + 7]} * rstd * gv[2 * j + 1] + bv[2 * j + 1];
            if (LAST) { float* o = A.out + (size_t)n * DM + 8 * lane + 512 * j; *(f32x4*)o = oa; *(f32x4*)(o + 4) = ob; }
            else { v4u w; w.x = pk2(oa.x, oa.y); w.y = pk2(oa.z, oa.w); w.z = pk2(ob.x, ob.y); w.w = pk2(ob.z, ob.w); *(v4u*)(hb + (size_t)n * DM + 8 * lane + 512 * j) = w; } }
#pragma unroll
        for (int j = 0; j < 2; ++j) hw[j] = hn[j];
#pragma unroll
        for (int k = 0; k < 4; ++k)
#pragma unroll
            for (int j = 0; j < 2; ++j) yw[k][j] = yn[k][j];
    }
#undef CMB_LOAD
}

#define IN(k) (lo <= (k) && (k) < hi)
#ifndef PROBE_BAR
#define PROBE_BAR 0
#endif
#define SEAM(k) do { if ((k) + 1 < hi) { xcd_barrier(bar); for (int pb_ = 0; pb_ < PROBE_BAR; ++pb_) xcd_barrier(bar); } } while (0)
#if PROBE_TIME
#define PT0(k) if ((k) == PROBE_TIME && xb_t0(wid0)) { volatile LAS unsigned* pm_ = (volatile LAS unsigned*)(lds + MISC_OFF) + 40; pm_[1] = (unsigned)__builtin_amdgcn_s_memrealtime(); }
#define PT1(k) if ((k) == PROBE_TIME && xb_t0(wid0)) { volatile LAS unsigned* pm_ = (volatile LAS unsigned*)(lds + MISC_OFF) + 40; pm_[0] = pm_[0] + ((unsigned)__builtin_amdgcn_s_memrealtime() - pm_[1]); }
#else
#define PT0(k)
#define PT1(k)
#endif
template <int layer>
__device__ __forceinline__ void run_layer(LAS unsigned char* lds, const int wg, const int G, const int wid0, const int lo, const int hi, const XcdBarrier& bar) {
        constexpr int pb = 1 + 8 * layer; constexpr bool fox = (layer & 1) != 0;
        if (IN(pb + 0)) { PT0(0)
            { const Args A = load_args(); unsigned char* ws = A.ws;
              DenseSched S{(const bf16*)(ws + WS_HB), (const bf16*)(ws + WS_WIN) + (size_t)layer * NPROJ * DM, NTOK / 256, NPROJ / 256, G, wg};
              EpiProjT<true, !fox> E{(bf16*)(ws + WS_PROJ), NPROJ, K_COL, QM_COL, (unsigned*)(ws + WS_CTL) + CW_NORM + layer * 256, (float*)(ws + WS_KSUM) + (size_t)(layer >> 1) * (NB * HS * 32 * 64)};
              gemm_fast<EpiProjT<true, !fox>, DenseSched, true>(lds, S, E, wid0); }
            if constexpr (layer == 0) { const Args A = load_args(); unsigned char* ws = A.ws;
              DenseSched S{(const bf16*)(ws + WS_MEMB), (const bf16*)(ws + WS_WMKV), NB * NMEM / 256, 2, G, wg};
              EpiProjT<false, false> E{(bf16*)(ws + WS_MKV), 512, 0, 1 << 30, nullptr, nullptr};
              gemm_fast<EpiProjT<false, false>, DenseSched, true>(lds, S, E, wid0); }
            if constexpr (fox) { const Args A = load_args(); ph_fox_gate(A, layer >> 1, wg, G, wid0); }
            SEAM(pb + 0); PT1(0)
        }
        if constexpr (fox) { if (IN(pb + 1)) { const Args A = load_args(); ph_fox_scan(A, lds, wg, G, wid0); SEAM(pb + 1); } }
        if (IN(pb + 2)) { PT0(2) const Args A = load_args(); for (int rep = 0; rep < PROBE_ATT; ++rep) ph_attn_fast<fox ? 1 : 0>(A, layer, rep, lds, wg, G, wid0); SEAM(pb + 2); PT1(2) }
        if (IN(pb + 3)) { PT0(3)
            const Args A = load_args(); unsigned char* ws = A.ws;
            DenseSched S{(const bf16*)(ws + WS_ATT), (const bf16*)(ws + WS_WO) + (size_t)layer * DM * DM, NTOK / 256, DM / 256, G, wg};
            EpiOutT<layer == 0> E{layer == 0 ? (const void*)A.in[I_X] : (const void*)(ws + WS_HB), (bf16*)(ws + WS_HB)};
            gemm_fast<EpiOutT<layer == 0>, DenseSched, true>(lds, S, E, wid0); SEAM(pb + 3); PT1(3)
        }
        if (IN(pb + 4)) { PT0(4) const Args A = load_args(); ph_ln1_router(A, layer, lds, wg, G, wid0); SEAM(pb + 4); PT1(4) }
        if (IN(pb + 5)) { PT0(5)
            const Args A = load_args(); unsigned char* ws = A.ws;
            LAS int* tab = (LAS int*)(lds + MISC_OFF) + 64; moe_tables(tab, (unsigned*)(ws + WS_CTL) + CW_ECNT + layer * 64, wid0);
            MoeSchedT<true> S{(const bf16*)(ws + WS_HB), (const bf16*)(ws + WS_WGU) + (size_t)layer * NEXP * 2048 * DM, (const unsigned*)(ws + WS_ELIST), tab, 8, 2048, G, wg, 2};
            EpiGU E{(bf16*)(ws + WS_ABUF), A.in[I_BGU] + (size_t)layer * NEXP * 2048};
            gemm_fast<EpiGU, MoeSchedT<true>, true>(lds, S, E, wid0); __syncthreads();
#if PROBE_MOE > 1
            gemm_fast<EpiGU, MoeSchedT<true>, true>(lds, S, E, wid0); __syncthreads();
#endif
            SEAM(pb + 5); PT1(5)
        }
        if (IN(pb + 6)) { PT0(6)
            const Args A = load_args(); unsigned char* ws = A.ws;
            LAS int* tab = (LAS int*)(lds + MISC_OFF) + 64; moe_tables(tab, (unsigned*)(ws + WS_CTL) + CW_ECNT + layer * 64, wid0);
            MoeSchedT<false> S{(const bf16*)(ws + WS_ABUF), (const bf16*)(ws + WS_WDN) + (size_t)layer * NEXP * DM * DM, (const unsigned*)(ws + WS_ELIST), tab, 4, 1024, G, wg, 0};
            EpiDN E{(bf16*)(ws + WS_YBUF), A.in[I_BDN] + (size_t)layer * NEXP * DM};
            gemm_fast<EpiDN, MoeSchedT<false>, true>(lds, S, E, wid0); __syncthreads();
#if PROBE_MOE > 1
            gemm_fast<EpiDN, MoeSchedT<false>, true>(lds, S, E, wid0); __syncthreads();
#endif
            SEAM(pb + 6); PT1(6)
        }
        if (IN(pb + 7)) { PT0(7) const Args A = load_args(); ph_combine_ln2<layer == DEPTH - 1>(A, layer, wg, G, wid0); SEAM(pb + 7); PT1(7) }
}
__global__ void __launch_bounds__(NTHR, 2) k_main(Args A0) {
    extern __shared__ __attribute__((aligned(16))) unsigned char lds_raw[];
    LAS unsigned char* lds = (LAS unsigned char*)lds_raw;
    volatile LAS unsigned* MISC = (volatile LAS unsigned*)(lds + MISC_OFF);
    const int wid0 = __builtin_amdgcn_readfirstlane((int)threadIdx.x >> 6);
    const int G = gridDim.x, wg = blockIdx.x;
    const int lo = A0.p_lo, hi = A0.p_hi;
    if (threadIdx.x < 64) MISC[threadIdx.x] = 0u;
    __syncthreads();
    XcdBarrier bar; bar.bar = (unsigned*)(A0.ws + WS_CTL) + CW_BAR; bar.x = 0; bar.st = nullptr; bar.wid = wid0;
    if (hi - lo > 1) bar = xcd_barrier_post((unsigned*)(A0.ws + WS_CTL) + CW_BAR + (size_t)lo * XCD_BAR_WORDS, MISC + 8, wid0);
    if (IN(0)) { const Args A = load_args(); for (int rep = 0; rep < PROBE_CVT; ++rep) ph_convert(A, lds, wg, G, wid0); SEAM(0); }
    run_layer<0>(lds, wg, G, wid0, lo, hi, bar); run_layer<1>(lds, wg, G, wid0, lo, hi, bar); run_layer<2>(lds, wg, G, wid0, lo, hi, bar); run_layer<3>(lds, wg, G, wid0, lo, hi, bar);
#if PROBE_TIME
    { const Args A = load_args(); unsigned* pw = (unsigned*)(A.ws + WS_CTL) + 3000; volatile LAS unsigned* pm_ = (volatile LAS unsigned*)(lds + MISC_OFF) + 40;
      if (blockIdx.x == 0 && xb_t0(wid0)) __hip_atomic_store(pw, pm_[0], __ATOMIC_RELAXED, __HIP_MEMORY_SCOPE_AGENT);
      xcd_barrier(bar);
      const float us = (float)__hip_atomic_load(pw, __ATOMIC_RELAXED, __HIP_MEMORY_SCOPE_AGENT) * 0.01f; const float v = log2f(us + 1.f) * 0.25f;
      { int ln_; asm volatile("v_mbcnt_lo_u32_b32 %0, -1, 0\n\tv_mbcnt_hi_u32_b32 %0, -1, %0" : "=v"(ln_)); for (size_t i = (size_t)blockIdx.x * NTHR + wid0 * 64 + ln_; i < (size_t)NTOK * DM; i += (size_t)gridDim.x * NTHR) A.out[i] = v; } }
#endif
#undef IN
#undef SEAM
}

#ifndef MK_ONE_LAUNCH
#define MK_ONE_LAUNCH 1
#endif
extern "C" void kernel_launch(void* const* d_in, const int* in_sizes, int n_in, void* d_out, int out_size, void* d_ws, size_t ws_size, hipStream_t stream) {
    static int grid = 0;
    if (grid == 0) {
        if (n_in != 17 || out_size != NTOK * DM || ws_size < WS_END) { fprintf(stderr, "kernel_launch: unexpected shapes (n_in %d out %d ws %zu, need %zu)\n", n_in, out_size, ws_size, (size_t)WS_END); grid = -1; return; }
        int dev = 0, cus = 0, per_cu = 0;
        if (hipGetDevice(&dev) != hipSuccess || hipDeviceGetAttribute(&cus, hipDeviceAttributeMultiprocessorCount, dev) != hipSuccess) { grid = -1; return; }
        if (hipFuncSetAttribute((const void*)k_main, hipFuncAttributeMaxDynamicSharedMemorySize, LDS_BYTES) != hipSuccess) { fprintf(stderr, "kernel_launch: hipFuncSetAttribute failed\n"); grid = -1; return; }
        if (hipOccupancyMaxActiveBlocksPerMultiprocessor(&per_cu, (const void*)k_main, NTHR, LDS_BYTES) != hipSuccess || per_cu < 1) { fprintf(stderr, "kernel_launch: occupancy query says %d\n", per_cu); }
        (void)hipGetLastError();
        grid = cus;
    }
    if (grid < 0) return;
    (void)hipMemsetAsync((char*)d_ws + WS_CTL, 0, CTL_ZERO_BYTES, stream);
    Args a{};
    for (int i = 0; i < 17; ++i) a.in[i] = (const float*)d_in[i];
    a.out = (float*)d_out; a.ws = (unsigned char*)d_ws;
#if MK_ONE_LAUNCH
    a.p_lo = 0; a.p_hi = NPHASE;
    hipLaunchKernelGGL(k_main, dim3(grid), dim3(NTHR), LDS_BYTES, stream, a);
#else
    for (int p = 0; p < NPHASE; ++p) { a.p_lo = p; a.p_hi = p + 1; hipLaunchKernelGGL(k_main, dim3(grid), dim3(NTHR), LDS_BYTES, stream, a); }
#endif
}
```

```cpp
#include <hip/hip_runtime.h>
#include <cstdio>
#include <cstdint>
#ifndef PROBE_ATT
#define PROBE_ATT 1
#endif
#ifndef PROBE_MOE
#define PROBE_MOE 1
#endif
#ifndef PROBE_CVT
#define PROBE_CVT 1
#endif
#ifndef PROBE_TIME
#define PROBE_TIME 0
#endif
#ifndef PROBE_INP
#define PROBE_INP 1
#endif

#define GAS __attribute__((address_space(1)))
#define LAS __attribute__((address_space(3)))
typedef unsigned short bf16;
typedef unsigned v4u __attribute__((ext_vector_type(4)));
typedef unsigned v2u __attribute__((ext_vector_type(2)));
typedef float f32x4 __attribute__((ext_vector_type(4)));
typedef short bf16x8 __attribute__((ext_vector_type(8)));

constexpr int NB = 4, SEQ = 8192, DM = 1024, NTOK = NB * SEQ;
constexpr int HS = 12, HMEM = 4, HD = 64, NMEM = 256, NPROJ = 2560, QM_COL = 2304, K_COL = 768, V_COL = 1536;
constexpr int NEXP = 32, TOPK = 4, DEPTH = 4, NASSIGN = NTOK * TOPK, DFF = 1024;
constexpr float ALPHA = 1.6817928305074290f, LN_EPS = 1e-5f, LOG2E = 1.4426950408889634f, C2 = 0.125f * 1.4426950408889634f;
constexpr float SW_LIMIT = 7.0f, SW_ALPHA = 1.702f;
constexpr int NWAVES = 8, NTHR = 512;

constexpr size_t MiB = 1u << 20;
constexpr size_t WS_CTL = 0, CTL_ZERO_BYTES = 2 * MiB;
constexpr size_t WS_KSUM = 1 * MiB;
constexpr size_t WS_WIN = 2 * MiB;
constexpr size_t WS_WFG = WS_WIN + (size_t)4 * NPROJ * DM * 2;
constexpr size_t WS_WMKV = WS_WFG + 1 * MiB;
constexpr size_t WS_WO = WS_WMKV + 1 * MiB;
constexpr size_t WS_WGU = WS_WO + 8 * MiB;
constexpr size_t WS_WDN = WS_WGU + 512 * MiB;
constexpr size_t WS_HB = WS_WDN + 256 * MiB;
constexpr size_t WS_MEMB = WS_HB + 64 * MiB;
constexpr size_t WS_MKV = WS_MEMB + 2 * MiB;
constexpr size_t WS_PROJ = WS_MKV + 1 * MiB;
constexpr size_t WS_CFOX = WS_PROJ + 160 * MiB;
constexpr size_t WS_LF = WS_CFOX + 2 * MiB;
constexpr size_t WS_KBAR = WS_LF + 2 * MiB;
constexpr size_t WS_ATT = WS_KBAR + 1 * MiB;
constexpr size_t WS_ELIST = WS_ATT + 64 * MiB;
constexpr size_t WS_AGATE = WS_ELIST + 8 * MiB;
constexpr size_t WS_ABUF = WS_AGATE + 1 * MiB;
constexpr size_t WS_YBUF = WS_ABUF + 288 * MiB;
constexpr size_t WS_END = WS_YBUF + 256 * MiB;

constexpr int CW_ECNT = 1024;
constexpr int CW_NORM = 1536;
constexpr int CW_AQ = 2560;
constexpr int CW_BAR = 4096;
constexpr int NPHASE = 1 + 8 * DEPTH;

constexpr int LDS_BYTES = 147456, SCR_BYTES = 146432, MISC_OFF = SCR_BYTES;

__device__ __forceinline__ unsigned f2bf(float f) { unsigned u = __float_as_uint(f); return (u + 0x7fffu + ((u >> 16) & 1u)) >> 16; }
typedef float f32x2_t __attribute__((ext_vector_type(2))); typedef __bf16 bf16x2_t __attribute__((ext_vector_type(2)));
__device__ __forceinline__ unsigned pk2(float lo, float hi) { const f32x2_t v = {lo, hi}; const bf16x2_t b = __builtin_convertvector(v, bf16x2_t); return __builtin_bit_cast(unsigned, b); }
__device__ __forceinline__ float bflo(unsigned w) { return __uint_as_float(w << 16); }
__device__ __forceinline__ float bfhi(unsigned w) { return __uint_as_float(w & 0xffff0000u); }
__device__ __forceinline__ float wave_sum(float v) {
    v += __builtin_bit_cast(float, __builtin_amdgcn_update_dpp(0, __builtin_bit_cast(int, v), 0xB1, 0xF, 0xF, false));
    v += __builtin_bit_cast(float, __builtin_amdgcn_update_dpp(0, __builtin_bit_cast(int, v), 0x4E, 0xF, 0xF, false));
    v += __builtin_bit_cast(float, __builtin_amdgcn_update_dpp(0, __builtin_bit_cast(int, v), 0x141, 0xF, 0xF, false));
    v += __builtin_bit_cast(float, __builtin_amdgcn_update_dpp(0, __builtin_bit_cast(int, v), 0x140, 0xF, 0xF, false));
    v += __builtin_bit_cast(float, __builtin_amdgcn_update_dpp(0, __builtin_bit_cast(int, v), 0x142, 0xA, 0xF, false));
    v += __builtin_bit_cast(float, __builtin_amdgcn_update_dpp(0, __builtin_bit_cast(int, v), 0x143, 0xC, 0xF, false));
    return __builtin_bit_cast(float, __builtin_amdgcn_readlane(__builtin_bit_cast(int, v), 63));
}
__device__ __forceinline__ void wave_sum4(float (&v)[4]) {
#define WS4_STEP(ctrl, rm) do { float t_[4]; _Pragma("unroll") for (int i_ = 0; i_ < 4; ++i_) t_[i_] = __builtin_bit_cast(float, __builtin_amdgcn_update_dpp(0, __builtin_bit_cast(int, v[i_]), ctrl, rm, 0xF, false)); \
        _Pragma("unroll") for (int i_ = 0; i_ < 4; ++i_) v[i_] += t_[i_]; } while (0)
    WS4_STEP(0xB1, 0xF); WS4_STEP(0x4E, 0xF); WS4_STEP(0x141, 0xF); WS4_STEP(0x140, 0xF); WS4_STEP(0x142, 0xA); WS4_STEP(0x143, 0xC);
#undef WS4_STEP
#pragma unroll
    for (int i = 0; i < 4; ++i) v[i] = __builtin_bit_cast(float, __builtin_amdgcn_readlane(__builtin_bit_cast(int, v[i]), 63));
}
__device__ __forceinline__ float row16_max(float v) {
    v = fmaxf(v, __builtin_bit_cast(float, __builtin_amdgcn_update_dpp(__builtin_bit_cast(int, v), __builtin_bit_cast(int, v), 0xB1, 0xF, 0xF, false)));
    v = fmaxf(v, __builtin_bit_cast(float, __builtin_amdgcn_update_dpp(__builtin_bit_cast(int, v), __builtin_bit_cast(int, v), 0x4E, 0xF, 0xF, false)));
    v = fmaxf(v, __builtin_bit_cast(float, __builtin_amdgcn_update_dpp(__builtin_bit_cast(int, v), __builtin_bit_cast(int, v), 0x141, 0xF, 0xF, false)));
    v = fmaxf(v, __builtin_bit_cast(float, __builtin_amdgcn_update_dpp(__builtin_bit_cast(int, v), __builtin_bit_cast(int, v), 0x140, 0xF, 0xF, false)));
    return v;
}
__device__ __forceinline__ float row16_sum(float v) {
    v += __builtin_bit_cast(float, __builtin_amdgcn_update_dpp(0, __builtin_bit_cast(int, v), 0xB1, 0xF, 0xF, false));
    v += __builtin_bit_cast(float, __builtin_amdgcn_update_dpp(0, __builtin_bit_cast(int, v), 0x4E, 0xF, 0xF, false));
    v += __builtin_bit_cast(float, __builtin_amdgcn_update_dpp(0, __builtin_bit_cast(int, v), 0x141, 0xF, 0xF, false));
    v += __builtin_bit_cast(float, __builtin_amdgcn_update_dpp(0, __builtin_bit_cast(int, v), 0x140, 0xF, 0xF, false));
    return v;
}
__device__ __forceinline__ float wave_max(float v) {
    v = row16_max(v);
    v = fmaxf(v, __builtin_bit_cast(float, __builtin_amdgcn_update_dpp(__builtin_bit_cast(int, v), __builtin_bit_cast(int, v), 0x142, 0xA, 0xF, false)));
    v = fmaxf(v, __builtin_bit_cast(float, __builtin_amdgcn_update_dpp(__builtin_bit_cast(int, v), __builtin_bit_cast(int, v), 0x143, 0xC, 0xF, false)));
    return __builtin_bit_cast(float, __builtin_amdgcn_readlane(__builtin_bit_cast(int, v), 63));
}
__device__ __forceinline__ float fexp2(float x) { return __builtin_amdgcn_exp2f(x); }
#define PH_IDS int lane; asm volatile("v_mbcnt_lo_u32_b32 %0, -1, 0\n\tv_mbcnt_hi_u32_b32 %0, -1, %0" : "=v"(lane)); const int wid = __builtin_amdgcn_readfirstlane(g_wid); const int tid = wid * 64 + lane; (void)tid

#define XB_TMO      128
#define XB_XCNT(j)  (256  + 64 * (j))
#define XB_XSUB(j)  (1280 + 64 * (j))
#define XB_XGEN(j)  (2304 + 64 * (j))
#define XB_TOP      3328
#define XB_TOPGEN   3392
#define XCD_BAR_WORDS 3456
#define XB_SPIN_CAP (1u << 22)
__device__ __forceinline__ unsigned xb_ld(unsigned* p)              { return __hip_atomic_load(p, __ATOMIC_RELAXED, __HIP_MEMORY_SCOPE_AGENT); }
__device__ __forceinline__ unsigned xb_add(unsigned* p, unsigned v) { return __hip_atomic_fetch_add(p, v, __ATOMIC_RELAXED, __HIP_MEMORY_SCOPE_AGENT); }
__device__ __forceinline__ unsigned xb_xcc_id() { return (unsigned)__builtin_amdgcn_s_getreg((3 << 11) | 20) & 0xFu; }
#define XB_SPIN(cond, bar) do { unsigned _sp = 0; while (cond) { __builtin_amdgcn_s_sleep(1); \
    if ((++_sp & 255u) == 0u) { if (xb_ld(&(bar)[XB_TMO])) break; if (_sp > XB_SPIN_CAP) { atomicAdd(&(bar)[XB_TMO], 1u); break; } } } } while (0)
struct XcdBarrier { unsigned* bar; unsigned x; volatile LAS unsigned* st; int wid; };
__device__ __forceinline__ bool xb_t0(int w) { int l; asm volatile("v_mbcnt_lo_u32_b32 %0, -1, 0\n\tv_mbcnt_hi_u32_b32 %0, -1, %0" : "=v"(l)); return w == 0 && l == 0; }
#define XB_T0(w) xb_t0(w)
__device__ __forceinline__ XcdBarrier xcd_barrier_post(unsigned* bar, volatile LAS unsigned* st, int wid) {
    XcdBarrier b; b.bar = bar; b.x = xb_xcc_id(); b.st = st; b.wid = wid;
    if (XB_T0(wid)) (void)xb_add(&bar[XB_XCNT(b.x)], 1u);
    return b;
}
__device__ __forceinline__ void xcd_barrier_complete(unsigned* bar, unsigned x, unsigned& nloc, unsigned& nx) {
    const unsigned G = gridDim.x * gridDim.y * gridDim.z;
    unsigned sum, cnt, mine, sp = 0u;
    for (;;) {
        sum = 0u; cnt = 0u; mine = 0u;
#pragma unroll
        for (unsigned j = 0; j < 16; ++j) { const unsigned c = xb_ld(&bar[XB_XCNT(j)]); sum += c; cnt += (c > 0u) ? 1u : 0u; mine = (j == x) ? c : mine; }
        if (sum == G) break;
        __builtin_amdgcn_s_sleep(1);
        if ((++sp & 255u) == 0u) { if (xb_ld(&bar[XB_TMO])) break; if (sp > XB_SPIN_CAP) { atomicAdd(&bar[XB_TMO], 1u); break; } }
    }
    nloc = mine > 0u ? mine : 1u; nx = cnt > 0u ? cnt : 1u;
}
__device__ __forceinline__ void xcd_barrier(const XcdBarrier& b) {
    asm volatile("s_waitcnt vmcnt(0)" ::: "memory");
    __syncthreads();
    if (XB_T0(b.wid)) {
        unsigned* bar = b.bar;
        __builtin_amdgcn_s_waitcnt(0);
        unsigned nloc = b.st[0], nx = b.st[1];
        if (nloc == 0u) { xcd_barrier_complete(bar, b.x, nloc, nx); b.st[0] = nloc; b.st[1] = nx; }
        const unsigned old = xb_add(&bar[XB_XSUB(b.x)], 1u);
        const unsigned gen = old / nloc;
        if (old + 1u == (gen + 1u) * nloc) {
            __builtin_amdgcn_fence(__ATOMIC_RELEASE, "agent");
            asm volatile("s_waitcnt vmcnt(0)" ::: "memory");
            const unsigned og = xb_add(&bar[XB_TOP], 1u);
            const unsigned tg = og / nx;
            if (og + 1u == (tg + 1u) * nx) xb_add(&bar[XB_TOPGEN], 1u);
            else XB_SPIN(xb_ld(&bar[XB_TOPGEN]) == tg, bar);
            __builtin_amdgcn_fence(__ATOMIC_ACQUIRE, "agent");
            xb_add(&bar[XB_XGEN(b.x)], 1u);
            asm volatile("s_waitcnt vmcnt(0)" ::: "memory");
        } else {
            XB_SPIN(xb_ld(&bar[XB_XGEN(b.x)]) == gen, bar);
            __builtin_amdgcn_fence(__ATOMIC_ACQUIRE, "agent");
            asm volatile("s_waitcnt vmcnt(0)" ::: "memory");
        }
    }
    __syncthreads();
}

struct Args { const float* in[17]; float* out; unsigned char* ws; int p_lo, p_hi; };
enum { I_X = 0, I_MEM, I_WIN_MOBA, I_WIN_FOX, I_BFG, I_WMKV, I_WO, I_LN1G, I_LN1B, I_RW, I_RB, I_WGU, I_BGU, I_WDN, I_BDN, I_LN2G, I_LN2B };

__device__ __forceinline__ Args load_args() {
#if defined(__HIP_DEVICE_COMPILE__)
    const __attribute__((address_space(4))) unsigned long long* p = (const __attribute__((address_space(4))) unsigned long long*)__builtin_amdgcn_kernarg_segment_ptr();
    asm volatile("" : "+s"(p));
    Args a;
#pragma unroll
    for (int i = 0; i < 17; ++i) a.in[i] = (const float*)(const GAS float*)p[i];
    a.out = (float*)(GAS float*)p[17]; a.ws = (unsigned char*)(GAS unsigned char*)p[18]; const unsigned long long w = p[19]; a.p_lo = (int)(unsigned)w; a.p_hi = (int)(unsigned)(w >> 32);
    return a;
#else
    return Args{};
#endif
}
struct CvtItem { const float* src; bf16* dst; int pitch; };
constexpr int CVT_I_IN = 16 * 40, CVT_I_MK = 16 * 8, CVT_I_O1 = 16 * 16, CVT_I_GU1 = 16 * 32, CVT_I_DN1 = 16 * 16;
constexpr int CVT_N_INIT = 4 * CVT_I_IN + CVT_I_MK + 4 * CVT_I_O1;
constexpr int CVT_N_MOE = NEXP * (CVT_I_GU1 + CVT_I_DN1), CVT_CHUNK = 32;
__device__ __forceinline__ bool cvt_decode(const Args& A, int it, CvtItem& c) {
    unsigned char* ws = A.ws;
    constexpr int N_IN = 4 * CVT_I_IN, N_MK = CVT_I_MK;
    if (it >= CVT_N_INIT) return false;
    int r = it;
    if (r < N_IN) { const int l = r / CVT_I_IN, q = r % CVT_I_IN, kb = q / 40, nb = q % 40, j = l >> 1; const int pitch = (l & 1) ? NPROJ + HS : NPROJ;
        const float* W = (l & 1) ? A.in[I_WIN_FOX] + (size_t)j * DM * (NPROJ + HS) : A.in[I_WIN_MOBA] + (size_t)j * DM * NPROJ;
        c.src = W + (size_t)(64 * kb) * pitch + 64 * nb; c.pitch = pitch; c.dst = (bf16*)(ws + WS_WIN) + ((size_t)l * NPROJ + 64 * nb) * DM + 64 * kb; return true; }
    r -= N_IN;
    if (r < N_MK) { const int kb = r / 8, nb = r % 8; c.src = A.in[I_WMKV] + (size_t)(64 * kb) * 512 + 64 * nb; c.pitch = 512; c.dst = (bf16*)(ws + WS_WMKV) + (size_t)(64 * nb) * DM + 64 * kb; return true; }
    r -= N_MK;
    { const int l = r / CVT_I_O1, q = r % CVT_I_O1, kb = q / 16, nb = q % 16; c.src = A.in[I_WO] + (size_t)l * DM * DM + (size_t)(64 * kb) * DM + 64 * nb; c.pitch = DM; c.dst = (bf16*)(ws + WS_WO) + ((size_t)l * DM + 64 * nb) * DM + 64 * kb; return true; }
}
__device__ __forceinline__ void cvt_decode_moe(const Args& A, int layer, int r, CvtItem& c) {
    unsigned char* ws = A.ws;
    if (r < NEXP * CVT_I_GU1) { const int le = layer * NEXP + r / CVT_I_GU1, q = r % CVT_I_GU1, kb = q / 32, nb = q % 32, col0 = 64 * nb;
        const int cc = col0 & 1023, drow0 = (cc >> 7) * 256 + (cc & 127) + ((col0 >= 1024) ? 128 : 0);
        c.src = A.in[I_WGU] + (size_t)le * DM * 2048 + (size_t)(64 * kb) * 2048 + col0; c.pitch = 2048; c.dst = (bf16*)(ws + WS_WGU) + ((size_t)le * 2048 + drow0) * DM + 64 * kb; return; }
    r -= NEXP * CVT_I_GU1;
    { const int le = layer * NEXP + r / CVT_I_DN1, q = r % CVT_I_DN1, kb = q / 16, nb = q % 16; c.src = A.in[I_WDN] + (size_t)le * DM * DM + (size_t)(64 * kb) * DM + 64 * nb; c.pitch = DM; c.dst = (bf16*)(ws + WS_WDN) + ((size_t)le * DM + 64 * nb) * DM + 64 * kb; }
}
__device__ __forceinline__ void cvt_load(const CvtItem& c, f32x4 (&v)[16], int lane) {
    const int a = lane >> 4, b4 = (lane & 15) * 4;
#pragma unroll
    for (int i = 0; i < 16; ++i) v[i] = __builtin_nontemporal_load((const f32x4*)(c.src + (size_t)(4 * i + a) * c.pitch + b4));
}
__device__ __forceinline__ void cvt_store(const CvtItem& c, const f32x4 (&v)[16], LAS float* scr, int lane) {
    const int a = lane >> 4, b4 = (lane & 15) * 4;
#pragma unroll
    for (int i = 0; i < 16; ++i) { LAS float* s = scr + (4 * i + a) * 65 + b4; s[0] = v[i].x; s[1] = v[i].y; s[2] = v[i].z; s[3] = v[i].w; }
    asm volatile("s_waitcnt lgkmcnt(0)" ::: "memory");
    const int cb = lane & 7;
#pragma unroll
    for (int j = 0; j < 8; ++j) {
        const int n = (lane >> 3) + 8 * j; const LAS float* s = scr + (8 * cb) * 65 + n;
        v4u o; o.x = pk2(s[0], s[65]); o.y = pk2(s[2 * 65], s[3 * 65]); o.z = pk2(s[4 * 65], s[5 * 65]); o.w = pk2(s[6 * 65], s[7 * 65]);
        __builtin_nontemporal_store(o, (v4u*)(c.dst + (size_t)n * DM + 8 * cb));
    }
    asm volatile("s_waitcnt lgkmcnt(0)" ::: "memory");
}
__device__ __forceinline__ void cvt_moe_chunk(const Args& A, int layer, int chunk, LAS unsigned char* lds, int wid, int lane) {
    LAS float* scr = (LAS float*)(lds + wid * 16896);
    CvtItem c0, c1; f32x4 va[16], vb[16];
    const int r0 = chunk * CVT_CHUNK + wid * 4;
    cvt_decode_moe(A, layer, r0, c0); cvt_load(c0, va, lane);
    cvt_decode_moe(A, layer, r0 + 1, c1); cvt_load(c1, vb, lane);
    cvt_store(c0, va, scr, lane);
    cvt_decode_moe(A, layer, r0 + 2, c0); cvt_load(c0, va, lane);
    cvt_store(c1, vb, scr, lane);
    cvt_decode_moe(A, layer, r0 + 3, c1); cvt_load(c1, vb, lane);
    cvt_store(c0, va, scr, lane);
    cvt_store(c1, vb, scr, lane);
}
__device__ __forceinline__ void ph_convert(const Args& A, LAS unsigned char* lds, int wg, int G, int g_wid) {
    PH_IDS;
    unsigned char* ws = A.ws;
    LAS float* scr = (LAS float*)(lds + wid * 16896);
    const int gw = wg * NWAVES + wid, NGW = G * NWAVES;
    { CvtItem cur, nxt; f32x4 va[16], vb[16];
      bool okc = cvt_decode(A, gw, cur);
      if (okc) cvt_load(cur, va, lane);
      for (int it = gw; okc; it += 2 * NGW) {
          const bool okn = cvt_decode(A, it + NGW, nxt);
          if (okn) cvt_load(nxt, vb, lane);
          cvt_store(cur, va, scr, lane);
          if (!okn) break;
          okc = cvt_decode(A, it + 2 * NGW, cur);
          if (okc) cvt_load(cur, va, lane);
          cvt_store(nxt, vb, scr, lane);
      } }
    { const int gt = wg * NTHR + tid, NGT = G * NTHR;
      for (int i = gt; i < 2 * 16 * DM; i += NGT) { const int j = i / (16 * DM), hh = (i / DM) & 15, k = i % DM;
          const float v = hh < HS ? A.in[I_WIN_FOX][(size_t)j * DM * (NPROJ + HS) + (size_t)k * (NPROJ + HS) + NPROJ + hh] : 0.f;
          ((bf16*)(ws + WS_WFG))[i] = (bf16)f2bf(v); }
      { constexpr size_t NX = (size_t)NTOK * DM / 8; const f32x4* xs = (const f32x4*)A.in[I_X]; v4u* xd = (v4u*)(ws + WS_HB);
        size_t i = gt;
        for (; i + 3 * (size_t)NGT < NX; i += 4 * (size_t)NGT) {
            f32x4 a[4], b[4];
#pragma unroll
            for (int q = 0; q < 4; ++q) { a[q] = __builtin_nontemporal_load(xs + 2 * (i + q * (size_t)NGT)); b[q] = __builtin_nontemporal_load(xs + 2 * (i + q * (size_t)NGT) + 1); }
#pragma unroll
            for (int q = 0; q < 4; ++q) { v4u o; o.x = pk2(a[q].x, a[q].y); o.y = pk2(a[q].z, a[q].w); o.z = pk2(b[q].x, b[q].y); o.w = pk2(b[q].z, b[q].w); xd[i + q * (size_t)NGT] = o; } }
        for (; i < NX; i += NGT) { const f32x4 a = xs[2 * i], b = xs[2 * i + 1]; v4u o; o.x = pk2(a.x, a.y); o.y = pk2(a.z, a.w); o.z = pk2(b.x, b.y); o.w = pk2(b.z, b.w); xd[i] = o; } }
      for (size_t i = gt; i < (size_t)NB * NMEM * DM / 8; i += NGT) { const f32x4 a = ((const f32x4*)A.in[I_MEM])[2 * i], b = ((const f32x4*)A.in[I_MEM])[2 * i + 1];
          v4u o; o.x = pk2(a.x, a.y); o.y = pk2(a.z, a.w); o.z = pk2(b.x, b.y); o.w = pk2(b.z, b.w); ((v4u*)(ws + WS_MEMB))[i] = o; }
    }
}

__device__ __forceinline__ void glds16(const void* gsrc, unsigned lds_dst) { unsigned keep;
    asm volatile("s_mov_b32 %0, m0\n\ts_mov_b32 m0, %2\n\ts_nop 0\n\tglobal_load_lds_dwordx4 %1, off\n\ts_mov_b32 m0, %0" : "=&s"(keep) : "v"(gsrc), "s"(lds_dst) : "memory"); }
__device__ __forceinline__ void glds4(const void* gsrc, unsigned lds_dst) { unsigned keep;
    asm volatile("s_mov_b32 %0, m0\n\ts_mov_b32 m0, %2\n\ts_nop 0\n\tglobal_load_lds_dword %1, off\n\ts_mov_b32 m0, %0" : "=&s"(keep) : "v"(gsrc), "s"(lds_dst) : "memory"); }
struct Unit { int pm, pn, e, rows, pa; const bf16* B; const unsigned* list; const LAS unsigned char* ls; };
struct DenseSched {
    static constexpr bool GATHER = false;
    const bf16* A; const bf16* Bt; int nM, nN, G, c;
    __device__ __forceinline__ bool next(int i, Unit& u) const {
        if ((G & 7) == 0 && (nM & 7) == 0) { const int x = c & 7, l = i * (G >> 3) + (c >> 3); u.pm = (l / nN) * 8 + x; u.pn = l % nN; if (u.pm >= nM) return false; }
        else { const int L = i * G + c; if (L >= nM * nN) return false; u.pm = L / nN; u.pn = L % nN; }
        u.pa = u.pm; u.e = 0; u.rows = 256; u.B = Bt + (size_t)u.pn * 256 * DM; u.list = nullptr; return true; }
    __device__ __forceinline__ unsigned arow(const Unit& u, int r) const { return (unsigned)(u.pm * 256 + r); }
    __device__ __forceinline__ unsigned araw(const Unit& u, int r) const { return (unsigned)(u.pm * 256 + r); }
    __device__ __forceinline__ unsigned afin(unsigned x) const { return x; }
};
template <bool GATHER_>
struct MoeSchedT {
    static constexpr bool GATHER = GATHER_;
    const bf16* A; const bf16* Bt; const unsigned* elist; const LAS int* tab; int nN, ntot, G, c, shift;
    __device__ __forceinline__ bool next(int i, Unit& u) const {
        const int tot = __builtin_amdgcn_readfirstlane(tab[64 + 32]); int g;
        if ((G & 7) == 0) { const int x = c & 7, l = i * (G >> 3) + (c >> 3); g = (l / nN) * 8 + x; u.pn = l % nN; if (g >= tot) return false; }
        else { const int L = i * G + c; if (L >= tot * nN) return false; u.pn = L % nN; g = L / nN; }
        int ln; asm volatile("v_mbcnt_lo_u32_b32 %0, -1, 0\n\tv_mbcnt_hi_u32_b32 %0, -1, %0" : "=v"(ln));
        const int offv = tab[64 + (ln & 31)];
        const unsigned long long mk = __builtin_amdgcn_ballot_w64(ln < 32 && offv <= g);
        const int e = __builtin_popcountll(mk) - 1;
        u.e = e; u.pa = g; u.pm = g - __builtin_amdgcn_readfirstlane(tab[64 + e]); const int rem = __builtin_amdgcn_readfirstlane(tab[e]) - 256 * u.pm; u.rows = rem < 256 ? rem : 256;
        u.B = Bt + ((size_t)e * ntot + (size_t)u.pn * 256) * DM; u.list = elist + ((size_t)e * NTOK + 256 * u.pm) * 2; return true; }
    __device__ __forceinline__ unsigned arow(const Unit& u, int r) const { const unsigned rr = (unsigned)r < (unsigned)u.rows ? (unsigned)r : (unsigned)(u.rows - 1); return *(const unsigned*)((const char*)u.list + rr * 8u) >> shift; }
    __device__ __forceinline__ unsigned araw(const Unit& u, int r) const { const unsigned rr = (unsigned)r < (unsigned)u.rows ? (unsigned)r : (unsigned)(u.rows - 1); return *(const unsigned*)((const char*)u.list + rr * 8u); }
    __device__ __forceinline__ unsigned afin(unsigned x) const { return x >> shift; }
};
__device__ __forceinline__ void moe_tables(LAS int* tab, const unsigned* ecnt, int g_wid) {
    PH_IDS;
    if (tid == 0) { int acc = 0; for (int e = 0; e < 32; ++e) { const int c = (int)ecnt[e]; tab[e] = c; tab[64 + e] = acc; acc += (c + 255) >> 8; } tab[64 + 32] = acc; }
    __syncthreads();
}

template <bool NORMS, bool KSUM>
struct EpiProjT {   static constexpr int NSTAGE = 0; __device__ __forceinline__ const void* stage_src(const Unit&, int, int) const { return nullptr; }
    bf16* O; int ldc, q_end, qm_begin; unsigned* norm; float* ksum;
    __device__ __forceinline__ void operator()(const f32x4 (&acc)[2][2][4][2], const Unit& u, int wr, int wc, int fr, int fq) const {
        float nmax[2] = {0.f, 0.f};
#pragma unroll
        for (int ai = 0; ai < 2; ++ai) { float nsq[4][2];
#pragma unroll
            for (int m = 0; m < 4; ++m) { const int row = u.pm * 256 + ai * 128 + wr * 64 + m * 16 + fr;
#pragma unroll
                for (int bj = 0; bj < 2; ++bj) { const int col = u.pn * 256 + bj * 128 + wc * 32 + 8 * fq; const float sc = (col < q_end || col >= qm_begin) ? C2 : 1.f;
                    const f32x4 v0 = acc[ai][bj][m][0] * sc, v1 = acc[ai][bj][m][1] * sc;
                    if (NORMS) nsq[m][bj] = (v0.x * v0.x + v0.y * v0.y) + (v0.z * v0.z + v0.w * v0.w) + (v1.x * v1.x + v1.y * v1.y) + (v1.z * v1.z + v1.w * v1.w);
                    v4u w; w.x = pk2(v0.x, v0.y); w.y = pk2(v0.z, v0.w); w.z = pk2(v1.x, v1.y); w.w = pk2(v1.z, v1.w);
                    *(v4u*)((char*)O + (unsigned)(row * ldc + col) * 2u) = w; } }
            if (NORMS) { if (u.pn < 6) {
                const int ln_ = fq * 16 + fr;
#pragma unroll
                for (int st = 16; st <= 32; st <<= 1) { float t_[4][2];
#pragma unroll
                    for (int m = 0; m < 4; ++m)
#pragma unroll
                        for (int bj = 0; bj < 2; ++bj) t_[m][bj] = __builtin_bit_cast(float, __builtin_amdgcn_ds_bpermute((ln_ ^ st) << 2, __builtin_bit_cast(int, nsq[m][bj])));
#pragma unroll
                    for (int m = 0; m < 4; ++m)
#pragma unroll
                        for (int bj = 0; bj < 2; ++bj) nsq[m][bj] += t_[m][bj]; }
#pragma unroll
                for (int m = 0; m < 4; ++m)
#pragma unroll
                    for (int bj = 0; bj < 2; ++bj) nmax[bj] = fmaxf(nmax[bj], nsq[m][bj]); } } }
        if (NORMS) { if (u.pn < 6) {
            const int b = u.pm >> 5;
#pragma unroll
            for (int bj = 0; bj < 2; ++bj) { const float mx = wave_max(nmax[bj]); const int c = u.pn * 256 + bj * 128 + wc * 32; const int isk = c >= K_COL ? 1 : 0, cc = c - isk * K_COL;
                if (fr == 0 && fq == 0) __hip_atomic_fetch_max(norm + (((b * HS + (cc >> 6)) * 2 + ((cc >> 5) & 1)) * 2 + isk), __float_as_uint(mx), __ATOMIC_RELAXED, __HIP_MEMORY_SCOPE_AGENT); } } }
        if (KSUM) { if (u.pn >= 3 && u.pn < 6) {
            const int b = u.pm >> 5, jblk = u.pm & 31;
#pragma unroll
            for (int bj = 0; bj < 2; ++bj) { const int c = u.pn * 256 + bj * 128 + wc * 32 + 8 * fq - K_COL; float* dst = ksum + ((size_t)((b * HS + (c >> 6)) * 32 + jblk)) * 64 + (c & 63);
#pragma unroll
                for (int n = 0; n < 2; ++n) { f32x4 s = acc[0][bj][0][n];
#pragma unroll
                    for (int ai = 0; ai < 2; ++ai)
#pragma unroll
                        for (int m = 0; m < 4; ++m) if (ai + m) s += acc[ai][bj][m][n];
                    s.x = row16_sum(s.x); s.y = row16_sum(s.y); s.z = row16_sum(s.z); s.w = row16_sum(s.w);
                    if (fr == 0) { atomicAdd(dst + 4 * n, s.x); atomicAdd(dst + 4 * n + 1, s.y); atomicAdd(dst + 4 * n + 2, s.z); atomicAdd(dst + 4 * n + 3, s.w); } } } } }
    }
};
template <bool BASE_F32>
struct EpiOutT {    static constexpr int NSTAGE = 0; __device__ __forceinline__ const void* stage_src(const Unit&, int, int) const { return nullptr; }
    const void* base; bf16* out;
    __device__ __forceinline__ void operator()(const f32x4 (&acc)[2][2][4][2], const Unit& u, int wr, int wc, int fr, int fq) const {
#pragma unroll
        for (int ai = 0; ai < 2; ++ai) {
            f32x4 b0[4][2], b1[4][2];
#pragma unroll
            for (int m = 0; m < 4; ++m)
#pragma unroll
                for (int bj = 0; bj < 2; ++bj) { const unsigned eo = (unsigned)((u.pm * 256 + ai * 128 + wr * 64 + m * 16 + fr) * DM + u.pn * 256 + bj * 128 + wc * 32 + 8 * fq);
                    if (BASE_F32) { b0[m][bj] = *(const f32x4*)((const char*)base + eo * 4u); b1[m][bj] = *(const f32x4*)((const char*)base + eo * 4u + 16); }
                    else { const v4u w = *(const v4u*)((const char*)base + eo * 2u); b0[m][bj] = (f32x4){bflo(w.x), bfhi(w.x), bflo(w.y), bfhi(w.y)}; b1[m][bj] = (f32x4){bflo(w.z), bfhi(w.z), bflo(w.w), bfhi(w.w)}; } }
#pragma unroll
            for (int m = 0; m < 4; ++m)
#pragma unroll
                for (int bj = 0; bj < 2; ++bj) { const unsigned eo = (unsigned)((u.pm * 256 + ai * 128 + wr * 64 + m * 16 + fr) * DM + u.pn * 256 + bj * 128 + wc * 32 + 8 * fq);
                    const f32x4 o0 = b0[m][bj] * ALPHA + acc[ai][bj][m][0], o1 = b1[m][bj] * ALPHA + acc[ai][bj][m][1];
                    v4u w; w.x = pk2(o0.x, o0.y); w.y = pk2(o0.z, o0.w); w.z = pk2(o1.x, o1.y); w.w = pk2(o1.z, o1.w); *(v4u*)((char*)out + eo * 2u) = w; } }
    }
};
__device__ __forceinline__ float swiglu(float g, float uu) {
    g = fminf(g, SW_LIMIT); uu = fminf(fmaxf(uu, -SW_LIMIT), SW_LIMIT);
    const float sg = __builtin_amdgcn_rcpf(1.f + fexp2(-SW_ALPHA * LOG2E * g));
    return g * sg * (uu + 1.f);
}
__device__ __forceinline__ f32x2_t swiglu2(f32x2_t g, f32x2_t uu) {
    g = __builtin_elementwise_min(g, (f32x2_t){SW_LIMIT, SW_LIMIT}); uu = __builtin_elementwise_min(__builtin_elementwise_max(uu, (f32x2_t){-SW_LIMIT, -SW_LIMIT}), (f32x2_t){SW_LIMIT, SW_LIMIT});
    const f32x2_t z = g * (-SW_ALPHA * LOG2E); f32x2_t d; d.x = 1.f + fexp2(z.x); d.y = 1.f + fexp2(z.y);
    f32x2_t sg; sg.x = __builtin_amdgcn_rcpf(d.x); sg.y = __builtin_amdgcn_rcpf(d.y);
    return g * sg * (uu + 1.f);
}
struct EpiGU {
    static constexpr int NSTAGE = 1;
    bf16* abuf; const float* bgu;
    __device__ __forceinline__ const void* stage_src(const Unit& u, int, int lane) const { return bgu + (size_t)u.e * 2048 + (lane >= 32 ? 1024 : 0) + u.pn * 128 + (lane & 31) * 4; }
    __device__ __forceinline__ void operator()(const f32x4 (&acc)[2][2][4][2], const Unit& u, int wr, int wc, int fr, int fq) const { if (u.rows == 256) body<false>(acc, u, wr, wc, fr, fq); else body<true>(acc, u, wr, wc, fr, fq); }
    template <bool CHECK> __device__ __forceinline__ void body(const f32x4 (&acc)[2][2][4][2], const Unit& u, int wr, int wc, int fr, int fq) const {
        const int c0 = u.pn * 128 + wc * 32 + 8 * fq; const LAS float* bl = (const LAS float*)u.ls + wc * 32 + 8 * fq;
        const f32x4 g0 = *(const LAS f32x4*)bl, g1 = *(const LAS f32x4*)(bl + 4), u0 = *(const LAS f32x4*)(bl + 128), u1 = *(const LAS f32x4*)(bl + 132);
#pragma unroll
        for (int ai = 0; ai < 2; ++ai)
#pragma unroll
            for (int m = 0; m < 4; ++m) { const int r = ai * 128 + wr * 64 + m * 16 + fr;
                if (!CHECK || r < u.rows) {
                    const f32x4 ga = acc[ai][0][m][0] + g0, gb = acc[ai][0][m][1] + g1, ua = acc[ai][1][m][0] + u0, ub = acc[ai][1][m][1] + u1;
                    const f32x2_t s0 = swiglu2((f32x2_t){ga.x, ga.y}, (f32x2_t){ua.x, ua.y}), s1 = swiglu2((f32x2_t){ga.z, ga.w}, (f32x2_t){ua.z, ua.w});
                    const f32x2_t s2 = swiglu2((f32x2_t){gb.x, gb.y}, (f32x2_t){ub.x, ub.y}), s3 = swiglu2((f32x2_t){gb.z, gb.w}, (f32x2_t){ub.z, ub.w});
                    v4u w; w.x = pk2(s0.x, s0.y); w.y = pk2(s1.x, s1.y); w.z = pk2(s2.x, s2.y); w.w = pk2(s3.x, s3.y);
                    *(v4u*)((char*)abuf + ((unsigned)(u.pa * 256 + r) * (unsigned)DM + (unsigned)c0) * 2u) = w; } }
    }
};
constexpr float Y_SCALE = 16.f;
struct EpiDN {
    static constexpr int NSTAGE = 3;
    bf16* ybuf; const float* bdn;
    __device__ __forceinline__ const void* stage_src(const Unit& u, int p, int lane) const {
        return p == 0 ? (const void*)(bdn + (size_t)u.e * DM + u.pn * 256 + lane * 4) : (const void*)((const char*)u.list + (p - 1) * 1024 + lane * 16); }
    __device__ __forceinline__ void operator()(const f32x4 (&acc)[2][2][4][2], const Unit& u, int wr, int wc, int fr, int fq) const { if (u.rows == 256) body<false>(acc, u, wr, wc, fr, fq); else body<true>(acc, u, wr, wc, fr, fq); }
    template <bool CHECK> __device__ __forceinline__ void body(const f32x4 (&acc)[2][2][4][2], const Unit& u, int wr, int wc, int fr, int fq) const {
        f32x4 bv[2][2];
#pragma unroll
        for (int bj = 0; bj < 2; ++bj) { const LAS float* bp = (const LAS float*)u.ls + bj * 128 + wc * 32 + 8 * fq; bv[bj][0] = *(const LAS f32x4*)bp; bv[bj][1] = *(const LAS f32x4*)(bp + 4); }
#pragma unroll
        for (int ai = 0; ai < 2; ++ai)
#pragma unroll
            for (int m = 0; m < 4; ++m) { const int r = ai * 128 + wr * 64 + m * 16 + fr;
                if (!CHECK || r < u.rows) { const v2u ag = *(const LAS v2u*)(u.ls + 1024 + r * 8); const unsigned aid = ag.x; const float gt = __uint_as_float(ag.y);
#pragma unroll
                    for (int bj = 0; bj < 2; ++bj) { const float g16 = gt * Y_SCALE; f32x4 v0 = (acc[ai][bj][m][0] + bv[bj][0]) * g16, v1 = (acc[ai][bj][m][1] + bv[bj][1]) * g16;
                        v0.x = __builtin_amdgcn_fmed3f(v0.x, -448.f, 448.f); v0.y = __builtin_amdgcn_fmed3f(v0.y, -448.f, 448.f); v0.z = __builtin_amdgcn_fmed3f(v0.z, -448.f, 448.f); v0.w = __builtin_amdgcn_fmed3f(v0.w, -448.f, 448.f);
                        v1.x = __builtin_amdgcn_fmed3f(v1.x, -448.f, 448.f); v1.y = __builtin_amdgcn_fmed3f(v1.y, -448.f, 448.f); v1.z = __builtin_amdgcn_fmed3f(v1.z, -448.f, 448.f); v1.w = __builtin_amdgcn_fmed3f(v1.w, -448.f, 448.f);
                        int w0 = __builtin_amdgcn_cvt_pk_fp8_f32(v0.x, v0.y, 0, false); w0 = __builtin_amdgcn_cvt_pk_fp8_f32(v0.z, v0.w, w0, true);
                        int w1 = __builtin_amdgcn_cvt_pk_fp8_f32(v1.x, v1.y, 0, false); w1 = __builtin_amdgcn_cvt_pk_fp8_f32(v1.z, v1.w, w1, true);
                        *(v2u*)((char*)ybuf + (aid * (unsigned)DM + (unsigned)(u.pn * 256 + bj * 128 + wc * 32 + 8 * fq))) = (v2u){(unsigned)w0, (unsigned)w1}; } } }
    }
};
template <class Epi, class Sched>
__device__ __forceinline__ void gemm_simple(const Sched& S, const Epi& E, int g_wid) {
    PH_IDS;
    const int wr = wid >> 2, wc = wid & 3, fr = lane & 15, fq = lane >> 4;
    Unit u;
    for (int i = 0; S.next(i, u); ++i) {
        f32x4 acc[2][2][4][2];
#pragma unroll
        for (int a = 0; a < 2; ++a)
#pragma unroll
            for (int b = 0; b < 2; ++b)
#pragma unroll
                for (int m = 0; m < 4; ++m)
#pragma unroll
                    for (int n = 0; n < 2; ++n) acc[a][b][m][n] = (f32x4){0.f, 0.f, 0.f, 0.f};
        unsigned aoff[2][4], boff[2][2];
#pragma unroll
        for (int ai = 0; ai < 2; ++ai)
#pragma unroll
            for (int m = 0; m < 4; ++m) aoff[ai][m] = S.arow(u, ai * 128 + wr * 64 + m * 16 + fr) * DM + 8 * fq;
#pragma unroll
        for (int bj = 0; bj < 2; ++bj)
#pragma unroll
            for (int n = 0; n < 2; ++n) boff[bj][n] = (unsigned)(bj * 128 + wc * 32 + 8 * (fr >> 2) + 4 * n + (fr & 3)) * DM + 8 * fq;
#pragma unroll 1
        for (int k0 = 0; k0 < DM; k0 += 32) {
            bf16x8 b[2][2];
#pragma unroll
            for (int bj = 0; bj < 2; ++bj)
#pragma unroll
                for (int n = 0; n < 2; ++n) b[bj][n] = *(const bf16x8*)(u.B + boff[bj][n] + k0);
#pragma unroll
            for (int ai = 0; ai < 2; ++ai) {
                bf16x8 a[4];
#pragma unroll
                for (int m = 0; m < 4; ++m) a[m] = *(const bf16x8*)(S.A + aoff[ai][m] + k0);
#pragma unroll
                for (int bj = 0; bj < 2; ++bj)
#pragma unroll
                    for (int m = 0; m < 4; ++m)
#pragma unroll
                        for (int n = 0; n < 2; ++n) acc[ai][bj][m][n] = __builtin_amdgcn_mfma_f32_16x16x32_bf16(b[bj][n], a[m], acc[ai][bj][m][n], 0, 0, 0);
            }
        }
        E(acc, u, wr, wc, fr, fq);
    }
}


namespace pg8 {
constexpr int BM = 256, BK = 64, HALF = 128, HTB = HALF * BK * 2, STAGE_BYTES = 8 * HTB;
__device__ __forceinline__ int lds_byte(int r, int c) { const int st = (r >> 4) * 2 + (c >> 5), rr = r & 15, cc = c & 31, ob = rr * 64 + cc * 2; return st * 1024 + (ob ^ (((ob >> 9) & 1) << 5)); }
__device__ __forceinline__ void stage_rc(int b, int& R, int& C) { const int st = b / 1024, sb = b % 1024, swz = sb ^ (((sb >> 9) & 1) << 5); R = (st >> 1) * 16 + swz / 64; C = (st & 1) * 32 + (swz % 64) / 2; }
__device__ __forceinline__ int perm32(int rho) { const int n = rho >> 4, i = rho & 15; return 8 * (i >> 2) + 4 * n + (i & 3); }
}
template <class Epi, class Sched, bool ALIGN_EPI>
__device__ __forceinline__ void gemm_fast(LAS unsigned char* lds, const Sched& S, const Epi& E, int g_wid) {
    using namespace pg8;
    PH_IDS;
    const int wr = wid >> 2, wc = wid & 3, fr = lane & 15, fq = lane >> 4;
    constexpr int K = DM, nt = K / BK;
    int Rr[2], Cc[2]; unsigned voffB[2];
#pragma unroll
    for (int i = 0; i < 2; ++i) { int R, C; stage_rc(tid * 16 + i * 8192, R, C); Rr[i] = R; Cc[i] = C; const int Rb = (R & ~31) + perm32(R & 31); voffB[i] = (unsigned)(Rb * K + C) * 2u; }
    constexpr unsigned kstep = BK * 2, hstep = HALF * K * 2;
    const unsigned ldsw = (unsigned)wid * 1024u;
    const int aoff = lds_byte(wr * 64 + fr, fq * 8), boff = lds_byte(wc * 32 + fr, fq * 8);
    const char* Ab = (const char*)S.A;
#define PG8_SA(b, h) (((b) * 2 + (h)) * HTB)
#define PG8_SB(b, h) ((4 + (b) * 2 + (h)) * HTB)
#define PG8_STAGEB(bufoff, gbase) do { const char* _ub = (const char*)(gbase); asm volatile("" : "+s"(_ub)); _Pragma("unroll") for (int _i = 0; _i < 2; ++_i) \
        __builtin_amdgcn_global_load_lds((const unsigned*)(_ub + voffB[_i]), (LAS unsigned*)(lds + (bufoff) + ldsw + _i * 8192), 16, 0, 0); } while (0)
#define PG8_STAGEA(bufoff, kb, vo, sb) do { const char* _ub = (sb) + (size_t)(kb); asm volatile("" : "+s"(_ub)); _Pragma("unroll") for (int _i = 0; _i < 2; ++_i) \
        __builtin_amdgcn_global_load_lds((const unsigned*)(_ub + (vo)[_i]), (LAS unsigned*)(lds + (bufoff) + ldsw + _i * 8192), 16, 0, 0); } while (0)
#define PG8_VA(h) (Sched::GATHER ? vA[h] : laneA)
#define PG8_VN(h) (Sched::GATHER ? vN[h] : laneA)
#define PG8_BA(h) (Sched::GATHER ? Ab : cAb + (h) * hstep)
#define PG8_BN(h) (Sched::GATHER ? Ab : nAb + (h) * hstep)
#define PG8_LDA(dst, b, h) do { _Pragma("unroll") for (int m = 0; m < 4; ++m) _Pragma("unroll") for (int k = 0; k < 2; ++k) dst[m][k] = *(const LAS bf16x8*)(lds + PG8_SA(b, h) + aoff + m * 2048 + k * 1024); } while (0)
#define PG8_LDB(dst, b, h) do { _Pragma("unroll") for (int n = 0; n < 2; ++n) _Pragma("unroll") for (int k = 0; k < 2; ++k) dst[n][k] = *(const LAS bf16x8*)(lds + PG8_SB(b, h) + boff + n * 2048 + k * 1024); } while (0)
#define PG8_MMA(ai, bj, At, Bt) do { __builtin_amdgcn_s_setprio(1); _Pragma("unroll") for (int m = 0; m < 4; ++m) _Pragma("unroll") for (int n = 0; n < 2; ++n) _Pragma("unroll") for (int k = 0; k < 2; ++k) \
        acc[ai][bj][m][n] = __builtin_amdgcn_mfma_f32_16x16x32_bf16(Bt[n][k], At[m][k], acc[ai][bj][m][n], 0, 0, 0); __builtin_amdgcn_s_setprio(0); } while (0)
#define PG8_WAIT_V(n) asm volatile("s_waitcnt vmcnt(" #n ")" ::: "memory")
#define PG8_WAIT_L(n) asm volatile("s_waitcnt lgkmcnt(" #n ")" ::: "memory")
#define PG8_BAR __builtin_amdgcn_s_barrier()
#define PG8_SCHED __builtin_amdgcn_sched_barrier(0)
#define PG8_OFFS_RAW(dst, un) do { _Pragma("unroll") for (int _h = 0; _h < 2; ++_h) _Pragma("unroll") for (int _i = 0; _i < 2; ++_i) dst[_h][_i] = S.araw(un, _h * 128 + Rr[_i]); } while (0)
#define PG8_OFFS_FIN(dst, raw) do { _Pragma("unroll") for (int _h = 0; _h < 2; ++_h) _Pragma("unroll") for (int _i = 0; _i < 2; ++_i) dst[_h][_i] = (S.afin(raw[_h][_i]) * (unsigned)K + (unsigned)Cc[_i]) * 2u; } while (0)
#define PG8_OFFS(dst, un) do { _Pragma("unroll") for (int _h = 0; _h < 2; ++_h) _Pragma("unroll") for (int _i = 0; _i < 2; ++_i) dst[_h][_i] = (S.arow(un, _h * 128 + Rr[_i]) * (unsigned)K + (unsigned)Cc[_i]) * 2u; } while (0)
    Unit cur, nxt, nn; int ui = 0;
    if (!S.next(0, cur)) return;
    f32x4 acc[2][2][4][2];
#pragma unroll
    for (int a = 0; a < 2; ++a)
#pragma unroll
        for (int b = 0; b < 2; ++b)
#pragma unroll
            for (int m = 0; m < 4; ++m)
#pragma unroll
                for (int n = 0; n < 2; ++n) acc[a][b][m][n] = (f32x4){0.f, 0.f, 0.f, 0.f};
    bf16x8 At[4][2], B0[2][2], B1[2][2];
    unsigned vA[2][2], vN[2][2], laneA[2];
#pragma unroll
    for (int i = 0; i < 2; ++i) laneA[i] = (unsigned)(Rr[i] * K + Cc[i]) * 2u;
    if constexpr (Sched::GATHER) { PG8_OFFS(vA, cur); }
    const char* cAb = Ab + (size_t)cur.pa * (2 * hstep); const char* nAb = cAb;
    const char* cB = (const char*)cur.B;
    PG8_STAGEB(PG8_SB(0, 0), cB); PG8_STAGEB(PG8_SB(0, 1), cB + hstep); PG8_STAGEA(PG8_SA(0, 0), 0, PG8_VA(0), PG8_BA(0)); PG8_STAGEA(PG8_SA(0, 1), 0, PG8_VA(1), PG8_BA(1));
    if (wr == 1) PG8_BAR;
    PG8_WAIT_V(2); PG8_BAR;
    PG8_STAGEB(PG8_SB(1, 0), cB + kstep); PG8_STAGEA(PG8_SA(1, 0), kstep, PG8_VA(0), PG8_BA(0)); PG8_STAGEB(PG8_SB(1, 1), cB + hstep + kstep);
    PG8_WAIT_V(6); PG8_BAR;
    bool has_next = S.next(1, nxt);
    unsigned rawN[2][2] = {{0u, 0u}, {0u, 0u}};
    if constexpr (Sched::GATHER) { if (has_next) { PG8_OFFS_RAW(rawN, nxt); } }
    for (;;) {
        if constexpr (Epi::NSTAGE > 0) {
            cur.ls = lds + STAGE_BYTES + (ui & 1) * 4096;
            if (wid == 0) {
#pragma unroll
                for (int p = 0; p < Epi::NSTAGE; ++p) glds16(E.stage_src(cur, p, lane), (unsigned)__builtin_amdgcn_readfirstlane((unsigned)(uintptr_t)cur.ls + p * 1024)); } }
        if constexpr (Sched::GATHER) {
            if (has_next) { PG8_OFFS_FIN(vN, rawN); } else {
#pragma unroll
                for (int h = 0; h < 2; ++h)
#pragma unroll
                    for (int i = 0; i < 2; ++i) vN[h][i] = vA[h][i]; } }
        else nAb = has_next ? Ab + (size_t)nxt.pa * (2 * hstep) : cAb;
        const char* nB = has_next ? (const char*)nxt.B : cB;
#define PG8_KSTEP(LAST, t) do { \
            const unsigned kb1 = (unsigned)((t) + 1) * kstep, kb2 = (LAST) ? 0u : (unsigned)((t) + 2) * kstep, kb3 = kb2 + kstep; \
            const char* b2 = (LAST) ? nB : cB + (size_t)((t) + 2) * kstep; const char* b3 = b2 + kstep; \
            PG8_LDB(B0, 0, 0); PG8_LDB(B1, 0, 1); PG8_SCHED; PG8_LDA(At, 0, 0); PG8_STAGEA(PG8_SA(1, 1), kb1, PG8_VA(1), PG8_BA(1)); \
            PG8_WAIT_V(8); PG8_WAIT_L(0); PG8_BAR; PG8_MMA(0, 0, At, B0); PG8_MMA(0, 1, At, B1); PG8_BAR; PG8_SCHED; \
            PG8_LDA(At, 0, 1); PG8_STAGEB(PG8_SB(0, 0), b2); PG8_STAGEB(PG8_SB(0, 1), b2 + hstep); if (LAST) { PG8_STAGEA(PG8_SA(0, 0), kb2, PG8_VN(0), PG8_BN(0)); } else { PG8_STAGEA(PG8_SA(0, 0), kb2, PG8_VA(0), PG8_BA(0)); } \
            PG8_WAIT_V(8); PG8_WAIT_L(0); PG8_BAR; PG8_MMA(1, 0, At, B0); PG8_MMA(1, 1, At, B1); PG8_BAR; PG8_SCHED; \
            PG8_LDB(B0, 1, 0); PG8_LDB(B1, 1, 1); PG8_SCHED; PG8_LDA(At, 1, 0); if (LAST) { PG8_STAGEA(PG8_SA(0, 1), kb2, PG8_VN(1), PG8_BN(1)); } else { PG8_STAGEA(PG8_SA(0, 1), kb2, PG8_VA(1), PG8_BA(1)); } \
            PG8_WAIT_V(8); PG8_WAIT_L(0); PG8_BAR; PG8_MMA(0, 0, At, B0); PG8_MMA(0, 1, At, B1); PG8_BAR; PG8_SCHED; \
            PG8_LDA(At, 1, 1); PG8_STAGEB(PG8_SB(1, 0), b3); PG8_STAGEB(PG8_SB(1, 1), b3 + hstep); if (LAST) { PG8_STAGEA(PG8_SA(1, 0), kb3, PG8_VN(0), PG8_BN(0)); } else { PG8_STAGEA(PG8_SA(1, 0), kb3, PG8_VA(0), PG8_BA(0)); } \
            PG8_WAIT_V(8); PG8_WAIT_L(0); PG8_BAR; PG8_MMA(1, 0, At, B0); PG8_MMA(1, 1, At, B1); PG8_BAR; PG8_SCHED; } while (0)
        for (int t = 0; t < nt - 2; t += 2) PG8_KSTEP(false, t);
        PG8_KSTEP(true, nt - 2);
#undef PG8_KSTEP
        if constexpr (ALIGN_EPI) { if (wr == 0) PG8_BAR; }
        bool has_nn = false; unsigned rawNN[2][2] = {{0u, 0u}, {0u, 0u}};
        if (has_next) { has_nn = S.next(ui + 2, nn); if constexpr (Sched::GATHER) { if (has_nn) { PG8_OFFS_RAW(rawNN, nn); } } }
        { int fr_e = fr, fq_e = fq; asm volatile("" : "+v"(fr_e), "+v"(fq_e));
          E(acc, cur, wr, wc, fr_e, fq_e); }
        if (!has_next) break;
#pragma unroll
        for (int a = 0; a < 2; ++a)
#pragma unroll
            for (int b = 0; b < 2; ++b)
#pragma unroll
                for (int m = 0; m < 4; ++m)
#pragma unroll
                    for (int n = 0; n < 2; ++n) acc[a][b][m][n] = (f32x4){0.f, 0.f, 0.f, 0.f};
        cur = nxt; nxt = nn; has_next = has_nn; cB = nB; cAb = nAb; ++ui;
#pragma unroll
        for (int h = 0; h < 2; ++h)
#pragma unroll
            for (int i = 0; i < 2; ++i) rawN[h][i] = rawNN[h][i];
        if constexpr (Sched::GATHER) {
#pragma unroll
            for (int h = 0; h < 2; ++h)
#pragma unroll
                for (int i = 0; i < 2; ++i) vA[h][i] = vN[h][i]; }
        if constexpr (ALIGN_EPI) { if (wr == 1) PG8_BAR; }
    }
    PG8_WAIT_V(0);
    if constexpr (!ALIGN_EPI) { if (wr == 0) PG8_BAR; }
    PG8_BAR;
#undef PG8_SA
#undef PG8_SB
#undef PG8_STAGEA
#undef PG8_VA
#undef PG8_VN
#undef PG8_BA
#undef PG8_BN
#undef PG8_STAGEB
#undef PG8_LDA
#undef PG8_LDB
#undef PG8_MMA
#undef PG8_WAIT_V
#undef PG8_WAIT_L
#undef PG8_BAR
#undef PG8_SCHED
#undef PG8_OFFS
#undef PG8_OFFS_RAW
#undef PG8_OFFS_FIN
}

__device__ __forceinline__ void ph_fox_gate(const Args& A, int j, int wg, int G, int g_wid) {
    PH_IDS;
    const bf16* hb = (const bf16*)(A.ws + WS_HB); const bf16* wfg = (const bf16*)(A.ws + WS_WFG) + (size_t)j * 16 * DM; float* lf = (float*)(A.ws + WS_LF);
    const float* bfg = A.in[I_BFG] + j * HS;
    const int gw = wg * NWAVES + wid, NGW = G * NWAVES;
    v4u wv[HS][2];
#pragma unroll
    for (int hh = 0; hh < HS; ++hh) { const v4u* wp = (const v4u*)(wfg + (size_t)hh * DM + 16 * lane); wv[hh][0] = wp[0]; wv[hh][1] = wp[1]; }
    v4u p0 = {0u, 0u, 0u, 0u}, p1 = {0u, 0u, 0u, 0u};
    if (gw < NTOK) { const v4u* hp = (const v4u*)(hb + (size_t)gw * DM + 16 * lane); p0 = hp[0]; p1 = hp[1]; }
    for (int n = gw; n < NTOK; n += NGW) {
        const v4u h0 = p0, h1 = p1;
        if (n + NGW < NTOK) { const v4u* hp = (const v4u*)(hb + (size_t)(n + NGW) * DM + 16 * lane); p0 = hp[0]; p1 = hp[1]; }
        float hv[16] = {bflo(h0.x), bfhi(h0.x), bflo(h0.y), bfhi(h0.y), bflo(h0.z), bfhi(h0.z), bflo(h0.w), bfhi(h0.w), bflo(h1.x), bfhi(h1.x), bflo(h1.y), bfhi(h1.y), bflo(h1.z), bfhi(h1.z), bflo(h1.w), bfhi(h1.w)};
        float mine = 0.f;
#pragma unroll
        for (int hh = 0; hh < HS; ++hh) {
            const v4u w0 = wv[hh][0], w1 = wv[hh][1];
            float s = hv[0] * bflo(w0.x) + hv[1] * bfhi(w0.x) + hv[2] * bflo(w0.y) + hv[3] * bfhi(w0.y) + hv[4] * bflo(w0.z) + hv[5] * bfhi(w0.z) + hv[6] * bflo(w0.w) + hv[7] * bfhi(w0.w)
                    + hv[8] * bflo(w1.x) + hv[9] * bfhi(w1.x) + hv[10] * bflo(w1.y) + hv[11] * bfhi(w1.y) + hv[12] * bflo(w1.z) + hv[13] * bfhi(w1.z) + hv[14] * bflo(w1.w) + hv[15] * bfhi(w1.w);
            s = wave_sum(s);
            if (lane == hh) mine = s;
        }
        if (lane < HS) { const float z = mine + bfg[lane];
            const float ls = fminf(z, 0.f) - __builtin_amdgcn_logf(1.f + fexp2(-fabsf(z) * LOG2E)) * 0.6931471805599453f;
            const int b = n >> 13, t = n & (SEQ - 1); lf[((size_t)(b * HS + lane)) * SEQ + t] = ls; }
    }
}
__device__ __forceinline__ void ph_fox_scan(const Args& A, LAS unsigned char* lds, int wg, int G, int g_wid) {
    PH_IDS;
    const float* lf = (const float*)(A.ws + WS_LF); float* c2 = (float*)(A.ws + WS_CFOX); LAS float* part = (LAS float*)lds;
    for (int s = wg; s < NB * HS; s += G) {
        const float* src = lf + (size_t)s * SEQ + tid * 16; float v[16]; float run = 0.f;
#pragma unroll
        for (int i = 0; i < 16; ++i) { run += src[i]; v[i] = run; }
        part[tid] = run; __syncthreads();
        if (tid == 0) { float acc = 0.f; for (int i = 0; i < NTHR; ++i) { const float x = part[i]; part[i] = acc; acc += x; } }
        __syncthreads();
        const float base = part[tid]; float* dst = c2 + (size_t)s * SEQ + tid * 16;
#pragma unroll
        for (int i = 0; i < 16; ++i) dst[i] = (base + v[i]) * LOG2E;
        __syncthreads();
    }
}
__device__ __forceinline__ void ph_kbar(const Args& A, LAS unsigned char* lds, int wg, int G, int g_wid) {
    PH_IDS;
    const bf16* proj = (const bf16*)(A.ws + WS_PROJ); float* kbar = (float*)(A.ws + WS_KBAR); LAS float* part = (LAS float*)lds;
    const int d = tid & 63, r8 = tid >> 6;
    for (int uidx = wg; uidx < NB * HS * 32; uidx += G) {
        const int j = uidx & 31, bh = uidx >> 5, b = bh / HS, h = bh % HS;
        const bf16* kp = proj + ((size_t)(b * SEQ + j * 256 + r8 * 32)) * NPROJ + K_COL + h * 64 + d;
        float s = 0.f;
        for (int r = 0; r < 32; ++r) s += __uint_as_float((unsigned)kp[(size_t)r * NPROJ] << 16);
        part[tid] = s; __syncthreads();
        if (tid < 64) { float t = 0.f;
#pragma unroll
            for (int q = 0; q < 8; ++q) t += part[q * 64 + tid];
            kbar[(size_t)uidx * 64 + tid] = t * (1.f / 256.f); ((bf16*)(A.ws + WS_KBAR + 512 * 1024))[(size_t)uidx * 64 + tid] = (bf16)f2bf(t * (1.f / 256.f)); }
        __syncthreads();
    }
}

__device__ __forceinline__ float alibi_slope(int h) { return h < 8 ? exp2f(-(float)(h + 1)) : exp2f(-(0.5f + (float)(h - 8))); }
#define ROW8(w, base, arr) do { arr[base + 0] = bflo(w.x); arr[base + 1] = bfhi(w.x); arr[base + 2] = bflo(w.y); arr[base + 3] = bfhi(w.y); arr[base + 4] = bflo(w.z); arr[base + 5] = bfhi(w.z); arr[base + 6] = bflo(w.w); arr[base + 7] = bfhi(w.w); } while (0)
__device__ __forceinline__ float dot_row64(const float (&q)[64], const bf16* p) {
    const v4u* p4 = (const v4u*)p; float s0 = 0.f, s1 = 0.f;
#pragma unroll
    for (int i = 0; i < 8; ++i) { if (i == 4) asm volatile("" ::: "memory"); const v4u w = p4[i];
        s0 += q[8 * i + 0] * bflo(w.x); s1 += q[8 * i + 1] * bfhi(w.x); s0 += q[8 * i + 2] * bflo(w.y); s1 += q[8 * i + 3] * bfhi(w.y);
        s0 += q[8 * i + 4] * bflo(w.z); s1 += q[8 * i + 5] * bfhi(w.z); s0 += q[8 * i + 6] * bflo(w.w); s1 += q[8 * i + 7] * bfhi(w.w); }
    return s0 + s1;
}
__device__ __forceinline__ void att_upd(float x, const bf16* vrow, float& m, float& l, float (&o)[64]) {
    const float mn = fmaxf(m, x), al = fexp2(m - mn), pp = fexp2(x - mn); m = mn; l = l * al + pp;
    const v4u* p4 = (const v4u*)vrow; asm volatile("" ::: "memory");
#pragma unroll
    for (int i = 0; i < 8; ++i) { if ((i & 1) == 0) asm volatile("" ::: "memory"); const v4u w = p4[i];
        o[8 * i + 0] = o[8 * i + 0] * al + pp * bflo(w.x); o[8 * i + 1] = o[8 * i + 1] * al + pp * bfhi(w.x); o[8 * i + 2] = o[8 * i + 2] * al + pp * bflo(w.y); o[8 * i + 3] = o[8 * i + 3] * al + pp * bfhi(w.y);
        o[8 * i + 4] = o[8 * i + 4] * al + pp * bflo(w.z); o[8 * i + 5] = o[8 * i + 5] * al + pp * bfhi(w.z); o[8 * i + 6] = o[8 * i + 6] * al + pp * bflo(w.w); o[8 * i + 7] = o[8 * i + 7] * al + pp * bfhi(w.w); }
}
template <int MODE, int H_LO = 0, int H_HI = 16>
__device__ __forceinline__ void ph_attn_naive(const Args& A, int wg, int G, int g_wid) {
    PH_IDS;
    const bf16* proj = (const bf16*)(A.ws + WS_PROJ); const bf16* mkv = (const bf16*)(A.ws + WS_MKV); bf16* att = (bf16*)(A.ws + WS_ATT);
    const float* kbar = (const float*)(A.ws + WS_KBAR); const float* cfox = (const float*)(A.ws + WS_CFOX);
    constexpr int NIT = 16 * (NTOK / 64);
    const int gw = wg * NWAVES + wid, NGW = G * NWAVES;
    for (int base = 0, rnd = 0; base < NIT; base += NGW, ++rnd) {
        const int it = base + ((rnd & 1) ? (NGW - 1 - gw) : gw);
        if (it >= NIT) continue;
        const int hh = it & 15, tg = it >> 4, n = tg * 64 + lane, b = n >> 13, t = n & (SEQ - 1);
        if (hh < H_LO || hh >= H_HI) continue;
        float q[64];
        { const v4u* p4 = (const v4u*)(proj + (size_t)n * NPROJ + (hh < HS ? hh * 64 : QM_COL + (hh - HS) * 64));
#pragma unroll
          for (int i = 0; i < 8; ++i) { const v4u w = p4[i]; ROW8(w, 8 * i, q); } }
        float m = -1e30f, l = 0.f; float o[64];
#pragma unroll
        for (int i = 0; i < 64; ++i) o[i] = 0.f;
        if (hh < HS) {
            const bf16* Kb = proj + (size_t)(b * SEQ) * NPROJ + K_COL + hh * 64; const bf16* Vb = Kb + (V_COL - K_COL);
            if (MODE == 0) {
                const float slope2 = alibi_slope(hh) * LOG2E; const int qb = t >> 8;
                const float* kb = kbar + (size_t)((b * HS + hh) * 32) * 64;
                float g0 = -INFINITY, g1 = -INFINITY, g2 = -INFINITY; int i0 = -1, i1 = -1, i2 = -1;
                for (int j = 0; j < qb; ++j) { float s0 = 0.f, s1 = 0.f;
#pragma unroll
                    for (int d = 0; d < 64; d += 2) { s0 += q[d] * kb[j * 64 + d]; s1 += q[d + 1] * kb[j * 64 + d + 1]; }
                    const float g = s0 + s1;
                    if (g > g0) { g2 = g1; i2 = i1; g1 = g0; i1 = i0; g0 = g; i0 = j; } else if (g > g1) { g2 = g1; i2 = i1; g1 = g; i1 = j; } else if (g > g2) { g2 = g; i2 = j; } }
                const int tend = (t | 63);
                for (int s = qb * 256; s <= tend; ++s) { if (s <= t) { const float x = dot_row64(q, Kb + (size_t)s * NPROJ) - slope2 * (float)(t - s); att_upd(x, Vb + (size_t)s * NPROJ, m, l, o); } }
                for (int sl = 0; sl < 3; ++sl) { const int jb = sl == 0 ? i0 : (sl == 1 ? i1 : i2);
                    if (jb >= 0) for (int s = 0; s < 256; ++s) { const int key = jb * 256 + s; const float x = dot_row64(q, Kb + (size_t)key * NPROJ) - slope2 * (float)(t - key); att_upd(x, Vb + (size_t)key * NPROJ, m, l, o); } }
            } else {
                const float* c2 = cfox + (size_t)(b * HS + hh) * SEQ; const float cq = c2[t]; const int tend = (t | 63);
                for (int s = 0; s <= tend; ++s) { if (s <= t) { const float x = dot_row64(q, Kb + (size_t)s * NPROJ) + (cq - c2[s]); att_upd(x, Vb + (size_t)s * NPROJ, m, l, o); } }
            }
        } else {
            const bf16* Kb = mkv + (size_t)(b * NMEM) * 512 + (hh - HS) * 64; const bf16* Vb = Kb + 256;
            for (int s = 0; s < NMEM; ++s) { const float x = dot_row64(q, Kb + (size_t)s * 512); att_upd(x, Vb + (size_t)s * 512, m, l, o); }
        }
        const float rl = 1.f / l; v4u* op = (v4u*)(att + (size_t)n * DM + hh * 64);
#pragma unroll
        for (int i = 0; i < 8; ++i) { v4u w; w.x = pk2(o[8 * i] * rl, o[8 * i + 1] * rl); w.y = pk2(o[8 * i + 2] * rl, o[8 * i + 3] * rl); w.z = pk2(o[8 * i + 4] * rl, o[8 * i + 5] * rl); w.w = pk2(o[8 * i + 6] * rl, o[8 * i + 7] * rl); op[i] = w; }
    }
}


__device__ __forceinline__ void ph_norms(const Args& A, int layer, LAS unsigned char* lds, int wg, int G, int g_wid) {
    PH_IDS;
    const bf16* proj = (const bf16*)(A.ws + WS_PROJ); unsigned* gn = (unsigned*)(A.ws + WS_CTL) + CW_NORM + layer * 128;
    LAS unsigned* ln = (LAS unsigned*)(lds + 65536);
    if (tid < 128) ln[tid] = 0u;
    __syncthreads();
    const int gt = wg * NTHR + tid, NGT = G * NTHR;
    for (int it = gt; it < NTOK * 4; it += NGT) {
        const int n = it >> 2, part = it & 3, b = n >> 13;
#pragma unroll
        for (int hq = 0; hq < 3; ++hq) { const int hh = part * 3 + hq;
#pragma unroll
            for (int kq = 0; kq < 2; ++kq) { const v4u* p4 = (const v4u*)(proj + (size_t)n * NPROJ + kq * K_COL + hh * 64); float s = 0.f;
#pragma unroll
                for (int i = 0; i < 8; ++i) { const v4u w = p4[i]; const float a0 = bflo(w.x), a1 = bfhi(w.x), a2 = bflo(w.y), a3 = bfhi(w.y), a4 = bflo(w.z), a5 = bfhi(w.z), a6 = bflo(w.w), a7 = bfhi(w.w);
                    s += (a0 * a0 + a1 * a1) + (a2 * a2 + a3 * a3) + (a4 * a4 + a5 * a5) + (a6 * a6 + a7 * a7); }
                atomicMax((unsigned*)ln + (b * HS + hh) * 2 + kq, __float_as_uint(s)); } }
    }
    __syncthreads();
    if (tid < 96) { const unsigned v = ln[tid]; if (v) __hip_atomic_fetch_max(gn + tid, v, __ATOMIC_RELAXED, __HIP_MEMORY_SCOPE_AGENT); }
    __syncthreads();
}

typedef float f32x16 __attribute__((ext_vector_type(16)));
typedef short s16x4 __attribute__((ext_vector_type(4)));
__device__ __forceinline__ int crow(int r, int hi) { return (r & 3) + 8 * (r >> 2) + 4 * hi; }
#define ATT_WAIT_BAR() asm volatile("s_waitcnt vmcnt(0) lgkmcnt(0)\n\ts_barrier" ::: "memory")
constexpr int ATT_K = 0, ATT_V = 16384, ATT_CK = 32768;
constexpr float ATT_THR = 8.0f, ATT_THETA = 45.0f;
__device__ __forceinline__ float max3f(float a, float b, float c) { float r; asm("v_max3_f32 %0, %1, %2, %3" : "=v"(r) : "v"(a), "v"(b), "v"(c)); return r; }
__device__ __forceinline__ float max2f(float a, float b) { float r; asm("v_max_f32_e32 %0, %1, %2" : "=v"(r) : "v"(a), "v"(b)); return r; }
__device__ __forceinline__ float swap_other(float v, int hi) { auto rr = __builtin_amdgcn_permlane32_swap(__float_as_uint(v), __float_as_uint(v), false, false); return __uint_as_float(hi ? rr[0] : rr[1]); }
__device__ __forceinline__ int swap_other_i(int v, int hi) { auto rr = __builtin_amdgcn_permlane32_swap((unsigned)v, (unsigned)v, false, false); return (int)(hi ? rr[0] : rr[1]); }

template <int MODE>
__device__ __forceinline__ void attn_unit(const Args& A, LAS unsigned char* lds, const int layer, const int b, const int h, const int qb, const int wid, const int lane) {
    const int r32 = lane & 31, hi = lane >> 5, q0 = qb * 256, wrow0 = q0 + wid * 32, trow = wrow0 + r32;
    const bf16* proj = (const bf16*)(A.ws + WS_PROJ);
    constexpr int pitch = (MODE == 2) ? 512 : NPROJ;
    const bf16* Kb = (MODE == 2) ? (const bf16*)(A.ws + WS_MKV) + (size_t)(b * NMEM) * 512 + h * 64 : proj + (size_t)(b * SEQ) * NPROJ + K_COL + h * 64;
    const bf16* Vb = (MODE == 2) ? Kb + 256 : Kb + (V_COL - K_COL);
    const bf16* Qrow = proj + (size_t)(b * SEQ + trow) * NPROJ + ((MODE == 2) ? QM_COL : 0) + h * 64;
    bf16x8 qr[4];
#pragma unroll
    for (int d0 = 0; d0 < 4; ++d0) qr[d0] = *(const bf16x8*)(Qrow + 16 * d0 + 8 * hi);
    const unsigned ldsb = (unsigned)(uintptr_t)lds;
    const bf16* ksrc = Kb + (size_t)lane * pitch + wid * 8;
    const bf16* vsrc = Vb + (size_t)(16 * (wid & 3) + (lane >> 2)) * pitch + (wid >> 2) * 32 + (lane & 3) * 8;
    float cq = 0.f, slope2 = 0.f; const float* c2 = nullptr;
    if (MODE == 1) { c2 = (const float*)(A.ws + WS_CFOX) + (size_t)(b * HS + h) * SEQ; cq = c2[trow]; }
    if (MODE == 0) { slope2 = alibi_slope(h) * LOG2E; cq = -slope2 * (float)(trow - q0); }
#define ATT_STAGE(kt, buf) do { glds16(ksrc + (size_t)(kt) * 64 * pitch, (unsigned)__builtin_amdgcn_readfirstlane(ldsb + ATT_K + (buf) * 8192 + wid * 1024)); \
        glds16(vsrc + (size_t)(kt) * 64 * pitch, (unsigned)__builtin_amdgcn_readfirstlane(ldsb + ATT_V + (buf) * 8192 + wid * 1024)); \
        if (MODE == 1 && wid == 0) glds4(c2 + (kt) * 64 + lane, (unsigned)__builtin_amdgcn_readfirstlane(ldsb + ATT_CK + (buf) * 256)); \
        if (MODE == 0 && wid == 0) ((LAS float*)(lds + ATT_CK + (buf) * 256))[lane] = -slope2 * (float)((kt) * 64 + lane - q0); } while (0)
    unsigned gnv[4] = {0u, 0u, 0u, 0u}; float cA = 0.f, cB = 0.f, cq0 = 0.f;
    if (MODE != 2) { const unsigned* gn = (const unsigned*)(A.ws + WS_CTL) + CW_NORM + layer * 256 + (b * HS + h) * 4; gnv[0] = gn[0]; gnv[1] = gn[1]; gnv[2] = gn[2]; gnv[3] = gn[3]; }
    const int ktA = 4 * qb - 1 - lane, ktB = ktA - 64;
    if (MODE == 1) { if (qb > 0) { cq0 = c2[q0]; if (ktA >= 0) cA = c2[64 * ktA + 63]; if (ktB >= 0) cB = c2[64 * ktB + 63]; } }
    f32x4 kv[4][2];
    if (MODE == 0) { if (qb > 0) { const float* kbp = (const float*)(A.ws + WS_KSUM) + (size_t)(layer >> 1) * (NB * HS * 32 * 64) + ((size_t)((b * HS + h) * 32 + r32)) * 64 + 8 * hi;
#pragma unroll
        for (int d0 = 0; d0 < 4; ++d0) { kv[d0][0] = *(const f32x4*)(kbp + 16 * d0); kv[d0][1] = *(const f32x4*)(kbp + 16 * d0 + 4); } } }
    ATT_STAGE((MODE == 2) ? 3 : 4 * qb + 3, 0);
    unsigned selmask = 0u;
    if (MODE == 0) { if (qb > 0) {
        f32x16 g;
#pragma unroll
        for (int i = 0; i < 16; ++i) g[i] = 0.f;
#pragma unroll
        for (int d0 = 0; d0 < 4; ++d0) { const f32x4 ka = kv[d0][0] * (1.f / 256.f), kc = kv[d0][1] * (1.f / 256.f);
            v4u kw; kw.x = pk2(ka.x, ka.y); kw.y = pk2(ka.z, ka.w); kw.z = pk2(kc.x, kc.y); kw.w = pk2(kc.z, kc.w);
            g = __builtin_amdgcn_mfma_f32_32x32x16_bf16(__builtin_bit_cast(bf16x8, kw), qr[d0], g, 0, 0, 0); }
#pragma unroll
        for (int i = 0; i < 16; ++i) if (crow(i, hi) >= qb) g[i] = -INFINITY;
#pragma unroll
        for (int pick = 0; pick < 3; ++pick) {
            float bv = -INFINITY; int bj = 64;
#pragma unroll
            for (int i = 0; i < 16; ++i) if (g[i] > bv) { bv = g[i]; bj = crow(i, hi); }
            const float pv = swap_other(bv, hi); const int pj = swap_other_i(bj, hi);
            if (pv > bv || (pv == bv && pj < bj)) { bv = pv; bj = pj; }
            if (bv > -INFINITY) { selmask |= 1u << bj;
#pragma unroll
                for (int i = 0; i < 16; ++i) if (crow(i, hi) == bj) g[i] = -INFINITY; }
        } } }
    float SKIP = -INFINITY, SKIPW = -INFINITY; int klo = 0;
    if (MODE != 2) {
        const float kmax2 = __uint_as_float(gnv[1]) + __uint_as_float(gnv[3]);
        const float Bq = sqrtf((__uint_as_float(gnv[0]) + __uint_as_float(gnv[2])) * kmax2); SKIP = -(ATT_THETA + 2.02f * Bq + 0.01f);
        float q2 = 0.f;
#pragma unroll
        for (int d0 = 0; d0 < 4; ++d0) { const v4u w = __builtin_bit_cast(v4u, qr[d0]); const float a0 = bflo(w.x), a1 = bfhi(w.x), a2 = bflo(w.y), a3 = bfhi(w.y), a4 = bflo(w.z), a5 = bfhi(w.z), a6 = bflo(w.w), a7 = bfhi(w.w);
            q2 += (a0 * a0 + a1 * a1) + (a2 * a2 + a3 * a3) + (a4 * a4 + a5 * a5) + (a6 * a6 + a7 * a7); }
        q2 += swap_other(q2, hi);
        SKIPW = -(ATT_THETA + 2.02f * sqrtf(wave_max(q2) * kmax2) + 0.01f); }
    if (MODE == 0) { if (qb > 0) { const float fl = ((float)(q0 - 63) + SKIP / slope2) * (1.f / 64.f); klo = fl <= 0.f ? 0 : (int)ceilf(fl); if (klo > 4 * qb) klo = 4 * qb; } }
    if (MODE == 1) { if (qb > 0) {
        const unsigned long long mkA = __builtin_amdgcn_ballot_w64(ktA >= 0 && (cq0 - cA) < SKIP);
        if (mkA) klo = 4 * qb - 1 - (int)__builtin_ctzll(mkA) + 1;
        else { const unsigned long long mkB = __builtin_amdgcn_ballot_w64(ktB >= 0 && (cq0 - cB) < SKIP); if (mkB) klo = 4 * qb - 1 - 64 - (int)__builtin_ctzll(mkB) + 1; } } }
    const float cw = __builtin_bit_cast(float, __builtin_amdgcn_readfirstlane(__builtin_bit_cast(int, cq)));
    const int ktop = (MODE == 2) ? 3 : 4 * qb + 3, ntile = ktop - klo + 1;
    float mhat = 0.f, lsum = 0.f; bool started = false;
    f32x16 o0, o1;
#pragma unroll
    for (int i = 0; i < 16; ++i) { o0[i] = 0.f; o1[i] = 0.f; }
    const LAS unsigned char* vp0 = lds + ATT_V + ((lane >> 4) & 1) * 32 + (lane & 3) * 8 + (4 * hi + ((lane & 15) >> 2)) * 64;
    for (int it = 0; it < ntile; ++it) {
        const int kt = ktop - it, buf = it & 1;
        ATT_WAIT_BAR();
        if (it + 1 < ntile) ATT_STAGE(kt - 1, buf ^ 1);
        bool active = true, diag = false, selv = true;
        if (MODE != 2) {
            if (kt * 64 > wrow0 + 31) active = false;
            diag = (kt * 64 + 63 > wrow0);
            if (MODE == 0) { const int j = kt >> 2; if (j < qb) { selv = ((selmask >> j) & 1u) != 0u; if (__builtin_amdgcn_ballot_w64(selv) == 0ull) active = false; } }
            if (active && kt * 64 + 63 < wrow0) {
                if (MODE == 0) { if (-slope2 * (float)(wrow0 - kt * 64 - 63) < SKIPW) active = false; }
                if (MODE == 1) { const float cke = __builtin_bit_cast(float, __builtin_amdgcn_readfirstlane(__builtin_bit_cast(int, ((const LAS float*)(lds + ATT_CK + buf * 256))[63]))); if (cw - cke < SKIPW) active = false; } }
        }
        if (active) {
            f32x16 p0, p1;
            const float bs = (MODE == 2) ? -mhat : (selv ? cq - mhat : -INFINITY);
            if (MODE == 2) {
#pragma unroll
                for (int r = 0; r < 16; ++r) { p0[r] = bs; p1[r] = bs; }
            } else {
                const LAS f32x4* ckp = (const LAS f32x4*)(lds + ATT_CK + buf * 256);
#pragma unroll
                for (int g = 0; g < 4; ++g) { const f32x4 c = ckp[2 * g + hi], d = ckp[8 + 2 * g + hi];
                    p0[4 * g] = bs - c.x; p0[4 * g + 1] = bs - c.y; p0[4 * g + 2] = bs - c.z; p0[4 * g + 3] = bs - c.w;
                    p1[4 * g] = bs - d.x; p1[4 * g + 1] = bs - d.y; p1[4 * g + 2] = bs - d.z; p1[4 * g + 3] = bs - d.w; }
            }
            const LAS unsigned char* kb = lds + ATT_K + buf * 8192 + hi * 1024 + r32 * 16;
#pragma unroll
            for (int d0 = 0; d0 < 4; ++d0) { const bf16x8 k0 = *(const LAS bf16x8*)(kb + d0 * 2048), k1 = *(const LAS bf16x8*)(kb + d0 * 2048 + 512);
                p0 = __builtin_amdgcn_mfma_f32_32x32x16_bf16(k0, qr[d0], p0, 0, 0, 0); p1 = __builtin_amdgcn_mfma_f32_32x32x16_bf16(k1, qr[d0], p1, 0, 0, 0); }
            asm volatile("s_nop 15\n\ts_nop 7" : "+v"(p0), "+v"(p1));
            if (diag) {
#pragma unroll
                for (int r = 0; r < 16; ++r) { const int kv = kt * 64 + crow(r, hi); if (kv > trow) p0[r] = -INFINITY; if (kv + 32 > trow) p1[r] = -INFINITY; }
            }
            float rm;
            { float a_ = max3f(p0[0], p0[1], p1[0]), b_ = max3f(p0[2], p0[3], p1[1]); a_ = max3f(a_, p1[2], p1[3]);
#pragma unroll
              for (int r = 4; r < 16; r += 4) { a_ = max3f(a_, p0[r], p0[r + 1]); b_ = max3f(b_, p0[r + 2], p0[r + 3]); a_ = max3f(a_, p1[r], p1[r + 1]); b_ = max3f(b_, p1[r + 2], p1[r + 3]); }
              rm = max2f(a_, b_); }
            rm = max2f(rm, swap_other(rm, hi));
            const bool need = started ? (__builtin_amdgcn_ballot_w64(rm > ATT_THR) != 0ull) : true;
            if (need) { const float dl = started ? fmaxf(rm, 0.f) : rm; mhat += dl;
#pragma unroll
                for (int r = 0; r < 16; ++r) { p0[r] -= dl; p1[r] -= dl; }
                if (started) { const float f = fexp2(-dl); lsum *= f;
#pragma unroll
                    for (int r = 0; r < 16; ++r) { o0[r] *= f; o1[r] *= f; } }
                started = true; }
            float s0 = 0.f, s1 = 0.f;
#pragma unroll
            for (int r = 0; r < 16; ++r) { p0[r] = fexp2(p0[r]); p1[r] = fexp2(p1[r]); s0 += p0[r]; s1 += p1[r]; }
            lsum += s0 + s1;
            bf16x8 pa[4];
#pragma unroll
            for (int ks = 0; ks < 4; ++ks) { v4u w;
                if (ks < 2) { w.x = pk2(p0[8 * ks], p0[8 * ks + 1]); w.y = pk2(p0[8 * ks + 2], p0[8 * ks + 3]); w.z = pk2(p0[8 * ks + 4], p0[8 * ks + 5]); w.w = pk2(p0[8 * ks + 6], p0[8 * ks + 7]); }
                else { const int k2 = ks - 2; w.x = pk2(p1[8 * k2], p1[8 * k2 + 1]); w.y = pk2(p1[8 * k2 + 2], p1[8 * k2 + 3]); w.z = pk2(p1[8 * k2 + 4], p1[8 * k2 + 5]); w.w = pk2(p1[8 * k2 + 6], p1[8 * k2 + 7]); }
                pa[ks] = __builtin_bit_cast(bf16x8, w); }
            const LAS unsigned char* vp = vp0 + buf * 8192;
#pragma unroll
            for (int ks = 0; ks < 4; ++ks) {
#pragma unroll
                for (int d0 = 0; d0 < 2; ++d0) {
                    const s16x4 lo = __builtin_bit_cast(s16x4, __builtin_amdgcn_ds_read_tr16_b64_v4i16((LAS s16x4*)(vp + d0 * 4096 + ks * 1024)));
                    const s16x4 hh = __builtin_bit_cast(s16x4, __builtin_amdgcn_ds_read_tr16_b64_v4i16((LAS s16x4*)(vp + d0 * 4096 + ks * 1024 + 512)));
                    const bf16x8 vf = (bf16x8){lo[0], lo[1], lo[2], lo[3], hh[0], hh[1], hh[2], hh[3]};
                    if (d0 == 0) o0 = __builtin_amdgcn_mfma_f32_32x32x16_bf16(vf, pa[ks], o0, 0, 0, 0); else o1 = __builtin_amdgcn_mfma_f32_32x32x16_bf16(vf, pa[ks], o1, 0, 0, 0); } }
        }
    }
    ATT_WAIT_BAR();
    lsum += swap_other(lsum, hi);
    const float rl = 1.f / lsum;
    bf16* Op = (bf16*)(A.ws + WS_ATT) + (size_t)(b * SEQ + trow) * DM + ((MODE == 2) ? HS * 64 : 0) + h * 64 + 4 * hi;
#pragma unroll
    for (int g = 0; g < 4; ++g) {
        v2u w0, w1; w0.x = pk2(o0[4 * g] * rl, o0[4 * g + 1] * rl); w0.y = pk2(o0[4 * g + 2] * rl, o0[4 * g + 3] * rl);
        w1.x = pk2(o1[4 * g] * rl, o1[4 * g + 1] * rl); w1.y = pk2(o1[4 * g + 2] * rl, o1[4 * g + 3] * rl);
        *(v2u*)(Op + 8 * g) = w0; *(v2u*)(Op + 32 + 8 * g) = w1; }
#undef ATT_STAGE
}
template <int MODE01>
__device__ __forceinline__ void ph_attn_fast(const Args& A, int layer, int rep, LAS unsigned char* lds, int wg, int G, int g_wid) {
    PH_IDS;
    constexpr int NSELF = NB * HS * 32, NU = NSELF + NB * HMEM * 32;
    unsigned* qh = (unsigned*)(A.ws + WS_CTL) + CW_AQ + layer * 64 + rep;
    volatile LAS int* qs = (volatile LAS int*)(lds + MISC_OFF) + 32;
    constexpr int NCH = CVT_N_MOE / CVT_CHUNK;
    unsigned* ch = qh + 16;
    if (tid == 0) { qs[0] = (int)__hip_atomic_fetch_add(qh, 1u, __ATOMIC_RELAXED, __HIP_MEMORY_SCOPE_AGENT); qs[1] = (rep == 0) ? (int)__hip_atomic_fetch_add(ch, 1u, __ATOMIC_RELAXED, __HIP_MEMORY_SCOPE_AGENT) : NCH; }
    __syncthreads();
    int L = __builtin_amdgcn_readfirstlane(qs[0]), C = __builtin_amdgcn_readfirstlane(qs[1]);
    __syncthreads();
    while (L < NU || C < NCH) {
        if (L < NU) {
            int nxt = 0;
            if (tid == 0) nxt = (int)__hip_atomic_fetch_add(qh, 1u, __ATOMIC_RELAXED, __HIP_MEMORY_SCOPE_AGENT);
            if (L < NSELF) { const int qb = 31 - L / (NB * HS), bh = L % (NB * HS); attn_unit<MODE01>(A, lds, layer, bh / HS, bh % HS, qb, wid, lane); }
            else { const int m = L - NSELF, qb = m & 31, bhm = m >> 5; attn_unit<2>(A, lds, layer, bhm >> 2, bhm & 3, qb, wid, lane); }
            if (tid == 0) qs[0] = nxt;
            __syncthreads();
            L = __builtin_amdgcn_readfirstlane(qs[0]);
            __syncthreads();
        }
        if (C < NCH) {
            int nxt = 0;
            if (tid == 0) nxt = (int)__hip_atomic_fetch_add(ch, 1u, __ATOMIC_RELAXED, __HIP_MEMORY_SCOPE_AGENT);
            cvt_moe_chunk(A, layer, C, lds, wid, lane);
            if (tid == 0) qs[1] = nxt;
            __syncthreads();
            C = __builtin_amdgcn_readfirstlane(qs[1]);
            __syncthreads();
        }
    }
}

__device__ __forceinline__ void ph_ln1_router(const Args& A, int layer, LAS unsigned char* lds, int wg, int G, int g_wid) {
    PH_IDS;
    bf16* hb = (bf16*)(A.ws + WS_HB); unsigned* elist = (unsigned*)(A.ws + WS_ELIST);
    unsigned* ecnt = (unsigned*)(A.ws + WS_CTL) + CW_ECNT + layer * 64;
    const float* rw = A.in[I_RW] + (size_t)layer * DM * NEXP; const float* rb = A.in[I_RB] + layer * NEXP;
    const float* g1 = A.in[I_LN1G] + layer * DM; const float* b1 = A.in[I_LN1B] + layer * DM;
    constexpr int RP = 1028;
    LAS float* rwT = (LAS float*)lds; LAS int* lcnt = (LAS int*)(lds + 32 * RP * 4); LAS int* gbase = lcnt + 32; LAS unsigned* rec = (LAS unsigned*)(lds + 32 * RP * 4 + 512);
    const int RPW = (NTOK + G - 1) / G;
    for (int i = tid; i < DM * NEXP; i += NTHR) rwT[(i & 31) * RP + (i >> 5)] = rw[i];
    if (tid < 32) lcnt[tid] = 0;
    __syncthreads();
    const int row0 = wg * RPW, row1 = (row0 + RPW < NTOK) ? row0 + RPW : NTOK;
    const float rbl = rb[lane & 31];
    v2u raw[4][4], rawn[4][4];
#define LN1_LOAD(nb_, R) do { _Pragma("unroll") for (int r = 0; r < 4; ++r) { const int n_ = ((nb_) + r < row1) ? (nb_) + r : row1 - 1; _Pragma("unroll") for (int j = 0; j < 4; ++j) R[r][j] = *(const v2u*)(hb + (size_t)n_ * DM + 4 * lane + 256 * j); } } while (0)
    if (row0 + wid * 4 < row1) LN1_LOAD(row0 + wid * 4, raw);
    for (int nb = row0 + wid * 4; nb < row1; nb += NWAVES * 4) {
        if (nb + NWAVES * 4 < row1) LN1_LOAD(nb + NWAVES * 4, rawn);
        f32x4 v[4][4];
#pragma unroll
        for (int r = 0; r < 4; ++r) { const int n = (nb + r < row1) ? nb + r : row1 - 1; float s = 0.f;
#pragma unroll
            for (int j = 0; j < 4; ++j) { const v2u w = raw[r][j]; v[r][j] = (f32x4){bflo(w.x), bfhi(w.x), bflo(w.y), bfhi(w.y)}; s += (v[r][j].x + v[r][j].y) + (v[r][j].z + v[r][j].w); }
            const float mean = wave_sum(s) * (1.f / DM); float s2 = 0.f;
#pragma unroll
            for (int j = 0; j < 4; ++j) { v[r][j] = v[r][j] - mean; s2 += (v[r][j].x * v[r][j].x + v[r][j].y * v[r][j].y) + (v[r][j].z * v[r][j].z + v[r][j].w * v[r][j].w); }
            const float rstd = 1.f / sqrtf(wave_sum(s2) * (1.f / DM) + LN_EPS);
#pragma unroll
            for (int j = 0; j < 4; ++j) { const f32x4 gg = *(const f32x4*)(g1 + 4 * lane + 256 * j), bb = *(const f32x4*)(b1 + 4 * lane + 256 * j);
                v[r][j] = v[r][j] * rstd * gg + bb;
                v2u w; w.x = pk2(v[r][j].x, v[r][j].y); w.y = pk2(v[r][j].z, v[r][j].w); *(v2u*)(hb + (size_t)n * DM + 4 * lane + 256 * j) = w; } }
        float mine[4] = {0.f, 0.f, 0.f, 0.f};
#pragma unroll
        for (int e = 0; e < 32; ++e) { f32x4 r4[4];
#pragma unroll
            for (int j = 0; j < 4; ++j) r4[j] = *(const LAS f32x4*)(rwT + e * RP + 4 * lane + 256 * j);
            float p[4];
#pragma unroll
            for (int r = 0; r < 4; ++r) { f32x2_t a2 = {0.f, 0.f};
#pragma unroll
                for (int j = 0; j < 4; ++j) { a2 += (f32x2_t){v[r][j].x, v[r][j].y} * (f32x2_t){r4[j].x, r4[j].y}; a2 += (f32x2_t){v[r][j].z, v[r][j].w} * (f32x2_t){r4[j].z, r4[j].w}; }
                p[r] = a2.x + a2.y; }
            wave_sum4(p);
#pragma unroll
            for (int r = 0; r < 4; ++r) mine[r] = (lane == e) ? p[r] : mine[r];
            asm volatile("" ::: "memory"); }
        { const float rbv = rbl;
#pragma unroll
          for (int r = 0; r < 4; ++r) mine[r] += rbv; }
#pragma unroll
        for (int r = 0; r < 4; ++r) { float x = (lane < 32) ? mine[r] : -INFINITY; float tv[4]; int ti[4];
#pragma unroll
            for (int k = 0; k < 4; ++k) { const float mx = wave_max(x); const unsigned long long mk = __builtin_amdgcn_ballot_w64(x == mx); const int idx = (int)__builtin_ctzll(mk);
                tv[k] = mx; ti[k] = idx; if (lane == idx) x = -INFINITY; }
            const float e1 = expf(tv[1] - tv[0]), e2 = expf(tv[2] - tv[0]), e3 = expf(tv[3] - tv[0]); const float inv = 1.f / (1.f + e1 + e2 + e3);
            if (lane < 4 && nb + r < row1) { const int ek = lane == 0 ? ti[0] : lane == 1 ? ti[1] : lane == 2 ? ti[2] : ti[3]; const float gk = (lane == 0 ? 1.f : lane == 1 ? e1 : lane == 2 ? e2 : e3) * inv;
                const int lp = atomicAdd((int*)lcnt + ek, 1);
                const int ri = (nb + r - row0) * 4 + lane; rec[2 * ri] = (unsigned)ek | ((unsigned)lp << 8); rec[2 * ri + 1] = __float_as_uint(gk); } }
#pragma unroll
        for (int r = 0; r < 4; ++r)
#pragma unroll
            for (int j = 0; j < 4; ++j) raw[r][j] = rawn[r][j];
    }
#undef LN1_LOAD
    __syncthreads();
    if (tid < 32) gbase[tid] = (int)__hip_atomic_fetch_add(ecnt + tid, (unsigned)lcnt[tid], __ATOMIC_RELAXED, __HIP_MEMORY_SCOPE_AGENT);
    __syncthreads();
    for (int ri = tid; ri < (row1 - row0) * 4; ri += NTHR) { const unsigned w = rec[2 * ri]; const int e = w & 31, lp = w >> 8; const unsigned aid = (unsigned)(row0 * 4 + ri);
        *(v2u*)(elist + ((size_t)e * NTOK + gbase[e] + lp) * 2) = (v2u){aid, rec[2 * ri + 1]}; }
    __syncthreads();
}

template <bool LAST>
__device__ __forceinline__ void ph_combine_ln2(const Args& A, int layer, int wg, int G, int g_wid) {
    PH_IDS;
    bf16* hb = (bf16*)(A.ws + WS_HB); const unsigned char* ybuf = (const unsigned char*)(A.ws + WS_YBUF);
    const float* g2 = A.in[I_LN2G] + layer * DM; const float* b2 = A.in[I_LN2B] + layer * DM;
    const int gw = wg * NWAVES + wid, NGW = G * NWAVES;
    f32x4 gv[4], bv[4];
#pragma unroll
    for (int j = 0; j < 2; ++j) { gv[2 * j] = *(const f32x4*)(g2 + 8 * lane + 512 * j); gv[2 * j + 1] = *(const f32x4*)(g2 + 8 * lane + 512 * j + 4); bv[2 * j] = *(const f32x4*)(b2 + 8 * lane + 512 * j); bv[2 * j + 1] = *(const f32x4*)(b2 + 8 * lane + 512 * j + 4); }
    v4u hw[2], hn[2]; v2u yw[4][2], yn[4][2];
#define CMB_LOAD(n_, H, Y) do { _Pragma("unroll") for (int j = 0; j < 2; ++j) H[j] = *(const v4u*)(hb + (size_t)(n_) * DM + 8 * lane + 512 * j); \
        _Pragma("unroll") for (int k = 0; k < 4; ++k) _Pragma("unroll") for (int j = 0; j < 2; ++j) Y[k][j] = __builtin_nontemporal_load((const v2u*)(ybuf + ((size_t)(n_) * 4 + k) * DM + 8 * lane + 512 * j)); } while (0)
    if (gw < NTOK) CMB_LOAD(gw, hw, yw);
    for (int n = gw; n < NTOK; n += NGW) {
        const int nn = n + NGW;
        if (nn < NTOK) CMB_LOAD(nn, hn, yn);
        float v[16]; float s = 0.f;
#pragma unroll
        for (int j = 0; j < 2; ++j) { const v4u w = hw[j];
            v[8 * j + 0] = bflo(w.x) * ALPHA; v[8 * j + 1] = bfhi(w.x) * ALPHA; v[8 * j + 2] = bflo(w.y) * ALPHA; v[8 * j + 3] = bfhi(w.y) * ALPHA;
            v[8 * j + 4] = bflo(w.z) * ALPHA; v[8 * j + 5] = bfhi(w.z) * ALPHA; v[8 * j + 6] = bflo(w.w) * ALPHA; v[8 * j + 7] = bfhi(w.w) * ALPHA; }
#pragma unroll
        for (int k = 0; k < 4; ++k)
#pragma unroll
            for (int j = 0; j < 2; ++j) { const v2u w = yw[k][j];
                const f32x2_t a = __builtin_amdgcn_cvt_pk_f32_fp8((int)w.x, false), b = __builtin_amdgcn_cvt_pk_f32_fp8((int)w.x, true), c = __builtin_amdgcn_cvt_pk_f32_fp8((int)w.y, false), d = __builtin_amdgcn_cvt_pk_f32_fp8((int)w.y, true);
                v[8 * j + 0] += a.x * (1.f / Y_SCALE); v[8 * j + 1] += a.y * (1.f / Y_SCALE); v[8 * j + 2] += b.x * (1.f / Y_SCALE); v[8 * j + 3] += b.y * (1.f / Y_SCALE);
                v[8 * j + 4] += c.x * (1.f / Y_SCALE); v[8 * j + 5] += c.y * (1.f / Y_SCALE); v[8 * j + 6] += d.x * (1.f / Y_SCALE); v[8 * j + 7] += d.y * (1.f / Y_SCALE); }
#pragma unroll
        for (int i = 0; i < 16; ++i) s += v[i];
        const float mean = wave_sum(s) * (1.f / DM); float s2 = 0.f;
#pragma unroll
        for (int i = 0; i < 16; ++i) { v[i] -= mean; s2 += v[i] * v[i]; }
        const float rstd = 1.f / sqrtf(wave_sum(s2) * (1.f / DM) + LN_EPS);
#pragma unroll
        for (int j = 0; j < 2; ++j) {
            const f32x4 oa = (f32x4){v[8 * j], v[8 * j + 1], v[8 * j + 2], v[8 * j + 3]} * rstd * gv[2 * j] + bv[2 * j], ob = (f32x4){v[8 * j + 4], v[8 * j + 5], v[8 * j + 6], v[8 * j + 7]} * rstd * gv[2 * j + 1] + bv[2 * j + 1];
            if (LAST) { float* o = A.out + (size_t)n * DM + 8 * lane + 512 * j; *(f32x4*)o = oa; *(f32x4*)(o + 4) = ob; }
            else { v4u w; w.x = pk2(oa.x, oa.y); w.y = pk2(oa.z, oa.w); w.z = pk2(ob.x, ob.y); w.w = pk2(ob.z, ob.w); *(v4u*)(hb + (size_t)n * DM + 8 * lane + 512 * j) = w; } }
#pragma unroll
        for (int j = 0; j < 2; ++j) hw[j] = hn[j];
#pragma unroll
        for (int k = 0; k < 4; ++k)
#pragma unroll
            for (int j = 0; j < 2; ++j) yw[k][j] = yn[k][j];
    }
#undef CMB_LOAD
}

#define IN(k) (lo <= (k) && (k) < hi)
#ifndef PROBE_BAR
#define PROBE_BAR 0
#endif
#define SEAM(k) do { if ((k) + 1 < hi) { xcd_barrier(bar); for (int pb_ = 0; pb_ < PROBE_BAR; ++pb_) xcd_barrier(bar); } } while (0)
#if PROBE_TIME
#define PT0(k) if ((k) == PROBE_TIME && xb_t0(wid0)) { volatile LAS unsigned* pm_ = (volatile LAS unsigned*)(lds + MISC_OFF) + 40; pm_[1] = (unsigned)__builtin_amdgcn_s_memrealtime(); }
#define PT1(k) if ((k) == PROBE_TIME && xb_t0(wid0)) { volatile LAS unsigned* pm_ = (volatile LAS unsigned*)(lds + MISC_OFF) + 40; pm_[0] = pm_[0] + ((unsigned)__builtin_amdgcn_s_memrealtime() - pm_[1]); }
#else
#define PT0(k)
#define PT1(k)
#endif
template <int layer>
__device__ __forceinline__ void run_layer(LAS unsigned char* lds, const int wg, const int G, const int wid0, const int lo, const int hi, const XcdBarrier& bar) {
        constexpr int pb = 1 + 8 * layer; constexpr bool fox = (layer & 1) != 0;
        if (IN(pb + 0)) { PT0(0)
            { const Args A = load_args(); unsigned char* ws = A.ws;
              DenseSched S{(const bf16*)(ws + WS_HB), (const bf16*)(ws + WS_WIN) + (size_t)layer * NPROJ * DM, NTOK / 256, NPROJ / 256, G, wg};
              EpiProjT<true, !fox> E{(bf16*)(ws + WS_PROJ), NPROJ, K_COL, QM_COL, (unsigned*)(ws + WS_CTL) + CW_NORM + layer * 256, (float*)(ws + WS_KSUM) + (size_t)(layer >> 1) * (NB * HS * 32 * 64)};
              gemm_fast<EpiProjT<true, !fox>, DenseSched, true>(lds, S, E, wid0); }
            if constexpr (layer == 0) { const Args A = load_args(); unsigned char* ws = A.ws;
              DenseSched S{(const bf16*)(ws + WS_MEMB), (const bf16*)(ws + WS_WMKV), NB * NMEM / 256, 2, G, wg};
              EpiProjT<false, false> E{(bf16*)(ws + WS_MKV), 512, 0, 1 << 30, nullptr, nullptr};
              gemm_fast<EpiProjT<false, false>, DenseSched, true>(lds, S, E, wid0); }
            if constexpr (fox) { const Args A = load_args(); ph_fox_gate(A, layer >> 1, wg, G, wid0); }
            SEAM(pb + 0); PT1(0)
        }
        if constexpr (fox) { if (IN(pb + 1)) { const Args A = load_args(); ph_fox_scan(A, lds, wg, G, wid0); SEAM(pb + 1); } }
        if (IN(pb + 2)) { PT0(2) const Args A = load_args(); for (int rep = 0; rep < PROBE_ATT; ++rep) ph_attn_fast<fox ? 1 : 0>(A, layer, rep, lds, wg, G, wid0); SEAM(pb + 2); PT1(2) }
        if (IN(pb + 3)) { PT0(3)
            const Args A = load_args(); unsigned char* ws = A.ws;
            DenseSched S{(const bf16*)(ws + WS_ATT), (const bf16*)(ws + WS_WO) + (size_t)layer * DM * DM, NTOK / 256, DM / 256, G, wg};
            EpiOutT<layer == 0> E{layer == 0 ? (const void*)A.in[I_X] : (const void*)(ws + WS_HB), (bf16*)(ws + WS_HB)};
            gemm_fast<EpiOutT<layer == 0>, DenseSched, true>(lds, S, E, wid0); SEAM(pb + 3); PT1(3)
        }
        if (IN(pb + 4)) { PT0(4) const Args A = load_args(); ph_ln1_router(A, layer, lds, wg, G, wid0); SEAM(pb + 4); PT1(4) }
        if (IN(pb + 5)) { PT0(5)
            const Args A = load_args(); unsigned char* ws = A.ws;
            LAS int* tab = (LAS int*)(lds + MISC_OFF) + 64; moe_tables(tab, (unsigned*)(ws + WS_CTL) + CW_ECNT + layer * 64, wid0);
            MoeSchedT<true> S{(const bf16*)(ws + WS_HB), (const bf16*)(ws + WS_WGU) + (size_t)layer * NEXP * 2048 * DM, (const unsigned*)(ws + WS_ELIST), tab, 8, 2048, G, wg, 2};
            EpiGU E{(bf16*)(ws + WS_ABUF), A.in[I_BGU] + (size_t)layer * NEXP * 2048};
            gemm_fast<EpiGU, MoeSchedT<true>, true>(lds, S, E, wid0); __syncthreads();
#if PROBE_MOE > 1
            gemm_fast<EpiGU, MoeSchedT<true>, true>(lds, S, E, wid0); __syncthreads();
#endif
            SEAM(pb + 5); PT1(5)
        }
        if (IN(pb + 6)) { PT0(6)
            const Args A = load_args(); unsigned char* ws = A.ws;
            LAS int* tab = (LAS int*)(lds + MISC_OFF) + 64; moe_tables(tab, (unsigned*)(ws + WS_CTL) + CW_ECNT + layer * 64, wid0);
            MoeSchedT<false> S{(const bf16*)(ws + WS_ABUF), (const bf16*)(ws + WS_WDN) + (size_t)layer * NEXP * DM * DM, (const unsigned*)(ws + WS_ELIST), tab, 4, 1024, G, wg, 0};
            EpiDN E{(bf16*)(ws + WS_YBUF), A.in[I_BDN] + (size_t)layer * NEXP * DM};
            gemm_fast<EpiDN, MoeSchedT<false>, true>(lds, S, E, wid0); __syncthreads();
#if PROBE_MOE > 1
            gemm_fast<EpiDN, MoeSchedT<false>, true>(lds, S, E, wid0); __syncthreads();
#endif
            SEAM(pb + 6); PT1(6)
        }
        if (IN(pb + 7)) { PT0(7) const Args A = load_args(); ph_combine_ln2<layer == DEPTH - 1>(A, layer, wg, G, wid0); SEAM(pb + 7); PT1(7) }
}
__global__ void __launch_bounds__(NTHR, 2) k_main(Args A0) {
    extern __shared__ __attribute__((aligned(16))) unsigned char lds_raw[];
    LAS unsigned char* lds = (LAS unsigned char*)lds_raw;
    volatile LAS unsigned* MISC = (volatile LAS unsigned*)(lds + MISC_OFF);
    const int wid0 = __builtin_amdgcn_readfirstlane((int)threadIdx.x >> 6);
    const int G = gridDim.x, wg = blockIdx.x;
    const int lo = A0.p_lo, hi = A0.p_hi;
    if (threadIdx.x < 64) MISC[threadIdx.x] = 0u;
    __syncthreads();
    XcdBarrier bar; bar.bar = (unsigned*)(A0.ws + WS_CTL) + CW_BAR; bar.x = 0; bar.st = nullptr; bar.wid = wid0;
    if (hi - lo > 1) bar = xcd_barrier_post((unsigned*)(A0.ws + WS_CTL) + CW_BAR + (size_t)lo * XCD_BAR_WORDS, MISC + 8, wid0);
    if (IN(0)) { const Args A = load_args(); for (int rep = 0; rep < PROBE_CVT; ++rep) ph_convert(A, lds, wg, G, wid0); SEAM(0); }
    run_layer<0>(lds, wg, G, wid0, lo, hi, bar); run_layer<1>(lds, wg, G, wid0, lo, hi, bar); run_layer<2>(lds, wg, G, wid0, lo, hi, bar); run_layer<3>(lds, wg, G, wid0, lo, hi, bar);
#if PROBE_TIME
    { const Args A = load_args(); unsigned* pw = (unsigned*)(A.ws + WS_CTL) + 3000; volatile LAS unsigned* pm_ = (volatile LAS unsigned*)(lds + MISC_OFF) + 40;
      if (blockIdx.x == 0 && xb_t0(wid0)) __hip_atomic_store(pw, pm_[0], __ATOMIC_RELAXED, __HIP_MEMORY_SCOPE_AGENT);
      xcd_barrier(bar);
      const float us = (float)__hip_atomic_load(pw, __ATOMIC_RELAXED, __HIP_MEMORY_SCOPE_AGENT) * 0.01f; const float v = log2f(us + 1.f) * 0.25f;
      { int ln_; asm volatile("v_mbcnt_lo_u32_b32 %0, -1, 0\n\tv_mbcnt_hi_u32_b32 %0, -1, %0" : "=v"(ln_)); for (size_t i = (size_t)blockIdx.x * NTHR + wid0 * 64 + ln_; i < (size_t)NTOK * DM; i += (size_t)gridDim.x * NTHR) A.out[i] = v; } }
#endif
#undef IN
#undef SEAM
}

#ifndef MK_ONE_LAUNCH
#define MK_ONE_LAUNCH 1
#endif
extern "C" void kernel_launch(void* const* d_in, const int* in_sizes, int n_in, void* d_out, int out_size, void* d_ws, size_t ws_size, hipStream_t stream) {
    static int grid = 0;
    if (grid == 0) {
        if (n_in != 17 || out_size != NTOK * DM || ws_size < WS_END) { fprintf(stderr, "kernel_launch: unexpected shapes (n_in %d out %d ws %zu, need %zu)\n", n_in, out_size, ws_size, (size_t)WS_END); grid = -1; return; }
        int dev = 0, cus = 0, per_cu = 0;
        if (hipGetDevice(&dev) != hipSuccess || hipDeviceGetAttribute(&cus, hipDeviceAttributeMultiprocessorCount, dev) != hipSuccess) { grid = -1; return; }
        if (hipFuncSetAttribute((const void*)k_main, hipFuncAttributeMaxDynamicSharedMemorySize, LDS_BYTES) != hipSuccess) { fprintf(stderr, "kernel_launch: hipFuncSetAttribute failed\n"); grid = -1; return; }
        if (hipOccupancyMaxActiveBlocksPerMultiprocessor(&per_cu, (const void*)k_main, NTHR, LDS_BYTES) != hipSuccess || per_cu < 1) { fprintf(stderr, "kernel_launch: occupancy query says %d\n", per_cu); }
        (void)hipGetLastError();
        grid = cus;
    }
    if (grid < 0) return;
    (void)hipMemsetAsync((char*)d_ws + WS_CTL, 0, CTL_ZERO_BYTES, stream);
    Args a{};
    for (int i = 0; i < 17; ++i) a.in[i] = (const float*)d_in[i];
    a.out = (float*)d_out; a.ws = (unsigned char*)d_ws;
#if MK_ONE_LAUNCH
    a.p_lo = 0; a.p_hi = NPHASE;
    hipLaunchKernelGGL(k_main, dim3(grid), dim3(NTHR), LDS_BYTES, stream, a);
#else
    for (int p = 0; p < NPHASE; ++p) { a.p_lo = p; a.p_hi = p + 1; hipLaunchKernelGGL(k_main, dim3(grid), dim3(NTHR), LDS_BYTES, stream, a); }
#endif
}
```
